# Optimizing an MI355X kernel written in HIP

```python
import jax, jax.numpy as jnp
from jax import lax
import numpy as np

D_MODEL = 2048
BATCH = 8
SEQ = 2048
DEPTH = 2

D_MIX = D_MODEL
RWKV_HEAD_DIM = 64
RWKV_WIDTH = D_MODEL // 2
RWKV_HEADS = RWKV_WIDTH // RWKV_HEAD_DIM
RWKV_DECAY_RANK = 64
RWKV_ICLR_RANK = 64
RWKV_GN_EPS = 64e-5
MOBA_HEAD_DIM = 128
MOBA_WIDTH = D_MODEL // 4
MOBA_HEADS = MOBA_WIDTH // MOBA_HEAD_DIM
MOBA_BLOCK = 256
MOBA_TOPK = 3
MOBA_Q_CHUNK = 16
GLA_WIDTH = D_MODEL // 4
GLA_KEY_WIDTH = GLA_WIDTH // 2
GLA_HEADS = 4
GLA_KEY_DIM = GLA_KEY_WIDTH // GLA_HEADS
GLA_VALUE_DIM = GLA_WIDTH // GLA_HEADS
GLA_GATE_RANK = 16
GLA_GATE_TEMP = 16.0
GLA_CHUNK = 64
NORM_EPS = 1e-6

RWKV_SHIFT_SIZES = (RWKV_WIDTH, RWKV_WIDTH, RWKV_WIDTH, RWKV_DECAY_RANK, RWKV_ICLR_RANK)
RWKV_SHIFT_COLS = 3 * RWKV_WIDTH + RWKV_DECAY_RANK + RWKV_ICLR_RANK
IN_SIZES = (RWKV_SHIFT_COLS, RWKV_WIDTH,
            MOBA_WIDTH, MOBA_WIDTH, MOBA_WIDTH, MOBA_WIDTH,
            GLA_KEY_WIDTH, GLA_KEY_WIDTH, GLA_WIDTH, GLA_WIDTH, GLA_GATE_RANK)
D_IN = RWKV_SHIFT_COLS + RWKV_WIDTH + 4 * MOBA_WIDTH + 2 * GLA_KEY_WIDTH + 2 * GLA_WIDTH + GLA_GATE_RANK

kernel_name = 'hybrid_rwkv7_moba_gla_parallel_heads'


def _split(t, sizes):
    offsets = np.cumsum(np.array(sizes))[:-1].tolist()
    return jnp.split(t, offsets, axis=-1)


def _rmsnorm(x, w):
    xf = x.astype(jnp.float32)
    y = xf * lax.rsqrt(jnp.mean(xf * xf, axis=-1, keepdims=True) + NORM_EPS)
    return (y * w.astype(jnp.float32)).astype(x.dtype)


def _rwkv7_mix(p_shift, g, mu, w0, w2, a0, a2, k_k, k_a, r_k, ln_w, ln_b):
    B, S, _ = p_shift.shape
    H, N = RWKV_HEADS, RWKV_HEAD_DIM
    p = p_shift.astype(jnp.float32)
    prev = jnp.pad(p, ((0, 0), (1, 0), (0, 0)))[:, :-1]
    p = p + mu * (prev - p)
    r, k, v, wd, ad = _split(p, RWKV_SHIFT_SIZES)
    w = w0 + jnp.tanh(wd) @ w2
    w = -jax.nn.softplus(-w) - 0.5
    decay = jnp.exp(-jnp.exp(w))
    a = jax.nn.sigmoid(a0 + ad @ a2)
    r, k, v, decay, a = (t.reshape(B, S, H, N) for t in (r, k, v, decay, a))
    kk = k * k_k.reshape(H, N)
    kk = kk * lax.rsqrt(jnp.maximum(jnp.sum(kk * kk, axis=-1, keepdims=True), 1e-24))
    k = k * (1.0 + (a - 1.0) * k_a.reshape(H, N))
    a_vec = -kk
    b_vec = kk * a

    def step(state, inp):
        r_t, w_t, k_t, v_t, a_t, b_t = inp
        sa = jnp.einsum('bhvk,bhk->bhv', state, a_t)
        state = (state * w_t[:, :, None, :] + sa[..., None] * b_t[:, :, None, :]
                 + v_t[..., None] * k_t[:, :, None, :])
        return state, jnp.einsum('bhvk,bhk->bhv', state, r_t)

    xs = (jnp.moveaxis(r, 1, 0), jnp.moveaxis(decay, 1, 0), jnp.moveaxis(k, 1, 0),
          jnp.moveaxis(v, 1, 0), jnp.moveaxis(a_vec, 1, 0), jnp.moveaxis(b_vec, 1, 0))
    _, y = lax.scan(step, jnp.zeros((B, H, N, N), jnp.float32), xs)
    y = jnp.moveaxis(y, 0, 1)
    mean = jnp.mean(y, axis=-1, keepdims=True)
    var = jnp.mean(jnp.square(y - mean), axis=-1, keepdims=True)
    y = (y - mean) * lax.rsqrt(var + RWKV_GN_EPS) * ln_w.reshape(H, N) + ln_b.reshape(H, N)
    y = y + jnp.sum(r * k * r_k, axis=-1, keepdims=True) * v
    return y.reshape(B, S, RWKV_WIDTH) * jax.nn.silu(g.astype(jnp.float32))


def _moba_mix(q, k, v, g):
    B, S, _ = q.shape
    H, D = MOBA_HEADS, MOBA_HEAD_DIM
    n_blocks = -(-S // MOBA_BLOCK)
    s_pad = n_blocks * MOBA_BLOCK

    def heads(t):
        t = t.astype(jnp.float32).reshape(B, S, H, D).transpose(0, 2, 1, 3)
        return jnp.pad(t, ((0, 0), (0, 0), (0, s_pad - S), (0, 0)))

    qh, kh, vh = heads(q), heads(k), heads(v)
    kb = kh.reshape(B, H, n_blocks, MOBA_BLOCK, D)
    vb = vh.reshape(B, H, n_blocks, MOBA_BLOCK, D)
    k_mean = jnp.mean(kb, axis=3)
    q_block = jnp.arange(s_pad) // MOBA_BLOCK
    past = jnp.arange(n_blocks)[None, :] < q_block[:, None]
    gate = jnp.where(past, jnp.einsum('bhsd,bhnd->bhsn', qh, k_mean), -jnp.inf)
    topk = min(MOBA_TOPK, n_blocks)
    _, sel = lax.top_k(gate, topk)
    sel_valid = sel < q_block[None, None, :, None]
    scale = D ** -0.5
    bi = jnp.arange(B)[:, None, None, None]
    hi = jnp.arange(H)[None, :, None, None]

    def chunk(i):
        start = i * MOBA_Q_CHUNK
        q_c = lax.dynamic_slice_in_dim(qh, start, MOBA_Q_CHUNK, axis=2)
        sel_c = lax.dynamic_slice_in_dim(sel, start, MOBA_Q_CHUNK, axis=2)
        val_c = lax.dynamic_slice_in_dim(sel_valid, start, MOBA_Q_CHUNK, axis=2)
        blk = start // MOBA_BLOCK
        k_own = lax.dynamic_slice_in_dim(kh, blk * MOBA_BLOCK, MOBA_BLOCK, axis=2)
        v_own = lax.dynamic_slice_in_dim(vh, blk * MOBA_BLOCK, MOBA_BLOCK, axis=2)
        k_sel = kb[bi, hi, sel_c]
        v_sel = vb[bi, hi, sel_c]
        s_sel = jnp.einsum('bhqd,bhqnjd->bhqnj', q_c, k_sel) * scale
        s_sel = jnp.where(val_c[..., None], s_sel, -jnp.inf)
        s_sel = s_sel.reshape(B, H, MOBA_Q_CHUNK, topk * MOBA_BLOCK)
        q_pos = start + jnp.arange(MOBA_Q_CHUNK)
        k_pos = blk * MOBA_BLOCK + jnp.arange(MOBA_BLOCK)
        s_own = jnp.einsum('bhqd,bhjd->bhqj', q_c, k_own) * scale
        s_own = jnp.where(k_pos[None, :] <= q_pos[:, None], s_own, -jnp.inf)
        p = jax.nn.softmax(jnp.concatenate([s_sel, s_own], axis=-1), axis=-1)
        p_sel = p[..., :topk * MOBA_BLOCK].reshape(B, H, MOBA_Q_CHUNK, topk, MOBA_BLOCK)
        p_own = p[..., topk * MOBA_BLOCK:]
        return (jnp.einsum('bhqnj,bhqnjd->bhqd', p_sel, v_sel)
                + jnp.einsum('bhqj,bhjd->bhqd', p_own, v_own))

    o = lax.map(chunk, jnp.arange(s_pad // MOBA_Q_CHUNK))
    o = o.transpose(1, 2, 0, 3, 4).reshape(B, H, s_pad, D)[:, :, :S]
    o = o.transpose(0, 2, 1, 3).reshape(B, S, MOBA_WIDTH)
    return o * jax.nn.silu(g.astype(jnp.float32))


def _gla_mix(q, k, v, g, gate_low, a_up, a_b, norm_w):
    B, S, _ = q.shape
    H, DK, DV, C = GLA_HEADS, GLA_KEY_DIM, GLA_VALUE_DIM, GLA_CHUNK
    n = S // C
    log_a = jax.nn.log_sigmoid(gate_low.astype(jnp.float32) @ a_up + a_b) / GLA_GATE_TEMP

    def chunks(t, d):
        return t.astype(jnp.float32).reshape(B, n, C, H, d).transpose(0, 3, 1, 2, 4)

    qc = chunks(q, DK) * (DK ** -0.5)
    kc, vc, la = chunks(k, DK), chunks(v, DV), chunks(log_a, DK)
    b = jnp.cumsum(la, axis=3)
    b_last = b[:, :, :, -1:, :]
    qe = qc * jnp.exp(b)
    ke = kc * jnp.exp(-b)
    kd = kc * jnp.exp(b_last - b)
    causal = jnp.tril(jnp.ones((C, C), dtype=bool))
    att = jnp.where(causal, jnp.einsum('bhncd,bhnjd->bhncj', qe, ke), 0.0)
    o_intra = jnp.einsum('bhncj,bhnje->bhnce', att, vc)
    ds = jnp.einsum('bhncd,bhnce->bhnde', kd, vc)
    dec = jnp.exp(b_last[:, :, :, 0, :])

    def step(state, inp):
        ds_n, dec_n = inp
        return dec_n[..., None] * state + ds_n, state

    _, s_prev = lax.scan(step, jnp.zeros((B, H, DK, DV), jnp.float32),
                         (jnp.moveaxis(ds, 2, 0), jnp.moveaxis(dec, 2, 0)))
    s_prev = jnp.moveaxis(s_prev, 0, 2)
    o = o_intra + jnp.einsum('bhncd,bhnde->bhnce', qe, s_prev)
    o = o.transpose(0, 2, 3, 1, 4).reshape(B, S, H, DV)
    o = o * lax.rsqrt(jnp.mean(o * o, axis=-1, keepdims=True) + NORM_EPS) * norm_w
    return o.reshape(B, S, GLA_WIDTH) * jax.nn.silu(g.astype(jnp.float32))


def setup_inputs(seed: int = 0) -> dict:
    key = jax.random.key(seed)
    ks = jax.random.split(key, 20)
    f32 = jnp.float32
    nrm = lambda k_, shape, s: jax.random.normal(k_, shape, f32) * s
    return {
        'x': nrm(ks[0], (BATCH, SEQ, D_MODEL), 1.0),
        'norm_w': 1.0 + nrm(ks[1], (DEPTH, D_MODEL), 0.02),
        'w_in': nrm(ks[2], (DEPTH, D_MODEL, D_IN), D_MODEL ** -0.5),
        'w_out': nrm(ks[3], (DEPTH, D_MIX, D_MODEL), 0.5 * D_MIX ** -0.5),
        'rwkv_mu': jax.random.uniform(ks[4], (DEPTH, RWKV_SHIFT_COLS), f32),
        'rwkv_w0': jax.random.uniform(ks[5], (DEPTH, RWKV_WIDTH), f32, -4.0, 0.0),
        'rwkv_w2': nrm(ks[6], (DEPTH, RWKV_DECAY_RANK, RWKV_WIDTH), 0.1),
        'rwkv_a0': nrm(ks[7], (DEPTH, RWKV_WIDTH), 0.1),
        'rwkv_a2': nrm(ks[8], (DEPTH, RWKV_ICLR_RANK, RWKV_WIDTH), RWKV_ICLR_RANK ** -0.5),
        'rwkv_k_k': 0.85 + nrm(ks[9], (DEPTH, RWKV_WIDTH), 0.05),
        'rwkv_k_a': 1.0 + nrm(ks[10], (DEPTH, RWKV_WIDTH), 0.05),
        'rwkv_r_k': nrm(ks[11], (DEPTH, RWKV_HEADS, RWKV_HEAD_DIM), 0.1),
        'rwkv_ln_w': 1.0 + nrm(ks[12], (DEPTH, RWKV_WIDTH), 0.02),
        'rwkv_ln_b': nrm(ks[13], (DEPTH, RWKV_WIDTH), 0.02),
        'gla_a_up': nrm(ks[14], (DEPTH, GLA_GATE_RANK, GLA_KEY_WIDTH), GLA_GATE_RANK ** -0.5),
        'gla_a_b': nrm(ks[15], (DEPTH, GLA_KEY_WIDTH), 0.1),
        'gla_norm_w': 1.0 + nrm(ks[16], (DEPTH, GLA_VALUE_DIM), 0.02),
        'final_norm_w': 1.0 + nrm(ks[17], (D_MODEL,), 0.02),
    }


def reference(x, norm_w, w_in, w_out, rwkv_mu, rwkv_w0, rwkv_w2, rwkv_a0, rwkv_a2,
              rwkv_k_k, rwkv_k_a, rwkv_r_k, rwkv_ln_w, rwkv_ln_b,
              gla_a_up, gla_a_b, gla_norm_w, final_norm_w):
    for l in range(DEPTH):
        h = _rmsnorm(x, norm_w[l])
        p = h @ w_in[l]
        (p_rwkv, g_a, q_b, k_b, v_b, g_b,
         q_c, k_c, v_c, g_c, low_c) = _split(p, IN_SIZES)
        y_a = _rwkv7_mix(p_rwkv, g_a, rwkv_mu[l], rwkv_w0[l], rwkv_w2[l], rwkv_a0[l], rwkv_a2[l],
                         rwkv_k_k[l], rwkv_k_a[l], rwkv_r_k[l], rwkv_ln_w[l], rwkv_ln_b[l])
        y_b = _moba_mix(q_b, k_b, v_b, g_b)
        y_c = _gla_mix(q_c, k_c, v_c, g_c, low_c, gla_a_up[l], gla_a_b[l], gla_norm_w[l])
        mix = jnp.concatenate([y_a, y_b, y_c], axis=-1).astype(x.dtype)
        x = x + mix @ w_out[l]
    return _rmsnorm(x, final_norm_w)
```

```cpp
#include <hip/hip_runtime.h>
#include <hip/hip_cooperative_groups.h>
#include <cstdio>
namespace cg = cooperative_groups;

#ifndef ONE_LAUNCH
#define ONE_LAUNCH 1
#endif

namespace pg8 {
#define PG8_LAS __attribute__((address_space(3)))
typedef unsigned short bf16_t;
typedef short bf16x8 __attribute__((ext_vector_type(8)));
typedef float f32x4 __attribute__((ext_vector_type(4)));
typedef unsigned u32x4 __attribute__((ext_vector_type(4)));
constexpr int BM = 256, BK = 64, HALF = 128, HTB = HALF * BK * 2  , STAGE_BYTES = 8 * HTB, NXCD = 8, WGM = 8;

__host__ __device__ __forceinline__ int lds_byte(int r, int c) { const int st = (r >> 4) * 2 + (c >> 5), rr = r & 15, cc = c & 31, ob = rr * 64 + cc * 2; return st * 1024 + (ob ^ (((ob >> 9) & 1) << 5)); }
__host__ __device__ __forceinline__ void stage_rc(int b, int& R, int& C) { const int st = b / 1024, sb = b % 1024, swz = sb ^ (((sb >> 9) & 1) << 5); R = (st >> 1) * 16 + swz / 64; C = (st & 1) * 32 + (swz % 64) / 2; }
__host__ __device__ __forceinline__ int perm32(int rho) { const int n = rho >> 4, i = rho & 15; return 8 * (i >> 2) + 4 * n + (i & 3); }

struct Unit { int pm, pn; };
struct Gemm { const bf16_t* A; const bf16_t* Bt; int M, N, K; };

struct StaticOrder {
    int nM, nN, nwg, G, c;
    __host__ __device__ void init(int M, int N, int G_, int c_) { nM = M / BM; nN = N / BM; nwg = nM * nN; G = G_; c = c_; }
    __host__ __device__ bool next(int i, Unit& u) const {
        const long L = (long)i * G + c; if (L >= nwg) return false;
        int wgid = (int)L; { const int q = nwg / NXCD, r = nwg % NXCD, xcd = wgid % NXCD, off = wgid / NXCD; wgid = (xcd < r ? xcd * (q + 1) : r * (q + 1) + (xcd - r) * q) + off; }
        const int nig = WGM * nN, gid = wgid / nig, fm = gid * WGM, gsz = (nM - fm) < WGM ? (nM - fm) : WGM;
        u.pm = fm + ((wgid % nig) % gsz); u.pn = (wgid % nig) / gsz; return true;
    }
    __device__ __forceinline__ void a_ready(const Unit&) const {}
    __device__ __forceinline__ void done(const Unit&) const {}
};
__device__ __forceinline__ unsigned cvt_pk_bf16(float lo, float hi) { unsigned r; asm volatile("v_cvt_pk_bf16_f32 %0, %1, %2" : "=v"(r) : "v"(lo), "v"(hi)); return r; }
template <class Epi, class Sched, bool STAMP = false>
__device__ __forceinline__ void gemm_phase(PG8_LAS unsigned char* lds, const Gemm g, const Sched& S, const Epi& E, unsigned long long* stamps) {
    int tid = threadIdx.x; asm volatile("" : "+v"(tid)); const int wid = __builtin_amdgcn_readfirstlane(tid >> 6), lane = tid & 63, wr = wid >> 2, wc = wid & 3, fr = lane & 15, fq = lane >> 4;
    const int K = g.K, nt = K / BK;
    int ts_lo = 0, ts_hi = 0, nts = 0; const unsigned long long rt_entry = STAMP ? (unsigned long long)wall_clock64() : 0ull;
#define PG8_STAMP() do { if (STAMP && wid == 0 && nts < 64) { const unsigned long long _c = (unsigned long long)clock64(); \
        ts_lo = (lane == nts) ? (int)(unsigned)_c : ts_lo; ts_hi = (lane == nts) ? (int)(unsigned)(_c >> 32) : ts_hi; ++nts; } } while (0)
    PG8_STAMP();
    unsigned voffA[2], voffB[2];
#pragma unroll
    for (int i = 0; i < 2; ++i) { int R, C; stage_rc(tid * 16 + i * 8192, R, C); const int Rb = Epi::PERM ? ((R & ~31) + perm32(R & 31)) : R;
        voffA[i] = (unsigned)(R * K + C) * 2u; voffB[i] = (unsigned)(Rb * K + C) * 2u; }
    const size_t kstep = (size_t)(BK * 2);
    const size_t hstep = (size_t)HALF * K * 2;
    const size_t tstep = 2 * hstep;
    const unsigned ldsw = (unsigned)wid * 1024u;
    const int aoff = lds_byte(wr * 64 + fr, fq * 8), boff = lds_byte(wc * 32 + fr, fq * 8);
#define PG8_SA(b, h) (((b) * 2 + (h)) * HTB)
#define PG8_SB(b, h) ((4 + (b) * 2 + (h)) * HTB)
#define PG8_STAGE(bufoff, gbase, voff) do { _Pragma("unroll") for (int _i = 0; _i < 2; ++_i) \
        __builtin_amdgcn_global_load_lds((const unsigned*)((const char*)(gbase) + (voff)[_i]), (PG8_LAS unsigned*)(lds + (bufoff) + ldsw + _i * 8192), 16, 0, 0); } while (0)
#define PG8_LDA(dst, b, h) do { _Pragma("unroll") for (int m = 0; m < 4; ++m) _Pragma("unroll") for (int k = 0; k < 2; ++k) dst[m][k] = *(const PG8_LAS bf16x8*)(lds + PG8_SA(b, h) + aoff + m * 2048 + k * 1024); } while (0)
#define PG8_LDB(dst, b, h) do { _Pragma("unroll") for (int n = 0; n < 2; ++n) _Pragma("unroll") for (int k = 0; k < 2; ++k) dst[n][k] = *(const PG8_LAS bf16x8*)(lds + PG8_SB(b, h) + boff + n * 2048 + k * 1024); } while (0)
#define PG8_MMA(ai, bj, At, Bt) do { __builtin_amdgcn_s_setprio(1); _Pragma("unroll") for (int m = 0; m < 4; ++m) _Pragma("unroll") for (int n = 0; n < 2; ++n) _Pragma("unroll") for (int k = 0; k < 2; ++k) \
        acc[ai][bj][m][n] = __builtin_amdgcn_mfma_f32_16x16x32_bf16(Bt[n][k], At[m][k], acc[ai][bj][m][n], 0, 0, 0); __builtin_amdgcn_s_setprio(0); } while (0)
#define PG8_WAIT_V(n) asm volatile("s_waitcnt vmcnt(" #n ")" ::: "memory")
#define PG8_WAIT_L(n) asm volatile("s_waitcnt lgkmcnt(" #n ")" ::: "memory")
#define PG8_BAR __builtin_amdgcn_s_barrier()
#define PG8_SCHED __builtin_amdgcn_sched_barrier(0)
    Unit cur, nxt; int ui = 0;
    if (!S.next(0, cur)) return;
    f32x4 acc[2][2][4][2];
#pragma unroll
    for (int a = 0; a < 2; ++a)
#pragma unroll
        for (int b = 0; b < 2; ++b)
#pragma unroll
            for (int m = 0; m < 4; ++m)
#pragma unroll
                for (int n = 0; n < 2; ++n) acc[a][b][m][n] = (f32x4){0.f, 0.f, 0.f, 0.f};
    bf16x8 At[4][2], B0[2][2], B1[2][2];
    const char* cA = (const char*)g.A + (size_t)cur.pm * tstep; const char* cB = (const char*)g.Bt + (size_t)cur.pn * tstep;
    S.a_ready(cur);
    PG8_STAGE(PG8_SB(0, 0), cB, voffB); PG8_STAGE(PG8_SA(0, 0), cA, voffA); PG8_STAGE(PG8_SB(0, 1), cB + hstep, voffB); PG8_STAGE(PG8_SA(0, 1), cA + hstep, voffA);
    if (wr == 1) PG8_BAR;
    PG8_WAIT_V(4); PG8_BAR;
    PG8_STAGE(PG8_SB(1, 0), cB + kstep, voffB); PG8_STAGE(PG8_SA(1, 0), cA + kstep, voffA); PG8_STAGE(PG8_SB(1, 1), cB + hstep + kstep, voffB);
    PG8_WAIT_V(6); PG8_BAR;
    PG8_STAMP();
    for (;;) {
        const bool has_next = S.next(ui + 1, nxt);
        const char* nA = has_next ? (const char*)g.A + (size_t)nxt.pm * tstep : cA; const char* nB = has_next ? (const char*)g.Bt + (size_t)nxt.pn * tstep : cB;
        for (int t = 0; t < nt; t += 2) {
            const bool last = (t == nt - 2);
            const char* a1 = cA + (size_t)(t + 1) * kstep;
            const char* a2 = last ? nA : cA + (size_t)(t + 2) * kstep; const char* b2 = last ? nB : cB + (size_t)(t + 2) * kstep;
            const char* a3 = a2 + kstep; const char* b3 = b2 + kstep;
            if (last && has_next) S.a_ready(nxt);
            PG8_LDB(B0, 0, 0); PG8_SCHED; PG8_LDA(At, 0, 0); PG8_STAGE(PG8_SA(1, 1), a1 + hstep, voffA);
            PG8_WAIT_L(8); PG8_BAR; PG8_WAIT_L(0); PG8_MMA(0, 0, At, B0); PG8_BAR; PG8_SCHED;
            PG8_LDB(B1, 0, 1); PG8_STAGE(PG8_SB(0, 0), b2, voffB);
            PG8_BAR; PG8_WAIT_L(0); PG8_MMA(0, 1, At, B1); PG8_BAR;
            PG8_LDA(At, 0, 1); PG8_STAGE(PG8_SA(0, 0), a2, voffA);
            PG8_BAR; PG8_WAIT_L(0); PG8_MMA(1, 0, At, B0); PG8_BAR; PG8_SCHED;
            PG8_STAGE(PG8_SB(0, 1), b2 + hstep, voffB);
            PG8_WAIT_V(6); PG8_BAR; PG8_MMA(1, 1, At, B1); PG8_BAR;
            PG8_LDB(B0, 1, 0); PG8_SCHED; PG8_LDA(At, 1, 0); PG8_STAGE(PG8_SA(0, 1), a2 + hstep, voffA);
            PG8_WAIT_L(8); PG8_BAR; PG8_WAIT_L(0); PG8_MMA(0, 0, At, B0); PG8_BAR; PG8_SCHED;
            PG8_LDB(B1, 1, 1); PG8_STAGE(PG8_SB(1, 0), b3, voffB);
            PG8_BAR; PG8_WAIT_L(0); PG8_MMA(0, 1, At, B1); PG8_BAR;
            PG8_LDA(At, 1, 1); PG8_STAGE(PG8_SA(1, 0), a3, voffA);
            PG8_BAR; PG8_WAIT_L(0); PG8_MMA(1, 0, At, B0); PG8_BAR; PG8_SCHED;
            PG8_STAGE(PG8_SB(1, 1), b3 + hstep, voffB);
            PG8_WAIT_V(6); PG8_BAR; PG8_MMA(1, 1, At, B1); PG8_BAR;
        }
        PG8_STAMP();
        if constexpr (!Epi::AFTER_DRAIN) { E(acc, cur, wr, wc, fr, fq); S.done(cur); }
        PG8_STAMP();
        if (!has_next) break;
#pragma unroll
        for (int a = 0; a < 2; ++a)
#pragma unroll
            for (int b = 0; b < 2; ++b)
#pragma unroll
                for (int m = 0; m < 4; ++m)
#pragma unroll
                    for (int n = 0; n < 2; ++n) acc[a][b][m][n] = (f32x4){0.f, 0.f, 0.f, 0.f};
        cur = nxt; cA = nA; cB = nB; ++ui;
    }
    PG8_WAIT_V(0);
    if (wr == 0) PG8_BAR;
    PG8_BAR;
    if constexpr (Epi::AFTER_DRAIN) { E.fused(acc, cur, wr, wc, fr, fq, lds, wid, lane); S.done(cur); }
    PG8_STAMP();
    if (STAMP && wid == 0) { stamps[lane] = lane < nts ? (((unsigned long long)(unsigned)ts_hi << 32) | (unsigned)ts_lo) : 0ull;
        if (lane == 62) stamps[62] = rt_entry; if (lane == 63) stamps[63] = (unsigned long long)wall_clock64(); }
#undef PG8_STAMP
#undef PG8_SA
#undef PG8_SB
#undef PG8_STAGE
#undef PG8_LDA
#undef PG8_LDB
#undef PG8_MMA
#undef PG8_WAIT_V
#undef PG8_WAIT_L
#undef PG8_BAR
#undef PG8_SCHED
}
}
using namespace pg8;
#define LAS PG8_LAS
typedef unsigned short u16;
typedef unsigned u32x2 __attribute__((ext_vector_type(2)));

constexpr int NBATCH = 8, SEQ = 2048, DM = 2048, MTOK = NBATCH * SEQ, DIN = 7824, NP = 7936;
constexpr int C_R = 0, C_K = 1024, C_V = 2048, C_WD = 3072, C_GA = 3200, C_QB = 4224, C_KB = 4736, C_VB = 5248, C_GB = 5760,
              C_QC = 6272, C_KC = 6528, C_VC = 6784, C_GC = 7296, C_LOW = 7808;
constexpr int LDS_BYTES = 131072;

struct Params {
    const float *x, *norm_w, *w_in, *w_out, *mu, *w0, *w2, *a0, *a2, *k_k, *k_a, *r_k, *ln_w, *ln_b, *a_up, *a_b, *gnw, *fnw;
    float* out;
    u16 *WtIn, *WtOut, *W2t, *A2t, *H, *P;
    float *yraw, *ybonus, *kmean;
    int phase_lo, phase_hi;
};

__device__ __forceinline__ int tid_() { int t = threadIdx.x; asm volatile("" : "+v"(t)); return t; }
__device__ __forceinline__ float bf2f(u16 v) { return __uint_as_float(((unsigned)v) << 16); }
__device__ __forceinline__ float bflo(unsigned w) { return __uint_as_float(w << 16); }
__device__ __forceinline__ float bfhi(unsigned w) { return __uint_as_float(w & 0xffff0000u); }
__device__ __forceinline__ u16 f2bf(float f) { return (u16)(cvt_pk_bf16(f, 0.f) & 0xffffu); }
template <int CTRL> __device__ __forceinline__ float dpp_f(float v) { return __int_as_float(__builtin_amdgcn_update_dpp(0, __float_as_int(v), CTRL, 0xF, 0xF, true)); }
__device__ __forceinline__ float red16_sum(float v) { v += dpp_f<0xB1>(v); v += dpp_f<0x4E>(v); v += dpp_f<0x141>(v); v += dpp_f<0x140>(v); return v; }
__device__ __forceinline__ float red8_sum(float v) { v += dpp_f<0xB1>(v); v += dpp_f<0x4E>(v); v += dpp_f<0x141>(v); return v; }
__device__ __forceinline__ float red16_max(float v) { v = fmaxf(v, dpp_f<0xB1>(v)); v = fmaxf(v, dpp_f<0x4E>(v)); v = fmaxf(v, dpp_f<0x141>(v)); v = fmaxf(v, dpp_f<0x140>(v)); return v; }
__device__ __forceinline__ float wave_sum(float v) {
#pragma unroll
    for (int o = 1; o < 64; o <<= 1) v += __shfl_xor(v, o);
    return v;
}
__device__ __forceinline__ float sigmoidf_(float x) { return 1.f / (1.f + __expf(-x)); }
__device__ __forceinline__ float siluf_(float x) { return x / (1.f + __expf(-x)); }
__device__ __forceinline__ float logsigmoidf_(float z) { return fminf(z, 0.f) - log1pf(__expf(-fabsf(z))); }
__device__ __forceinline__ f32x4 mfma16(bf16x8 a, bf16x8 b, f32x4 c) { return __builtin_amdgcn_mfma_f32_16x16x32_bf16(a, b, c, 0, 0, 0); }

struct EpiP {
    static constexpr bool PERM = true, AFTER_DRAIN = false;
    bf16_t* O; int ldc;
    __device__ __forceinline__ void operator()(const f32x4 (&acc)[2][2][4][2], const Unit& u, int wr, int wc, int fr, int fq) const {
        const int row0 = u.pm * BM + wr * 64 + fr, col0 = u.pn * BM + wc * 32 + 8 * fq;
#pragma unroll
        for (int ai = 0; ai < 2; ++ai)
#pragma unroll
            for (int m = 0; m < 4; ++m) { bf16_t* rowp = O + (size_t)(row0 + ai * HALF + m * 16) * ldc + col0;
#pragma unroll
                for (int bj = 0; bj < 2; ++bj) { const f32x4 v0 = acc[ai][bj][m][0], v1 = acc[ai][bj][m][1];
                    u32x4 w; w.x = cvt_pk_bf16(v0[0], v0[1]); w.y = cvt_pk_bf16(v0[2], v0[3]); w.z = cvt_pk_bf16(v1[0], v1[1]); w.w = cvt_pk_bf16(v1[2], v1[3]);
                    *(u32x4*)(rowp + bj * HALF) = w; } }
    }
};
struct EpiRes {
    static constexpr bool PERM = false, AFTER_DRAIN = false;
    const float* R; float* C; int ldc;
    __device__ __forceinline__ void operator()(const f32x4 (&acc)[2][2][4][2], const Unit& u, int wr, int wc, int fr, int fq) const {
        const int row0 = u.pm * BM + wr * 64 + fr, col0 = u.pn * BM + wc * 32 + 4 * fq;
#pragma unroll
        for (int ai = 0; ai < 2; ++ai)
#pragma unroll
            for (int m = 0; m < 4; ++m) { const size_t off = (size_t)(row0 + ai * HALF + m * 16) * ldc + col0;
#pragma unroll
                for (int bj = 0; bj < 2; ++bj)
#pragma unroll
                    for (int n = 0; n < 2; ++n) { const f32x4 r = *(const f32x4*)(R + off + bj * HALF + n * 16); *(f32x4*)(C + off + bj * HALF + n * 16) = acc[ai][bj][m][n] + r; }
                asm volatile("" ::: "memory"); }
    }
};

__device__ void transpose_cvt(LAS unsigned char* lds, const float* src, u16* dst, int K, int N, int Npad, int bid, int nb) {
    LAS float* tile = (LAS float*)lds;
    const int tilesN = Npad / 64, tilesK = K / 64, tid = tid_();
    for (int t = bid; t < tilesN * tilesK; t += nb) {
        const int tn = t % tilesN, tk = t / tilesN, n0 = tn * 64, k0 = tk * 64;
#pragma unroll
        for (int i = 0; i < 2; ++i) { const int idx = tid + i * 512, kk = idx >> 4, n4 = (idx & 15) * 4;
            float4 v = make_float4(0.f, 0.f, 0.f, 0.f);
            if (n0 + n4 < N) v = *(const float4*)(src + (size_t)(k0 + kk) * N + n0 + n4);
            tile[(n4 + 0) * 65 + kk] = v.x; tile[(n4 + 1) * 65 + kk] = v.y; tile[(n4 + 2) * 65 + kk] = v.z; tile[(n4 + 3) * 65 + kk] = v.w; }
        __syncthreads();
        { const int n = tid >> 3, k8 = (tid & 7) * 8; const LAS float* r = tile + n * 65 + k8;
            u32x4 o; o.x = cvt_pk_bf16(r[0], r[1]); o.y = cvt_pk_bf16(r[2], r[3]); o.z = cvt_pk_bf16(r[4], r[5]); o.w = cvt_pk_bf16(r[6], r[7]);
            *(u32x4*)(dst + (size_t)(n0 + n) * K + k0 + k8) = o; }
        __syncthreads();
    }
}

__device__ void rmsnorm_phase(const float* x, const float* w, u16* hb, float* of, int bid, int nb) {
    const int tid0 = tid_(), wid = tid0 >> 6, lane = tid0 & 63;
    for (int row = bid * 8 + wid; row < MTOK; row += nb * 8) {
        const float4* xr = (const float4*)(x + (size_t)row * DM);
        float4 v[8]; float s = 0.f;
#pragma unroll
        for (int i = 0; i < 8; ++i) { v[i] = xr[i * 64 + lane]; s += v[i].x * v[i].x + v[i].y * v[i].y + v[i].z * v[i].z + v[i].w * v[i].w; }
        s = wave_sum(s);
        const float rs = rsqrtf(s * (1.f / DM) + 1e-6f);
#pragma unroll
        for (int i = 0; i < 8; ++i) { const float4 wv = ((const float4*)w)[i * 64 + lane];
            const float a = v[i].x * rs * wv.x, b = v[i].y * rs * wv.y, c = v[i].z * rs * wv.z, d = v[i].w * rs * wv.w;
            if (hb) { uint2 o; o.x = cvt_pk_bf16(a, b); o.y = cvt_pk_bf16(c, d); *(uint2*)(hb + (size_t)row * DM + (i * 64 + lane) * 4) = o; }
            else { ((float4*)(of + (size_t)row * DM))[i * 64 + lane] = make_float4(a, b, c, d); } }
    }
}

__device__ void kmean_phase(const Params& p, LAS unsigned char* lds, int bid, int nb) {
    LAS float* part = (LAS float*)lds;
    const int tid = tid_();
    for (int task = bid; task < 256; task += nb) {
        const int b = task >> 5, h = (task >> 3) & 3, blk = task & 7;
        const int d8 = (tid & 15) * 8, kg = tid >> 4;
        float s[8];
#pragma unroll
        for (int e = 0; e < 8; ++e) s[e] = 0.f;
        for (int kk = 0; kk < 8; ++kk) {
            const int tok = b * SEQ + blk * 256 + kg * 8 + kk;
            const uint4 v = *(const uint4*)(p.P + (size_t)tok * NP + C_KB + h * 128 + d8);
            s[0] += bflo(v.x); s[1] += bfhi(v.x); s[2] += bflo(v.y); s[3] += bfhi(v.y); s[4] += bflo(v.z); s[5] += bfhi(v.z); s[6] += bflo(v.w); s[7] += bfhi(v.w);
        }
        __syncthreads();
#pragma unroll
        for (int e = 0; e < 8; ++e) part[kg * 128 + d8 + e] = s[e];
        __syncthreads();
        if (tid < 128) { float a = 0.f; for (int g = 0; g < 32; ++g) a += part[g * 128 + tid]; p.kmean[(size_t)task * 128 + tid] = a * (1.f / 256.f); }
    }
    __syncthreads();
}

constexpr int RW_T = 32;
constexpr int RW_RAW = 0, RW_A1 = 21504, RW_A2 = 26112, RW_OPW = 30720, RW_OPA = 38912, RW_OPB = 47104, RW_OPK = 55296, RW_OPR = 63488,
              RW_KS = 71680, RW_AS = 79872, RW_OPV = 88064, RW_YB = 92160, RW_MU = 96256, RW_PAR = 97536;
__device__ __forceinline__ void rw_issue(const Params& p, int tid, int b, int h, int t0, u32x4 (&rg)[3]) {
#pragma unroll
    for (int i = 0; i < 3; ++i) { const int piece = tid + 512 * i; rg[i] = (u32x4){0u, 0u, 0u, 0u};
        if (piece < 33 * 40) { const int row = piece / 40, pc = piece % 40; const int t = t0 - 1 + row;
            const int col = pc < 8 ? C_R + h * 64 + pc * 8 : pc < 16 ? C_K + h * 64 + (pc - 8) * 8 : pc < 24 ? C_V + h * 64 + (pc - 16) * 8 : C_WD + (pc - 24) * 8;
            if (t >= 0) rg[i] = *(const u32x4*)(p.P + (size_t)(b * SEQ + t) * NP + col); } }
}
__device__ void rwkv_scan_phase(const Params& p, int l, LAS unsigned char* lds, int bid, int nb) {
    const int tid = tid_(), wid = tid >> 6, lane = tid & 63, row = tid >> 4, sub = tid & 15;
    LAS u16* raw = (LAS u16*)(lds + RW_RAW); LAS u16* A1 = (LAS u16*)(lds + RW_A1); LAS u16* A2 = (LAS u16*)(lds + RW_A2);
    LAS float* opW = (LAS float*)(lds + RW_OPW); LAS float* opA = (LAS float*)(lds + RW_OPA); LAS float* opB = (LAS float*)(lds + RW_OPB);
    LAS float* opK = (LAS float*)(lds + RW_OPK); LAS float* opR = (LAS float*)(lds + RW_OPR); LAS float* kS = (LAS float*)(lds + RW_KS);
    LAS float* aS = (LAS float*)(lds + RW_AS); LAS float* opV = (LAS float*)(lds + RW_OPV); LAS float* yb = (LAS float*)(lds + RW_YB);
    LAS float* muS = (LAS float*)(lds + RW_MU); LAS float* parS = (LAS float*)(lds + RW_PAR);
    for (int task = bid; task < 256; task += nb) {
        const int b = task >> 5, h = (task >> 1) & 15, half = task & 1;
        __syncthreads();
        if (tid < 320) { const int c = tid; const int mi = c < 64 ? h * 64 + c : c < 128 ? 1024 + h * 64 + (c - 64) : c < 192 ? 2048 + h * 64 + (c - 128) : 3072 + (c - 192);
            muS[c] = p.mu[(size_t)l * 3200 + mi]; }
        if (tid >= 320 && tid < 384) { const int c = tid - 320; const size_t o = (size_t)l * 1024 + h * 64 + c;
            parS[c] = p.w0[o]; parS[64 + c] = p.a0[o]; parS[128 + c] = p.k_k[o]; parS[192 + c] = p.k_a[o]; parS[256 + c] = p.r_k[o]; }
        const int mat = wid >> 2, ct = wid & 3;
        bf16x8 bfr[2];
        { const u16* Bt = (mat ? p.A2t : p.W2t) + (size_t)l * 1024 * 64 + (size_t)(h * 64 + ct * 16 + (lane & 15)) * 64 + (lane >> 4) * 8;
            bfr[0] = *(const bf16x8*)(Bt); bfr[1] = *(const bf16x8*)(Bt + 32); }
        float S0 = 0.f, S1 = 0.f, S2 = 0.f, S3 = 0.f;
        u32x4 rg[3];
        rw_issue(p, tid, b, h, 0, rg);
        for (int c = 0; c < SEQ / RW_T; ++c) {
            const int t0 = c * RW_T;
#pragma unroll
            for (int i = 0; i < 3; ++i) { const int piece = tid + 512 * i; if (piece < 33 * 40) *(LAS u32x4*)(raw + (piece / 40) * 320 + (piece % 40) * 8) = rg[i]; }
            __syncthreads();
            if (c + 1 < SEQ / RW_T) rw_issue(p, tid, b, h, t0 + RW_T, rg);
            for (int i = 0; i < 20; ++i) { const int e = tid + 512 * i, t = e / 320, cc = e % 320;
                const float cur = bf2f(raw[(t + 1) * 320 + cc]), prv = bf2f(raw[t * 320 + cc]);
                const float xs = cur + muS[cc] * (prv - cur);
                if (cc < 64) opR[t * 64 + cc] = xs;
                else if (cc < 128) kS[t * 64 + cc - 64] = xs;
                else if (cc < 192) { const int v = cc - 128; if ((v >> 5) == half) opV[t * 32 + (v & 31)] = xs; }
                else if (cc < 256) { const float e2 = __expf(2.f * xs); A1[t * 72 + cc - 192] = f2bf(1.f - 2.f / (e2 + 1.f)); }
                else A2[t * 72 + cc - 256] = f2bf(xs); }
            __syncthreads();
            { LAS u16* Ab = mat ? A2 : A1;
#pragma unroll
                for (int rt = 0; rt < 2; ++rt) { f32x4 acc = {0.f, 0.f, 0.f, 0.f};
#pragma unroll
                    for (int ks = 0; ks < 2; ++ks) { const bf16x8 af = *(const LAS bf16x8*)(Ab + (rt * 16 + (lane & 15)) * 72 + ks * 32 + (lane >> 4) * 8); acc = mfma16(af, bfr[ks], acc); }
                    const int cc = ct * 16 + (lane & 15);
#pragma unroll
                    for (int i = 0; i < 4; ++i) { const int t = rt * 16 + (lane >> 4) * 4 + i;
                        if (mat == 0) { float wv = parS[cc] + acc[i]; wv = fminf(wv, 0.f) - log1pf(__expf(-fabsf(wv))) - 0.5f; opW[t * 64 + cc] = __expf(-__expf(wv)); }
                        else aS[t * 64 + cc] = sigmoidf_(parS[64 + cc] + acc[i]); } } }
            __syncthreads();
            { const int t = row, c4 = sub * 4;
                const f32x4 kr = *(const LAS f32x4*)(kS + t * 64 + c4), av = *(const LAS f32x4*)(aS + t * 64 + c4), rr = *(const LAS f32x4*)(opR + t * 64 + c4);
                const f32x4 kkp = *(const LAS f32x4*)(parS + 128 + c4), kap = *(const LAS f32x4*)(parS + 192 + c4), rkp = *(const LAS f32x4*)(parS + 256 + c4);
                f32x4 kk = kr * kkp;
                float ss = kk.x * kk.x + kk.y * kk.y + kk.z * kk.z + kk.w * kk.w; ss = red16_sum(ss);
                const float inv = rsqrtf(fmaxf(ss, 1e-24f));
                kk.x *= inv; kk.y *= inv; kk.z *= inv; kk.w *= inv;
                const f32x4 km = kr * (1.f + (av - 1.f) * kap);
                *(LAS f32x4*)(opA + t * 64 + c4) = -kk;
                *(LAS f32x4*)(opB + t * 64 + c4) = kk * av;
                *(LAS f32x4*)(opK + t * 64 + c4) = km;
                float bo = rr.x * km.x * rkp.x + rr.y * km.y * rkp.y + rr.z * km.z * rkp.z + rr.w * km.w * rkp.w; bo = red16_sum(bo);
                if (half == 0 && sub == 0) p.ybonus[(size_t)(b * SEQ + t0 + t) * 16 + h] = bo; }
            __syncthreads();
#pragma unroll 4
            for (int t = 0; t < RW_T; ++t) {
                const f32x4 w = *(const LAS f32x4*)(opW + t * 64 + sub * 4), a = *(const LAS f32x4*)(opA + t * 64 + sub * 4), bb = *(const LAS f32x4*)(opB + t * 64 + sub * 4);
                const f32x4 kk = *(const LAS f32x4*)(opK + t * 64 + sub * 4), rr = *(const LAS f32x4*)(opR + t * 64 + sub * 4);
                const float vv = opV[t * 32 + row];
                float sa = S0 * a.x + S1 * a.y + S2 * a.z + S3 * a.w; sa = red16_sum(sa);
                S0 = S0 * w.x + sa * bb.x + vv * kk.x; S1 = S1 * w.y + sa * bb.y + vv * kk.y; S2 = S2 * w.z + sa * bb.z + vv * kk.z; S3 = S3 * w.w + sa * bb.w + vv * kk.w;
                float y = S0 * rr.x + S1 * rr.y + S2 * rr.z + S3 * rr.w; y = red16_sum(y);
                if (sub == 0) yb[t * 32 + row] = y;
            }
            __syncthreads();
            if (tid < 256) { const int t = tid >> 3, r4 = (tid & 7) * 4;
                *(f32x4*)(p.yraw + (size_t)(b * SEQ + t0 + t) * 1024 + h * 64 + half * 32 + r4) = *(const LAS f32x4*)(yb + t * 32 + r4); }
        }
    }
    __syncthreads();
}

__device__ void rwkv_post_item(const Params& p, int l, int item) {
    const int tid = tid_(), pair = item * 32 + (tid >> 4), tok = pair >> 4, h = pair & 15, c4 = (tid & 15) * 4;
    const float4 y = *(const float4*)(p.yraw + (size_t)tok * 1024 + h * 64 + c4);
    const float mean = red16_sum(y.x + y.y + y.z + y.w) * (1.f / 64.f);
    const float d0 = y.x - mean, d1 = y.y - mean, d2 = y.z - mean, d3 = y.w - mean;
    const float var = red16_sum(d0 * d0 + d1 * d1 + d2 * d2 + d3 * d3) * (1.f / 64.f);
    const float rs = rsqrtf(var + 64e-5f);
    const size_t po = (size_t)l * 1024 + h * 64 + c4;
    const float4 lw = *(const float4*)(p.ln_w + po), lb = *(const float4*)(p.ln_b + po), muv = *(const float4*)(p.mu + (size_t)l * 3200 + 2048 + h * 64 + c4);
    const uint2 vc = *(const uint2*)(p.P + (size_t)tok * NP + C_V + h * 64 + c4);
    uint2 vp = make_uint2(0u, 0u);
    if ((tok & (SEQ - 1)) != 0) vp = *(const uint2*)(p.P + (size_t)(tok - 1) * NP + C_V + h * 64 + c4);
    const uint2 gg = *(const uint2*)(p.P + (size_t)tok * NP + C_GA + h * 64 + c4);
    const float bo = p.ybonus[(size_t)tok * 16 + h];
    float v0 = bflo(vc.x), v1 = bfhi(vc.x), v2 = bflo(vc.y), v3 = bfhi(vc.y);
    v0 += muv.x * (bflo(vp.x) - v0); v1 += muv.y * (bfhi(vp.x) - v1); v2 += muv.z * (bflo(vp.y) - v2); v3 += muv.w * (bfhi(vp.y) - v3);
    const float o0 = (d0 * rs * lw.x + lb.x + bo * v0) * siluf_(bflo(gg.x)), o1 = (d1 * rs * lw.y + lb.y + bo * v1) * siluf_(bfhi(gg.x));
    const float o2 = (d2 * rs * lw.z + lb.z + bo * v2) * siluf_(bflo(gg.y)), o3 = (d3 * rs * lw.w + lb.w + bo * v3) * siluf_(bfhi(gg.y));
    uint2 o; o.x = cvt_pk_bf16(o0, o1); o.y = cvt_pk_bf16(o2, o3);
    *(uint2*)(p.H + (size_t)tok * DM + h * 64 + c4) = o;
}

constexpr int MB_K = 0, MB_VT = 17408, MB_PW = 35840, MB_KM = 54272, MB_SEL = 57856, MB_TM = 58368;
__device__ void moba_task(const Params& p, LAS unsigned char* lds, int task) {
    const int tid = tid_(), wid = tid >> 6, lane = tid & 63, l15 = lane & 15, lq = lane >> 4;
    const int qt = 15 - (task >> 5), bh = task & 31, b = bh >> 2, h = bh & 3, qblk = qt >> 1, q0 = qt * 128;
    LAS u16* Kt = (LAS u16*)(lds + MB_K); LAS u16* VT = (LAS u16*)(lds + MB_VT); LAS u16* Pw = (LAS u16*)(lds + MB_PW) + wid * 16 * 72;
    LAS float* kmS = (LAS float*)(lds + MB_KM); LAS int* selS = (LAS int*)(lds + MB_SEL); LAS int* tmS = (LAS int*)(lds + MB_TM);
    __syncthreads();
    for (int i = tid; i < qblk * 128; i += 512) kmS[i] = p.kmean[(size_t)(bh * 8) * 128 + i];
    if (tid == 0) *tmS = 0;
    __syncthreads();
    if (tid < 128) {
        const u16* qp = p.P + (size_t)(b * SEQ + q0 + tid) * NP + C_QB + h * 128;
        float g[7];
#pragma unroll
        for (int j = 0; j < 7; ++j) g[j] = 0.f;
        for (int d8 = 0; d8 < 128; d8 += 8) {
            const uint4 v = *(const uint4*)(qp + d8);
            const float q[8] = {bflo(v.x), bfhi(v.x), bflo(v.y), bfhi(v.y), bflo(v.z), bfhi(v.z), bflo(v.w), bfhi(v.w)};
#pragma unroll
            for (int j = 0; j < 7; ++j) if (j < qblk) {
#pragma unroll
                for (int e = 0; e < 8; ++e) g[j] += q[e] * kmS[j * 128 + d8 + e]; }
        }
        int mask = 0;
#pragma unroll
        for (int r = 0; r < 3; ++r) { float best = -INFINITY; int bi = -1;
#pragma unroll
            for (int j = 0; j < 7; ++j) if (j < qblk && !((mask >> j) & 1) && g[j] > best) { best = g[j]; bi = j; }
            if (bi >= 0) mask |= 1 << bi; }
        mask |= 1 << qblk;
        selS[tid] = mask; atomicOr((int*)tmS, mask);
    }
    __syncthreads();
    const int tmask = *tmS;
    bf16x8 qf[4];
    { const u16* qp = p.P + (size_t)(b * SEQ + q0 + wid * 16 + l15) * NP + C_QB + h * 128 + lq * 8;
#pragma unroll
        for (int ks = 0; ks < 4; ++ks) qf[ks] = *(const bf16x8*)(qp + ks * 32); }
    int rm[4]; int wmask = 0;
#pragma unroll
    for (int i = 0; i < 4; ++i) rm[i] = selS[wid * 16 + lq * 4 + i];
    for (int i = 0; i < 16; ++i) wmask |= selS[wid * 16 + i];
    float m[4], ls[4]; f32x4 O[8];
#pragma unroll
    for (int i = 0; i < 4; ++i) { m[i] = -1e30f; ls[i] = 0.f; }
#pragma unroll
    for (int dt = 0; dt < 8; ++dt) O[dt] = (f32x4){0.f, 0.f, 0.f, 0.f};
    const float scale = 0.08838834764831845f;
    for (int j = 0; j <= qblk; ++j) {
        if (!((tmask >> j) & 1)) continue;
        for (int kt = 0; kt < 4; ++kt) {
            const int key0 = j * 256 + kt * 64;
            if (key0 > q0 + 127) break;
            __syncthreads();
#pragma unroll
            for (int i = 0; i < 2; ++i) { const int piece = tid + 512 * i, key = piece >> 4, d8 = (piece & 15) * 8;
                const u16* src = p.P + (size_t)(b * SEQ + key0 + key) * NP + h * 128 + d8;
                const u32x4 kv = *(const u32x4*)(src + C_KB), vv = *(const u32x4*)(src + C_VB);
                *(LAS u32x4*)(Kt + key * 136 + d8) = kv;
                LAS u16* vt = VT + d8 * 72 + key;
                vt[0] = (u16)(vv.x & 0xffff); vt[72] = (u16)(vv.x >> 16); vt[144] = (u16)(vv.y & 0xffff); vt[216] = (u16)(vv.y >> 16);
                vt[288] = (u16)(vv.z & 0xffff); vt[360] = (u16)(vv.z >> 16); vt[432] = (u16)(vv.w & 0xffff); vt[504] = (u16)(vv.w >> 16); }
            __syncthreads();
            if ((wmask >> j) & 1) {
                f32x4 s[4];
#pragma unroll
                for (int nt = 0; nt < 4; ++nt) { s[nt] = (f32x4){0.f, 0.f, 0.f, 0.f};
#pragma unroll
                    for (int ks = 0; ks < 4; ++ks) { const bf16x8 kf = *(const LAS bf16x8*)(Kt + (nt * 16 + l15) * 136 + ks * 32 + lq * 8); s[nt] = mfma16(qf[ks], kf, s[nt]); } }
#pragma unroll
                for (int i = 0; i < 4; ++i) {
                    const int qpos = q0 + wid * 16 + lq * 4 + i; const bool rsel = (rm[i] >> j) & 1;
                    float mx = -1e30f;
#pragma unroll
                    for (int nt = 0; nt < 4; ++nt) { const int kpos = key0 + nt * 16 + l15;
                        const bool valid = (j == qblk) ? (kpos <= qpos) : rsel;
                        const float sv = valid ? s[nt][i] * scale : -1e30f; s[nt][i] = sv; mx = fmaxf(mx, sv); }
                    mx = red16_max(mx);
                    const float mnew = fmaxf(m[i], mx), alpha = __expf(m[i] - mnew);
                    float rs = 0.f;
#pragma unroll
                    for (int nt = 0; nt < 4; ++nt) { const float pv = s[nt][i] > -1e29f ? __expf(s[nt][i] - mnew) : 0.f; rs += pv; Pw[(lq * 4 + i) * 72 + nt * 16 + l15] = f2bf(pv); }
                    rs = red16_sum(rs);
                    ls[i] = ls[i] * alpha + rs; m[i] = mnew;
#pragma unroll
                    for (int dt = 0; dt < 8; ++dt) O[dt][i] *= alpha;
                }
                __builtin_amdgcn_wave_barrier();
                bf16x8 pf[2];
#pragma unroll
                for (int ks = 0; ks < 2; ++ks) pf[ks] = *(const LAS bf16x8*)(Pw + l15 * 72 + ks * 32 + lq * 8);
#pragma unroll
                for (int dt = 0; dt < 8; ++dt)
#pragma unroll
                    for (int ks = 0; ks < 2; ++ks) { const bf16x8 vf = *(const LAS bf16x8*)(VT + (dt * 16 + l15) * 72 + ks * 32 + lq * 8); O[dt] = mfma16(pf[ks], vf, O[dt]); }
                __builtin_amdgcn_wave_barrier();
            }
        }
    }
#pragma unroll
    for (int i = 0; i < 4; ++i) { const float inv = 1.f / ls[i]; const size_t tok = (size_t)(b * SEQ + q0 + wid * 16 + lq * 4 + i);
#pragma unroll
        for (int dt = 0; dt < 8; ++dt) { const int d = dt * 16 + l15;
            const float g = bf2f(p.P[tok * NP + C_GB + h * 128 + d]);
            p.H[tok * DM + 1024 + h * 128 + d] = f2bf(O[dt][i] * inv * siluf_(g)); } }
}

constexpr int GL_QE = 0, GL_KE = 9216, GL_KDT = 18432, GL_VT = 27648, GL_ATT = 46080, GL_ST = 55296, GL_LA = 73728, GL_TOT = 90112,
              GL_AUP = 92160, GL_LOW = 96256, GL_DEC = 100352, GL_OB = 0;
__device__ void gla_task(const Params& p, int l, LAS unsigned char* lds, int task) {
    const int tid = tid_(), wid = tid >> 6, lane = tid & 63, l15 = lane & 15, lq = lane >> 4;
    const int b = task >> 2, h = task & 3;
    LAS u16* QE = (LAS u16*)(lds + GL_QE); LAS u16* KE = (LAS u16*)(lds + GL_KE); LAS u16* KDT = (LAS u16*)(lds + GL_KDT); LAS u16* VT = (LAS u16*)(lds + GL_VT);
    LAS u16* ATT = (LAS u16*)(lds + GL_ATT); LAS u16* ST = (LAS u16*)(lds + GL_ST); LAS float* LA = (LAS float*)(lds + GL_LA); LAS float* TOT = (LAS float*)(lds + GL_TOT);
    LAS float* AUP = (LAS float*)(lds + GL_AUP); LAS float* LOW = (LAS float*)(lds + GL_LOW); LAS float* DEC = (LAS float*)(lds + GL_DEC); LAS float* OB = (LAS float*)(lds + GL_OB);
    __syncthreads();
    for (int i = tid; i < 1024; i += 512) AUP[i] = p.a_up[(size_t)l * 16 * 256 + (i >> 6) * 256 + h * 64 + (i & 63)];
    for (int i = tid; i < 128 * 72 / 2; i += 512) ((LAS unsigned*)ST)[i] = 0u;
    f32x4 Sacc[4];
#pragma unroll
    for (int c = 0; c < 4; ++c) Sacc[c] = (f32x4){0.f, 0.f, 0.f, 0.f};
    const int rt = wid >> 1, dv0t = (wid & 1) * 4;
    for (int n = 0; n < 32; ++n) {
        const size_t tokb = (size_t)(b * SEQ + n * 64);
        { const int e2 = tid * 2, t = e2 >> 4, r = e2 & 15; const unsigned v = *(const unsigned*)(p.P + (tokb + t) * NP + C_LOW + r); LOW[t * 16 + r] = bflo(v); LOW[t * 16 + r + 1] = bfhi(v); }
        __syncthreads();
        { const int t = tid >> 3, d0 = (tid & 7) * 8;
#pragma unroll 1
            for (int dd = 0; dd < 8; ++dd) { const int d = d0 + dd; float z = p.a_b[(size_t)l * 256 + h * 64 + d];
#pragma unroll
                for (int r = 0; r < 16; ++r) z += LOW[t * 16 + r] * AUP[r * 64 + d];
                LA[t * 64 + d] = logsigmoidf_(z) * (1.f / 16.f); } }
        __syncthreads();
        { float a = 0.f;
#pragma unroll
            for (int tt = 0; tt < 8; ++tt) { a += LA[(wid * 8 + tt) * 64 + lane]; LA[(wid * 8 + tt) * 64 + lane] = a; }
            TOT[wid * 64 + lane] = a; }
        __syncthreads();
        { const int t = tid >> 3, d0 = (tid & 7) * 8, wt = t >> 3;
            const uint4 qv = *(const uint4*)(p.P + (tokb + t) * NP + C_QC + h * 64 + d0), kv = *(const uint4*)(p.P + (tokb + t) * NP + C_KC + h * 64 + d0);
            const float q[8] = {bflo(qv.x), bfhi(qv.x), bflo(qv.y), bfhi(qv.y), bflo(qv.z), bfhi(qv.z), bflo(qv.w), bfhi(qv.w)};
            const float k[8] = {bflo(kv.x), bfhi(kv.x), bflo(kv.y), bfhi(kv.y), bflo(kv.z), bfhi(kv.z), bflo(kv.w), bfhi(kv.w)};
            float qe[8], ke[8], off[8], tot[8];
#pragma unroll
            for (int dd = 0; dd < 8; ++dd) { off[dd] = 0.f; tot[dd] = 0.f; }
#pragma unroll 1
            for (int w2 = 0; w2 < 8; ++w2) { const f32x4 ta = *(const LAS f32x4*)(TOT + w2 * 64 + d0), tb = *(const LAS f32x4*)(TOT + w2 * 64 + d0 + 4);
                const float sel = (w2 < wt) ? 1.f : 0.f;
#pragma unroll
                for (int dd = 0; dd < 4; ++dd) { tot[dd] += ta[dd]; off[dd] += sel * ta[dd]; tot[dd + 4] += tb[dd]; off[dd + 4] += sel * tb[dd]; } }
            const f32x4 la0 = *(const LAS f32x4*)(LA + t * 64 + d0), la1 = *(const LAS f32x4*)(LA + t * 64 + d0 + 4);
#pragma unroll
            for (int dd = 0; dd < 8; ++dd) { const int d = d0 + dd;
                const float bv = (dd < 4 ? la0[dd & 3] : la1[dd & 3]) + off[dd];
                qe[dd] = q[dd] * 0.125f * __expf(bv); ke[dd] = k[dd] * __expf(-bv);
                KDT[d * 72 + t] = f2bf(k[dd] * __expf(tot[dd] - bv));
                if (t == 0) DEC[d] = __expf(tot[dd]); }
            u32x4 o; o.x = cvt_pk_bf16(qe[0], qe[1]); o.y = cvt_pk_bf16(qe[2], qe[3]); o.z = cvt_pk_bf16(qe[4], qe[5]); o.w = cvt_pk_bf16(qe[6], qe[7]);
            *(LAS u32x4*)(QE + t * 72 + d0) = o;
            o.x = cvt_pk_bf16(ke[0], ke[1]); o.y = cvt_pk_bf16(ke[2], ke[3]); o.z = cvt_pk_bf16(ke[4], ke[5]); o.w = cvt_pk_bf16(ke[6], ke[7]);
            *(LAS u32x4*)(KE + t * 72 + d0) = o;
#pragma unroll
            for (int i = 0; i < 2; ++i) { const int piece = tid + 512 * i, tv = piece >> 4, dv8 = (piece & 15) * 8;
                const uint4 vv = *(const uint4*)(p.P + (tokb + tv) * NP + C_VC + h * 128 + dv8);
                LAS u16* vt = VT + dv8 * 72 + tv;
                vt[0] = (u16)(vv.x & 0xffff); vt[72] = (u16)(vv.x >> 16); vt[144] = (u16)(vv.y & 0xffff); vt[216] = (u16)(vv.y >> 16);
                vt[288] = (u16)(vv.z & 0xffff); vt[360] = (u16)(vv.z >> 16); vt[432] = (u16)(vv.w & 0xffff); vt[504] = (u16)(vv.w >> 16); } }
        __syncthreads();
        { bf16x8 af[2];
#pragma unroll
            for (int ks = 0; ks < 2; ++ks) af[ks] = *(const LAS bf16x8*)(QE + (rt * 16 + l15) * 72 + ks * 32 + lq * 8);
#pragma unroll
            for (int c2 = 0; c2 < 2; ++c2) { const int ctile = (wid & 1) * 2 + c2; f32x4 acc = {0.f, 0.f, 0.f, 0.f};
#pragma unroll
                for (int ks = 0; ks < 2; ++ks) { const bf16x8 bf = *(const LAS bf16x8*)(KE + (ctile * 16 + l15) * 72 + ks * 32 + lq * 8); acc = mfma16(af[ks], bf, acc); }
#pragma unroll
                for (int i = 0; i < 4; ++i) { const int t = rt * 16 + lq * 4 + i, jj = ctile * 16 + l15; ATT[t * 72 + jj] = f2bf(jj <= t ? acc[i] : 0.f); } } }
        __syncthreads();
        f32x4 oacc[4];
        { bf16x8 at[2], qf[2], kd[2];
#pragma unroll
            for (int ks = 0; ks < 2; ++ks) { at[ks] = *(const LAS bf16x8*)(ATT + (rt * 16 + l15) * 72 + ks * 32 + lq * 8); qf[ks] = *(const LAS bf16x8*)(QE + (rt * 16 + l15) * 72 + ks * 32 + lq * 8);
                kd[ks] = *(const LAS bf16x8*)(KDT + (rt * 16 + l15) * 72 + ks * 32 + lq * 8); }
            float dec[4];
#pragma unroll
            for (int i = 0; i < 4; ++i) dec[i] = DEC[rt * 16 + lq * 4 + i];
#pragma unroll
            for (int c = 0; c < 4; ++c) { const int dvt = dv0t + c; f32x4 acc = {0.f, 0.f, 0.f, 0.f};
#pragma unroll
                for (int i = 0; i < 4; ++i) Sacc[c][i] *= dec[i];
#pragma unroll
                for (int ks = 0; ks < 2; ++ks) { const bf16x8 vf = *(const LAS bf16x8*)(VT + (dvt * 16 + l15) * 72 + ks * 32 + lq * 8), sf = *(const LAS bf16x8*)(ST + (dvt * 16 + l15) * 72 + ks * 32 + lq * 8);
                    acc = mfma16(at[ks], vf, acc); acc = mfma16(qf[ks], sf, acc); Sacc[c] = mfma16(kd[ks], vf, Sacc[c]); }
                oacc[c] = acc; } }
        __syncthreads();
#pragma unroll
        for (int c = 0; c < 4; ++c) { const int dv = (dv0t + c) * 16 + l15;
#pragma unroll
            for (int i = 0; i < 4; ++i) OB[(rt * 16 + lq * 4 + i) * 132 + dv] = oacc[c][i];
            u32x2 sv; sv.x = cvt_pk_bf16(Sacc[c][0], Sacc[c][1]); sv.y = cvt_pk_bf16(Sacc[c][2], Sacc[c][3]);
            *(LAS u32x2*)(ST + dv * 72 + rt * 16 + lq * 4) = sv; }
        __syncthreads();
        { const int t = tid >> 3, dvb = (tid & 7) * 16; float o[16]; float ss = 0.f;
#pragma unroll
            for (int e = 0; e < 16; ++e) { o[e] = OB[t * 132 + dvb + e]; ss += o[e] * o[e]; }
            ss = red8_sum(ss);
            const float rs = rsqrtf(ss * (1.f / 128.f) + 1e-6f);
            const u16* gp = p.P + (tokb + t) * NP + C_GC + h * 128 + dvb;
            const uint4 g0 = *(const uint4*)gp, g1 = *(const uint4*)(gp + 8);
            const float g[16] = {bflo(g0.x), bfhi(g0.x), bflo(g0.y), bfhi(g0.y), bflo(g0.z), bfhi(g0.z), bflo(g0.w), bfhi(g0.w),
                                 bflo(g1.x), bfhi(g1.x), bflo(g1.y), bfhi(g1.y), bflo(g1.z), bfhi(g1.z), bflo(g1.w), bfhi(g1.w)};
            float r[16];
#pragma unroll
            for (int e = 0; e < 16; ++e) r[e] = o[e] * rs * p.gnw[(size_t)l * 128 + dvb + e] * siluf_(g[e]);
            u32x4 w0, w1; w0.x = cvt_pk_bf16(r[0], r[1]); w0.y = cvt_pk_bf16(r[2], r[3]); w0.z = cvt_pk_bf16(r[4], r[5]); w0.w = cvt_pk_bf16(r[6], r[7]);
            w1.x = cvt_pk_bf16(r[8], r[9]); w1.y = cvt_pk_bf16(r[10], r[11]); w1.z = cvt_pk_bf16(r[12], r[13]); w1.w = cvt_pk_bf16(r[14], r[15]);
            u16* op = p.H + (tokb + t) * DM + 1536 + h * 128 + dvb;
            *(u32x4*)op = w0; *(u32x4*)(op + 8) = w1; }
        __syncthreads();
    }
}

constexpr int N_PHASES = 11;
__device__ __forceinline__ void run_phase(const Params& p, int ph, LAS unsigned char* lds, int bid, int nb) {
    if (ph == 0) {
        for (int l = 0; l < 2; ++l) {
            transpose_cvt(lds, p.w_in + (size_t)l * DM * DIN, p.WtIn + (size_t)l * NP * DM, DM, DIN, NP, bid, nb);
            transpose_cvt(lds, p.w_out + (size_t)l * DM * DM, p.WtOut + (size_t)l * DM * DM, DM, DM, DM, bid, nb);
            transpose_cvt(lds, p.w2 + (size_t)l * 64 * 1024, p.W2t + (size_t)l * 1024 * 64, 64, 1024, 1024, bid, nb);
            transpose_cvt(lds, p.a2 + (size_t)l * 64 * 1024, p.A2t + (size_t)l * 1024 * 64, 64, 1024, 1024, bid, nb);
        }
        rmsnorm_phase(p.x, p.norm_w, p.H, nullptr, bid, nb);
        return;
    }
    const int l = (ph - 1) / 5, s = (ph - 1) % 5;
    if (s == 0) {
        Gemm g; g.A = p.H; g.Bt = p.WtIn + (size_t)l * NP * DM; g.M = MTOK; g.N = NP; g.K = DM;
        StaticOrder S; S.init(MTOK, NP, nb, bid);
        EpiP E; E.O = p.P; E.ldc = NP;
#ifndef SKIP_GEMM
        gemm_phase<EpiP, StaticOrder, false>(lds, g, S, E, nullptr);
#endif
    } else if (s == 1) {
        kmean_phase(p, lds, bid, nb);
#ifndef SKIP_RWKV
        rwkv_scan_phase(p, l, lds, bid, nb);
#endif
    } else if (s == 2) {
        for (int tk = bid; tk < 32 + 512 + 8192; tk += nb) {
            if (tk < 32) {
#ifndef SKIP_GLA
                gla_task(p, l, lds, tk);
#endif
            } else if (tk < 544) {
#ifndef SKIP_MOBA
                moba_task(p, lds, tk - 32);
#endif
            }
            else rwkv_post_item(p, l, tk - 544);
        }
    } else if (s == 3) {
        Gemm g; g.A = p.H; g.Bt = p.WtOut + (size_t)l * DM * DM; g.M = MTOK; g.N = DM; g.K = DM;
        StaticOrder S; S.init(MTOK, DM, nb, bid);
        EpiRes E; E.R = (l == 0) ? p.x : p.out; E.C = p.out; E.ldc = DM;
#ifndef SKIP_GEMM
        gemm_phase<EpiRes, StaticOrder, false>(lds, g, S, E, nullptr);
#endif
    } else {
        if (l == 0) rmsnorm_phase(p.out, p.norm_w + DM, p.H, nullptr, bid, nb);
        else rmsnorm_phase(p.out, p.fnw, nullptr, p.out, bid, nb);
    }
}

__global__ void __launch_bounds__(512, 2) hybrid_fwd(Params p) {
    extern __shared__ __attribute__((aligned(16))) unsigned char shm[];
    LAS unsigned char* lds = (LAS unsigned char*)shm;
    const int bid = blockIdx.x, nb = gridDim.x;
#if defined(TEST_GEMM)
    { Gemm g; g.A = p.H; g.Bt = p.WtIn; g.M = MTOK; g.N = NP; g.K = DM;
      StaticOrder S; S.init(MTOK, NP, nb, bid);
      EpiP E; E.O = p.P; E.ldc = NP;
      gemm_phase<EpiP, StaticOrder, false>(lds, g, S, E, nullptr);
#if TEST_GEMM >= 2
      if (p.phase_lo) {
      Gemm g2; g2.A = p.H; g2.Bt = p.WtOut; g2.M = MTOK; g2.N = DM; g2.K = DM;
      StaticOrder S2; S2.init(MTOK, DM, nb, bid);
      EpiRes E2; E2.R = p.x; E2.C = p.out; E2.ldc = DM;
      gemm_phase<EpiRes, StaticOrder, false>(lds, g2, S2, E2, nullptr); }
#endif
    }
#elif ONE_LAUNCH
    cg::grid_group grid = cg::this_grid();
    for (int ph = p.phase_lo; ph < p.phase_hi; ++ph) {
        run_phase(p, ph, lds, bid, nb);
        if (ph + 1 < p.phase_hi) grid.sync();
    }
#else
    run_phase(p, p.phase_lo, lds, bid, nb);
#endif
}

extern "C" void kernel_launch(void* const* d_in, const int* in_sizes, int n_in, void* d_out, int out_size, void* d_ws, size_t ws_size, hipStream_t stream) {
    static int grid = 0;
    if (grid == 0) {
        int dev = 0, cus = 0, per_cu = 0;
        hipGetDevice(&dev);
        hipDeviceGetAttribute(&cus, hipDeviceAttributeMultiprocessorCount, dev);
        hipFuncSetAttribute((const void*)hybrid_fwd, hipFuncAttributeMaxDynamicSharedMemorySize, LDS_BYTES);
        hipOccupancyMaxActiveBlocksPerMultiprocessor(&per_cu, (const void*)hybrid_fwd, 512, LDS_BYTES);
        if (per_cu < 1) { fprintf(stderr, "kernel_launch: occupancy query says %d blocks per CU\n", per_cu); per_cu = 1; }
        (void)hipGetLastError();
        grid = cus;
    }
    Params p{};
    const float* const* in = (const float* const*)d_in;
    p.x = in[0]; p.norm_w = in[1]; p.w_in = in[2]; p.w_out = in[3]; p.mu = in[4]; p.w0 = in[5]; p.w2 = in[6]; p.a0 = in[7]; p.a2 = in[8];
    p.k_k = in[9]; p.k_a = in[10]; p.r_k = in[11]; p.ln_w = in[12]; p.ln_b = in[13]; p.a_up = in[14]; p.a_b = in[15]; p.gnw = in[16]; p.fnw = in[17];
    p.out = (float*)d_out;
    unsigned char* ws = (unsigned char*)d_ws; size_t off = 0;
    auto take = [&](size_t bytes) { unsigned char* r = ws + off; off += (bytes + 255) & ~(size_t)255; return r; };
    p.WtIn = (u16*)take((size_t)2 * NP * DM * 2); p.WtOut = (u16*)take((size_t)2 * DM * DM * 2);
    p.W2t = (u16*)take((size_t)2 * 1024 * 64 * 2); p.A2t = (u16*)take((size_t)2 * 1024 * 64 * 2);
    p.H = (u16*)take((size_t)MTOK * DM * 2); p.P = (u16*)take((size_t)MTOK * NP * 2);
    p.yraw = (float*)take((size_t)MTOK * 1024 * 4); p.ybonus = (float*)take((size_t)MTOK * 16 * 4); p.kmean = (float*)take((size_t)256 * 128 * 4);
    if (off > ws_size) { fprintf(stderr, "kernel_launch: workspace too small (%zu > %zu)\n", off, ws_size); return; }
#if ONE_LAUNCH
    p.phase_lo = 0; p.phase_hi = N_PHASES;
    void* args[] = {&p};
    hipError_t e = hipLaunchCooperativeKernel((const void*)hybrid_fwd, dim3(grid), dim3(512), args, LDS_BYTES, stream);
    if (e != hipSuccess) fprintf(stderr, "cooperative launch failed: %s (grid %d)\n", hipGetErrorString(e), grid);
#else
    for (int ph = 0; ph < N_PHASES; ++ph) { p.phase_lo = ph; p.phase_hi = ph + 1; hipLaunchKernelGGL(hybrid_fwd, dim3(grid), dim3(512), LDS_BYTES, stream, p); }
#endif
}
```

```cpp
#include <hip/hip_runtime.h>
#include <hip/hip_cooperative_groups.h>
#include <cstdio>
namespace cg = cooperative_groups;

#ifndef ONE_LAUNCH
#define ONE_LAUNCH 1
#endif

namespace pg8 {
#define PG8_LAS __attribute__((address_space(3)))
typedef unsigned short bf16_t;
typedef short bf16x8 __attribute__((ext_vector_type(8)));
typedef float f32x4 __attribute__((ext_vector_type(4)));
typedef unsigned u32x4 __attribute__((ext_vector_type(4)));
constexpr int BM = 256, BK = 64, HALF = 128, HTB = HALF * BK * 2  , STAGE_BYTES = 8 * HTB, NXCD = 8, WGM = 8;

__host__ __device__ __forceinline__ int lds_byte(int r, int c) { const int st = (r >> 4) * 2 + (c >> 5), rr = r & 15, cc = c & 31, ob = rr * 64 + cc * 2; return st * 1024 + (ob ^ (((ob >> 9) & 1) << 5)); }
__host__ __device__ __forceinline__ void stage_rc(int b, int& R, int& C) { const int st = b / 1024, sb = b % 1024, swz = sb ^ (((sb >> 9) & 1) << 5); R = (st >> 1) * 16 + swz / 64; C = (st & 1) * 32 + (swz % 64) / 2; }
__host__ __device__ __forceinline__ int perm32(int rho) { const int n = rho >> 4, i = rho & 15; return 8 * (i >> 2) + 4 * n + (i & 3); }

struct Unit { int pm, pn; };
struct Gemm { const bf16_t* A; const bf16_t* Bt; int M, N, K; };

struct StaticOrder {
    int nM, nN, nwg, G, c;
    __host__ __device__ void init(int M, int N, int G_, int c_) { nM = M / BM; nN = N / BM; nwg = nM * nN; G = G_; c = c_; }
    __host__ __device__ bool next(int i, Unit& u) const {
        const long L = (long)i * G + c; if (L >= nwg) return false;
        int wgid = (int)L; { const int q = nwg / NXCD, r = nwg % NXCD, xcd = wgid % NXCD, off = wgid / NXCD; wgid = (xcd < r ? xcd * (q + 1) : r * (q + 1) + (xcd - r) * q) + off; }
        const int nig = WGM * nN, gid = wgid / nig, fm = gid * WGM, gsz = (nM - fm) < WGM ? (nM - fm) : WGM;
        u.pm = fm + ((wgid % nig) % gsz); u.pn = (wgid % nig) / gsz; return true;
    }
    __device__ __forceinline__ void a_ready(const Unit&) const {}
    __device__ __forceinline__ void done(const Unit&) const {}
};
__device__ __forceinline__ unsigned cvt_pk_bf16(float lo, float hi) { unsigned r; asm volatile("v_cvt_pk_bf16_f32 %0, %1, %2" : "=v"(r) : "v"(lo), "v"(hi)); return r; }
template <class Epi, class Sched, bool STAMP = false>
__device__ __forceinline__ void gemm_phase(PG8_LAS unsigned char* lds, const Gemm g, const Sched& S, const Epi& E, unsigned long long* stamps) {
    int tid = threadIdx.x; asm volatile("" : "+v"(tid)); const int wid = __builtin_amdgcn_readfirstlane(tid >> 6), lane = tid & 63, wr = wid >> 2, wc = wid & 3, fr = lane & 15, fq = lane >> 4;
    const int K = g.K, nt = K / BK;
    int ts_lo = 0, ts_hi = 0, nts = 0; const unsigned long long rt_entry = STAMP ? (unsigned long long)wall_clock64() : 0ull;
#define PG8_STAMP() do { if (STAMP && wid == 0 && nts < 64) { const unsigned long long _c = (unsigned long long)clock64(); \
        ts_lo = (lane == nts) ? (int)(unsigned)_c : ts_lo; ts_hi = (lane == nts) ? (int)(unsigned)(_c >> 32) : ts_hi; ++nts; } } while (0)
    PG8_STAMP();
    unsigned voffA[2], voffB[2];
#pragma unroll
    for (int i = 0; i < 2; ++i) { int R, C; stage_rc(tid * 16 + i * 8192, R, C); const int Rb = Epi::PERM ? ((R & ~31) + perm32(R & 31)) : R;
        voffA[i] = (unsigned)(R * K + C) * 2u; voffB[i] = (unsigned)(Rb * K + C) * 2u; }
    const size_t kstep = (size_t)(BK * 2);
    const size_t hstep = (size_t)HALF * K * 2;
    const size_t tstep = 2 * hstep;
    const unsigned ldsw = (unsigned)wid * 1024u;
    const int aoff = lds_byte(wr * 64 + fr, fq * 8), boff = lds_byte(wc * 32 + fr, fq * 8);
#define PG8_SA(b, h) (((b) * 2 + (h)) * HTB)
#define PG8_SB(b, h) ((4 + (b) * 2 + (h)) * HTB)
#define PG8_STAGE(bufoff, gbase, voff) do { _Pragma("unroll") for (int _i = 0; _i < 2; ++_i) \
        __builtin_amdgcn_global_load_lds((const unsigned*)((const char*)(gbase) + (voff)[_i]), (PG8_LAS unsigned*)(lds + (bufoff) + ldsw + _i * 8192), 16, 0, 0); } while (0)
#define PG8_LDA(dst, b, h) do { _Pragma("unroll") for (int m = 0; m < 4; ++m) _Pragma("unroll") for (int k = 0; k < 2; ++k) dst[m][k] = *(const PG8_LAS bf16x8*)(lds + PG8_SA(b, h) + aoff + m * 2048 + k * 1024); } while (0)
#define PG8_LDB(dst, b, h) do { _Pragma("unroll") for (int n = 0; n < 2; ++n) _Pragma("unroll") for (int k = 0; k < 2; ++k) dst[n][k] = *(const PG8_LAS bf16x8*)(lds + PG8_SB(b, h) + boff + n * 2048 + k * 1024); } while (0)
#define PG8_MMA(ai, bj, At, Bt) do { __builtin_amdgcn_s_setprio(1); _Pragma("unroll") for (int m = 0; m < 4; ++m) _Pragma("unroll") for (int n = 0; n < 2; ++n) _Pragma("unroll") for (int k = 0; k < 2; ++k) \
        acc[ai][bj][m][n] = __builtin_amdgcn_mfma_f32_16x16x32_bf16(Bt[n][k], At[m][k], acc[ai][bj][m][n], 0, 0, 0); __builtin_amdgcn_s_setprio(0); } while (0)
#define PG8_WAIT_V(n) asm volatile("s_waitcnt vmcnt(" #n ")" ::: "memory")
#define PG8_WAIT_L(n) asm volatile("s_waitcnt lgkmcnt(" #n ")" ::: "memory")
#define PG8_BAR __builtin_amdgcn_s_barrier()
#define PG8_SCHED __builtin_amdgcn_sched_barrier(0)
    Unit cur, nxt; int ui = 0;
    if (!S.next(0, cur)) return;
    f32x4 acc[2][2][4][2];
#pragma unroll
    for (int a = 0; a < 2; ++a)
#pragma unroll
        for (int b = 0; b < 2; ++b)
#pragma unroll
            for (int m = 0; m < 4; ++m)
#pragma unroll
                for (int n = 0; n < 2; ++n) acc[a][b][m][n] = (f32x4){0.f, 0.f, 0.f, 0.f};
    bf16x8 At[4][2], B0[2][2], B1[2][2];
    const char* cA = (const char*)g.A + (size_t)cur.pm * tstep; const char* cB = (const char*)g.Bt + (size_t)cur.pn * tstep;
    S.a_ready(cur);
    PG8_STAGE(PG8_SB(0, 0), cB, voffB); PG8_STAGE(PG8_SA(0, 0), cA, voffA); PG8_STAGE(PG8_SB(0, 1), cB + hstep, voffB); PG8_STAGE(PG8_SA(0, 1), cA + hstep, voffA);
    if (wr == 1) PG8_BAR;
    PG8_WAIT_V(4); PG8_BAR;
    PG8_STAGE(PG8_SB(1, 0), cB + kstep, voffB); PG8_STAGE(PG8_SA(1, 0), cA + kstep, voffA); PG8_STAGE(PG8_SB(1, 1), cB + hstep + kstep, voffB);
    PG8_WAIT_V(6); PG8_BAR;
    PG8_STAMP();
    for (;;) {
        const bool has_next = S.next(ui + 1, nxt);
        const char* nA = has_next ? (const char*)g.A + (size_t)nxt.pm * tstep : cA; const char* nB = has_next ? (const char*)g.Bt + (size_t)nxt.pn * tstep : cB;
        for (int t = 0; t < nt; t += 2) {
            const bool last = (t == nt - 2);
            const char* a1 = cA + (size_t)(t + 1) * kstep;
            const char* a2 = last ? nA : cA + (size_t)(t + 2) * kstep; const char* b2 = last ? nB : cB + (size_t)(t + 2) * kstep;
            const char* a3 = a2 + kstep; const char* b3 = b2 + kstep;
            if (last && has_next) S.a_ready(nxt);
            PG8_LDB(B0, 0, 0); PG8_SCHED; PG8_LDA(At, 0, 0); PG8_STAGE(PG8_SA(1, 1), a1 + hstep, voffA);
            PG8_WAIT_L(8); PG8_BAR; PG8_WAIT_L(0); PG8_MMA(0, 0, At, B0); PG8_BAR; PG8_SCHED;
            PG8_LDB(B1, 0, 1); PG8_STAGE(PG8_SB(0, 0), b2, voffB);
            PG8_BAR; PG8_WAIT_L(0); PG8_MMA(0, 1, At, B1); PG8_BAR;
            PG8_LDA(At, 0, 1); PG8_STAGE(PG8_SA(0, 0), a2, voffA);
            PG8_BAR; PG8_WAIT_L(0); PG8_MMA(1, 0, At, B0); PG8_BAR; PG8_SCHED;
            PG8_STAGE(PG8_SB(0, 1), b2 + hstep, voffB);
            PG8_WAIT_V(6); PG8_BAR; PG8_MMA(1, 1, At, B1); PG8_BAR;
            PG8_LDB(B0, 1, 0); PG8_SCHED; PG8_LDA(At, 1, 0); PG8_STAGE(PG8_SA(0, 1), a2 + hstep, voffA);
            PG8_WAIT_L(8); PG8_BAR; PG8_WAIT_L(0); PG8_MMA(0, 0, At, B0); PG8_BAR; PG8_SCHED;
            PG8_LDB(B1, 1, 1); PG8_STAGE(PG8_SB(1, 0), b3, voffB);
            PG8_BAR; PG8_WAIT_L(0); PG8_MMA(0, 1, At, B1); PG8_BAR;
            PG8_LDA(At, 1, 1); PG8_STAGE(PG8_SA(1, 0), a3, voffA);
            PG8_BAR; PG8_WAIT_L(0); PG8_MMA(1, 0, At, B0); PG8_BAR; PG8_SCHED;
            PG8_STAGE(PG8_SB(1, 1), b3 + hstep, voffB);
            PG8_WAIT_V(6); PG8_BAR; PG8_MMA(1, 1, At, B1); PG8_BAR;
        }
        PG8_STAMP();
        if constexpr (!Epi::AFTER_DRAIN) { E(acc, cur, wr, wc, fr, fq); S.done(cur); }
        PG8_STAMP();
        if (!has_next) break;
#pragma unroll
        for (int a = 0; a < 2; ++a)
#pragma unroll
            for (int b = 0; b < 2; ++b)
#pragma unroll
                for (int m = 0; m < 4; ++m)
#pragma unroll
                    for (int n = 0; n < 2; ++n) acc[a][b][m][n] = (f32x4){0.f, 0.f, 0.f, 0.f};
        cur = nxt; cA = nA; cB = nB; ++ui;
    }
    PG8_WAIT_V(0);
    if (wr == 0) PG8_BAR;
    PG8_BAR;
    if constexpr (Epi::AFTER_DRAIN) { E.fused(acc, cur, wr, wc, fr, fq, lds, wid, lane); S.done(cur); }
    PG8_STAMP();
    if (STAMP && wid == 0) { stamps[lane] = lane < nts ? (((unsigned long long)(unsigned)ts_hi << 32) | (unsigned)ts_lo) : 0ull;
        if (lane == 62) stamps[62] = rt_entry; if (lane == 63) stamps[63] = (unsigned long long)wall_clock64(); }
#undef PG8_STAMP
#undef PG8_SA
#undef PG8_SB
#undef PG8_STAGE
#undef PG8_LDA
#undef PG8_LDB
#undef PG8_MMA
#undef PG8_WAIT_V
#undef PG8_WAIT_L
#undef PG8_BAR
#undef PG8_SCHED
}
}
using namespace pg8;
#define LAS PG8_LAS
typedef unsigned short u16;
typedef unsigned u32x2 __attribute__((ext_vector_type(2)));

constexpr int NBATCH = 8, SEQ = 2048, DM = 2048, MTOK = NBATCH * SEQ, DIN = 7824, NP = 7936;
constexpr int C_R = 0, C_K = 1024, C_V = 2048, C_WD = 3072, C_GA = 3200, C_QB = 4224, C_KB = 4736, C_VB = 5248, C_GB = 5760,
              C_QC = 6272, C_KC = 6528, C_VC = 6784, C_GC = 7296, C_LOW = 7808;
constexpr int LDS_BYTES = 131072;

struct Params {
    const float *x, *norm_w, *w_in, *w_out, *mu, *w0, *w2, *a0, *a2, *k_k, *k_a, *r_k, *ln_w, *ln_b, *a_up, *a_b, *gnw, *fnw;
    float* out;
    u16 *WtIn, *WtOut, *W2t, *A2t, *H, *P;
    float *yraw, *ybonus, *kmean;
    unsigned* bar;
    int phase_lo, phase_hi;
};

__device__ __forceinline__ int tid_() { int t = threadIdx.x; asm volatile("" : "+v"(t)); return t; }
__device__ __forceinline__ float bf2f(u16 v) { return __uint_as_float(((unsigned)v) << 16); }
__device__ __forceinline__ float bflo(unsigned w) { return __uint_as_float(w << 16); }
__device__ __forceinline__ float bfhi(unsigned w) { return __uint_as_float(w & 0xffff0000u); }
__device__ __forceinline__ u16 f2bf(float f) { return (u16)(cvt_pk_bf16(f, 0.f) & 0xffffu); }
template <int CTRL> __device__ __forceinline__ float dpp_f(float v) { return __int_as_float(__builtin_amdgcn_update_dpp(0, __float_as_int(v), CTRL, 0xF, 0xF, true)); }
__device__ __forceinline__ float red16_sum(float v) { v += dpp_f<0xB1>(v); v += dpp_f<0x4E>(v); v += dpp_f<0x141>(v); v += dpp_f<0x140>(v); return v; }
__device__ __forceinline__ float red8_sum(float v) { v += dpp_f<0xB1>(v); v += dpp_f<0x4E>(v); v += dpp_f<0x141>(v); return v; }
__device__ __forceinline__ float red16_max(float v) { v = fmaxf(v, dpp_f<0xB1>(v)); v = fmaxf(v, dpp_f<0x4E>(v)); v = fmaxf(v, dpp_f<0x141>(v)); v = fmaxf(v, dpp_f<0x140>(v)); return v; }
__device__ __forceinline__ float wave_sum(float v) {
#pragma unroll
    for (int o = 1; o < 64; o <<= 1) v += __shfl_xor(v, o);
    return v;
}
__device__ __forceinline__ float sigmoidf_(float x) { return 1.f / (1.f + __expf(-x)); }
__device__ __forceinline__ float siluf_(float x) { return x / (1.f + __expf(-x)); }
__device__ __forceinline__ float logsigmoidf_(float z) { return fminf(z, 0.f) - log1pf(__expf(-fabsf(z))); }
__device__ __forceinline__ f32x4 mfma16(bf16x8 a, bf16x8 b, f32x4 c) { return __builtin_amdgcn_mfma_f32_16x16x32_bf16(a, b, c, 0, 0, 0); }

struct EpiP {
    static constexpr bool PERM = true, AFTER_DRAIN = false;
    bf16_t* O; int ldc;
    __device__ __forceinline__ void operator()(const f32x4 (&acc)[2][2][4][2], const Unit& u, int wr, int wc, int fr, int fq) const {
        const int row0 = u.pm * BM + wr * 64 + fr, col0 = u.pn * BM + wc * 32 + 8 * fq;
#pragma unroll
        for (int ai = 0; ai < 2; ++ai)
#pragma unroll
            for (int m = 0; m < 4; ++m) { bf16_t* rowp = O + (size_t)(row0 + ai * HALF + m * 16) * ldc + col0;
#pragma unroll
                for (int bj = 0; bj < 2; ++bj) { const f32x4 v0 = acc[ai][bj][m][0], v1 = acc[ai][bj][m][1];
                    u32x4 w; w.x = cvt_pk_bf16(v0[0], v0[1]); w.y = cvt_pk_bf16(v0[2], v0[3]); w.z = cvt_pk_bf16(v1[0], v1[1]); w.w = cvt_pk_bf16(v1[2], v1[3]);
                    *(u32x4*)(rowp + bj * HALF) = w; } }
    }
};
struct EpiRes {
    static constexpr bool PERM = false, AFTER_DRAIN = false;
    const float* R; float* C; int ldc;
    __device__ __forceinline__ void operator()(const f32x4 (&acc)[2][2][4][2], const Unit& u, int wr, int wc, int fr, int fq) const {
        const int row0 = u.pm * BM + wr * 64 + fr, col0 = u.pn * BM + wc * 32 + 4 * fq;
#pragma unroll
        for (int ai = 0; ai < 2; ++ai)
#pragma unroll
            for (int m = 0; m < 4; ++m) { const size_t off = (size_t)(row0 + ai * HALF + m * 16) * ldc + col0;
#pragma unroll
                for (int bj = 0; bj < 2; ++bj)
#pragma unroll
                    for (int n = 0; n < 2; ++n) { const f32x4 r = *(const f32x4*)(R + off + bj * HALF + n * 16); *(f32x4*)(C + off + bj * HALF + n * 16) = acc[ai][bj][m][n] + r; }
                asm volatile("" ::: "memory"); }
    }
};

__device__ void transpose_cvt(LAS unsigned char* lds, const float* src, u16* dst, int K, int N, int Npad, int bid, int nb) {
    LAS float* tile = (LAS float*)lds;
    const int tilesN = Npad / 64, tilesK = K / 64, tid = tid_();
    for (int t = bid; t < tilesN * tilesK; t += nb) {
        const int tn = t % tilesN, tk = t / tilesN, n0 = tn * 64, k0 = tk * 64;
#pragma unroll
        for (int i = 0; i < 2; ++i) { const int idx = tid + i * 512, kk = idx >> 4, n4 = (idx & 15) * 4;
            float4 v = make_float4(0.f, 0.f, 0.f, 0.f);
            if (n0 + n4 < N) v = *(const float4*)(src + (size_t)(k0 + kk) * N + n0 + n4);
            tile[(n4 + 0) * 65 + kk] = v.x; tile[(n4 + 1) * 65 + kk] = v.y; tile[(n4 + 2) * 65 + kk] = v.z; tile[(n4 + 3) * 65 + kk] = v.w; }
        __syncthreads();
        { const int n = tid >> 3, k8 = (tid & 7) * 8; const LAS float* r = tile + n * 65 + k8;
            u32x4 o; o.x = cvt_pk_bf16(r[0], r[1]); o.y = cvt_pk_bf16(r[2], r[3]); o.z = cvt_pk_bf16(r[4], r[5]); o.w = cvt_pk_bf16(r[6], r[7]);
            *(u32x4*)(dst + (size_t)(n0 + n) * K + k0 + k8) = o; }
        __syncthreads();
    }
}

__device__ void rmsnorm_phase(const float* x, const float* w, u16* hb, float* of, int bid, int nb) {
    const int tid0 = tid_(), wid = tid0 >> 6, lane = tid0 & 63;
    for (int row = bid * 8 + wid; row < MTOK; row += nb * 8) {
        const float4* xr = (const float4*)(x + (size_t)row * DM);
        float4 v[8]; float s = 0.f;
#pragma unroll
        for (int i = 0; i < 8; ++i) { v[i] = xr[i * 64 + lane]; s += v[i].x * v[i].x + v[i].y * v[i].y + v[i].z * v[i].z + v[i].w * v[i].w; }
        s = wave_sum(s);
        const float rs = rsqrtf(s * (1.f / DM) + 1e-6f);
#pragma unroll
        for (int i = 0; i < 8; ++i) { const float4 wv = ((const float4*)w)[i * 64 + lane];
            const float a = v[i].x * rs * wv.x, b = v[i].y * rs * wv.y, c = v[i].z * rs * wv.z, d = v[i].w * rs * wv.w;
            if (hb) { uint2 o; o.x = cvt_pk_bf16(a, b); o.y = cvt_pk_bf16(c, d); *(uint2*)(hb + (size_t)row * DM + (i * 64 + lane) * 4) = o; }
            else { ((float4*)(of + (size_t)row * DM))[i * 64 + lane] = make_float4(a, b, c, d); } }
    }
}

__device__ void kmean_phase(const Params& p, LAS unsigned char* lds, int bid, int nb) {
    LAS float* part = (LAS float*)lds;
    const int tid = tid_();
    for (int task = bid; task < 256; task += nb) {
        const int b = task >> 5, h = (task >> 3) & 3, blk = task & 7;
        const int d8 = (tid & 15) * 8, kg = tid >> 4;
        float s[8];
#pragma unroll
        for (int e = 0; e < 8; ++e) s[e] = 0.f;
        for (int kk = 0; kk < 8; ++kk) {
            const int tok = b * SEQ + blk * 256 + kg * 8 + kk;
            const uint4 v = *(const uint4*)(p.P + (size_t)tok * NP + C_KB + h * 128 + d8);
            s[0] += bflo(v.x); s[1] += bfhi(v.x); s[2] += bflo(v.y); s[3] += bfhi(v.y); s[4] += bflo(v.z); s[5] += bfhi(v.z); s[6] += bflo(v.w); s[7] += bfhi(v.w);
        }
        __syncthreads();
#pragma unroll
        for (int e = 0; e < 8; ++e) part[kg * 128 + d8 + e] = s[e];
        __syncthreads();
        if (tid < 128) { float a = 0.f; for (int g = 0; g < 32; ++g) a += part[g * 128 + tid]; p.kmean[(size_t)task * 128 + tid] = a * (1.f / 256.f); }
    }
    __syncthreads();
}

constexpr int RW_T = 32;
constexpr int RW_RAW = 0, RW_A1 = 21504, RW_A2 = 26112, RW_OPW = 30720, RW_OPA = 38912, RW_OPB = 47104, RW_OPK = 55296, RW_OPR = 63488,
              RW_KS = 71680, RW_AS = 79872, RW_OPV = 88064, RW_YB = 92160, RW_MU = 96256, RW_PAR = 97536;
__device__ __forceinline__ void rw_issue(const Params& p, int tid, int b, int h, int t0, u32x4 (&rg)[3]) {
#pragma unroll
    for (int i = 0; i < 3; ++i) { const int piece = tid + 512 * i; rg[i] = (u32x4){0u, 0u, 0u, 0u};
        if (piece < 33 * 40) { const int row = piece / 40, pc = piece % 40; const int t = t0 - 1 + row;
            const int col = pc < 8 ? C_R + h * 64 + pc * 8 : pc < 16 ? C_K + h * 64 + (pc - 8) * 8 : pc < 24 ? C_V + h * 64 + (pc - 16) * 8 : C_WD + (pc - 24) * 8;
            if (t >= 0) rg[i] = *(const u32x4*)(p.P + (size_t)(b * SEQ + t) * NP + col); } }
}
__device__ void rwkv_scan_phase(const Params& p, int l, LAS unsigned char* lds, int bid, int nb) {
    const int tid = tid_(), wid = tid >> 6, lane = tid & 63, row = tid >> 4, sub = tid & 15;
    LAS u16* raw = (LAS u16*)(lds + RW_RAW); LAS u16* A1 = (LAS u16*)(lds + RW_A1); LAS u16* A2 = (LAS u16*)(lds + RW_A2);
    LAS float* opW = (LAS float*)(lds + RW_OPW); LAS float* opA = (LAS float*)(lds + RW_OPA); LAS float* opB = (LAS float*)(lds + RW_OPB);
    LAS float* opK = (LAS float*)(lds + RW_OPK); LAS float* opR = (LAS float*)(lds + RW_OPR); LAS float* kS = (LAS float*)(lds + RW_KS);
    LAS float* aS = (LAS float*)(lds + RW_AS); LAS float* opV = (LAS float*)(lds + RW_OPV); LAS float* yb = (LAS float*)(lds + RW_YB);
    LAS float* muS = (LAS float*)(lds + RW_MU); LAS float* parS = (LAS float*)(lds + RW_PAR);
    for (int task = bid; task < 256; task += nb) {
        const int b = task >> 5, h = (task >> 1) & 15, half = task & 1;
        __syncthreads();
        if (tid < 320) { const int c = tid; const int mi = c < 64 ? h * 64 + c : c < 128 ? 1024 + h * 64 + (c - 64) : c < 192 ? 2048 + h * 64 + (c - 128) : 3072 + (c - 192);
            muS[c] = p.mu[(size_t)l * 3200 + mi]; }
        if (tid >= 320 && tid < 384) { const int c = tid - 320; const size_t o = (size_t)l * 1024 + h * 64 + c;
            parS[c] = p.w0[o]; parS[64 + c] = p.a0[o]; parS[128 + c] = p.k_k[o]; parS[192 + c] = p.k_a[o]; parS[256 + c] = p.r_k[o]; }
        const int mat = wid >> 2, ct = wid & 3;
        bf16x8 bfr[2];
        { const u16* Bt = (mat ? p.A2t : p.W2t) + (size_t)l * 1024 * 64 + (size_t)(h * 64 + ct * 16 + (lane & 15)) * 64 + (lane >> 4) * 8;
            bfr[0] = *(const bf16x8*)(Bt); bfr[1] = *(const bf16x8*)(Bt + 32); }
        float S0 = 0.f, S1 = 0.f, S2 = 0.f, S3 = 0.f;
        u32x4 rg[3];
        rw_issue(p, tid, b, h, 0, rg);
        for (int c = 0; c < SEQ / RW_T; ++c) {
            const int t0 = c * RW_T;
#pragma unroll
            for (int i = 0; i < 3; ++i) { const int piece = tid + 512 * i; if (piece < 33 * 40) *(LAS u32x4*)(raw + (piece / 40) * 320 + (piece % 40) * 8) = rg[i]; }
            __syncthreads();
            if (c + 1 < SEQ / RW_T) rw_issue(p, tid, b, h, t0 + RW_T, rg);
            for (int i = 0; i < 20; ++i) { const int e = tid + 512 * i, t = e / 320, cc = e % 320;
                const float cur = bf2f(raw[(t + 1) * 320 + cc]), prv = bf2f(raw[t * 320 + cc]);
                const float xs = cur + muS[cc] * (prv - cur);
                if (cc < 64) opR[t * 64 + cc] = xs;
                else if (cc < 128) kS[t * 64 + cc - 64] = xs;
                else if (cc < 192) { const int v = cc - 128; if ((v >> 5) == half) opV[t * 32 + (v & 31)] = xs; }
                else if (cc < 256) { const float e2 = __expf(2.f * xs); A1[t * 72 + cc - 192] = f2bf(1.f - 2.f / (e2 + 1.f)); }
                else A2[t * 72 + cc - 256] = f2bf(xs); }
            __syncthreads();
            { LAS u16* Ab = mat ? A2 : A1;
#pragma unroll
                for (int rt = 0; rt < 2; ++rt) { f32x4 acc = {0.f, 0.f, 0.f, 0.f};
#pragma unroll
                    for (int ks = 0; ks < 2; ++ks) { const bf16x8 af = *(const LAS bf16x8*)(Ab + (rt * 16 + (lane & 15)) * 72 + ks * 32 + (lane >> 4) * 8); acc = mfma16(af, bfr[ks], acc); }
                    const int cc = ct * 16 + (lane & 15);
#pragma unroll
                    for (int i = 0; i < 4; ++i) { const int t = rt * 16 + (lane >> 4) * 4 + i;
                        if (mat == 0) { float wv = parS[cc] + acc[i]; wv = fminf(wv, 0.f) - log1pf(__expf(-fabsf(wv))) - 0.5f; opW[t * 64 + cc] = __expf(-__expf(wv)); }
                        else aS[t * 64 + cc] = sigmoidf_(parS[64 + cc] + acc[i]); } } }
            __syncthreads();
            { const int t = row, c4 = sub * 4;
                const f32x4 kr = *(const LAS f32x4*)(kS + t * 64 + c4), av = *(const LAS f32x4*)(aS + t * 64 + c4), rr = *(const LAS f32x4*)(opR + t * 64 + c4);
                const f32x4 kkp = *(const LAS f32x4*)(parS + 128 + c4), kap = *(const LAS f32x4*)(parS + 192 + c4), rkp = *(const LAS f32x4*)(parS + 256 + c4);
                f32x4 kk = kr * kkp;
                float ss = kk.x * kk.x + kk.y * kk.y + kk.z * kk.z + kk.w * kk.w; ss = red16_sum(ss);
                const float inv = rsqrtf(fmaxf(ss, 1e-24f));
                kk.x *= inv; kk.y *= inv; kk.z *= inv; kk.w *= inv;
                const f32x4 km = kr * (1.f + (av - 1.f) * kap);
                *(LAS f32x4*)(opA + t * 64 + c4) = -kk;
                *(LAS f32x4*)(opB + t * 64 + c4) = kk * av;
                *(LAS f32x4*)(opK + t * 64 + c4) = km;
                float bo = rr.x * km.x * rkp.x + rr.y * km.y * rkp.y + rr.z * km.z * rkp.z + rr.w * km.w * rkp.w; bo = red16_sum(bo);
                if (half == 0 && sub == 0) p.ybonus[(size_t)(b * SEQ + t0 + t) * 16 + h] = bo; }
            __syncthreads();
#pragma unroll 4
            for (int t = 0; t < RW_T; ++t) {
                const f32x4 w = *(const LAS f32x4*)(opW + t * 64 + sub * 4), a = *(const LAS f32x4*)(opA + t * 64 + sub * 4), bb = *(const LAS f32x4*)(opB + t * 64 + sub * 4);
                const f32x4 kk = *(const LAS f32x4*)(opK + t * 64 + sub * 4), rr = *(const LAS f32x4*)(opR + t * 64 + sub * 4);
                const float vv = opV[t * 32 + row];
                float sa = S0 * a.x + S1 * a.y + S2 * a.z + S3 * a.w; sa = red16_sum(sa);
                S0 = S0 * w.x + sa * bb.x + vv * kk.x; S1 = S1 * w.y + sa * bb.y + vv * kk.y; S2 = S2 * w.z + sa * bb.z + vv * kk.z; S3 = S3 * w.w + sa * bb.w + vv * kk.w;
                float y = S0 * rr.x + S1 * rr.y + S2 * rr.z + S3 * rr.w; y = red16_sum(y);
                if (sub == 0) yb[t * 32 + row] = y;
            }
            __syncthreads();
            if (tid < 256) { const int t = tid >> 3, r4 = (tid & 7) * 4;
                *(f32x4*)(p.yraw + (size_t)(b * SEQ + t0 + t) * 1024 + h * 64 + half * 32 + r4) = *(const LAS f32x4*)(yb + t * 32 + r4); }
        }
    }
    __syncthreads();
}

__device__ void rwkv_post_item(const Params& p, int l, int item) {
    const int tid = tid_(), pair = item * 32 + (tid >> 4), tok = pair >> 4, h = pair & 15, c4 = (tid & 15) * 4;
    const float4 y = *(const float4*)(p.yraw + (size_t)tok * 1024 + h * 64 + c4);
    const float mean = red16_sum(y.x + y.y + y.z + y.w) * (1.f / 64.f);
    const float d0 = y.x - mean, d1 = y.y - mean, d2 = y.z - mean, d3 = y.w - mean;
    const float var = red16_sum(d0 * d0 + d1 * d1 + d2 * d2 + d3 * d3) * (1.f / 64.f);
    const float rs = rsqrtf(var + 64e-5f);
    const size_t po = (size_t)l * 1024 + h * 64 + c4;
    const float4 lw = *(const float4*)(p.ln_w + po), lb = *(const float4*)(p.ln_b + po), muv = *(const float4*)(p.mu + (size_t)l * 3200 + 2048 + h * 64 + c4);
    const uint2 vc = *(const uint2*)(p.P + (size_t)tok * NP + C_V + h * 64 + c4);
    uint2 vp = make_uint2(0u, 0u);
    if ((tok & (SEQ - 1)) != 0) vp = *(const uint2*)(p.P + (size_t)(tok - 1) * NP + C_V + h * 64 + c4);
    const uint2 gg = *(const uint2*)(p.P + (size_t)tok * NP + C_GA + h * 64 + c4);
    const float bo = p.ybonus[(size_t)tok * 16 + h];
    float v0 = bflo(vc.x), v1 = bfhi(vc.x), v2 = bflo(vc.y), v3 = bfhi(vc.y);
    v0 += muv.x * (bflo(vp.x) - v0); v1 += muv.y * (bfhi(vp.x) - v1); v2 += muv.z * (bflo(vp.y) - v2); v3 += muv.w * (bfhi(vp.y) - v3);
    const float o0 = (d0 * rs * lw.x + lb.x + bo * v0) * siluf_(bflo(gg.x)), o1 = (d1 * rs * lw.y + lb.y + bo * v1) * siluf_(bfhi(gg.x));
    const float o2 = (d2 * rs * lw.z + lb.z + bo * v2) * siluf_(bflo(gg.y)), o3 = (d3 * rs * lw.w + lb.w + bo * v3) * siluf_(bfhi(gg.y));
    uint2 o; o.x = cvt_pk_bf16(o0, o1); o.y = cvt_pk_bf16(o2, o3);
    *(uint2*)(p.H + (size_t)tok * DM + h * 64 + c4) = o;
}

constexpr int MB_K = 0, MB_VT = 17408, MB_PW = 35840, MB_KM = 54272, MB_SEL = 57856, MB_TM = 58368;
__device__ void moba_task(const Params& p, LAS unsigned char* lds, int task) {
    const int tid = tid_(), wid = tid >> 6, lane = tid & 63, l15 = lane & 15, lq = lane >> 4;
    const int qt = 15 - (task >> 5), bh = task & 31, b = bh >> 2, h = bh & 3, qblk = qt >> 1, q0 = qt * 128;
    LAS u16* Kt = (LAS u16*)(lds + MB_K); LAS u16* VT = (LAS u16*)(lds + MB_VT); LAS u16* Pw = (LAS u16*)(lds + MB_PW) + wid * 16 * 72;
    LAS float* kmS = (LAS float*)(lds + MB_KM); LAS int* selS = (LAS int*)(lds + MB_SEL); LAS int* tmS = (LAS int*)(lds + MB_TM);
    __syncthreads();
    for (int i = tid; i < qblk * 128; i += 512) kmS[i] = p.kmean[(size_t)(bh * 8) * 128 + i];
    if (tid == 0) *tmS = 0;
    __syncthreads();
    if (tid < 128) {
        const u16* qp = p.P + (size_t)(b * SEQ + q0 + tid) * NP + C_QB + h * 128;
        float g[7];
#pragma unroll
        for (int j = 0; j < 7; ++j) g[j] = 0.f;
        for (int d8 = 0; d8 < 128; d8 += 8) {
            const uint4 v = *(const uint4*)(qp + d8);
            const float q[8] = {bflo(v.x), bfhi(v.x), bflo(v.y), bfhi(v.y), bflo(v.z), bfhi(v.z), bflo(v.w), bfhi(v.w)};
#pragma unroll
            for (int j = 0; j < 7; ++j) if (j < qblk) {
#pragma unroll
                for (int e = 0; e < 8; ++e) g[j] += q[e] * kmS[j * 128 + d8 + e]; }
        }
        int mask = 0;
#pragma unroll
        for (int r = 0; r < 3; ++r) { float best = -INFINITY; int bi = -1;
#pragma unroll
            for (int j = 0; j < 7; ++j) if (j < qblk && !((mask >> j) & 1) && g[j] > best) { best = g[j]; bi = j; }
            if (bi >= 0) mask |= 1 << bi; }
        mask |= 1 << qblk;
        selS[tid] = mask; atomicOr((int*)tmS, mask);
    }
    __syncthreads();
    const int tmask = *tmS;
    bf16x8 qf[4];
    { const u16* qp = p.P + (size_t)(b * SEQ + q0 + wid * 16 + l15) * NP + C_QB + h * 128 + lq * 8;
#pragma unroll
        for (int ks = 0; ks < 4; ++ks) qf[ks] = *(const bf16x8*)(qp + ks * 32); }
    int rm[4]; int wmask = 0;
#pragma unroll
    for (int i = 0; i < 4; ++i) rm[i] = selS[wid * 16 + lq * 4 + i];
    for (int i = 0; i < 16; ++i) wmask |= selS[wid * 16 + i];
    float m[4], ls[4]; f32x4 O[8];
#pragma unroll
    for (int i = 0; i < 4; ++i) { m[i] = -1e30f; ls[i] = 0.f; }
#pragma unroll
    for (int dt = 0; dt < 8; ++dt) O[dt] = (f32x4){0.f, 0.f, 0.f, 0.f};
    const float scale = 0.08838834764831845f;
    for (int j = 0; j <= qblk; ++j) {
        if (!((tmask >> j) & 1)) continue;
        for (int kt = 0; kt < 4; ++kt) {
            const int key0 = j * 256 + kt * 64;
            if (key0 > q0 + 127) break;
            __syncthreads();
#pragma unroll
            for (int i = 0; i < 2; ++i) { const int piece = tid + 512 * i, key = piece >> 4, d8 = (piece & 15) * 8;
                const u16* src = p.P + (size_t)(b * SEQ + key0 + key) * NP + h * 128 + d8;
                const u32x4 kv = *(const u32x4*)(src + C_KB), vv = *(const u32x4*)(src + C_VB);
                *(LAS u32x4*)(Kt + key * 136 + d8) = kv;
                LAS u16* vt = VT + d8 * 72 + key;
                vt[0] = (u16)(vv.x & 0xffff); vt[72] = (u16)(vv.x >> 16); vt[144] = (u16)(vv.y & 0xffff); vt[216] = (u16)(vv.y >> 16);
                vt[288] = (u16)(vv.z & 0xffff); vt[360] = (u16)(vv.z >> 16); vt[432] = (u16)(vv.w & 0xffff); vt[504] = (u16)(vv.w >> 16); }
            __syncthreads();
            if ((wmask >> j) & 1) {
                f32x4 s[4];
#pragma unroll
                for (int nt = 0; nt < 4; ++nt) { s[nt] = (f32x4){0.f, 0.f, 0.f, 0.f};
#pragma unroll
                    for (int ks = 0; ks < 4; ++ks) { const bf16x8 kf = *(const LAS bf16x8*)(Kt + (nt * 16 + l15) * 136 + ks * 32 + lq * 8); s[nt] = mfma16(qf[ks], kf, s[nt]); } }
#pragma unroll
                for (int i = 0; i < 4; ++i) {
                    const int qpos = q0 + wid * 16 + lq * 4 + i; const bool rsel = (rm[i] >> j) & 1;
                    float mx = -1e30f;
#pragma unroll
                    for (int nt = 0; nt < 4; ++nt) { const int kpos = key0 + nt * 16 + l15;
                        const bool valid = (j == qblk) ? (kpos <= qpos) : rsel;
                        const float sv = valid ? s[nt][i] * scale : -1e30f; s[nt][i] = sv; mx = fmaxf(mx, sv); }
                    mx = red16_max(mx);
                    const float mnew = fmaxf(m[i], mx), alpha = __expf(m[i] - mnew);
                    float rs = 0.f;
#pragma unroll
                    for (int nt = 0; nt < 4; ++nt) { const float pv = s[nt][i] > -1e29f ? __expf(s[nt][i] - mnew) : 0.f; rs += pv; Pw[(lq * 4 + i) * 72 + nt * 16 + l15] = f2bf(pv); }
                    rs = red16_sum(rs);
                    ls[i] = ls[i] * alpha + rs; m[i] = mnew;
#pragma unroll
                    for (int dt = 0; dt < 8; ++dt) O[dt][i] *= alpha;
                }
                __builtin_amdgcn_wave_barrier();
                bf16x8 pf[2];
#pragma unroll
                for (int ks = 0; ks < 2; ++ks) pf[ks] = *(const LAS bf16x8*)(Pw + l15 * 72 + ks * 32 + lq * 8);
#pragma unroll
                for (int dt = 0; dt < 8; ++dt)
#pragma unroll
                    for (int ks = 0; ks < 2; ++ks) { const bf16x8 vf = *(const LAS bf16x8*)(VT + (dt * 16 + l15) * 72 + ks * 32 + lq * 8); O[dt] = mfma16(pf[ks], vf, O[dt]); }
                __builtin_amdgcn_wave_barrier();
            }
        }
    }
#pragma unroll
    for (int i = 0; i < 4; ++i) { const float inv = 1.f / ls[i]; const size_t tok = (size_t)(b * SEQ + q0 + wid * 16 + lq * 4 + i);
#pragma unroll
        for (int dt = 0; dt < 8; ++dt) { const int d = dt * 16 + l15;
            const float g = bf2f(p.P[tok * NP + C_GB + h * 128 + d]);
            p.H[tok * DM + 1024 + h * 128 + d] = f2bf(O[dt][i] * inv * siluf_(g)); } }
}

constexpr int GL_QE = 0, GL_KE = 9216, GL_KDT = 18432, GL_VT = 27648, GL_ATT = 46080, GL_ST = 55296, GL_LA = 73728, GL_TOT = 90112,
              GL_AUP = 92160, GL_LOW = 96256, GL_DEC = 100352, GL_OB = 0;
__device__ void gla_task(const Params& p, int l, LAS unsigned char* lds, int task) {
    const int tid = tid_(), wid = tid >> 6, lane = tid & 63, l15 = lane & 15, lq = lane >> 4;
    const int b = task >> 2, h = task & 3;
    LAS u16* QE = (LAS u16*)(lds + GL_QE); LAS u16* KE = (LAS u16*)(lds + GL_KE); LAS u16* KDT = (LAS u16*)(lds + GL_KDT); LAS u16* VT = (LAS u16*)(lds + GL_VT);
    LAS u16* ATT = (LAS u16*)(lds + GL_ATT); LAS u16* ST = (LAS u16*)(lds + GL_ST); LAS float* LA = (LAS float*)(lds + GL_LA); LAS float* TOT = (LAS float*)(lds + GL_TOT);
    LAS float* AUP = (LAS float*)(lds + GL_AUP); LAS float* LOW = (LAS float*)(lds + GL_LOW); LAS float* DEC = (LAS float*)(lds + GL_DEC); LAS float* OB = (LAS float*)(lds + GL_OB);
    __syncthreads();
    for (int i = tid; i < 1024; i += 512) AUP[i] = p.a_up[(size_t)l * 16 * 256 + (i >> 6) * 256 + h * 64 + (i & 63)];
    for (int i = tid; i < 128 * 72 / 2; i += 512) ((LAS unsigned*)ST)[i] = 0u;
    f32x4 Sacc[4];
#pragma unroll
    for (int c = 0; c < 4; ++c) Sacc[c] = (f32x4){0.f, 0.f, 0.f, 0.f};
    const int rt = wid >> 1, dv0t = (wid & 1) * 4;
    for (int n = 0; n < 32; ++n) {
        const size_t tokb = (size_t)(b * SEQ + n * 64);
        { const int e2 = tid * 2, t = e2 >> 4, r = e2 & 15; const unsigned v = *(const unsigned*)(p.P + (tokb + t) * NP + C_LOW + r); LOW[t * 16 + r] = bflo(v); LOW[t * 16 + r + 1] = bfhi(v); }
        __syncthreads();
        { const int t = tid >> 3, d0 = (tid & 7) * 8;
#pragma unroll 1
            for (int dd = 0; dd < 8; ++dd) { const int d = d0 + dd; float z = p.a_b[(size_t)l * 256 + h * 64 + d];
#pragma unroll
                for (int r = 0; r < 16; ++r) z += LOW[t * 16 + r] * AUP[r * 64 + d];
                LA[t * 64 + d] = logsigmoidf_(z) * (1.f / 16.f); } }
        __syncthreads();
        { float a = 0.f;
#pragma unroll
            for (int tt = 0; tt < 8; ++tt) { a += LA[(wid * 8 + tt) * 64 + lane]; LA[(wid * 8 + tt) * 64 + lane] = a; }
            TOT[wid * 64 + lane] = a; }
        __syncthreads();
        { const int t = tid >> 3, d0 = (tid & 7) * 8, wt = t >> 3;
            const uint4 qv = *(const uint4*)(p.P + (tokb + t) * NP + C_QC + h * 64 + d0), kv = *(const uint4*)(p.P + (tokb + t) * NP + C_KC + h * 64 + d0);
            const float q[8] = {bflo(qv.x), bfhi(qv.x), bflo(qv.y), bfhi(qv.y), bflo(qv.z), bfhi(qv.z), bflo(qv.w), bfhi(qv.w)};
            const float k[8] = {bflo(kv.x), bfhi(kv.x), bflo(kv.y), bfhi(kv.y), bflo(kv.z), bfhi(kv.z), bflo(kv.w), bfhi(kv.w)};
            float qe[8], ke[8], off[8], tot[8];
#pragma unroll
            for (int dd = 0; dd < 8; ++dd) { off[dd] = 0.f; tot[dd] = 0.f; }
#pragma unroll 1
            for (int w2 = 0; w2 < 8; ++w2) { const f32x4 ta = *(const LAS f32x4*)(TOT + w2 * 64 + d0), tb = *(const LAS f32x4*)(TOT + w2 * 64 + d0 + 4);
                const float sel = (w2 < wt) ? 1.f : 0.f;
#pragma unroll
                for (int dd = 0; dd < 4; ++dd) { tot[dd] += ta[dd]; off[dd] += sel * ta[dd]; tot[dd + 4] += tb[dd]; off[dd + 4] += sel * tb[dd]; } }
            const f32x4 la0 = *(const LAS f32x4*)(LA + t * 64 + d0), la1 = *(const LAS f32x4*)(LA + t * 64 + d0 + 4);
#pragma unroll
            for (int dd = 0; dd < 8; ++dd) { const int d = d0 + dd;
                const float bv = (dd < 4 ? la0[dd & 3] : la1[dd & 3]) + off[dd];
                qe[dd] = q[dd] * 0.125f * __expf(bv); ke[dd] = k[dd] * __expf(-bv);
                KDT[d * 72 + t] = f2bf(k[dd] * __expf(tot[dd] - bv));
                if (t == 0) DEC[d] = __expf(tot[dd]); }
            u32x4 o; o.x = cvt_pk_bf16(qe[0], qe[1]); o.y = cvt_pk_bf16(qe[2], qe[3]); o.z = cvt_pk_bf16(qe[4], qe[5]); o.w = cvt_pk_bf16(qe[6], qe[7]);
            *(LAS u32x4*)(QE + t * 72 + d0) = o;
            o.x = cvt_pk_bf16(ke[0], ke[1]); o.y = cvt_pk_bf16(ke[2], ke[3]); o.z = cvt_pk_bf16(ke[4], ke[5]); o.w = cvt_pk_bf16(ke[6], ke[7]);
            *(LAS u32x4*)(KE + t * 72 + d0) = o;
#pragma unroll
            for (int i = 0; i < 2; ++i) { const int piece = tid + 512 * i, tv = piece >> 4, dv8 = (piece & 15) * 8;
                const uint4 vv = *(const uint4*)(p.P + (tokb + tv) * NP + C_VC + h * 128 + dv8);
                LAS u16* vt = VT + dv8 * 72 + tv;
                vt[0] = (u16)(vv.x & 0xffff); vt[72] = (u16)(vv.x >> 16); vt[144] = (u16)(vv.y & 0xffff); vt[216] = (u16)(vv.y >> 16);
                vt[288] = (u16)(vv.z & 0xffff); vt[360] = (u16)(vv.z >> 16); vt[432] = (u16)(vv.w & 0xffff); vt[504] = (u16)(vv.w >> 16); } }
        __syncthreads();
        { bf16x8 af[2];
#pragma unroll
            for (int ks = 0; ks < 2; ++ks) af[ks] = *(const LAS bf16x8*)(QE + (rt * 16 + l15) * 72 + ks * 32 + lq * 8);
#pragma unroll
            for (int c2 = 0; c2 < 2; ++c2) { const int ctile = (wid & 1) * 2 + c2; f32x4 acc = {0.f, 0.f, 0.f, 0.f};
#pragma unroll
                for (int ks = 0; ks < 2; ++ks) { const bf16x8 bf = *(const LAS bf16x8*)(KE + (ctile * 16 + l15) * 72 + ks * 32 + lq * 8); acc = mfma16(af[ks], bf, acc); }
#pragma unroll
                for (int i = 0; i < 4; ++i) { const int t = rt * 16 + lq * 4 + i, jj = ctile * 16 + l15; ATT[t * 72 + jj] = f2bf(jj <= t ? acc[i] : 0.f); } } }
        __syncthreads();
        f32x4 oacc[4];
        { bf16x8 at[2], qf[2], kd[2];
#pragma unroll
            for (int ks = 0; ks < 2; ++ks) { at[ks] = *(const LAS bf16x8*)(ATT + (rt * 16 + l15) * 72 + ks * 32 + lq * 8); qf[ks] = *(const LAS bf16x8*)(QE + (rt * 16 + l15) * 72 + ks * 32 + lq * 8);
                kd[ks] = *(const LAS bf16x8*)(KDT + (rt * 16 + l15) * 72 + ks * 32 + lq * 8); }
            float dec[4];
#pragma unroll
            for (int i = 0; i < 4; ++i) dec[i] = DEC[rt * 16 + lq * 4 + i];
#pragma unroll
            for (int c = 0; c < 4; ++c) { const int dvt = dv0t + c; f32x4 acc = {0.f, 0.f, 0.f, 0.f};
#pragma unroll
                for (int i = 0; i < 4; ++i) Sacc[c][i] *= dec[i];
#pragma unroll
                for (int ks = 0; ks < 2; ++ks) { const bf16x8 vf = *(const LAS bf16x8*)(VT + (dvt * 16 + l15) * 72 + ks * 32 + lq * 8), sf = *(const LAS bf16x8*)(ST + (dvt * 16 + l15) * 72 + ks * 32 + lq * 8);
                    acc = mfma16(at[ks], vf, acc); acc = mfma16(qf[ks], sf, acc); Sacc[c] = mfma16(kd[ks], vf, Sacc[c]); }
                oacc[c] = acc; } }
        __syncthreads();
#pragma unroll
        for (int c = 0; c < 4; ++c) { const int dv = (dv0t + c) * 16 + l15;
#pragma unroll
            for (int i = 0; i < 4; ++i) OB[(rt * 16 + lq * 4 + i) * 132 + dv] = oacc[c][i];
            u32x2 sv; sv.x = cvt_pk_bf16(Sacc[c][0], Sacc[c][1]); sv.y = cvt_pk_bf16(Sacc[c][2], Sacc[c][3]);
            *(LAS u32x2*)(ST + dv * 72 + rt * 16 + lq * 4) = sv; }
        __syncthreads();
        { const int t = tid >> 3, dvb = (tid & 7) * 16; float o[16]; float ss = 0.f;
#pragma unroll
            for (int e = 0; e < 16; ++e) { o[e] = OB[t * 132 + dvb + e]; ss += o[e] * o[e]; }
            ss = red8_sum(ss);
            const float rs = rsqrtf(ss * (1.f / 128.f) + 1e-6f);
            const u16* gp = p.P + (tokb + t) * NP + C_GC + h * 128 + dvb;
            const uint4 g0 = *(const uint4*)gp, g1 = *(const uint4*)(gp + 8);
            const float g[16] = {bflo(g0.x), bfhi(g0.x), bflo(g0.y), bfhi(g0.y), bflo(g0.z), bfhi(g0.z), bflo(g0.w), bfhi(g0.w),
                                 bflo(g1.x), bfhi(g1.x), bflo(g1.y), bfhi(g1.y), bflo(g1.z), bfhi(g1.z), bflo(g1.w), bfhi(g1.w)};
            float r[16];
#pragma unroll
            for (int e = 0; e < 16; ++e) r[e] = o[e] * rs * p.gnw[(size_t)l * 128 + dvb + e] * siluf_(g[e]);
            u32x4 w0, w1; w0.x = cvt_pk_bf16(r[0], r[1]); w0.y = cvt_pk_bf16(r[2], r[3]); w0.z = cvt_pk_bf16(r[4], r[5]); w0.w = cvt_pk_bf16(r[6], r[7]);
            w1.x = cvt_pk_bf16(r[8], r[9]); w1.y = cvt_pk_bf16(r[10], r[11]); w1.z = cvt_pk_bf16(r[12], r[13]); w1.w = cvt_pk_bf16(r[14], r[15]);
            u16* op = p.H + (tokb + t) * DM + 1536 + h * 128 + dvb;
            *(u32x4*)op = w0; *(u32x4*)(op + 8) = w1; }
        __syncthreads();
    }
}

#define XB_TMO      128
#define XB_XCNT(j)  (256  + 64 * (j))
#define XB_XSUB(j)  (1280 + 64 * (j))
#define XB_XGEN(j)  (2304 + 64 * (j))
#define XB_TOP      3328
#define XB_TOPGEN   3392
#define XCD_BAR_WORDS 3456
#define XB_SPIN_CAP (1u << 18)

__device__ __forceinline__ unsigned xb_ld(unsigned* p)              { return __hip_atomic_load(p, __ATOMIC_RELAXED, __HIP_MEMORY_SCOPE_AGENT); }
__device__ __forceinline__ unsigned xb_add(unsigned* p, unsigned v) { return __hip_atomic_fetch_add(p, v, __ATOMIC_RELAXED, __HIP_MEMORY_SCOPE_AGENT); }
__device__ __forceinline__ unsigned xb_xcc_id() { return (unsigned)__builtin_amdgcn_s_getreg((3 << 11) | 20) & 0xFu; }
#define XB_SPIN(cond, bar) do { unsigned _sp = 0; while (cond) { __builtin_amdgcn_s_sleep(1); \
    if ((++_sp & 255u) == 0u) { if (xb_ld(&(bar)[XB_TMO])) break; if (_sp > XB_SPIN_CAP) { atomicAdd(&(bar)[XB_TMO], 1u); break; } } } } while (0)

struct XcdBarrier {
    unsigned* bar; unsigned x;
    volatile LAS unsigned* st;
};

__device__ __forceinline__ XcdBarrier xcd_barrier_post(unsigned* bar, volatile LAS unsigned* st) {
    XcdBarrier b; b.bar = bar; b.x = xb_xcc_id(); b.st = st;
    if (threadIdx.x == 0) (void)xb_add(&bar[XB_XCNT(b.x)], 1u);
    return b;
}
__device__ __forceinline__ void xcd_barrier_complete(unsigned* bar, unsigned x, unsigned& nloc, unsigned& nx) {
    const unsigned G = gridDim.x * gridDim.y * gridDim.z;
    unsigned sum, cnt, mine, sp = 0u;
    for (;;) {
        sum = 0u; cnt = 0u; mine = 0u;
#pragma unroll
        for (unsigned j = 0; j < 16; ++j) { const unsigned c = xb_ld(&bar[XB_XCNT(j)]); sum += c; cnt += (c > 0u) ? 1u : 0u; mine = (j == x) ? c : mine; }
        if (sum == G) break;
        __builtin_amdgcn_s_sleep(1);
        if ((++sp & 255u) == 0u) { if (xb_ld(&bar[XB_TMO])) break; if (sp > XB_SPIN_CAP) { atomicAdd(&bar[XB_TMO], 1u); break; } }
    }
    nloc = mine > 0u ? mine : 1u; nx = cnt > 0u ? cnt : 1u;
}

__device__ __forceinline__ void xcd_barrier(const XcdBarrier& b) {
    asm volatile("s_waitcnt vmcnt(0)" ::: "memory");
    __syncthreads();
    if (threadIdx.x == 0) {
        unsigned* bar = b.bar;
        __builtin_amdgcn_s_waitcnt(0);
        unsigned nloc = b.st[0], nx = b.st[1];
        if (nloc == 0u) { xcd_barrier_complete(bar, b.x, nloc, nx); b.st[0] = nloc; b.st[1] = nx; }
        const unsigned old = xb_add(&bar[XB_XSUB(b.x)], 1u);
        const unsigned gen = old / nloc;
        if (old + 1u == (gen + 1u) * nloc) {
            __builtin_amdgcn_fence(__ATOMIC_RELEASE, "agent");
            asm volatile("s_waitcnt vmcnt(0)" ::: "memory");
            const unsigned og = xb_add(&bar[XB_TOP], 1u);
            const unsigned tg = og / nx;
            if (og + 1u == (tg + 1u) * nx) xb_add(&bar[XB_TOPGEN], 1u);
            else XB_SPIN(xb_ld(&bar[XB_TOPGEN]) == tg, bar);
            __builtin_amdgcn_fence(__ATOMIC_ACQUIRE, "agent");
            xb_add(&bar[XB_XGEN(b.x)], 1u);
            asm volatile("s_waitcnt vmcnt(0)" ::: "memory");
        } else {
            XB_SPIN(xb_ld(&bar[XB_XGEN(b.x)]) == gen, bar);
            __builtin_amdgcn_fence(__ATOMIC_ACQUIRE, "agent");
            asm volatile("s_waitcnt vmcnt(0)" ::: "memory");
        }
    }
    __syncthreads();
}

constexpr int N_PHASES = 11;
__device__ __forceinline__ void run_phase(const Params& p, int ph, LAS unsigned char* lds, int bid, int nb) {
    if (ph == 0) {
        for (int l = 0; l < 2; ++l) {
            transpose_cvt(lds, p.w_in + (size_t)l * DM * DIN, p.WtIn + (size_t)l * NP * DM, DM, DIN, NP, bid, nb);
            transpose_cvt(lds, p.w_out + (size_t)l * DM * DM, p.WtOut + (size_t)l * DM * DM, DM, DM, DM, bid, nb);
            transpose_cvt(lds, p.w2 + (size_t)l * 64 * 1024, p.W2t + (size_t)l * 1024 * 64, 64, 1024, 1024, bid, nb);
            transpose_cvt(lds, p.a2 + (size_t)l * 64 * 1024, p.A2t + (size_t)l * 1024 * 64, 64, 1024, 1024, bid, nb);
        }
        rmsnorm_phase(p.x, p.norm_w, p.H, nullptr, bid, nb);
        return;
    }
    const int l = (ph - 1) / 5, s = (ph - 1) % 5;
    if (s == 0) {
        Gemm g; g.A = p.H; g.Bt = p.WtIn + (size_t)l * NP * DM; g.M = MTOK; g.N = NP; g.K = DM;
        StaticOrder S; S.init(MTOK, NP, nb, bid);
        EpiP E; E.O = p.P; E.ldc = NP;
#ifndef SKIP_GEMM
        gemm_phase<EpiP, StaticOrder, false>(lds, g, S, E, nullptr);
#endif
    } else if (s == 1) {
        kmean_phase(p, lds, bid, nb);
#ifndef SKIP_RWKV
        rwkv_scan_phase(p, l, lds, bid, nb);
#endif
    } else if (s == 2) {
        for (int tk = bid; tk < 32 + 512 + 8192; tk += nb) {
            if (tk < 32) {
#ifndef SKIP_GLA
                gla_task(p, l, lds, tk);
#endif
            } else if (tk < 544) {
#ifndef SKIP_MOBA
                moba_task(p, lds, tk - 32);
#endif
            }
            else rwkv_post_item(p, l, tk - 544);
        }
    } else if (s == 3) {
        Gemm g; g.A = p.H; g.Bt = p.WtOut + (size_t)l * DM * DM; g.M = MTOK; g.N = DM; g.K = DM;
        StaticOrder S; S.init(MTOK, DM, nb, bid);
        EpiRes E; E.R = (l == 0) ? p.x : p.out; E.C = p.out; E.ldc = DM;
#ifndef SKIP_GEMM
        gemm_phase<EpiRes, StaticOrder, false>(lds, g, S, E, nullptr);
#endif
    } else {
        if (l == 0) rmsnorm_phase(p.out, p.norm_w + DM, p.H, nullptr, bid, nb);
        else rmsnorm_phase(p.out, p.fnw, nullptr, p.out, bid, nb);
    }
}

__global__ void __launch_bounds__(512, 2) hybrid_fwd(Params p) {
    extern __shared__ __attribute__((aligned(16))) unsigned char shm[];
    LAS unsigned char* lds = (LAS unsigned char*)shm;
    const int bid = blockIdx.x, nb = gridDim.x;
#if defined(TEST_GEMM)
    { Gemm g; g.A = p.H; g.Bt = p.WtIn; g.M = MTOK; g.N = NP; g.K = DM;
      StaticOrder S; S.init(MTOK, NP, nb, bid);
      EpiP E; E.O = p.P; E.ldc = NP;
      gemm_phase<EpiP, StaticOrder, false>(lds, g, S, E, nullptr);
#if TEST_GEMM >= 2
      if (p.phase_lo) {
      Gemm g2; g2.A = p.H; g2.Bt = p.WtOut; g2.M = MTOK; g2.N = DM; g2.K = DM;
      StaticOrder S2; S2.init(MTOK, DM, nb, bid);
      EpiRes E2; E2.R = p.x; E2.C = p.out; E2.ldc = DM;
      gemm_phase<EpiRes, StaticOrder, false>(lds, g2, S2, E2, nullptr); }
#endif
    }
#elif ONE_LAUNCH
    cg::grid_group grid = cg::this_grid();
    __shared__ uint4 xb_words;
    if (threadIdx.x == 0) xb_words = make_uint4(0u, 0u, 0u, 0u);
    __syncthreads();
    const XcdBarrier xb = xcd_barrier_post(p.bar, (volatile LAS unsigned*)&xb_words);
    for (int ph = p.phase_lo; ph < p.phase_hi; ++ph) {
        run_phase(p, ph, lds, bid, nb);
#ifdef REPEAT_PH
        if (ph == REPEAT_PH) { xcd_barrier(xb); run_phase(p, ph, lds, bid, nb); }
#endif
        if (ph + 1 < p.phase_hi) { if (ph == 0) grid.sync(); else xcd_barrier(xb); }
    }
#else
    run_phase(p, p.phase_lo, lds, bid, nb);
#endif
}

extern "C" void kernel_launch(void* const* d_in, const int* in_sizes, int n_in, void* d_out, int out_size, void* d_ws, size_t ws_size, hipStream_t stream) {
    static int grid = 0;
    if (grid == 0) {
        int dev = 0, cus = 0, per_cu = 0;
        hipGetDevice(&dev);
        hipDeviceGetAttribute(&cus, hipDeviceAttributeMultiprocessorCount, dev);
        hipFuncSetAttribute((const void*)hybrid_fwd, hipFuncAttributeMaxDynamicSharedMemorySize, LDS_BYTES);
        hipOccupancyMaxActiveBlocksPerMultiprocessor(&per_cu, (const void*)hybrid_fwd, 512, LDS_BYTES);
        if (per_cu < 1) { fprintf(stderr, "kernel_launch: occupancy query says %d blocks per CU\n", per_cu); per_cu = 1; }
        (void)hipGetLastError();
        grid = cus;
    }
    Params p{};
    const float* const* in = (const float* const*)d_in;
    p.x = in[0]; p.norm_w = in[1]; p.w_in = in[2]; p.w_out = in[3]; p.mu = in[4]; p.w0 = in[5]; p.w2 = in[6]; p.a0 = in[7]; p.a2 = in[8];
    p.k_k = in[9]; p.k_a = in[10]; p.r_k = in[11]; p.ln_w = in[12]; p.ln_b = in[13]; p.a_up = in[14]; p.a_b = in[15]; p.gnw = in[16]; p.fnw = in[17];
    p.out = (float*)d_out;
    unsigned char* ws = (unsigned char*)d_ws; size_t off = 0;
    auto take = [&](size_t bytes) { unsigned char* r = ws + off; off += (bytes + 255) & ~(size_t)255; return r; };
    p.WtIn = (u16*)take((size_t)2 * NP * DM * 2); p.WtOut = (u16*)take((size_t)2 * DM * DM * 2);
    p.W2t = (u16*)take((size_t)2 * 1024 * 64 * 2); p.A2t = (u16*)take((size_t)2 * 1024 * 64 * 2);
    p.H = (u16*)take((size_t)MTOK * DM * 2); p.P = (u16*)take((size_t)MTOK * NP * 2);
    p.yraw = (float*)take((size_t)MTOK * 1024 * 4); p.ybonus = (float*)take((size_t)MTOK * 16 * 4); p.kmean = (float*)take((size_t)256 * 128 * 4);
    p.bar = (unsigned*)take((size_t)XCD_BAR_WORDS * 4);
    if (off > ws_size) { fprintf(stderr, "kernel_launch: workspace too small (%zu > %zu)\n", off, ws_size); return; }
#if ONE_LAUNCH
    hipMemsetAsync(p.bar, 0, (size_t)XCD_BAR_WORDS * 4, stream);
    p.phase_lo = 0; p.phase_hi = N_PHASES;
    void* args[] = {&p};
    hipError_t e = hipLaunchCooperativeKernel((const void*)hybrid_fwd, dim3(grid), dim3(512), args, LDS_BYTES, stream);
    if (e != hipSuccess) fprintf(stderr, "cooperative launch failed: %s (grid %d)\n", hipGetErrorString(e), grid);
#else
    for (int ph = 0; ph < N_PHASES; ++ph) { p.phase_lo = ph; p.phase_hi = ph + 1; hipLaunchKernelGGL(hybrid_fwd, dim3(grid), dim3(512), LDS_BYTES, stream, p); }
#endif
}
```

```cpp
#include <hip/hip_runtime.h>
#include <hip/hip_cooperative_groups.h>
#include <cstdio>
namespace cg = cooperative_groups;

#ifndef ONE_LAUNCH
#define ONE_LAUNCH 1
#endif

namespace pg8 {
#define PG8_LAS __attribute__((address_space(3)))
typedef unsigned short bf16_t;
typedef short bf16x8 __attribute__((ext_vector_type(8)));
typedef float f32x4 __attribute__((ext_vector_type(4)));
typedef unsigned u32x4 __attribute__((ext_vector_type(4)));
constexpr int BM = 256, BK = 64, HALF = 128, HTB = HALF * BK * 2  , STAGE_BYTES = 8 * HTB, NXCD = 8, WGM = 8;

__host__ __device__ __forceinline__ int lds_byte(int r, int c) { const int st = (r >> 4) * 2 + (c >> 5), rr = r & 15, cc = c & 31, ob = rr * 64 + cc * 2; return st * 1024 + (ob ^ (((ob >> 9) & 1) << 5)); }
__host__ __device__ __forceinline__ void stage_rc(int b, int& R, int& C) { const int st = b / 1024, sb = b % 1024, swz = sb ^ (((sb >> 9) & 1) << 5); R = (st >> 1) * 16 + swz / 64; C = (st & 1) * 32 + (swz % 64) / 2; }
__host__ __device__ __forceinline__ int perm32(int rho) { const int n = rho >> 4, i = rho & 15; return 8 * (i >> 2) + 4 * n + (i & 3); }

struct Unit { int pm, pn; };
struct Gemm { const bf16_t* A; const bf16_t* Bt; int M, N, K; };

struct StaticOrder {
    int nM, nN, nwg, G, c;
    __host__ __device__ void init(int M, int N, int G_, int c_) { nM = M / BM; nN = N / BM; nwg = nM * nN; G = G_; c = c_; }
    __host__ __device__ bool next(int i, Unit& u) const {
        const long L = (long)i * G + c; if (L >= nwg) return false;
        int wgid = (int)L; { const int q = nwg / NXCD, r = nwg % NXCD, xcd = wgid % NXCD, off = wgid / NXCD; wgid = (xcd < r ? xcd * (q + 1) : r * (q + 1) + (xcd - r) * q) + off; }
        const int nig = WGM * nN, gid = wgid / nig, fm = gid * WGM, gsz = (nM - fm) < WGM ? (nM - fm) : WGM;
        u.pm = fm + ((wgid % nig) % gsz); u.pn = (wgid % nig) / gsz; return true;
    }
    __device__ __forceinline__ void a_ready(const Unit&) const {}
    __device__ __forceinline__ void done(const Unit&) const {}
};
__device__ __forceinline__ unsigned cvt_pk_bf16(float lo, float hi) { unsigned r; asm volatile("v_cvt_pk_bf16_f32 %0, %1, %2" : "=v"(r) : "v"(lo), "v"(hi)); return r; }
template <class Epi, class Sched, bool STAMP = false>
__device__ __forceinline__ void gemm_phase(PG8_LAS unsigned char* lds, const Gemm g, const Sched& S, const Epi& E, unsigned long long* stamps) {
    int tid = threadIdx.x; asm volatile("" : "+v"(tid)); const int wid = __builtin_amdgcn_readfirstlane(tid >> 6), lane = tid & 63, wr = wid >> 2, wc = wid & 3, fr = lane & 15, fq = lane >> 4;
    const int K = g.K, nt = K / BK;
    int ts_lo = 0, ts_hi = 0, nts = 0; const unsigned long long rt_entry = STAMP ? (unsigned long long)wall_clock64() : 0ull;
#define PG8_STAMP() do { if (STAMP && wid == 0 && nts < 64) { const unsigned long long _c = (unsigned long long)clock64(); \
        ts_lo = (lane == nts) ? (int)(unsigned)_c : ts_lo; ts_hi = (lane == nts) ? (int)(unsigned)(_c >> 32) : ts_hi; ++nts; } } while (0)
    PG8_STAMP();
    unsigned voffA[2], voffB[2];
#pragma unroll
    for (int i = 0; i < 2; ++i) { int R, C; stage_rc(tid * 16 + i * 8192, R, C); const int Rb = Epi::PERM ? ((R & ~31) + perm32(R & 31)) : R;
        voffA[i] = (unsigned)(R * K + C) * 2u; voffB[i] = (unsigned)(Rb * K + C) * 2u; }
    const size_t kstep = (size_t)(BK * 2);
    const size_t hstep = (size_t)HALF * K * 2;
    const size_t tstep = 2 * hstep;
    const unsigned ldsw = (unsigned)wid * 1024u;
    const int aoff = lds_byte(wr * 64 + fr, fq * 8), boff = lds_byte(wc * 32 + fr, fq * 8);
#define PG8_SA(b, h) (((b) * 2 + (h)) * HTB)
#define PG8_SB(b, h) ((4 + (b) * 2 + (h)) * HTB)
#define PG8_STAGE(bufoff, gbase, voff) do { _Pragma("unroll") for (int _i = 0; _i < 2; ++_i) \
        __builtin_amdgcn_global_load_lds((const unsigned*)((const char*)(gbase) + (voff)[_i]), (PG8_LAS unsigned*)(lds + (bufoff) + ldsw + _i * 8192), 16, 0, 0); } while (0)
#define PG8_LDA(dst, b, h) do { _Pragma("unroll") for (int m = 0; m < 4; ++m) _Pragma("unroll") for (int k = 0; k < 2; ++k) dst[m][k] = *(const PG8_LAS bf16x8*)(lds + PG8_SA(b, h) + aoff + m * 2048 + k * 1024); } while (0)
#define PG8_LDB(dst, b, h) do { _Pragma("unroll") for (int n = 0; n < 2; ++n) _Pragma("unroll") for (int k = 0; k < 2; ++k) dst[n][k] = *(const PG8_LAS bf16x8*)(lds + PG8_SB(b, h) + boff + n * 2048 + k * 1024); } while (0)
#define PG8_MMA(ai, bj, At, Bt) do { __builtin_amdgcn_s_setprio(1); _Pragma("unroll") for (int m = 0; m < 4; ++m) _Pragma("unroll") for (int n = 0; n < 2; ++n) _Pragma("unroll") for (int k = 0; k < 2; ++k) \
        acc[ai][bj][m][n] = __builtin_amdgcn_mfma_f32_16x16x32_bf16(Bt[n][k], At[m][k], acc[ai][bj][m][n], 0, 0, 0); __builtin_amdgcn_s_setprio(0); } while (0)
#define PG8_WAIT_V(n) asm volatile("s_waitcnt vmcnt(" #n ")" ::: "memory")
#define PG8_WAIT_L(n) asm volatile("s_waitcnt lgkmcnt(" #n ")" ::: "memory")
#define PG8_BAR __builtin_amdgcn_s_barrier()
#define PG8_SCHED __builtin_amdgcn_sched_barrier(0)
    Unit cur, nxt; int ui = 0;
    if (!S.next(0, cur)) return;
    f32x4 acc[2][2][4][2];
#pragma unroll
    for (int a = 0; a < 2; ++a)
#pragma unroll
        for (int b = 0; b < 2; ++b)
#pragma unroll
            for (int m = 0; m < 4; ++m)
#pragma unroll
                for (int n = 0; n < 2; ++n) acc[a][b][m][n] = (f32x4){0.f, 0.f, 0.f, 0.f};
    bf16x8 At[4][2], B0[2][2], B1[2][2];
    const char* cA = (const char*)g.A + (size_t)cur.pm * tstep; const char* cB = (const char*)g.Bt + (size_t)cur.pn * tstep;
    S.a_ready(cur);
    PG8_STAGE(PG8_SB(0, 0), cB, voffB); PG8_STAGE(PG8_SA(0, 0), cA, voffA); PG8_STAGE(PG8_SB(0, 1), cB + hstep, voffB); PG8_STAGE(PG8_SA(0, 1), cA + hstep, voffA);
    if (wr == 1) PG8_BAR;
    PG8_WAIT_V(4); PG8_BAR;
    PG8_STAGE(PG8_SB(1, 0), cB + kstep, voffB); PG8_STAGE(PG8_SA(1, 0), cA + kstep, voffA); PG8_STAGE(PG8_SB(1, 1), cB + hstep + kstep, voffB);
    PG8_WAIT_V(6); PG8_BAR;
    PG8_STAMP();
    for (;;) {
        const bool has_next = S.next(ui + 1, nxt);
        const char* nA = has_next ? (const char*)g.A + (size_t)nxt.pm * tstep : cA; const char* nB = has_next ? (const char*)g.Bt + (size_t)nxt.pn * tstep : cB;
        for (int t = 0; t < nt; t += 2) {
            const bool last = (t == nt - 2);
            const char* a1 = cA + (size_t)(t + 1) * kstep;
            const char* a2 = last ? nA : cA + (size_t)(t + 2) * kstep; const char* b2 = last ? nB : cB + (size_t)(t + 2) * kstep;
            const char* a3 = a2 + kstep; const char* b3 = b2 + kstep;
            if (last && has_next) S.a_ready(nxt);
            PG8_LDB(B0, 0, 0); PG8_SCHED; PG8_LDA(At, 0, 0); PG8_STAGE(PG8_SA(1, 1), a1 + hstep, voffA);
            PG8_WAIT_L(8); PG8_BAR; PG8_WAIT_L(0); PG8_MMA(0, 0, At, B0); PG8_BAR; PG8_SCHED;
            PG8_LDB(B1, 0, 1); PG8_STAGE(PG8_SB(0, 0), b2, voffB);
            PG8_BAR; PG8_WAIT_L(0); PG8_MMA(0, 1, At, B1); PG8_BAR;
            PG8_LDA(At, 0, 1); PG8_STAGE(PG8_SA(0, 0), a2, voffA);
            PG8_BAR; PG8_WAIT_L(0); PG8_MMA(1, 0, At, B0); PG8_BAR; PG8_SCHED;
            PG8_STAGE(PG8_SB(0, 1), b2 + hstep, voffB);
            PG8_WAIT_V(6); PG8_BAR; PG8_MMA(1, 1, At, B1); PG8_BAR;
            PG8_LDB(B0, 1, 0); PG8_SCHED; PG8_LDA(At, 1, 0); PG8_STAGE(PG8_SA(0, 1), a2 + hstep, voffA);
            PG8_WAIT_L(8); PG8_BAR; PG8_WAIT_L(0); PG8_MMA(0, 0, At, B0); PG8_BAR; PG8_SCHED;
            PG8_LDB(B1, 1, 1); PG8_STAGE(PG8_SB(1, 0), b3, voffB);
            PG8_BAR; PG8_WAIT_L(0); PG8_MMA(0, 1, At, B1); PG8_BAR;
            PG8_LDA(At, 1, 1); PG8_STAGE(PG8_SA(1, 0), a3, voffA);
            PG8_BAR; PG8_WAIT_L(0); PG8_MMA(1, 0, At, B0); PG8_BAR; PG8_SCHED;
            PG8_STAGE(PG8_SB(1, 1), b3 + hstep, voffB);
            PG8_WAIT_V(6); PG8_BAR; PG8_MMA(1, 1, At, B1); PG8_BAR;
        }
        PG8_STAMP();
        if constexpr (!Epi::AFTER_DRAIN) { E(acc, cur, wr, wc, fr, fq); S.done(cur); }
        PG8_STAMP();
        if (!has_next) break;
#pragma unroll
        for (int a = 0; a < 2; ++a)
#pragma unroll
            for (int b = 0; b < 2; ++b)
#pragma unroll
                for (int m = 0; m < 4; ++m)
#pragma unroll
                    for (int n = 0; n < 2; ++n) acc[a][b][m][n] = (f32x4){0.f, 0.f, 0.f, 0.f};
        cur = nxt; cA = nA; cB = nB; ++ui;
    }
    PG8_WAIT_V(0);
    if (wr == 0) PG8_BAR;
    PG8_BAR;
    if constexpr (Epi::AFTER_DRAIN) { E.fused(acc, cur, wr, wc, fr, fq, lds, wid, lane); S.done(cur); }
    PG8_STAMP();
    if (STAMP && wid == 0) { stamps[lane] = lane < nts ? (((unsigned long long)(unsigned)ts_hi << 32) | (unsigned)ts_lo) : 0ull;
        if (lane == 62) stamps[62] = rt_entry; if (lane == 63) stamps[63] = (unsigned long long)wall_clock64(); }
#undef PG8_STAMP
#undef PG8_SA
#undef PG8_SB
#undef PG8_STAGE
#undef PG8_LDA
#undef PG8_LDB
#undef PG8_MMA
#undef PG8_WAIT_V
#undef PG8_WAIT_L
#undef PG8_BAR
#undef PG8_SCHED
}
}
using namespace pg8;
#define LAS PG8_LAS
typedef unsigned short u16;
typedef unsigned u32x2 __attribute__((ext_vector_type(2)));
typedef float f32x2 __attribute__((ext_vector_type(2)));

constexpr int NBATCH = 8, SEQ = 2048, DM = 2048, MTOK = NBATCH * SEQ, DIN = 7824, NP = 7936;
constexpr int C_R = 0, C_K = 1024, C_V = 2048, C_WD = 3072, C_GA = 3200, C_QB = 4224, C_KB = 4736, C_VB = 5248, C_GB = 5760,
              C_QC = 6272, C_KC = 6528, C_VC = 6784, C_GC = 7296, C_LOW = 7808;
constexpr int LDS_BYTES = 131072;

struct Params {
    const float *x, *norm_w, *w_in, *w_out, *mu, *w0, *w2, *a0, *a2, *k_k, *k_a, *r_k, *ln_w, *ln_b, *a_up, *a_b, *gnw, *fnw;
    float* out;
    u16 *WtIn, *WtOut, *W2t, *A2t, *H, *P;
    float *yraw, *ybonus, *kmean;
    unsigned* bar;
    int phase_lo, phase_hi;
};

__device__ __forceinline__ int tid_() { int t = threadIdx.x; asm volatile("" : "+v"(t)); return t; }
__device__ __forceinline__ float bf2f(u16 v) { return __uint_as_float(((unsigned)v) << 16); }
__device__ __forceinline__ float bflo(unsigned w) { return __uint_as_float(w << 16); }
__device__ __forceinline__ float bfhi(unsigned w) { return __uint_as_float(w & 0xffff0000u); }
__device__ __forceinline__ u16 f2bf(float f) { return (u16)(cvt_pk_bf16(f, 0.f) & 0xffffu); }
template <int CTRL> __device__ __forceinline__ float dpp_f(float v) { return __int_as_float(__builtin_amdgcn_update_dpp(0, __float_as_int(v), CTRL, 0xF, 0xF, true)); }
__device__ __forceinline__ float red16_sum(float v) { v += dpp_f<0xB1>(v); v += dpp_f<0x4E>(v); v += dpp_f<0x141>(v); v += dpp_f<0x140>(v); return v; }
__device__ __forceinline__ float red8_sum(float v) { v += dpp_f<0xB1>(v); v += dpp_f<0x4E>(v); v += dpp_f<0x141>(v); return v; }
__device__ __forceinline__ float red16_max(float v) { v = fmaxf(v, dpp_f<0xB1>(v)); v = fmaxf(v, dpp_f<0x4E>(v)); v = fmaxf(v, dpp_f<0x141>(v)); v = fmaxf(v, dpp_f<0x140>(v)); return v; }
__device__ __forceinline__ float wave_sum(float v) {
#pragma unroll
    for (int o = 1; o < 64; o <<= 1) v += __shfl_xor(v, o);
    return v;
}
__device__ __forceinline__ float sigmoidf_(float x) { return 1.f / (1.f + __expf(-x)); }
__device__ __forceinline__ float siluf_(float x) { return x / (1.f + __expf(-x)); }
__device__ __forceinline__ float logsigmoidf_(float z) { return fminf(z, 0.f) - log1pf(__expf(-fabsf(z))); }
__device__ __forceinline__ f32x4 mfma16(bf16x8 a, bf16x8 b, f32x4 c) { return __builtin_amdgcn_mfma_f32_16x16x32_bf16(a, b, c, 0, 0, 0); }

struct EpiP {
    static constexpr bool PERM = true, AFTER_DRAIN = false;
    bf16_t* O; int ldc;
    __device__ __forceinline__ void operator()(const f32x4 (&acc)[2][2][4][2], const Unit& u, int wr, int wc, int fr, int fq) const {
        const int row0 = u.pm * BM + wr * 64 + fr, col0 = u.pn * BM + wc * 32 + 8 * fq;
#pragma unroll
        for (int ai = 0; ai < 2; ++ai)
#pragma unroll
            for (int m = 0; m < 4; ++m) { bf16_t* rowp = O + (size_t)(row0 + ai * HALF + m * 16) * ldc + col0;
#pragma unroll
                for (int bj = 0; bj < 2; ++bj) { const f32x4 v0 = acc[ai][bj][m][0], v1 = acc[ai][bj][m][1];
                    u32x4 w; w.x = cvt_pk_bf16(v0[0], v0[1]); w.y = cvt_pk_bf16(v0[2], v0[3]); w.z = cvt_pk_bf16(v1[0], v1[1]); w.w = cvt_pk_bf16(v1[2], v1[3]);
                    *(u32x4*)(rowp + bj * HALF) = w; } }
    }
};
struct EpiRes {
    static constexpr bool PERM = false, AFTER_DRAIN = false;
    const float* R; float* C; int ldc;
    __device__ __forceinline__ void operator()(const f32x4 (&acc)[2][2][4][2], const Unit& u, int wr, int wc, int fr, int fq) const {
        const int row0 = u.pm * BM + wr * 64 + fr, col0 = u.pn * BM + wc * 32 + 4 * fq;
#pragma unroll
        for (int ai = 0; ai < 2; ++ai)
#pragma unroll
            for (int m = 0; m < 4; ++m) { const size_t off = (size_t)(row0 + ai * HALF + m * 16) * ldc + col0;
#pragma unroll
                for (int bj = 0; bj < 2; ++bj)
#pragma unroll
                    for (int n = 0; n < 2; ++n) { const f32x4 r = *(const f32x4*)(R + off + bj * HALF + n * 16); *(f32x4*)(C + off + bj * HALF + n * 16) = acc[ai][bj][m][n] + r; }
                asm volatile("" ::: "memory"); }
    }
};

__device__ void transpose_cvt(LAS unsigned char* lds, const float* src, u16* dst, int K, int N, int Npad, int bid, int nb) {
    LAS float* tile = (LAS float*)lds;
    const int tilesN = Npad / 64, tilesK = K / 64, tid = tid_();
    for (int t = bid; t < tilesN * tilesK; t += nb) {
        const int tn = t % tilesN, tk = t / tilesN, n0 = tn * 64, k0 = tk * 64;
#pragma unroll
        for (int i = 0; i < 2; ++i) { const int idx = tid + i * 512, kk = idx >> 4, n4 = (idx & 15) * 4;
            float4 v = make_float4(0.f, 0.f, 0.f, 0.f);
            if (n0 + n4 < N) v = *(const float4*)(src + (size_t)(k0 + kk) * N + n0 + n4);
            tile[(n4 + 0) * 65 + kk] = v.x; tile[(n4 + 1) * 65 + kk] = v.y; tile[(n4 + 2) * 65 + kk] = v.z; tile[(n4 + 3) * 65 + kk] = v.w; }
        __syncthreads();
        { const int n = tid >> 3, k8 = (tid & 7) * 8; const LAS float* r = tile + n * 65 + k8;
            u32x4 o; o.x = cvt_pk_bf16(r[0], r[1]); o.y = cvt_pk_bf16(r[2], r[3]); o.z = cvt_pk_bf16(r[4], r[5]); o.w = cvt_pk_bf16(r[6], r[7]);
            *(u32x4*)(dst + (size_t)(n0 + n) * K + k0 + k8) = o; }
        __syncthreads();
    }
}

__device__ void rmsnorm_phase(const float* x, const float* w, u16* hb, float* of, int bid, int nb) {
    const int tid0 = tid_(), wid = tid0 >> 6, lane = tid0 & 63;
    for (int row = bid * 8 + wid; row < MTOK; row += nb * 8) {
        const float4* xr = (const float4*)(x + (size_t)row * DM);
        float4 v[8]; float s = 0.f;
#pragma unroll
        for (int i = 0; i < 8; ++i) { v[i] = xr[i * 64 + lane]; s += v[i].x * v[i].x + v[i].y * v[i].y + v[i].z * v[i].z + v[i].w * v[i].w; }
        s = wave_sum(s);
        const float rs = rsqrtf(s * (1.f / DM) + 1e-6f);
#pragma unroll
        for (int i = 0; i < 8; ++i) { const float4 wv = ((const float4*)w)[i * 64 + lane];
            const float a = v[i].x * rs * wv.x, b = v[i].y * rs * wv.y, c = v[i].z * rs * wv.z, d = v[i].w * rs * wv.w;
            if (hb) { uint2 o; o.x = cvt_pk_bf16(a, b); o.y = cvt_pk_bf16(c, d); *(uint2*)(hb + (size_t)row * DM + (i * 64 + lane) * 4) = o; }
            else { ((float4*)(of + (size_t)row * DM))[i * 64 + lane] = make_float4(a, b, c, d); } }
    }
}

__device__ void kmean_phase(const Params& p, LAS unsigned char* lds, int bid, int nb) {
    LAS float* part = (LAS float*)lds;
    const int tid = tid_();
    for (int task = bid; task < 256; task += nb) {
        const int b = task >> 5, h = (task >> 3) & 3, blk = task & 7;
        const int d8 = (tid & 15) * 8, kg = tid >> 4;
        float s[8];
#pragma unroll
        for (int e = 0; e < 8; ++e) s[e] = 0.f;
        for (int kk = 0; kk < 8; ++kk) {
            const int tok = b * SEQ + blk * 256 + kg * 8 + kk;
            const uint4 v = *(const uint4*)(p.P + (size_t)tok * NP + C_KB + h * 128 + d8);
            s[0] += bflo(v.x); s[1] += bfhi(v.x); s[2] += bflo(v.y); s[3] += bfhi(v.y); s[4] += bflo(v.z); s[5] += bfhi(v.z); s[6] += bflo(v.w); s[7] += bfhi(v.w);
        }
        __syncthreads();
#pragma unroll
        for (int e = 0; e < 8; ++e) part[kg * 128 + d8 + e] = s[e];
        __syncthreads();
        if (tid < 128) { float a = 0.f; for (int g = 0; g < 32; ++g) a += part[g * 128 + tid]; p.kmean[(size_t)task * 128 + tid] = a * (1.f / 256.f); }
    }
    __syncthreads();
}

constexpr int RW_T = 32;
constexpr int RW_RAW = 0, RW_A1 = 21504, RW_A2 = 26112, RW_OPW = 30720, RW_OPA = 38912, RW_OPB = 47104, RW_OPK = 55296, RW_OPR = 63488,
              RW_KS = 71680, RW_AS = 79872, RW_OPV = 88064, RW_YB = 92160, RW_MU = 96256, RW_PAR = 97536;
__device__ __forceinline__ void rw_issue(const Params& p, int tid, int b, int h, int t0, u32x4 (&rg)[3]) {
#pragma unroll
    for (int i = 0; i < 3; ++i) { const int piece = tid + 512 * i; rg[i] = (u32x4){0u, 0u, 0u, 0u};
        if (piece < 33 * 40) { const int row = piece / 40, pc = piece % 40; const int t = t0 - 1 + row;
            const int col = pc < 8 ? C_R + h * 64 + pc * 8 : pc < 16 ? C_K + h * 64 + (pc - 8) * 8 : pc < 24 ? C_V + h * 64 + (pc - 16) * 8 : C_WD + (pc - 24) * 8;
            if (t >= 0) rg[i] = *(const u32x4*)(p.P + (size_t)(b * SEQ + t) * NP + col); } }
}
__device__ void rwkv_scan_phase(const Params& p, int l, LAS unsigned char* lds, int bid, int nb) {
    const int tid = tid_(), wid = tid >> 6, lane = tid & 63, row = tid >> 4, sub = tid & 15;
    LAS u16* raw = (LAS u16*)(lds + RW_RAW); LAS u16* A1 = (LAS u16*)(lds + RW_A1); LAS u16* A2 = (LAS u16*)(lds + RW_A2);
    LAS float* opW = (LAS float*)(lds + RW_OPW); LAS float* opA = (LAS float*)(lds + RW_OPA); LAS float* opB = (LAS float*)(lds + RW_OPB);
    LAS float* opK = (LAS float*)(lds + RW_OPK); LAS float* opR = (LAS float*)(lds + RW_OPR); LAS float* kS = (LAS float*)(lds + RW_KS);
    LAS float* aS = (LAS float*)(lds + RW_AS); LAS float* opV = (LAS float*)(lds + RW_OPV); LAS float* yb = (LAS float*)(lds + RW_YB);
    LAS float* muS = (LAS float*)(lds + RW_MU); LAS float* parS = (LAS float*)(lds + RW_PAR);
    for (int task = bid; task < 256; task += nb) {
        const int b = task >> 5, h = (task >> 1) & 15, half = task & 1;
        __syncthreads();
        if (tid < 320) { const int c = tid; const int mi = c < 64 ? h * 64 + c : c < 128 ? 1024 + h * 64 + (c - 64) : c < 192 ? 2048 + h * 64 + (c - 128) : 3072 + (c - 192);
            muS[c] = p.mu[(size_t)l * 3200 + mi]; }
        if (tid >= 320 && tid < 384) { const int c = tid - 320; const size_t o = (size_t)l * 1024 + h * 64 + c;
            parS[c] = p.w0[o]; parS[64 + c] = p.a0[o]; parS[128 + c] = p.k_k[o]; parS[192 + c] = p.k_a[o]; parS[256 + c] = p.r_k[o]; }
        const int mat = wid >> 2, ct = wid & 3;
        bf16x8 bfr[2];
        { const u16* Bt = (mat ? p.A2t : p.W2t) + (size_t)l * 1024 * 64 + (size_t)(h * 64 + ct * 16 + (lane & 15)) * 64 + (lane >> 4) * 8;
            bfr[0] = *(const bf16x8*)(Bt); bfr[1] = *(const bf16x8*)(Bt + 32); }
        f32x2 S01 = {0.f, 0.f}, S23 = {0.f, 0.f};
        u32x4 rg[3];
        rw_issue(p, tid, b, h, 0, rg);
        for (int c = 0; c <= SEQ / RW_T; ++c) {
            const int t0 = c * RW_T;
            if (c < SEQ / RW_T) {
#pragma unroll
                for (int i = 0; i < 3; ++i) { const int piece = tid + 512 * i; if (piece < 33 * 40) *(LAS u32x4*)(raw + (piece / 40) * 320 + (piece % 40) * 8) = rg[i]; }
            }
            __syncthreads();
            if (c > 0 && tid < 256) { const int t = tid >> 3, r4 = (tid & 7) * 4;
                *(f32x4*)(p.yraw + (size_t)(b * SEQ + t0 - RW_T + t) * 1024 + h * 64 + half * 32 + r4) = *(const LAS f32x4*)(yb + t * 32 + r4); }
            if (c == SEQ / RW_T) break;
            if (c + 1 < SEQ / RW_T) rw_issue(p, tid, b, h, t0 + RW_T, rg);
#pragma unroll
            for (int reg = 0; reg < 5; ++reg)
#pragma unroll
                for (int i = 0; i < 2; ++i) { const int e = tid + 512 * i, t = e >> 5, pr = e & 31, cc = reg * 64 + 2 * pr;
                    const unsigned cu = *(const LAS unsigned*)(raw + (t + 1) * 320 + cc), pu = *(const LAS unsigned*)(raw + t * 320 + cc);
                    const f32x2 mu2 = *(const LAS f32x2*)(muS + cc);
                    const f32x2 cur = {bflo(cu), bfhi(cu)}, prv = {bflo(pu), bfhi(pu)};
                    const f32x2 xs = cur + mu2 * (prv - cur);
                    if (reg == 0) *(LAS f32x2*)(opR + t * 64 + 2 * pr) = xs;
                    else if (reg == 1) *(LAS f32x2*)(kS + t * 64 + 2 * pr) = xs;
                    else if (reg == 2) { if ((pr >> 4) == half) *(LAS f32x2*)(opV + t * 32 + ((2 * pr) & 31)) = xs; }
                    else if (reg == 3) { const float e0 = __expf(2.f * xs.x), e1 = __expf(2.f * xs.y);
                        *(LAS unsigned*)(A1 + t * 72 + 2 * pr) = cvt_pk_bf16(1.f - 2.f * __builtin_amdgcn_rcpf(e0 + 1.f), 1.f - 2.f * __builtin_amdgcn_rcpf(e1 + 1.f)); }
                    else *(LAS unsigned*)(A2 + t * 72 + 2 * pr) = cvt_pk_bf16(xs.x, xs.y); }
            __syncthreads();
            { LAS u16* Ab = mat ? A2 : A1;
#pragma unroll
                for (int rt = 0; rt < 2; ++rt) { f32x4 acc = {0.f, 0.f, 0.f, 0.f};
#pragma unroll
                    for (int ks = 0; ks < 2; ++ks) { const bf16x8 af = *(const LAS bf16x8*)(Ab + (rt * 16 + (lane & 15)) * 72 + ks * 32 + (lane >> 4) * 8); acc = mfma16(af, bfr[ks], acc); }
                    const int cc = ct * 16 + (lane & 15);
#pragma unroll
                    for (int i = 0; i < 4; ++i) { const int t = rt * 16 + (lane >> 4) * 4 + i;
                        if (mat == 0) { float wv = parS[cc] + acc[i]; wv = fminf(wv, 0.f) - __logf(1.f + __expf(-fabsf(wv))) - 0.5f; opW[t * 64 + cc] = __expf(-__expf(wv)); }
                        else aS[t * 64 + cc] = __builtin_amdgcn_rcpf(1.f + __expf(-(parS[64 + cc] + acc[i]))); } } }
            __syncthreads();
            { const int t = row, c4 = sub * 4;
                const f32x4 kr = *(const LAS f32x4*)(kS + t * 64 + c4), av = *(const LAS f32x4*)(aS + t * 64 + c4), rr = *(const LAS f32x4*)(opR + t * 64 + c4);
                const f32x4 kkp = *(const LAS f32x4*)(parS + 128 + c4), kap = *(const LAS f32x4*)(parS + 192 + c4), rkp = *(const LAS f32x4*)(parS + 256 + c4);
                f32x4 kk = kr * kkp;
                float ss = kk.x * kk.x + kk.y * kk.y + kk.z * kk.z + kk.w * kk.w; ss = red16_sum(ss);
                const float inv = rsqrtf(fmaxf(ss, 1e-24f));
                kk.x *= inv; kk.y *= inv; kk.z *= inv; kk.w *= inv;
                const f32x4 km = kr * (1.f + (av - 1.f) * kap);
                *(LAS f32x4*)(opA + t * 64 + c4) = -kk;
                *(LAS f32x4*)(opB + t * 64 + c4) = kk * av;
                *(LAS f32x4*)(opK + t * 64 + c4) = km;
                float bo = rr.x * km.x * rkp.x + rr.y * km.y * rkp.y + rr.z * km.z * rkp.z + rr.w * km.w * rkp.w; bo = red16_sum(bo);
                if (half == 0 && sub == 0) p.ybonus[(size_t)(b * SEQ + t0 + t) * 16 + h] = bo; }
            __syncthreads();
            {
                const LAS float* ob = opW + sub * 4;
                f32x4 nw = *(const LAS f32x4*)(ob), na = *(const LAS f32x4*)(ob + 2048), nbb = *(const LAS f32x4*)(ob + 4096), nk = *(const LAS f32x4*)(ob + 6144), nr = *(const LAS f32x4*)(ob + 8192);
                float nv = opV[row];
                float ykeep = 0.f;
#pragma unroll
                for (int t = 0; t < RW_T; ++t) {
                    const f32x4 w = nw, a = na, bb = nbb, kk = nk, rr = nr; const float vv = nv;
                    if (t + 1 < RW_T) { const LAS float* o2 = ob + (t + 1) * 64;
                        nw = *(const LAS f32x4*)(o2); na = *(const LAS f32x4*)(o2 + 2048); nbb = *(const LAS f32x4*)(o2 + 4096); nk = *(const LAS f32x4*)(o2 + 6144); nr = *(const LAS f32x4*)(o2 + 8192);
                        nv = opV[(t + 1) * 32 + row]; }
                    const f32x2 sa2 = S01 * a.lo + S23 * a.hi;
                    const float sa = red16_sum(sa2.x + sa2.y);
                    const f32x2 sav = {sa, sa}, vv2 = {vv, vv};
                    S01 = S01 * w.lo + sav * bb.lo + vv2 * kk.lo;
                    S23 = S23 * w.hi + sav * bb.hi + vv2 * kk.hi;
                    const f32x2 y2 = S01 * rr.lo + S23 * rr.hi;
                    const float y = red16_sum(y2.x + y2.y);
                    ykeep = (sub == (t & 15)) ? y : ykeep;
                    if ((t & 15) == 15) yb[((t & ~15) + sub) * 32 + row] = ykeep;
                }
            }
        }
    }
    __syncthreads();
}

__device__ void rwkv_post_item(const Params& p, int l, int item) {
    const int tid = tid_(), pair = item * 32 + (tid >> 4), tok = pair >> 4, h = pair & 15, c4 = (tid & 15) * 4;
    const float4 y = *(const float4*)(p.yraw + (size_t)tok * 1024 + h * 64 + c4);
    const float mean = red16_sum(y.x + y.y + y.z + y.w) * (1.f / 64.f);
    const float d0 = y.x - mean, d1 = y.y - mean, d2 = y.z - mean, d3 = y.w - mean;
    const float var = red16_sum(d0 * d0 + d1 * d1 + d2 * d2 + d3 * d3) * (1.f / 64.f);
    const float rs = rsqrtf(var + 64e-5f);
    const size_t po = (size_t)l * 1024 + h * 64 + c4;
    const float4 lw = *(const float4*)(p.ln_w + po), lb = *(const float4*)(p.ln_b + po), muv = *(const float4*)(p.mu + (size_t)l * 3200 + 2048 + h * 64 + c4);
    const uint2 vc = *(const uint2*)(p.P + (size_t)tok * NP + C_V + h * 64 + c4);
    uint2 vp = make_uint2(0u, 0u);
    if ((tok & (SEQ - 1)) != 0) vp = *(const uint2*)(p.P + (size_t)(tok - 1) * NP + C_V + h * 64 + c4);
    const uint2 gg = *(const uint2*)(p.P + (size_t)tok * NP + C_GA + h * 64 + c4);
    const float bo = p.ybonus[(size_t)tok * 16 + h];
    float v0 = bflo(vc.x), v1 = bfhi(vc.x), v2 = bflo(vc.y), v3 = bfhi(vc.y);
    v0 += muv.x * (bflo(vp.x) - v0); v1 += muv.y * (bfhi(vp.x) - v1); v2 += muv.z * (bflo(vp.y) - v2); v3 += muv.w * (bfhi(vp.y) - v3);
    const float o0 = (d0 * rs * lw.x + lb.x + bo * v0) * siluf_(bflo(gg.x)), o1 = (d1 * rs * lw.y + lb.y + bo * v1) * siluf_(bfhi(gg.x));
    const float o2 = (d2 * rs * lw.z + lb.z + bo * v2) * siluf_(bflo(gg.y)), o3 = (d3 * rs * lw.w + lb.w + bo * v3) * siluf_(bfhi(gg.y));
    uint2 o; o.x = cvt_pk_bf16(o0, o1); o.y = cvt_pk_bf16(o2, o3);
    *(uint2*)(p.H + (size_t)tok * DM + h * 64 + c4) = o;
}

constexpr int MB_K = 0, MB_VT = 17408, MB_PW = 35840, MB_KM = 54272, MB_SEL = 57856, MB_TM = 58368;
__device__ void moba_task(const Params& p, LAS unsigned char* lds, int task) {
    const int tid = tid_(), wid = tid >> 6, lane = tid & 63, l15 = lane & 15, lq = lane >> 4;
    const int qt = 15 - (task >> 5), bh = task & 31, b = bh >> 2, h = bh & 3, qblk = qt >> 1, q0 = qt * 128;
    LAS u16* Kt = (LAS u16*)(lds + MB_K); LAS u16* VT = (LAS u16*)(lds + MB_VT); LAS u16* Pw = (LAS u16*)(lds + MB_PW) + wid * 16 * 72;
    LAS float* kmS = (LAS float*)(lds + MB_KM); LAS int* selS = (LAS int*)(lds + MB_SEL); LAS int* tmS = (LAS int*)(lds + MB_TM);
    __syncthreads();
    for (int i = tid; i < qblk * 128; i += 512) kmS[i] = p.kmean[(size_t)(bh * 8) * 128 + i];
    if (tid == 0) *tmS = 0;
    __syncthreads();
    if (tid < 128) {
        const u16* qp = p.P + (size_t)(b * SEQ + q0 + tid) * NP + C_QB + h * 128;
        float g[7];
#pragma unroll
        for (int j = 0; j < 7; ++j) g[j] = 0.f;
        for (int d8 = 0; d8 < 128; d8 += 8) {
            const uint4 v = *(const uint4*)(qp + d8);
            const float q[8] = {bflo(v.x), bfhi(v.x), bflo(v.y), bfhi(v.y), bflo(v.z), bfhi(v.z), bflo(v.w), bfhi(v.w)};
#pragma unroll
            for (int j = 0; j < 7; ++j) if (j < qblk) {
#pragma unroll
                for (int e = 0; e < 8; ++e) g[j] += q[e] * kmS[j * 128 + d8 + e]; }
        }
        int mask = 0;
#pragma unroll
        for (int r = 0; r < 3; ++r) { float best = -INFINITY; int bi = -1;
#pragma unroll
            for (int j = 0; j < 7; ++j) if (j < qblk && !((mask >> j) & 1) && g[j] > best) { best = g[j]; bi = j; }
            if (bi >= 0) mask |= 1 << bi; }
        mask |= 1 << qblk;
        selS[tid] = mask; atomicOr((int*)tmS, mask);
    }
    __syncthreads();
    const int tmask = *tmS;
    bf16x8 qf[4];
    { const u16* qp = p.P + (size_t)(b * SEQ + q0 + wid * 16 + l15) * NP + C_QB + h * 128 + lq * 8;
#pragma unroll
        for (int ks = 0; ks < 4; ++ks) qf[ks] = *(const bf16x8*)(qp + ks * 32); }
    int rm[4]; int wmask = 0;
#pragma unroll
    for (int i = 0; i < 4; ++i) rm[i] = selS[wid * 16 + lq * 4 + i];
    for (int i = 0; i < 16; ++i) wmask |= selS[wid * 16 + i];
    float m[4], ls[4]; f32x4 O[8];
#pragma unroll
    for (int i = 0; i < 4; ++i) { m[i] = -1e30f; ls[i] = 0.f; }
#pragma unroll
    for (int dt = 0; dt < 8; ++dt) O[dt] = (f32x4){0.f, 0.f, 0.f, 0.f};
    const float scale = 0.08838834764831845f;
    const int last = (q0 + 127) >> 6;
    int ti = 0;
    while (ti <= last && !((tmask >> (ti >> 2)) & 1)) ++ti;
    const int kp = lane & 31, vd8 = (wid * 2 + (lane >> 5)) * 8;
    u32x4 pk0, pk1, pv0, pv1;
#define MOBA_ISSUE(tt) do { const size_t kb_ = (size_t)(b * SEQ + (tt) * 64); \
        pk0 = *(const u32x4*)(p.P + (kb_ + (tid >> 4)) * NP + C_KB + h * 128 + (tid & 15) * 8); pk1 = *(const u32x4*)(p.P + (kb_ + 32 + (tid >> 4)) * NP + C_KB + h * 128 + (tid & 15) * 8); \
        pv0 = *(const u32x4*)(p.P + (kb_ + 2 * kp) * NP + C_VB + h * 128 + vd8); pv1 = *(const u32x4*)(p.P + (kb_ + 2 * kp + 1) * NP + C_VB + h * 128 + vd8); } while (0)
    if (ti <= last) MOBA_ISSUE(ti);
    while (ti <= last) {
        {
            const int j = ti >> 2, key0 = ti * 64;
            __syncthreads();
            *(LAS u32x4*)(Kt + (tid >> 4) * 136 + (tid & 15) * 8) = pk0; *(LAS u32x4*)(Kt + (32 + (tid >> 4)) * 136 + (tid & 15) * 8) = pk1;
            { LAS unsigned* vt = (LAS unsigned*)(VT + vd8 * 72 + 2 * kp);
                vt[0] = (pv0.x & 0xffffu) | (pv1.x << 16); vt[36] = (pv0.x >> 16) | (pv1.x & 0xffff0000u);
                vt[72] = (pv0.y & 0xffffu) | (pv1.y << 16); vt[108] = (pv0.y >> 16) | (pv1.y & 0xffff0000u);
                vt[144] = (pv0.z & 0xffffu) | (pv1.z << 16); vt[180] = (pv0.z >> 16) | (pv1.z & 0xffff0000u);
                vt[216] = (pv0.w & 0xffffu) | (pv1.w << 16); vt[252] = (pv0.w >> 16) | (pv1.w & 0xffff0000u); }
            __syncthreads();
            int tn = ti + 1;
            while (tn <= last && !((tmask >> (tn >> 2)) & 1)) ++tn;
            if (tn <= last) MOBA_ISSUE(tn);
            ti = tn;
            if ((wmask >> j) & 1) {
                f32x4 s[4];
#pragma unroll
                for (int nt = 0; nt < 4; ++nt) { s[nt] = (f32x4){0.f, 0.f, 0.f, 0.f};
#pragma unroll
                    for (int ks = 0; ks < 4; ++ks) { const bf16x8 kf = *(const LAS bf16x8*)(Kt + (nt * 16 + l15) * 136 + ks * 32 + lq * 8); s[nt] = mfma16(qf[ks], kf, s[nt]); } }
#pragma unroll
                for (int i = 0; i < 4; ++i) {
                    const int qpos = q0 + wid * 16 + lq * 4 + i; const bool rsel = (rm[i] >> j) & 1;
                    float mx = -1e30f;
#pragma unroll
                    for (int nt = 0; nt < 4; ++nt) { const int kpos = key0 + nt * 16 + l15;
                        const bool valid = (j == qblk) ? (kpos <= qpos) : rsel;
                        const float sv = valid ? s[nt][i] * scale : -1e30f; s[nt][i] = sv; mx = fmaxf(mx, sv); }
                    mx = red16_max(mx);
                    const float mnew = fmaxf(m[i], mx), alpha = __expf(m[i] - mnew);
                    float rs = 0.f;
#pragma unroll
                    for (int nt = 0; nt < 4; ++nt) { const float pv = s[nt][i] > -1e29f ? __expf(s[nt][i] - mnew) : 0.f; rs += pv; Pw[(lq * 4 + i) * 72 + nt * 16 + l15] = f2bf(pv); }
                    rs = red16_sum(rs);
                    ls[i] = ls[i] * alpha + rs; m[i] = mnew;
#pragma unroll
                    for (int dt = 0; dt < 8; ++dt) O[dt][i] *= alpha;
                }
                __builtin_amdgcn_wave_barrier();
                bf16x8 pf[2];
#pragma unroll
                for (int ks = 0; ks < 2; ++ks) pf[ks] = *(const LAS bf16x8*)(Pw + l15 * 72 + ks * 32 + lq * 8);
#pragma unroll
                for (int dt = 0; dt < 8; ++dt)
#pragma unroll
                    for (int ks = 0; ks < 2; ++ks) { const bf16x8 vf = *(const LAS bf16x8*)(VT + (dt * 16 + l15) * 72 + ks * 32 + lq * 8); O[dt] = mfma16(pf[ks], vf, O[dt]); }
                __builtin_amdgcn_wave_barrier();
            }
        }
    }
#pragma unroll
    for (int i = 0; i < 4; ++i) { const float inv = 1.f / ls[i]; const size_t tok = (size_t)(b * SEQ + q0 + wid * 16 + lq * 4 + i);
#pragma unroll
        for (int dt = 0; dt < 8; ++dt) { const int d = dt * 16 + l15;
            const float g = bf2f(p.P[tok * NP + C_GB + h * 128 + d]);
            p.H[tok * DM + 1024 + h * 128 + d] = f2bf(O[dt][i] * inv * siluf_(g)); } }
}

constexpr int GL_QE = 0, GL_KE = 9216, GL_KDT = 18432, GL_VT = 27648, GL_ATT = 46080, GL_ST = 55296, GL_LA = 73728, GL_TOT = 90112,
              GL_AUP = 92160, GL_LOW = 96256, GL_DEC = 100352, GL_ABS = 100608, GL_GNW = 100864, GL_OB = 0;
__device__ void gla_task(const Params& p, int l, LAS unsigned char* lds, int task) {
    const int tid = tid_(), wid = tid >> 6, lane = tid & 63, l15 = lane & 15, lq = lane >> 4;
    const int b = task >> 2, h = task & 3;
    LAS u16* QE = (LAS u16*)(lds + GL_QE); LAS u16* KE = (LAS u16*)(lds + GL_KE); LAS u16* KDT = (LAS u16*)(lds + GL_KDT); LAS u16* VT = (LAS u16*)(lds + GL_VT);
    LAS u16* ATT = (LAS u16*)(lds + GL_ATT); LAS u16* ST = (LAS u16*)(lds + GL_ST); LAS float* LA = (LAS float*)(lds + GL_LA); LAS float* TOT = (LAS float*)(lds + GL_TOT);
    LAS float* AUP = (LAS float*)(lds + GL_AUP); LAS float* LOW = (LAS float*)(lds + GL_LOW); LAS float* DEC = (LAS float*)(lds + GL_DEC); LAS float* OB = (LAS float*)(lds + GL_OB); LAS float* ABS = (LAS float*)(lds + GL_ABS); LAS float* GNW = (LAS float*)(lds + GL_GNW);
    __syncthreads();
    for (int i = tid; i < 1024; i += 512) AUP[i] = p.a_up[(size_t)l * 16 * 256 + (i >> 6) * 256 + h * 64 + (i & 63)];
    for (int i = tid; i < 128 * 72 / 2; i += 512) ((LAS unsigned*)ST)[i] = 0u;
    if (tid < 64) ABS[tid] = p.a_b[(size_t)l * 256 + h * 64 + tid];
    if (tid >= 64 && tid < 192) GNW[tid - 64] = p.gnw[(size_t)l * 128 + tid - 64];
    f32x4 Sacc[4];
#pragma unroll
    for (int c = 0; c < 4; ++c) Sacc[c] = (f32x4){0.f, 0.f, 0.f, 0.f};
    const int rt = wid >> 1, dv0t = (wid & 1) * 4;
    for (int n = 0; n < 32; ++n) {
        const size_t tokb = (size_t)(b * SEQ + n * 64);
        { const int e2 = tid * 2, t = e2 >> 4, r = e2 & 15; const unsigned v = *(const unsigned*)(p.P + (tokb + t) * NP + C_LOW + r); LOW[t * 16 + r] = bflo(v); LOW[t * 16 + r + 1] = bfhi(v); }
        __syncthreads();
        { const int t = tid >> 3, d0 = (tid & 7) * 8;
#pragma unroll 1
            for (int dd = 0; dd < 8; ++dd) { const int d = d0 + dd; float z = ABS[d];
#pragma unroll
                for (int r = 0; r < 16; ++r) z += LOW[t * 16 + r] * AUP[r * 64 + d];
                LA[t * 64 + d] = (fminf(z, 0.f) - __logf(1.f + __expf(-fabsf(z)))) * (1.f / 16.f); } }
        __syncthreads();
        { float a = 0.f;
#pragma unroll
            for (int tt = 0; tt < 8; ++tt) { a += LA[(wid * 8 + tt) * 64 + lane]; LA[(wid * 8 + tt) * 64 + lane] = a; }
            TOT[wid * 64 + lane] = a; }
        __syncthreads();
        { const int t = tid >> 3, d0 = (tid & 7) * 8, wt = t >> 3;
            const uint4 qv = *(const uint4*)(p.P + (tokb + t) * NP + C_QC + h * 64 + d0), kv = *(const uint4*)(p.P + (tokb + t) * NP + C_KC + h * 64 + d0);
            const float q[8] = {bflo(qv.x), bfhi(qv.x), bflo(qv.y), bfhi(qv.y), bflo(qv.z), bfhi(qv.z), bflo(qv.w), bfhi(qv.w)};
            const float k[8] = {bflo(kv.x), bfhi(kv.x), bflo(kv.y), bfhi(kv.y), bflo(kv.z), bfhi(kv.z), bflo(kv.w), bfhi(kv.w)};
            float qe[8], ke[8], off[8], tot[8];
#pragma unroll
            for (int dd = 0; dd < 8; ++dd) { off[dd] = 0.f; tot[dd] = 0.f; }
#pragma unroll 1
            for (int w2 = 0; w2 < 8; ++w2) { const f32x4 ta = *(const LAS f32x4*)(TOT + w2 * 64 + d0), tb = *(const LAS f32x4*)(TOT + w2 * 64 + d0 + 4);
                const float sel = (w2 < wt) ? 1.f : 0.f;
#pragma unroll
                for (int dd = 0; dd < 4; ++dd) { tot[dd] += ta[dd]; off[dd] += sel * ta[dd]; tot[dd + 4] += tb[dd]; off[dd + 4] += sel * tb[dd]; } }
            const f32x4 la0 = *(const LAS f32x4*)(LA + t * 64 + d0), la1 = *(const LAS f32x4*)(LA + t * 64 + d0 + 4);
#pragma unroll
            for (int dd = 0; dd < 8; ++dd) { const int d = d0 + dd;
                const float bv = (dd < 4 ? la0[dd & 3] : la1[dd & 3]) + off[dd];
                qe[dd] = q[dd] * 0.125f * __expf(bv); ke[dd] = k[dd] * __expf(-bv);
                KDT[d * 72 + t] = f2bf(k[dd] * __expf(tot[dd] - bv));
                if (t == 0) DEC[d] = __expf(tot[dd]); }
            u32x4 o; o.x = cvt_pk_bf16(qe[0], qe[1]); o.y = cvt_pk_bf16(qe[2], qe[3]); o.z = cvt_pk_bf16(qe[4], qe[5]); o.w = cvt_pk_bf16(qe[6], qe[7]);
            *(LAS u32x4*)(QE + t * 72 + d0) = o;
            o.x = cvt_pk_bf16(ke[0], ke[1]); o.y = cvt_pk_bf16(ke[2], ke[3]); o.z = cvt_pk_bf16(ke[4], ke[5]); o.w = cvt_pk_bf16(ke[6], ke[7]);
            *(LAS u32x4*)(KE + t * 72 + d0) = o;
#pragma unroll
            for (int i = 0; i < 2; ++i) { const int piece = tid + 512 * i, tv = piece >> 4, dv8 = (piece & 15) * 8;
                const uint4 vv = *(const uint4*)(p.P + (tokb + tv) * NP + C_VC + h * 128 + dv8);
                LAS u16* vt = VT + dv8 * 72 + tv;
                vt[0] = (u16)(vv.x & 0xffff); vt[72] = (u16)(vv.x >> 16); vt[144] = (u16)(vv.y & 0xffff); vt[216] = (u16)(vv.y >> 16);
                vt[288] = (u16)(vv.z & 0xffff); vt[360] = (u16)(vv.z >> 16); vt[432] = (u16)(vv.w & 0xffff); vt[504] = (u16)(vv.w >> 16); } }
        __syncthreads();
        { bf16x8 af[2];
#pragma unroll
            for (int ks = 0; ks < 2; ++ks) af[ks] = *(const LAS bf16x8*)(QE + (rt * 16 + l15) * 72 + ks * 32 + lq * 8);
#pragma unroll
            for (int c2 = 0; c2 < 2; ++c2) { const int ctile = (wid & 1) * 2 + c2; f32x4 acc = {0.f, 0.f, 0.f, 0.f};
#pragma unroll
                for (int ks = 0; ks < 2; ++ks) { const bf16x8 bf = *(const LAS bf16x8*)(KE + (ctile * 16 + l15) * 72 + ks * 32 + lq * 8); acc = mfma16(af[ks], bf, acc); }
#pragma unroll
                for (int i = 0; i < 4; ++i) { const int t = rt * 16 + lq * 4 + i, jj = ctile * 16 + l15; ATT[t * 72 + jj] = f2bf(jj <= t ? acc[i] : 0.f); } } }
        __syncthreads();
        f32x4 oacc[4];
        { bf16x8 at[2], qf[2], kd[2];
#pragma unroll
            for (int ks = 0; ks < 2; ++ks) { at[ks] = *(const LAS bf16x8*)(ATT + (rt * 16 + l15) * 72 + ks * 32 + lq * 8); qf[ks] = *(const LAS bf16x8*)(QE + (rt * 16 + l15) * 72 + ks * 32 + lq * 8);
                kd[ks] = *(const LAS bf16x8*)(KDT + (rt * 16 + l15) * 72 + ks * 32 + lq * 8); }
            float dec[4];
#pragma unroll
            for (int i = 0; i < 4; ++i) dec[i] = DEC[rt * 16 + lq * 4 + i];
#pragma unroll
            for (int c = 0; c < 4; ++c) { const int dvt = dv0t + c; f32x4 acc = {0.f, 0.f, 0.f, 0.f};
#pragma unroll
                for (int i = 0; i < 4; ++i) Sacc[c][i] *= dec[i];
#pragma unroll
                for (int ks = 0; ks < 2; ++ks) { const bf16x8 vf = *(const LAS bf16x8*)(VT + (dvt * 16 + l15) * 72 + ks * 32 + lq * 8), sf = *(const LAS bf16x8*)(ST + (dvt * 16 + l15) * 72 + ks * 32 + lq * 8);
                    acc = mfma16(at[ks], vf, acc); acc = mfma16(qf[ks], sf, acc); Sacc[c] = mfma16(kd[ks], vf, Sacc[c]); }
                oacc[c] = acc; } }
        __syncthreads();
#pragma unroll
        for (int c = 0; c < 4; ++c) { const int dv = (dv0t + c) * 16 + l15;
#pragma unroll
            for (int i = 0; i < 4; ++i) OB[(rt * 16 + lq * 4 + i) * 132 + dv] = oacc[c][i];
            u32x2 sv; sv.x = cvt_pk_bf16(Sacc[c][0], Sacc[c][1]); sv.y = cvt_pk_bf16(Sacc[c][2], Sacc[c][3]);
            *(LAS u32x2*)(ST + dv * 72 + rt * 16 + lq * 4) = sv; }
        __syncthreads();
        { const int t = tid >> 3, dvb = (tid & 7) * 16; float o[16]; float ss = 0.f;
#pragma unroll
            for (int e = 0; e < 16; ++e) { o[e] = OB[t * 132 + dvb + e]; ss += o[e] * o[e]; }
            ss = red8_sum(ss);
            const float rs = rsqrtf(ss * (1.f / 128.f) + 1e-6f);
            const u16* gp = p.P + (tokb + t) * NP + C_GC + h * 128 + dvb;
            const uint4 g0 = *(const uint4*)gp, g1 = *(const uint4*)(gp + 8);
            const float g[16] = {bflo(g0.x), bfhi(g0.x), bflo(g0.y), bfhi(g0.y), bflo(g0.z), bfhi(g0.z), bflo(g0.w), bfhi(g0.w),
                                 bflo(g1.x), bfhi(g1.x), bflo(g1.y), bfhi(g1.y), bflo(g1.z), bfhi(g1.z), bflo(g1.w), bfhi(g1.w)};
            float r[16];
#pragma unroll
            for (int e = 0; e < 16; ++e) r[e] = o[e] * rs * GNW[dvb + e] * siluf_(g[e]);
            u32x4 w0, w1; w0.x = cvt_pk_bf16(r[0], r[1]); w0.y = cvt_pk_bf16(r[2], r[3]); w0.z = cvt_pk_bf16(r[4], r[5]); w0.w = cvt_pk_bf16(r[6], r[7]);
            w1.x = cvt_pk_bf16(r[8], r[9]); w1.y = cvt_pk_bf16(r[10], r[11]); w1.z = cvt_pk_bf16(r[12], r[13]); w1.w = cvt_pk_bf16(r[14], r[15]);
            u16* op = p.H + (tokb + t) * DM + 1536 + h * 128 + dvb;
            *(u32x4*)op = w0; *(u32x4*)(op + 8) = w1; }
        __syncthreads();
    }
}

#define XB_TMO      128
#define XB_XCNT(j)  (256  + 64 * (j))
#define XB_XSUB(j)  (1280 + 64 * (j))
#define XB_XGEN(j)  (2304 + 64 * (j))
#define XB_TOP      3328
#define XB_TOPGEN   3392
#define XCD_BAR_WORDS 3456
#define XB_SPIN_CAP (1u << 18)

__device__ __forceinline__ unsigned xb_ld(unsigned* p)              { return __hip_atomic_load(p, __ATOMIC_RELAXED, __HIP_MEMORY_SCOPE_AGENT); }
__device__ __forceinline__ unsigned xb_add(unsigned* p, unsigned v) { return __hip_atomic_fetch_add(p, v, __ATOMIC_RELAXED, __HIP_MEMORY_SCOPE_AGENT); }
__device__ __forceinline__ unsigned xb_xcc_id() { return (unsigned)__builtin_amdgcn_s_getreg((3 << 11) | 20) & 0xFu; }
#define XB_SPIN(cond, bar) do { unsigned _sp = 0; while (cond) { __builtin_amdgcn_s_sleep(1); \
    if ((++_sp & 255u) == 0u) { if (xb_ld(&(bar)[XB_TMO])) break; if (_sp > XB_SPIN_CAP) { atomicAdd(&(bar)[XB_TMO], 1u); break; } } } } while (0)

struct XcdBarrier {
    unsigned* bar; unsigned x;
    volatile LAS unsigned* st;
};

__device__ __forceinline__ XcdBarrier xcd_barrier_post(unsigned* bar, volatile LAS unsigned* st) {
    XcdBarrier b; b.bar = bar; b.x = xb_xcc_id(); b.st = st;
    if (threadIdx.x == 0) (void)xb_add(&bar[XB_XCNT(b.x)], 1u);
    return b;
}
__device__ __forceinline__ void xcd_barrier_complete(unsigned* bar, unsigned x, unsigned& nloc, unsigned& nx) {
    const unsigned G = gridDim.x * gridDim.y * gridDim.z;
    unsigned sum, cnt, mine, sp = 0u;
    for (;;) {
        sum = 0u; cnt = 0u; mine = 0u;
#pragma unroll
        for (unsigned j = 0; j < 16; ++j) { const unsigned c = xb_ld(&bar[XB_XCNT(j)]); sum += c; cnt += (c > 0u) ? 1u : 0u; mine = (j == x) ? c : mine; }
        if (sum == G) break;
        __builtin_amdgcn_s_sleep(1);
        if ((++sp & 255u) == 0u) { if (xb_ld(&bar[XB_TMO])) break; if (sp > XB_SPIN_CAP) { atomicAdd(&bar[XB_TMO], 1u); break; } }
    }
    nloc = mine > 0u ? mine : 1u; nx = cnt > 0u ? cnt : 1u;
}

__device__ __forceinline__ void xcd_barrier(const XcdBarrier& b) {
    asm volatile("s_waitcnt vmcnt(0)" ::: "memory");
    __syncthreads();
    if (threadIdx.x == 0) {
        unsigned* bar = b.bar;
        __builtin_amdgcn_s_waitcnt(0);
        unsigned nloc = b.st[0], nx = b.st[1];
        if (nloc == 0u) { xcd_barrier_complete(bar, b.x, nloc, nx); b.st[0] = nloc; b.st[1] = nx; }
        const unsigned old = xb_add(&bar[XB_XSUB(b.x)], 1u);
        const unsigned gen = old / nloc;
        if (old + 1u == (gen + 1u) * nloc) {
            __builtin_amdgcn_fence(__ATOMIC_RELEASE, "agent");
            asm volatile("s_waitcnt vmcnt(0)" ::: "memory");
            const unsigned og = xb_add(&bar[XB_TOP], 1u);
            const unsigned tg = og / nx;
            if (og + 1u == (tg + 1u) * nx) xb_add(&bar[XB_TOPGEN], 1u);
            else XB_SPIN(xb_ld(&bar[XB_TOPGEN]) == tg, bar);
            __builtin_amdgcn_fence(__ATOMIC_ACQUIRE, "agent");
            xb_add(&bar[XB_XGEN(b.x)], 1u);
            asm volatile("s_waitcnt vmcnt(0)" ::: "memory");
        } else {
            XB_SPIN(xb_ld(&bar[XB_XGEN(b.x)]) == gen, bar);
            __builtin_amdgcn_fence(__ATOMIC_ACQUIRE, "agent");
            asm volatile("s_waitcnt vmcnt(0)" ::: "memory");
        }
    }
    __syncthreads();
}

constexpr int N_PHASES = 11;
__device__ __forceinline__ void run_phase(const Params& p, int ph, LAS unsigned char* lds, LAS unsigned* qslot, int bid, int nb) {
    if (ph == 0) {
        for (int l = 0; l < 2; ++l) {
            transpose_cvt(lds, p.w_in + (size_t)l * DM * DIN, p.WtIn + (size_t)l * NP * DM, DM, DIN, NP, bid, nb);
            transpose_cvt(lds, p.w_out + (size_t)l * DM * DM, p.WtOut + (size_t)l * DM * DM, DM, DM, DM, bid, nb);
            transpose_cvt(lds, p.w2 + (size_t)l * 64 * 1024, p.W2t + (size_t)l * 1024 * 64, 64, 1024, 1024, bid, nb);
            transpose_cvt(lds, p.a2 + (size_t)l * 64 * 1024, p.A2t + (size_t)l * 1024 * 64, 64, 1024, 1024, bid, nb);
        }
        rmsnorm_phase(p.x, p.norm_w, p.H, nullptr, bid, nb);
        return;
    }
    const int l = (ph - 1) / 5, s = (ph - 1) % 5;
    if (s == 0) {
        Gemm g; g.A = p.H; g.Bt = p.WtIn + (size_t)l * NP * DM; g.M = MTOK; g.N = NP; g.K = DM;
        StaticOrder S; S.init(MTOK, NP, nb, bid);
        EpiP E; E.O = p.P; E.ldc = NP;
#ifndef SKIP_GEMM
        gemm_phase<EpiP, StaticOrder, false>(lds, g, S, E, nullptr);
#endif
    } else if (s == 1) {
        kmean_phase(p, lds, bid, nb);
#ifndef SKIP_RWKV
        rwkv_scan_phase(p, l, lds, bid, nb);
#endif
    } else if (s == 2) {
#if ONE_LAUNCH && !defined(STATIC_Q)
        LAS int* slot = (LAS int*)qslot;
        for (;;) {
            __syncthreads();
            if (tid_() == 0) *slot = (int)atomicAdd(p.bar + 64 * l, 1u);
            __syncthreads();
            const int tk = *slot;
            if (tk >= 32 + 512 + 512) break;
            if (tk < 32) gla_task(p, l, lds, tk);
            else if (tk < 544) moba_task(p, lds, tk - 32);
            else { for (int it = 0; it < 16; ++it) rwkv_post_item(p, l, (tk - 544) * 16 + it); }
        }
#else
        for (int tk = bid; tk < 32 + 512 + 8192; tk += nb) {
            if (tk < 32) gla_task(p, l, lds, tk);
            else if (tk < 544) moba_task(p, lds, tk - 32);
            else rwkv_post_item(p, l, tk - 544);
        }
#endif
    } else if (s == 3) {
        Gemm g; g.A = p.H; g.Bt = p.WtOut + (size_t)l * DM * DM; g.M = MTOK; g.N = DM; g.K = DM;
        StaticOrder S; S.init(MTOK, DM, nb, bid);
        EpiRes E; E.R = (l == 0) ? p.x : p.out; E.C = p.out; E.ldc = DM;
#ifndef SKIP_GEMM
        gemm_phase<EpiRes, StaticOrder, false>(lds, g, S, E, nullptr);
#endif
    } else {
        if (l == 0) rmsnorm_phase(p.out, p.norm_w + DM, p.H, nullptr, bid, nb);
        else rmsnorm_phase(p.out, p.fnw, nullptr, p.out, bid, nb);
    }
}

__global__ void __launch_bounds__(512, 2) hybrid_fwd(Params p) {
    extern __shared__ __attribute__((aligned(16))) unsigned char shm[];
    LAS unsigned char* lds = (LAS unsigned char*)shm;
    const int bid = blockIdx.x, nb = gridDim.x;
#if defined(TEST_GEMM)
    { Gemm g; g.A = p.H; g.Bt = p.WtIn; g.M = MTOK; g.N = NP; g.K = DM;
      StaticOrder S; S.init(MTOK, NP, nb, bid);
      EpiP E; E.O = p.P; E.ldc = NP;
      gemm_phase<EpiP, StaticOrder, false>(lds, g, S, E, nullptr);
#if TEST_GEMM >= 2
      if (p.phase_lo) {
      Gemm g2; g2.A = p.H; g2.Bt = p.WtOut; g2.M = MTOK; g2.N = DM; g2.K = DM;
      StaticOrder S2; S2.init(MTOK, DM, nb, bid);
      EpiRes E2; E2.R = p.x; E2.C = p.out; E2.ldc = DM;
      gemm_phase<EpiRes, StaticOrder, false>(lds, g2, S2, E2, nullptr); }
#endif
    }
#elif ONE_LAUNCH
    cg::grid_group grid = cg::this_grid();
    __shared__ uint4 xb_words;
    if (threadIdx.x == 0) xb_words = make_uint4(0u, 0u, 0u, 0u);
    __syncthreads();
    const XcdBarrier xb = xcd_barrier_post(p.bar, (volatile LAS unsigned*)&xb_words);
    for (int ph = p.phase_lo; ph < p.phase_hi; ++ph) {
        run_phase(p, ph, lds, (LAS unsigned*)&xb_words.z, bid, nb);
#ifdef REPEAT_PH
        if (ph == REPEAT_PH) { xcd_barrier(xb); run_phase(p, ph, lds, (LAS unsigned*)&xb_words.z, bid, nb); }
#endif
        if (ph + 1 < p.phase_hi) { if (ph == 0) grid.sync(); else xcd_barrier(xb); }
    }
#else
    run_phase(p, p.phase_lo, lds, nullptr, bid, nb);
#endif
}

extern "C" void kernel_launch(void* const* d_in, const int* in_sizes, int n_in, void* d_out, int out_size, void* d_ws, size_t ws_size, hipStream_t stream) {
    static int grid = 0;
    if (grid == 0) {
        int dev = 0, cus = 0, per_cu = 0;
        hipGetDevice(&dev);
        hipDeviceGetAttribute(&cus, hipDeviceAttributeMultiprocessorCount, dev);
        hipFuncSetAttribute((const void*)hybrid_fwd, hipFuncAttributeMaxDynamicSharedMemorySize, LDS_BYTES);
        hipOccupancyMaxActiveBlocksPerMultiprocessor(&per_cu, (const void*)hybrid_fwd, 512, LDS_BYTES);
        if (per_cu < 1) { fprintf(stderr, "kernel_launch: occupancy query says %d blocks per CU\n", per_cu); per_cu = 1; }
        (void)hipGetLastError();
        grid = cus;
    }
    Params p{};
    const float* const* in = (const float* const*)d_in;
    p.x = in[0]; p.norm_w = in[1]; p.w_in = in[2]; p.w_out = in[3]; p.mu = in[4]; p.w0 = in[5]; p.w2 = in[6]; p.a0 = in[7]; p.a2 = in[8];
    p.k_k = in[9]; p.k_a = in[10]; p.r_k = in[11]; p.ln_w = in[12]; p.ln_b = in[13]; p.a_up = in[14]; p.a_b = in[15]; p.gnw = in[16]; p.fnw = in[17];
    p.out = (float*)d_out;
    unsigned char* ws = (unsigned char*)d_ws; size_t off = 0;
    auto take = [&](size_t bytes) { unsigned char* r = ws + off; off += (bytes + 255) & ~(size_t)255; return r; };
    p.WtIn = (u16*)take((size_t)2 * NP * DM * 2); p.WtOut = (u16*)take((size_t)2 * DM * DM * 2);
    p.W2t = (u16*)take((size_t)2 * 1024 * 64 * 2); p.A2t = (u16*)take((size_t)2 * 1024 * 64 * 2);
    p.H = (u16*)take((size_t)MTOK * DM * 2); p.P = (u16*)take((size_t)MTOK * NP * 2);
    p.yraw = (float*)take((size_t)MTOK * 1024 * 4); p.ybonus = (float*)take((size_t)MTOK * 16 * 4); p.kmean = (float*)take((size_t)256 * 128 * 4);
    p.bar = (unsigned*)take((size_t)XCD_BAR_WORDS * 4);
    if (off > ws_size) { fprintf(stderr, "kernel_launch: workspace too small (%zu > %zu)\n", off, ws_size); return; }
#if ONE_LAUNCH
    hipMemsetAsync(p.bar, 0, (size_t)XCD_BAR_WORDS * 4, stream);
    p.phase_lo = 0; p.phase_hi = N_PHASES;
    void* args[] = {&p};
    hipError_t e = hipLaunchCooperativeKernel((const void*)hybrid_fwd, dim3(grid), dim3(512), args, LDS_BYTES, stream);
    if (e != hipSuccess) fprintf(stderr, "cooperative launch failed: %s (grid %d)\n", hipGetErrorString(e), grid);
#else
    for (int ph = 0; ph < N_PHASES; ++ph) { p.phase_lo = ph; p.phase_hi = ph + 1; hipLaunchKernelGGL(hybrid_fwd, dim3(grid), dim3(512), LDS_BYTES, stream, p); }
#endif
}
```

```cpp
#include <hip/hip_runtime.h>
#include <hip/hip_cooperative_groups.h>
#include <cstdio>
namespace cg = cooperative_groups;

#ifndef ONE_LAUNCH
#define ONE_LAUNCH 1
#endif

namespace pg8 {
#define PG8_LAS __attribute__((address_space(3)))
typedef unsigned short bf16_t;
typedef short bf16x8 __attribute__((ext_vector_type(8)));
typedef float f32x4 __attribute__((ext_vector_type(4)));
typedef unsigned u32x4 __attribute__((ext_vector_type(4)));
constexpr int BM = 256, BK = 64, HALF = 128, HTB = HALF * BK * 2  , STAGE_BYTES = 8 * HTB, NXCD = 8, WGM = 8;

__host__ __device__ __forceinline__ int lds_byte(int r, int c) { const int st = (r >> 4) * 2 + (c >> 5), rr = r & 15, cc = c & 31, ob = rr * 64 + cc * 2; return st * 1024 + (ob ^ (((ob >> 9) & 1) << 5)); }
__host__ __device__ __forceinline__ void stage_rc(int b, int& R, int& C) { const int st = b / 1024, sb = b % 1024, swz = sb ^ (((sb >> 9) & 1) << 5); R = (st >> 1) * 16 + swz / 64; C = (st & 1) * 32 + (swz % 64) / 2; }
__host__ __device__ __forceinline__ int perm32(int rho) { const int n = rho >> 4, i = rho & 15; return 8 * (i >> 2) + 4 * n + (i & 3); }

struct Unit { int pm, pn; };
struct Gemm { const bf16_t* A; const bf16_t* Bt; int M, N, K; };

struct StaticOrder {
    int nM, nN, nwg, G, c;
    __host__ __device__ void init(int M, int N, int G_, int c_) { nM = M / BM; nN = N / BM; nwg = nM * nN; G = G_; c = c_; }
    __host__ __device__ bool next(int i, Unit& u) const {
        const long L = (long)i * G + c; if (L >= nwg) return false;
        int wgid = (int)L; { const int q = nwg / NXCD, r = nwg % NXCD, xcd = wgid % NXCD, off = wgid / NXCD; wgid = (xcd < r ? xcd * (q + 1) : r * (q + 1) + (xcd - r) * q) + off; }
        const int nig = WGM * nN, gid = wgid / nig, fm = gid * WGM, gsz = (nM - fm) < WGM ? (nM - fm) : WGM;
        u.pm = fm + ((wgid % nig) % gsz); u.pn = (wgid % nig) / gsz; return true;
    }
    __device__ __forceinline__ void a_ready(const Unit&) const {}
    __device__ __forceinline__ void done(const Unit&) const {}
};
__device__ __forceinline__ unsigned cvt_pk_bf16(float lo, float hi) { unsigned r; asm volatile("v_cvt_pk_bf16_f32 %0, %1, %2" : "=v"(r) : "v"(lo), "v"(hi)); return r; }
template <class Epi, class Sched, bool STAMP = false>
__device__ __forceinline__ void gemm_phase(PG8_LAS unsigned char* lds, const Gemm g, const Sched& S, const Epi& E, unsigned long long* stamps) {
    int tid = threadIdx.x; asm volatile("" : "+v"(tid)); const int wid = __builtin_amdgcn_readfirstlane(tid >> 6), lane = tid & 63, wr = wid >> 2, wc = wid & 3, fr = lane & 15, fq = lane >> 4;
    const int K = g.K, nt = K / BK;
    int ts_lo = 0, ts_hi = 0, nts = 0; const unsigned long long rt_entry = STAMP ? (unsigned long long)wall_clock64() : 0ull;
#define PG8_STAMP() do { if (STAMP && wid == 0 && nts < 64) { const unsigned long long _c = (unsigned long long)clock64(); \
        ts_lo = (lane == nts) ? (int)(unsigned)_c : ts_lo; ts_hi = (lane == nts) ? (int)(unsigned)(_c >> 32) : ts_hi; ++nts; } } while (0)
    PG8_STAMP();
    unsigned voffA[2], voffB[2];
#pragma unroll
    for (int i = 0; i < 2; ++i) { int R, C; stage_rc(tid * 16 + i * 8192, R, C); const int Rb = Epi::PERM ? ((R & ~31) + perm32(R & 31)) : R;
        voffA[i] = (unsigned)(R * K + C) * 2u; voffB[i] = (unsigned)(Rb * K + C) * 2u; }
    const size_t kstep = (size_t)(BK * 2);
    const size_t hstep = (size_t)HALF * K * 2;
    const size_t tstep = 2 * hstep;
    const unsigned ldsw = (unsigned)wid * 1024u;
    const int aoff = lds_byte(wr * 64 + fr, fq * 8), boff = lds_byte(wc * 32 + fr, fq * 8);
#define PG8_SA(b, h) (((b) * 2 + (h)) * HTB)
#define PG8_SB(b, h) ((4 + (b) * 2 + (h)) * HTB)
#define PG8_STAGE(bufoff, gbase, voff) do { _Pragma("unroll") for (int _i = 0; _i < 2; ++_i) \
        __builtin_amdgcn_global_load_lds((const unsigned*)((const char*)(gbase) + (voff)[_i]), (PG8_LAS unsigned*)(lds + (bufoff) + ldsw + _i * 8192), 16, 0, 0); } while (0)
#define PG8_LDA(dst, b, h) do { _Pragma("unroll") for (int m = 0; m < 4; ++m) _Pragma("unroll") for (int k = 0; k < 2; ++k) dst[m][k] = *(const PG8_LAS bf16x8*)(lds + PG8_SA(b, h) + aoff + m * 2048 + k * 1024); } while (0)
#define PG8_LDB(dst, b, h) do { _Pragma("unroll") for (int n = 0; n < 2; ++n) _Pragma("unroll") for (int k = 0; k < 2; ++k) dst[n][k] = *(const PG8_LAS bf16x8*)(lds + PG8_SB(b, h) + boff + n * 2048 + k * 1024); } while (0)
#define PG8_MMA(ai, bj, At, Bt) do { __builtin_amdgcn_s_setprio(1); _Pragma("unroll") for (int m = 0; m < 4; ++m) _Pragma("unroll") for (int n = 0; n < 2; ++n) _Pragma("unroll") for (int k = 0; k < 2; ++k) \
        acc[ai][bj][m][n] = __builtin_amdgcn_mfma_f32_16x16x32_bf16(Bt[n][k], At[m][k], acc[ai][bj][m][n], 0, 0, 0); __builtin_amdgcn_s_setprio(0); } while (0)
#define PG8_WAIT_V(n) asm volatile("s_waitcnt vmcnt(" #n ")" ::: "memory")
#define PG8_WAIT_L(n) asm volatile("s_waitcnt lgkmcnt(" #n ")" ::: "memory")
#define PG8_BAR __builtin_amdgcn_s_barrier()
#define PG8_SCHED __builtin_amdgcn_sched_barrier(0)
    Unit cur, nxt; int ui = 0;
    if (!S.next(0, cur)) return;
    f32x4 acc[2][2][4][2];
#pragma unroll
    for (int a = 0; a < 2; ++a)
#pragma unroll
        for (int b = 0; b < 2; ++b)
#pragma unroll
            for (int m = 0; m < 4; ++m)
#pragma unroll
                for (int n = 0; n < 2; ++n) acc[a][b][m][n] = (f32x4){0.f, 0.f, 0.f, 0.f};
    bf16x8 At[4][2], B0[2][2], B1[2][2];
    const char* cA = (const char*)g.A + (size_t)cur.pm * tstep; const char* cB = (const char*)g.Bt + (size_t)cur.pn * tstep;
    S.a_ready(cur);
    PG8_STAGE(PG8_SB(0, 0), cB, voffB); PG8_STAGE(PG8_SA(0, 0), cA, voffA); PG8_STAGE(PG8_SB(0, 1), cB + hstep, voffB); PG8_STAGE(PG8_SA(0, 1), cA + hstep, voffA);
    if (wr == 1) PG8_BAR;
    PG8_WAIT_V(4); PG8_BAR;
    PG8_STAGE(PG8_SB(1, 0), cB + kstep, voffB); PG8_STAGE(PG8_SA(1, 0), cA + kstep, voffA); PG8_STAGE(PG8_SB(1, 1), cB + hstep + kstep, voffB);
    PG8_WAIT_V(6); PG8_BAR;
    PG8_STAMP();
    for (;;) {
        const bool has_next = S.next(ui + 1, nxt);
        const char* nA = has_next ? (const char*)g.A + (size_t)nxt.pm * tstep : cA; const char* nB = has_next ? (const char*)g.Bt + (size_t)nxt.pn * tstep : cB;
        for (int t = 0; t < nt; t += 2) {
            const bool last = (t == nt - 2);
            const char* a1 = cA + (size_t)(t + 1) * kstep;
            const char* a2 = last ? nA : cA + (size_t)(t + 2) * kstep; const char* b2 = last ? nB : cB + (size_t)(t + 2) * kstep;
            const char* a3 = a2 + kstep; const char* b3 = b2 + kstep;
            if (last && has_next) S.a_ready(nxt);
            PG8_LDB(B0, 0, 0); PG8_SCHED; PG8_LDA(At, 0, 0); PG8_STAGE(PG8_SA(1, 1), a1 + hstep, voffA);
            PG8_WAIT_L(8); PG8_BAR; PG8_WAIT_L(0); PG8_MMA(0, 0, At, B0); PG8_BAR; PG8_SCHED;
            PG8_LDB(B1, 0, 1); PG8_STAGE(PG8_SB(0, 0), b2, voffB);
            PG8_BAR; PG8_WAIT_L(0); PG8_MMA(0, 1, At, B1); PG8_BAR;
            PG8_LDA(At, 0, 1); PG8_STAGE(PG8_SA(0, 0), a2, voffA);
            PG8_BAR; PG8_WAIT_L(0); PG8_MMA(1, 0, At, B0); PG8_BAR; PG8_SCHED;
            PG8_STAGE(PG8_SB(0, 1), b2 + hstep, voffB);
            PG8_WAIT_V(6); PG8_BAR; PG8_MMA(1, 1, At, B1); PG8_BAR;
            PG8_LDB(B0, 1, 0); PG8_SCHED; PG8_LDA(At, 1, 0); PG8_STAGE(PG8_SA(0, 1), a2 + hstep, voffA);
            PG8_WAIT_L(8); PG8_BAR; PG8_WAIT_L(0); PG8_MMA(0, 0, At, B0); PG8_BAR; PG8_SCHED;
            PG8_LDB(B1, 1, 1); PG8_STAGE(PG8_SB(1, 0), b3, voffB);
            PG8_BAR; PG8_WAIT_L(0); PG8_MMA(0, 1, At, B1); PG8_BAR;
            PG8_LDA(At, 1, 1); PG8_STAGE(PG8_SA(1, 0), a3, voffA);
            PG8_BAR; PG8_WAIT_L(0); PG8_MMA(1, 0, At, B0); PG8_BAR; PG8_SCHED;
            PG8_STAGE(PG8_SB(1, 1), b3 + hstep, voffB);
            PG8_WAIT_V(6); PG8_BAR; PG8_MMA(1, 1, At, B1); PG8_BAR;
        }
        PG8_STAMP();
        if constexpr (!Epi::AFTER_DRAIN) { E(acc, cur, wr, wc, fr, fq); S.done(cur); }
        PG8_STAMP();
        if (!has_next) break;
#pragma unroll
        for (int a = 0; a < 2; ++a)
#pragma unroll
            for (int b = 0; b < 2; ++b)
#pragma unroll
                for (int m = 0; m < 4; ++m)
#pragma unroll
                    for (int n = 0; n < 2; ++n) acc[a][b][m][n] = (f32x4){0.f, 0.f, 0.f, 0.f};
        cur = nxt; cA = nA; cB = nB; ++ui;
    }
    PG8_WAIT_V(0);
    if (wr == 0) PG8_BAR;
    PG8_BAR;
    if constexpr (Epi::AFTER_DRAIN) { E.fused(acc, cur, wr, wc, fr, fq, lds, wid, lane); S.done(cur); }
    PG8_STAMP();
    if (STAMP && wid == 0) { stamps[lane] = lane < nts ? (((unsigned long long)(unsigned)ts_hi << 32) | (unsigned)ts_lo) : 0ull;
        if (lane == 62) stamps[62] = rt_entry; if (lane == 63) stamps[63] = (unsigned long long)wall_clock64(); }
#undef PG8_STAMP
#undef PG8_SA
#undef PG8_SB
#undef PG8_STAGE
#undef PG8_LDA
#undef PG8_LDB
#undef PG8_MMA
#undef PG8_WAIT_V
#undef PG8_WAIT_L
#undef PG8_BAR
#undef PG8_SCHED
}
}
using namespace pg8;
#define LAS PG8_LAS
typedef unsigned short u16;
typedef unsigned u32x2 __attribute__((ext_vector_type(2)));
typedef float f32x2 __attribute__((ext_vector_type(2)));

constexpr int NBATCH = 8, SEQ = 2048, DM = 2048, MTOK = NBATCH * SEQ, DIN = 7824, NP = 7936;
constexpr int C_R = 0, C_K = 1024, C_V = 2048, C_WD = 3072, C_GA = 3200, C_QB = 4224, C_KB = 4736, C_VB = 5248, C_GB = 5760,
              C_QC = 6272, C_KC = 6528, C_VC = 6784, C_GC = 7296, C_LOW = 7808;
constexpr int LDS_BYTES = 143360;

struct Params {
    const float *x, *norm_w, *w_in, *w_out, *mu, *w0, *w2, *a0, *a2, *k_k, *k_a, *r_k, *ln_w, *ln_b, *a_up, *a_b, *gnw, *fnw;
    float* out;
    u16 *WtIn, *WtOut, *W2t, *A2t, *H, *P;
    float *yraw, *ybonus, *kmean;
    unsigned* bar;
    int phase_lo, phase_hi;
};

__device__ __forceinline__ int tid_() { int t = threadIdx.x; asm volatile("" : "+v"(t)); return t; }
__device__ __forceinline__ float bf2f(u16 v) { return __uint_as_float(((unsigned)v) << 16); }
__device__ __forceinline__ float bflo(unsigned w) { return __uint_as_float(w << 16); }
__device__ __forceinline__ float bfhi(unsigned w) { return __uint_as_float(w & 0xffff0000u); }
__device__ __forceinline__ u16 f2bf(float f) { return (u16)(cvt_pk_bf16(f, 0.f) & 0xffffu); }
template <int CTRL> __device__ __forceinline__ float dpp_f(float v) { return __int_as_float(__builtin_amdgcn_update_dpp(0, __float_as_int(v), CTRL, 0xF, 0xF, true)); }
__device__ __forceinline__ float red16_sum(float v) { v += dpp_f<0xB1>(v); v += dpp_f<0x4E>(v); v += dpp_f<0x141>(v); v += dpp_f<0x140>(v); return v; }
__device__ __forceinline__ float red8_sum(float v) { v += dpp_f<0xB1>(v); v += dpp_f<0x4E>(v); v += dpp_f<0x141>(v); return v; }
__device__ __forceinline__ float red16_max(float v) { v = fmaxf(v, dpp_f<0xB1>(v)); v = fmaxf(v, dpp_f<0x4E>(v)); v = fmaxf(v, dpp_f<0x141>(v)); v = fmaxf(v, dpp_f<0x140>(v)); return v; }
__device__ __forceinline__ float wave_sum(float v) {
#pragma unroll
    for (int o = 1; o < 64; o <<= 1) v += __shfl_xor(v, o);
    return v;
}
__device__ __forceinline__ float sigmoidf_(float x) { return 1.f / (1.f + __expf(-x)); }
__device__ __forceinline__ float siluf_(float x) { return x / (1.f + __expf(-x)); }
__device__ __forceinline__ float logsigmoidf_(float z) { return fminf(z, 0.f) - log1pf(__expf(-fabsf(z))); }
__device__ __forceinline__ f32x4 mfma16(bf16x8 a, bf16x8 b, f32x4 c) { return __builtin_amdgcn_mfma_f32_16x16x32_bf16(a, b, c, 0, 0, 0); }

struct EpiP {
    static constexpr bool PERM = true, AFTER_DRAIN = false;
    bf16_t* O; int ldc;
    __device__ __forceinline__ void operator()(const f32x4 (&acc)[2][2][4][2], const Unit& u, int wr, int wc, int fr, int fq) const {
        const int row0 = u.pm * BM + wr * 64 + fr, col0 = u.pn * BM + wc * 32 + 8 * fq;
#pragma unroll
        for (int ai = 0; ai < 2; ++ai)
#pragma unroll
            for (int m = 0; m < 4; ++m) { bf16_t* rowp = O + (size_t)(row0 + ai * HALF + m * 16) * ldc + col0;
#pragma unroll
                for (int bj = 0; bj < 2; ++bj) { const f32x4 v0 = acc[ai][bj][m][0], v1 = acc[ai][bj][m][1];
                    u32x4 w; w.x = cvt_pk_bf16(v0[0], v0[1]); w.y = cvt_pk_bf16(v0[2], v0[3]); w.z = cvt_pk_bf16(v1[0], v1[1]); w.w = cvt_pk_bf16(v1[2], v1[3]);
                    *(u32x4*)(rowp + bj * HALF) = w; } }
    }
};
struct EpiRes {
    static constexpr bool PERM = false, AFTER_DRAIN = false;
    const float* R; float* C; int ldc;
    __device__ __forceinline__ void operator()(const f32x4 (&acc)[2][2][4][2], const Unit& u, int wr, int wc, int fr, int fq) const {
        const int row0 = u.pm * BM + wr * 64 + fr, col0 = u.pn * BM + wc * 32 + 4 * fq;
#pragma unroll
        for (int ai = 0; ai < 2; ++ai)
#pragma unroll
            for (int m = 0; m < 4; ++m) { const size_t off = (size_t)(row0 + ai * HALF + m * 16) * ldc + col0;
#pragma unroll
                for (int bj = 0; bj < 2; ++bj)
#pragma unroll
                    for (int n = 0; n < 2; ++n) { const f32x4 r = *(const f32x4*)(R + off + bj * HALF + n * 16); *(f32x4*)(C + off + bj * HALF + n * 16) = acc[ai][bj][m][n] + r; }
                asm volatile("" ::: "memory"); }
    }
};

__device__ void transpose_cvt(LAS unsigned char* lds, const float* src, u16* dst, int K, int N, int Npad, int bid, int nb) {
    LAS float* tile = (LAS float*)lds;
    const int tilesN = Npad / 64, tilesK = K / 64, tid = tid_();
    for (int t = bid; t < tilesN * tilesK; t += nb) {
        const int tn = t % tilesN, tk = t / tilesN, n0 = tn * 64, k0 = tk * 64;
#pragma unroll
        for (int i = 0; i < 2; ++i) { const int idx = tid + i * 512, kk = idx >> 4, n4 = (idx & 15) * 4;
            float4 v = make_float4(0.f, 0.f, 0.f, 0.f);
            if (n0 + n4 < N) v = *(const float4*)(src + (size_t)(k0 + kk) * N + n0 + n4);
            tile[(n4 + 0) * 65 + kk] = v.x; tile[(n4 + 1) * 65 + kk] = v.y; tile[(n4 + 2) * 65 + kk] = v.z; tile[(n4 + 3) * 65 + kk] = v.w; }
        __syncthreads();
        { const int n = tid >> 3, k8 = (tid & 7) * 8; const LAS float* r = tile + n * 65 + k8;
            u32x4 o; o.x = cvt_pk_bf16(r[0], r[1]); o.y = cvt_pk_bf16(r[2], r[3]); o.z = cvt_pk_bf16(r[4], r[5]); o.w = cvt_pk_bf16(r[6], r[7]);
            *(u32x4*)(dst + (size_t)(n0 + n) * K + k0 + k8) = o; }
        __syncthreads();
    }
}

__device__ void rmsnorm_phase(const float* x, const float* w, u16* hb, float* of, int bid, int nb) {
    const int tid0 = tid_(), wid = tid0 >> 6, lane = tid0 & 63;
    for (int row = bid * 8 + wid; row < MTOK; row += nb * 8) {
        const float4* xr = (const float4*)(x + (size_t)row * DM);
        float4 v[8]; float s = 0.f;
#pragma unroll
        for (int i = 0; i < 8; ++i) { v[i] = xr[i * 64 + lane]; s += v[i].x * v[i].x + v[i].y * v[i].y + v[i].z * v[i].z + v[i].w * v[i].w; }
        s = wave_sum(s);
        const float rs = rsqrtf(s * (1.f / DM) + 1e-6f);
#pragma unroll
        for (int i = 0; i < 8; ++i) { const float4 wv = ((const float4*)w)[i * 64 + lane];
            const float a = v[i].x * rs * wv.x, b = v[i].y * rs * wv.y, c = v[i].z * rs * wv.z, d = v[i].w * rs * wv.w;
            if (hb) { uint2 o; o.x = cvt_pk_bf16(a, b); o.y = cvt_pk_bf16(c, d); *(uint2*)(hb + (size_t)row * DM + (i * 64 + lane) * 4) = o; }
            else { ((float4*)(of + (size_t)row * DM))[i * 64 + lane] = make_float4(a, b, c, d); } }
    }
}

__device__ void kmean_phase(const Params& p, LAS unsigned char* lds, int bid, int nb) {
    LAS float* part = (LAS float*)lds;
    const int tid = tid_();
    for (int task = bid; task < 256; task += nb) {
        const int b = task >> 5, h = (task >> 3) & 3, blk = task & 7;
        const int d8 = (tid & 15) * 8, kg = tid >> 4;
        float s[8];
#pragma unroll
        for (int e = 0; e < 8; ++e) s[e] = 0.f;
        for (int kk = 0; kk < 8; ++kk) {
            const int tok = b * SEQ + blk * 256 + kg * 8 + kk;
            const uint4 v = *(const uint4*)(p.P + (size_t)tok * NP + C_KB + h * 128 + d8);
            s[0] += bflo(v.x); s[1] += bfhi(v.x); s[2] += bflo(v.y); s[3] += bfhi(v.y); s[4] += bflo(v.z); s[5] += bfhi(v.z); s[6] += bflo(v.w); s[7] += bfhi(v.w);
        }
        __syncthreads();
#pragma unroll
        for (int e = 0; e < 8; ++e) part[kg * 128 + d8 + e] = s[e];
        __syncthreads();
        if (tid < 128) { float a = 0.f; for (int g = 0; g < 32; ++g) a += part[g * 128 + tid]; p.kmean[(size_t)task * 128 + tid] = a * (1.f / 256.f); }
    }
    __syncthreads();
}

constexpr int RW_T = 32;
constexpr int RW_XB = 45056;
constexpr int RW_RAW = 90112, RW_A1 = 111616, RW_A2 = 116224, RW_KS = 120832, RW_AS = 129024, RW_MU = 137216, RW_PAR = 138496, RW_FLG = 139776;
__device__ __forceinline__ void rw_issue(const Params& p, int pt, int b, int h, int t0, u32x4 (&rg)[6]) {
#pragma unroll
    for (int i = 0; i < 6; ++i) { const int piece = pt + 256 * i; rg[i] = (u32x4){0u, 0u, 0u, 0u};
        if (piece < 33 * 40) { const int row = piece / 40, pc = piece % 40; const int t = t0 - 1 + row;
            const int col = pc < 8 ? C_R + h * 64 + pc * 8 : pc < 16 ? C_K + h * 64 + (pc - 8) * 8 : pc < 24 ? C_V + h * 64 + (pc - 16) * 8 : C_WD + (pc - 24) * 8;
            if (t >= 0) rg[i] = *(const u32x4*)(p.P + (size_t)(b * SEQ + t) * NP + col); } }
}
__device__ __forceinline__ void prep_bar(volatile LAS unsigned* flg, int pw, int lane, unsigned& ep) {
    ++ep;
    asm volatile("s_waitcnt lgkmcnt(0)" ::: "memory");
    if (lane == 0) flg[pw] = ep;
    for (;;) { const unsigned f0 = flg[0], f1 = flg[1], f2 = flg[2], f3 = flg[3]; if (f0 >= ep && f1 >= ep && f2 >= ep && f3 >= ep) break; __builtin_amdgcn_s_sleep(1); }
    asm volatile("s_waitcnt lgkmcnt(0)" ::: "memory");
}
__device__ void rwkv_scan_phase(const Params& p, int l, LAS unsigned char* lds, int bid, int nb) {
    const int tid = tid_(), wid = tid >> 6, lane = tid & 63;
    LAS u16* raw = (LAS u16*)(lds + RW_RAW); LAS u16* A1 = (LAS u16*)(lds + RW_A1); LAS u16* A2 = (LAS u16*)(lds + RW_A2);
    LAS float* kS = (LAS float*)(lds + RW_KS); LAS float* aS = (LAS float*)(lds + RW_AS);
    LAS float* muS = (LAS float*)(lds + RW_MU); LAS float* parS = (LAS float*)(lds + RW_PAR);
    volatile LAS unsigned* flg = (volatile LAS unsigned*)(lds + RW_FLG);
    for (int task = bid; task < 256; task += nb) {
        const int b = task >> 5, h = (task >> 1) & 15, half = task & 1;
        __syncthreads();
        if (tid >= 256 && tid < 260) flg[tid - 256] = 0u;
        __syncthreads();
        if (wid < 4) {
            const int srow = tid >> 3, ssub = tid & 7;
            f32x2 S01 = {0.f, 0.f}, S23 = {0.f, 0.f}, S45 = {0.f, 0.f}, S67 = {0.f, 0.f};
            float* yout = p.yraw + (size_t)(b * SEQ + ssub) * 1024 + h * 64 + half * 32 + srow;
            for (int c = 0; c < SEQ / RW_T; ++c) {
                __syncthreads();
                const LAS float* ob = (const LAS float*)(lds + (c & 1) * RW_XB) + ssub * 8;
                const LAS float* ov = (const LAS float*)(lds + (c & 1) * RW_XB + 40960) + srow;
                f32x4 nw0 = *(const LAS f32x4*)(ob), nw1 = *(const LAS f32x4*)(ob + 4), na0 = *(const LAS f32x4*)(ob + 2048), na1 = *(const LAS f32x4*)(ob + 2052);
                f32x4 nb0 = *(const LAS f32x4*)(ob + 4096), nb1 = *(const LAS f32x4*)(ob + 4100), nk0 = *(const LAS f32x4*)(ob + 6144), nk1 = *(const LAS f32x4*)(ob + 6148);
                f32x4 nr0 = *(const LAS f32x4*)(ob + 8192), nr1 = *(const LAS f32x4*)(ob + 8196);
                float nv = ov[0];
                float ykeep = 0.f;
#pragma unroll
                for (int t = 0; t < RW_T; ++t) {
                    const f32x4 w0 = nw0, w1 = nw1, a0 = na0, a1 = na1, b0 = nb0, b1 = nb1, k0 = nk0, k1 = nk1, r0 = nr0, r1 = nr1; const float vv = nv;
                    if (t + 1 < RW_T) { const LAS float* o2 = ob + (t + 1) * 64;
                        nw0 = *(const LAS f32x4*)(o2); nw1 = *(const LAS f32x4*)(o2 + 4); na0 = *(const LAS f32x4*)(o2 + 2048); na1 = *(const LAS f32x4*)(o2 + 2052);
                        nb0 = *(const LAS f32x4*)(o2 + 4096); nb1 = *(const LAS f32x4*)(o2 + 4100); nk0 = *(const LAS f32x4*)(o2 + 6144); nk1 = *(const LAS f32x4*)(o2 + 6148);
                        nr0 = *(const LAS f32x4*)(o2 + 8192); nr1 = *(const LAS f32x4*)(o2 + 8196);
                        nv = ov[(t + 1) * 32]; }
                    const f32x2 sa2 = (S01 * a0.lo + S23 * a0.hi) + (S45 * a1.lo + S67 * a1.hi);
                    const float sa = red8_sum(sa2.x + sa2.y);
                    const f32x2 sav = {sa, sa}, vv2 = {vv, vv};
                    S01 = S01 * w0.lo + sav * b0.lo + vv2 * k0.lo;
                    S23 = S23 * w0.hi + sav * b0.hi + vv2 * k0.hi;
                    S45 = S45 * w1.lo + sav * b1.lo + vv2 * k1.lo;
                    S67 = S67 * w1.hi + sav * b1.hi + vv2 * k1.hi;
                    const f32x2 y2 = (S01 * r0.lo + S23 * r0.hi) + (S45 * r1.lo + S67 * r1.hi);
                    const float y = red8_sum(y2.x + y2.y);
                    ykeep = (ssub == (t & 7)) ? y : ykeep;
                    if ((t & 7) == 7) yout[(size_t)(c * RW_T + (t & ~7)) * 1024] = ykeep;
                }
            }
        } else {
            const int pt = tid - 256, pw = wid - 4;
            unsigned ep = 0u;
            for (int c2 = pt; c2 < 320; c2 += 256) { const int mi = c2 < 64 ? h * 64 + c2 : c2 < 128 ? 1024 + h * 64 + (c2 - 64) : c2 < 192 ? 2048 + h * 64 + (c2 - 128) : 3072 + (c2 - 192);
                muS[c2] = p.mu[(size_t)l * 3200 + mi]; }
            if (pt < 64) { const size_t o = (size_t)l * 1024 + h * 64 + pt;
                parS[pt] = p.w0[o]; parS[64 + pt] = p.a0[o]; parS[128 + pt] = p.k_k[o]; parS[192 + pt] = p.k_a[o]; parS[256 + pt] = p.r_k[o]; }
            const int mat = pw >> 1, ct0 = (pw & 1) * 2;
            bf16x8 bfr[2][2];
#pragma unroll
            for (int ci = 0; ci < 2; ++ci) { const u16* Bt = (mat ? p.A2t : p.W2t) + (size_t)l * 1024 * 64 + (size_t)(h * 64 + (ct0 + ci) * 16 + (lane & 15)) * 64 + (lane >> 4) * 8;
                bfr[ci][0] = *(const bf16x8*)(Bt); bfr[ci][1] = *(const bf16x8*)(Bt + 32); }
            u32x4 rg[6];
            rw_issue(p, pt, b, h, 0, rg);
            for (int c = 0; c < SEQ / RW_T; ++c) {
                const int t0 = c * RW_T;
                LAS float* opW = (LAS float*)(lds + (c & 1) * RW_XB); LAS float* opA = opW + 2048; LAS float* opB = opW + 4096; LAS float* opK = opW + 6144; LAS float* opR = opW + 8192; LAS float* opV = opW + 10240;
#pragma unroll
                for (int i = 0; i < 6; ++i) { const int piece = pt + 256 * i; if (piece < 33 * 40) *(LAS u32x4*)(raw + (piece / 40) * 320 + (piece % 40) * 8) = rg[i]; }
                prep_bar(flg, pw, lane, ep);
                if (c + 1 < SEQ / RW_T) rw_issue(p, pt, b, h, t0 + RW_T, rg);
#pragma unroll
                for (int reg = 0; reg < 5; ++reg)
#pragma unroll
                    for (int i = 0; i < 4; ++i) { const int e = pt + 256 * i, t = e >> 5, pr = e & 31, cc = reg * 64 + 2 * pr;
                        const unsigned cu = *(const LAS unsigned*)(raw + (t + 1) * 320 + cc), pu = *(const LAS unsigned*)(raw + t * 320 + cc);
                        const f32x2 mu2 = *(const LAS f32x2*)(muS + cc);
                        const f32x2 cur = {bflo(cu), bfhi(cu)}, prv = {bflo(pu), bfhi(pu)};
                        const f32x2 xs = cur + mu2 * (prv - cur);
                        if (reg == 0) *(LAS f32x2*)(opR + t * 64 + 2 * pr) = xs;
                        else if (reg == 1) *(LAS f32x2*)(kS + t * 64 + 2 * pr) = xs;
                        else if (reg == 2) { if ((pr >> 4) == half) *(LAS f32x2*)(opV + t * 32 + ((2 * pr) & 31)) = xs; }
                        else if (reg == 3) { const float e0 = __expf(2.f * xs.x), e1 = __expf(2.f * xs.y);
                            *(LAS unsigned*)(A1 + t * 72 + 2 * pr) = cvt_pk_bf16(1.f - 2.f * __builtin_amdgcn_rcpf(e0 + 1.f), 1.f - 2.f * __builtin_amdgcn_rcpf(e1 + 1.f)); }
                        else *(LAS unsigned*)(A2 + t * 72 + 2 * pr) = cvt_pk_bf16(xs.x, xs.y); }
                prep_bar(flg, pw, lane, ep);
                { LAS u16* Ab = mat ? A2 : A1;
#pragma unroll
                    for (int ci = 0; ci < 2; ++ci)
#pragma unroll
                        for (int rt = 0; rt < 2; ++rt) { f32x4 acc = {0.f, 0.f, 0.f, 0.f};
#pragma unroll
                            for (int ks = 0; ks < 2; ++ks) { const bf16x8 af = *(const LAS bf16x8*)(Ab + (rt * 16 + (lane & 15)) * 72 + ks * 32 + (lane >> 4) * 8); acc = mfma16(af, bfr[ci][ks], acc); }
                            const int cc = (ct0 + ci) * 16 + (lane & 15);
#pragma unroll
                            for (int i = 0; i < 4; ++i) { const int t = rt * 16 + (lane >> 4) * 4 + i;
                                if (mat == 0) { float wv = parS[cc] + acc[i]; wv = fminf(wv, 0.f) - __logf(1.f + __expf(-fabsf(wv))) - 0.5f; opW[t * 64 + cc] = __expf(-__expf(wv)); }
                                else aS[t * 64 + cc] = __builtin_amdgcn_rcpf(1.f + __expf(-(parS[64 + cc] + acc[i]))); } } }
                prep_bar(flg, pw, lane, ep);
#pragma unroll
                for (int j = 0; j < 2; ++j) { const int item = pt + 256 * j, t = item >> 4, sub = item & 15, c4 = sub * 4;
                    const f32x4 kr = *(const LAS f32x4*)(kS + t * 64 + c4), av = *(const LAS f32x4*)(aS + t * 64 + c4), rr = *(const LAS f32x4*)(opR + t * 64 + c4);
                    const f32x4 kkp = *(const LAS f32x4*)(parS + 128 + c4), kap = *(const LAS f32x4*)(parS + 192 + c4), rkp = *(const LAS f32x4*)(parS + 256 + c4);
                    f32x4 kk = kr * kkp;
                    float ss = kk.x * kk.x + kk.y * kk.y + kk.z * kk.z + kk.w * kk.w; ss = red16_sum(ss);
                    const float inv = rsqrtf(fmaxf(ss, 1e-24f));
                    kk.x *= inv; kk.y *= inv; kk.z *= inv; kk.w *= inv;
                    const f32x4 km = kr * (1.f + (av - 1.f) * kap);
                    *(LAS f32x4*)(opA + t * 64 + c4) = -kk;
                    *(LAS f32x4*)(opB + t * 64 + c4) = kk * av;
                    *(LAS f32x4*)(opK + t * 64 + c4) = km;
                    float bo = rr.x * km.x * rkp.x + rr.y * km.y * rkp.y + rr.z * km.z * rkp.z + rr.w * km.w * rkp.w; bo = red16_sum(bo);
                    if (half == 0 && sub == 0) p.ybonus[(size_t)(b * SEQ + t0 + t) * 16 + h] = bo; }
                __syncthreads();
            }
        }
    }
    __syncthreads();
}

__device__ void rwkv_post_item(const Params& p, int l, int item) {
    const int tid = tid_(), pair = item * 32 + (tid >> 4), tok = pair >> 4, h = pair & 15, c4 = (tid & 15) * 4;
    const float4 y = *(const float4*)(p.yraw + (size_t)tok * 1024 + h * 64 + c4);
    const float mean = red16_sum(y.x + y.y + y.z + y.w) * (1.f / 64.f);
    const float d0 = y.x - mean, d1 = y.y - mean, d2 = y.z - mean, d3 = y.w - mean;
    const float var = red16_sum(d0 * d0 + d1 * d1 + d2 * d2 + d3 * d3) * (1.f / 64.f);
    const float rs = rsqrtf(var + 64e-5f);
    const size_t po = (size_t)l * 1024 + h * 64 + c4;
    const float4 lw = *(const float4*)(p.ln_w + po), lb = *(const float4*)(p.ln_b + po), muv = *(const float4*)(p.mu + (size_t)l * 3200 + 2048 + h * 64 + c4);
    const uint2 vc = *(const uint2*)(p.P + (size_t)tok * NP + C_V + h * 64 + c4);
    uint2 vp = make_uint2(0u, 0u);
    if ((tok & (SEQ - 1)) != 0) vp = *(const uint2*)(p.P + (size_t)(tok - 1) * NP + C_V + h * 64 + c4);
    const uint2 gg = *(const uint2*)(p.P + (size_t)tok * NP + C_GA + h * 64 + c4);
    const float bo = p.ybonus[(size_t)tok * 16 + h];
    float v0 = bflo(vc.x), v1 = bfhi(vc.x), v2 = bflo(vc.y), v3 = bfhi(vc.y);
    v0 += muv.x * (bflo(vp.x) - v0); v1 += muv.y * (bfhi(vp.x) - v1); v2 += muv.z * (bflo(vp.y) - v2); v3 += muv.w * (bfhi(vp.y) - v3);
    const float o0 = (d0 * rs * lw.x + lb.x + bo * v0) * siluf_(bflo(gg.x)), o1 = (d1 * rs * lw.y + lb.y + bo * v1) * siluf_(bfhi(gg.x));
    const float o2 = (d2 * rs * lw.z + lb.z + bo * v2) * siluf_(bflo(gg.y)), o3 = (d3 * rs * lw.w + lb.w + bo * v3) * siluf_(bfhi(gg.y));
    uint2 o; o.x = cvt_pk_bf16(o0, o1); o.y = cvt_pk_bf16(o2, o3);
    *(uint2*)(p.H + (size_t)tok * DM + h * 64 + c4) = o;
}

constexpr int MB_K = 0, MB_VT = 17408, MB_PW = 35840, MB_KM = 54272, MB_SEL = 57856, MB_TM = 58368;
__device__ void moba_task(const Params& p, LAS unsigned char* lds, int task) {
    const int tid = tid_(), wid = tid >> 6, lane = tid & 63, l15 = lane & 15, lq = lane >> 4;
    const int qt = 15 - (task >> 5), bh = task & 31, b = bh >> 2, h = bh & 3, qblk = qt >> 1, q0 = qt * 128;
    LAS u16* Kt = (LAS u16*)(lds + MB_K); LAS u16* VT = (LAS u16*)(lds + MB_VT); LAS u16* Pw = (LAS u16*)(lds + MB_PW) + wid * 16 * 72;
    LAS float* kmS = (LAS float*)(lds + MB_KM); LAS int* selS = (LAS int*)(lds + MB_SEL); LAS int* tmS = (LAS int*)(lds + MB_TM);
    __syncthreads();
    for (int i = tid; i < qblk * 128; i += 512) kmS[i] = p.kmean[(size_t)(bh * 8) * 128 + i];
    if (tid == 0) *tmS = 0;
    __syncthreads();
    if (tid < 128) {
        const u16* qp = p.P + (size_t)(b * SEQ + q0 + tid) * NP + C_QB + h * 128;
        float g[7];
#pragma unroll
        for (int j = 0; j < 7; ++j) g[j] = 0.f;
        for (int d8 = 0; d8 < 128; d8 += 8) {
            const uint4 v = *(const uint4*)(qp + d8);
            const float q[8] = {bflo(v.x), bfhi(v.x), bflo(v.y), bfhi(v.y), bflo(v.z), bfhi(v.z), bflo(v.w), bfhi(v.w)};
#pragma unroll
            for (int j = 0; j < 7; ++j) if (j < qblk) {
#pragma unroll
                for (int e = 0; e < 8; ++e) g[j] += q[e] * kmS[j * 128 + d8 + e]; }
        }
        int mask = 0;
#pragma unroll
        for (int r = 0; r < 3; ++r) { float best = -INFINITY; int bi = -1;
#pragma unroll
            for (int j = 0; j < 7; ++j) if (j < qblk && !((mask >> j) & 1) && g[j] > best) { best = g[j]; bi = j; }
            if (bi >= 0) mask |= 1 << bi; }
        mask |= 1 << qblk;
        selS[tid] = mask; atomicOr((int*)tmS, mask);
    }
    __syncthreads();
    const int tmask = *tmS;
    bf16x8 qf[4];
    { const u16* qp = p.P + (size_t)(b * SEQ + q0 + wid * 16 + l15) * NP + C_QB + h * 128 + lq * 8;
#pragma unroll
        for (int ks = 0; ks < 4; ++ks) qf[ks] = *(const bf16x8*)(qp + ks * 32); }
    int rm[4]; int wmask = 0;
#pragma unroll
    for (int i = 0; i < 4; ++i) rm[i] = selS[wid * 16 + lq * 4 + i];
    for (int i = 0; i < 16; ++i) wmask |= selS[wid * 16 + i];
    float m[4], ls[4]; f32x4 O[8];
#pragma unroll
    for (int i = 0; i < 4; ++i) { m[i] = -1e30f; ls[i] = 0.f; }
#pragma unroll
    for (int dt = 0; dt < 8; ++dt) O[dt] = (f32x4){0.f, 0.f, 0.f, 0.f};
    const float scale = 0.08838834764831845f;
    const int last = (q0 + 127) >> 6;
    int ti = 0;
    while (ti <= last && !((tmask >> (ti >> 2)) & 1)) ++ti;
    const int kp = lane & 31, vd8 = (wid * 2 + (lane >> 5)) * 8;
    u32x4 pk0, pk1, pv0, pv1;
#define MOBA_ISSUE(tt) do { const size_t kb_ = (size_t)(b * SEQ + (tt) * 64); \
        pk0 = *(const u32x4*)(p.P + (kb_ + (tid >> 4)) * NP + C_KB + h * 128 + (tid & 15) * 8); pk1 = *(const u32x4*)(p.P + (kb_ + 32 + (tid >> 4)) * NP + C_KB + h * 128 + (tid & 15) * 8); \
        pv0 = *(const u32x4*)(p.P + (kb_ + 2 * kp) * NP + C_VB + h * 128 + vd8); pv1 = *(const u32x4*)(p.P + (kb_ + 2 * kp + 1) * NP + C_VB + h * 128 + vd8); } while (0)
    if (ti <= last) MOBA_ISSUE(ti);
    while (ti <= last) {
        {
            const int j = ti >> 2, key0 = ti * 64;
            __syncthreads();
            *(LAS u32x4*)(Kt + (tid >> 4) * 136 + (tid & 15) * 8) = pk0; *(LAS u32x4*)(Kt + (32 + (tid >> 4)) * 136 + (tid & 15) * 8) = pk1;
            { LAS unsigned* vt = (LAS unsigned*)(VT + vd8 * 72 + 2 * kp);
                vt[0] = (pv0.x & 0xffffu) | (pv1.x << 16); vt[36] = (pv0.x >> 16) | (pv1.x & 0xffff0000u);
                vt[72] = (pv0.y & 0xffffu) | (pv1.y << 16); vt[108] = (pv0.y >> 16) | (pv1.y & 0xffff0000u);
                vt[144] = (pv0.z & 0xffffu) | (pv1.z << 16); vt[180] = (pv0.z >> 16) | (pv1.z & 0xffff0000u);
                vt[216] = (pv0.w & 0xffffu) | (pv1.w << 16); vt[252] = (pv0.w >> 16) | (pv1.w & 0xffff0000u); }
            __syncthreads();
            int tn = ti + 1;
            while (tn <= last && !((tmask >> (tn >> 2)) & 1)) ++tn;
            if (tn <= last) MOBA_ISSUE(tn);
            ti = tn;
            if ((wmask >> j) & 1) {
                f32x4 s[4];
#pragma unroll
                for (int nt = 0; nt < 4; ++nt) { s[nt] = (f32x4){0.f, 0.f, 0.f, 0.f};
#pragma unroll
                    for (int ks = 0; ks < 4; ++ks) { const bf16x8 kf = *(const LAS bf16x8*)(Kt + (nt * 16 + l15) * 136 + ks * 32 + lq * 8); s[nt] = mfma16(qf[ks], kf, s[nt]); } }
#pragma unroll
                for (int i = 0; i < 4; ++i) {
                    const int qpos = q0 + wid * 16 + lq * 4 + i; const bool rsel = (rm[i] >> j) & 1;
                    float mx = -1e30f;
#pragma unroll
                    for (int nt = 0; nt < 4; ++nt) { const int kpos = key0 + nt * 16 + l15;
                        const bool valid = (j == qblk) ? (kpos <= qpos) : rsel;
                        const float sv = valid ? s[nt][i] * scale : -1e30f; s[nt][i] = sv; mx = fmaxf(mx, sv); }
                    mx = red16_max(mx);
                    const float mnew = fmaxf(m[i], mx), alpha = __expf(m[i] - mnew);
                    float rs = 0.f;
#pragma unroll
                    for (int nt = 0; nt < 4; ++nt) { const float pv = s[nt][i] > -1e29f ? __expf(s[nt][i] - mnew) : 0.f; rs += pv; Pw[(lq * 4 + i) * 72 + nt * 16 + l15] = f2bf(pv); }
                    rs = red16_sum(rs);
                    ls[i] = ls[i] * alpha + rs; m[i] = mnew;
#pragma unroll
                    for (int dt = 0; dt < 8; ++dt) O[dt][i] *= alpha;
                }
                __builtin_amdgcn_wave_barrier();
                bf16x8 pf[2];
#pragma unroll
                for (int ks = 0; ks < 2; ++ks) pf[ks] = *(const LAS bf16x8*)(Pw + l15 * 72 + ks * 32 + lq * 8);
#pragma unroll
                for (int dt = 0; dt < 8; ++dt)
#pragma unroll
                    for (int ks = 0; ks < 2; ++ks) { const bf16x8 vf = *(const LAS bf16x8*)(VT + (dt * 16 + l15) * 72 + ks * 32 + lq * 8); O[dt] = mfma16(pf[ks], vf, O[dt]); }
                __builtin_amdgcn_wave_barrier();
            }
        }
    }
#pragma unroll
    for (int i = 0; i < 4; ++i) { const float inv = 1.f / ls[i]; const size_t tok = (size_t)(b * SEQ + q0 + wid * 16 + lq * 4 + i);
#pragma unroll
        for (int dt = 0; dt < 8; ++dt) { const int d = dt * 16 + l15;
            const float g = bf2f(p.P[tok * NP + C_GB + h * 128 + d]);
            p.H[tok * DM + 1024 + h * 128 + d] = f2bf(O[dt][i] * inv * siluf_(g)); } }
}

constexpr int GL_QE = 0, GL_KE = 9216, GL_KDT = 18432, GL_VT = 27648, GL_ATT = 46080, GL_ST = 55296, GL_LA = 73728, GL_TOT = 90112,
              GL_AUP = 92160, GL_LOW = 96256, GL_DEC = 100352, GL_ABS = 100608, GL_GNW = 100864, GL_OB = 0;
__device__ void gla_task(const Params& p, int l, LAS unsigned char* lds, int task) {
    const int tid = tid_(), wid = tid >> 6, lane = tid & 63, l15 = lane & 15, lq = lane >> 4;
    const int b = task >> 2, h = task & 3;
    LAS u16* QE = (LAS u16*)(lds + GL_QE); LAS u16* KE = (LAS u16*)(lds + GL_KE); LAS u16* KDT = (LAS u16*)(lds + GL_KDT); LAS u16* VT = (LAS u16*)(lds + GL_VT);
    LAS u16* ATT = (LAS u16*)(lds + GL_ATT); LAS u16* ST = (LAS u16*)(lds + GL_ST); LAS float* LA = (LAS float*)(lds + GL_LA); LAS float* TOT = (LAS float*)(lds + GL_TOT);
    LAS float* AUP = (LAS float*)(lds + GL_AUP); LAS float* LOW = (LAS float*)(lds + GL_LOW); LAS float* DEC = (LAS float*)(lds + GL_DEC); LAS float* OB = (LAS float*)(lds + GL_OB); LAS float* ABS = (LAS float*)(lds + GL_ABS); LAS float* GNW = (LAS float*)(lds + GL_GNW);
    __syncthreads();
    for (int i = tid; i < 1024; i += 512) AUP[i] = p.a_up[(size_t)l * 16 * 256 + (i >> 6) * 256 + h * 64 + (i & 63)];
    for (int i = tid; i < 128 * 72 / 2; i += 512) ((LAS unsigned*)ST)[i] = 0u;
    if (tid < 64) ABS[tid] = p.a_b[(size_t)l * 256 + h * 64 + tid];
    if (tid >= 64 && tid < 192) GNW[tid - 64] = p.gnw[(size_t)l * 128 + tid - 64];
    f32x4 Sacc[4];
#pragma unroll
    for (int c = 0; c < 4; ++c) Sacc[c] = (f32x4){0.f, 0.f, 0.f, 0.f};
    const int rt = wid >> 1, dv0t = (wid & 1) * 4;
    const int tp = lane & 31, dg = wid * 2 + (lane >> 5);
    for (int n = 0; n < 32; ++n) {
        const size_t tokb = (size_t)(b * SEQ + n * 64);
        const u16* rowp = p.P + (tokb + (tid >> 3)) * NP;
        const u16* rp0 = p.P + (tokb + 2 * tp) * NP; const u16* rp1 = rp0 + NP;
        const unsigned c_low = *(const unsigned*)(rowp + C_LOW + (tid & 7) * 2);
        const u32x2 c_q0 = *(const u32x2*)(rp0 + C_QC + h * 64 + dg * 4), c_q1 = *(const u32x2*)(rp1 + C_QC + h * 64 + dg * 4);
        const u32x2 c_k0 = *(const u32x2*)(rp0 + C_KC + h * 64 + dg * 4), c_k1 = *(const u32x2*)(rp1 + C_KC + h * 64 + dg * 4);
        const u32x4 c_v0 = *(const u32x4*)(rp0 + C_VC + h * 128 + dg * 8), c_v1 = *(const u32x4*)(rp1 + C_VC + h * 128 + dg * 8);
        const u32x4 c_g0 = *(const u32x4*)(rowp + C_GC + h * 128 + (tid & 7) * 16), c_g1 = *(const u32x4*)(rowp + C_GC + h * 128 + (tid & 7) * 16 + 8);
        { const int e2 = tid * 2, t = e2 >> 4, r = e2 & 15; LOW[t * 16 + r] = bflo(c_low); LOW[t * 16 + r + 1] = bfhi(c_low); }
        __syncthreads();
        { const int t = tid >> 3, d0 = (tid & 7) * 8;
            f32x4 lo[4];
#pragma unroll
            for (int i = 0; i < 4; ++i) lo[i] = *(const LAS f32x4*)(LOW + t * 16 + 4 * i);
            f32x4 z0 = *(const LAS f32x4*)(ABS + d0), z1 = *(const LAS f32x4*)(ABS + d0 + 4);
#pragma unroll
            for (int r = 0; r < 16; ++r) { const f32x4 u0 = *(const LAS f32x4*)(AUP + r * 64 + d0), u1 = *(const LAS f32x4*)(AUP + r * 64 + d0 + 4);
                const float lv = lo[r >> 2][r & 3]; z0 += lv * u0; z1 += lv * u1; }
#pragma unroll
            for (int e = 0; e < 4; ++e) { z0[e] = (fminf(z0[e], 0.f) - __logf(1.f + __expf(-fabsf(z0[e])))) * (1.f / 16.f); z1[e] = (fminf(z1[e], 0.f) - __logf(1.f + __expf(-fabsf(z1[e])))) * (1.f / 16.f); }
            *(LAS f32x4*)(LA + t * 64 + d0) = z0; *(LAS f32x4*)(LA + t * 64 + d0 + 4) = z1; }
        __syncthreads();
        { float a = 0.f;
#pragma unroll
            for (int tt = 0; tt < 8; ++tt) { a += LA[(wid * 8 + tt) * 64 + lane]; LA[(wid * 8 + tt) * 64 + lane] = a; }
            TOT[wid * 64 + lane] = a; }
        __syncthreads();
        { const int t0 = 2 * tp, wt = tp >> 2, d0 = dg * 4;
            f32x4 off = {0.f, 0.f, 0.f, 0.f}, tot = {0.f, 0.f, 0.f, 0.f};
#pragma unroll
            for (int w2 = 0; w2 < 8; ++w2) { const f32x4 tv = *(const LAS f32x4*)(TOT + w2 * 64 + d0); tot += tv; off += (w2 < wt) ? tv : (f32x4){0.f, 0.f, 0.f, 0.f}; }
            const f32x4 b0 = *(const LAS f32x4*)(LA + t0 * 64 + d0) + off, b1 = *(const LAS f32x4*)(LA + (t0 + 1) * 64 + d0) + off;
            const float q0[4] = {bflo(c_q0.x), bfhi(c_q0.x), bflo(c_q0.y), bfhi(c_q0.y)}, q1[4] = {bflo(c_q1.x), bfhi(c_q1.x), bflo(c_q1.y), bfhi(c_q1.y)};
            const float k0[4] = {bflo(c_k0.x), bfhi(c_k0.x), bflo(c_k0.y), bfhi(c_k0.y)}, k1[4] = {bflo(c_k1.x), bfhi(c_k1.x), bflo(c_k1.y), bfhi(c_k1.y)};
            float qe0[4], qe1[4], ke0[4], ke1[4];
#pragma unroll
            for (int e = 0; e < 4; ++e) {
                qe0[e] = q0[e] * 0.125f * __expf(b0[e]); qe1[e] = q1[e] * 0.125f * __expf(b1[e]);
                ke0[e] = k0[e] * __expf(-b0[e]); ke1[e] = k1[e] * __expf(-b1[e]);
                *(LAS unsigned*)(KDT + (d0 + e) * 72 + t0) = cvt_pk_bf16(k0[e] * __expf(tot[e] - b0[e]), k1[e] * __expf(tot[e] - b1[e]));
                if (tp == 0) DEC[d0 + e] = __expf(tot[e]); }
            u32x2 o; o.x = cvt_pk_bf16(qe0[0], qe0[1]); o.y = cvt_pk_bf16(qe0[2], qe0[3]); *(LAS u32x2*)(QE + t0 * 72 + d0) = o;
            o.x = cvt_pk_bf16(qe1[0], qe1[1]); o.y = cvt_pk_bf16(qe1[2], qe1[3]); *(LAS u32x2*)(QE + (t0 + 1) * 72 + d0) = o;
            o.x = cvt_pk_bf16(ke0[0], ke0[1]); o.y = cvt_pk_bf16(ke0[2], ke0[3]); *(LAS u32x2*)(KE + t0 * 72 + d0) = o;
            o.x = cvt_pk_bf16(ke1[0], ke1[1]); o.y = cvt_pk_bf16(ke1[2], ke1[3]); *(LAS u32x2*)(KE + (t0 + 1) * 72 + d0) = o;
            { LAS unsigned* vt = (LAS unsigned*)(VT + dg * 8 * 72 + t0);
                vt[0] = (c_v0.x & 0xffffu) | (c_v1.x << 16); vt[36] = (c_v0.x >> 16) | (c_v1.x & 0xffff0000u);
                vt[72] = (c_v0.y & 0xffffu) | (c_v1.y << 16); vt[108] = (c_v0.y >> 16) | (c_v1.y & 0xffff0000u);
                vt[144] = (c_v0.z & 0xffffu) | (c_v1.z << 16); vt[180] = (c_v0.z >> 16) | (c_v1.z & 0xffff0000u);
                vt[216] = (c_v0.w & 0xffffu) | (c_v1.w << 16); vt[252] = (c_v0.w >> 16) | (c_v1.w & 0xffff0000u); } }
        __syncthreads();
        { bf16x8 af[2];
#pragma unroll
            for (int ks = 0; ks < 2; ++ks) af[ks] = *(const LAS bf16x8*)(QE + (rt * 16 + l15) * 72 + ks * 32 + lq * 8);
#pragma unroll
            for (int c2 = 0; c2 < 2; ++c2) { const int ctile = (wid & 1) * 2 + c2; f32x4 acc = {0.f, 0.f, 0.f, 0.f};
#pragma unroll
                for (int ks = 0; ks < 2; ++ks) { const bf16x8 bf = *(const LAS bf16x8*)(KE + (ctile * 16 + l15) * 72 + ks * 32 + lq * 8); acc = mfma16(af[ks], bf, acc); }
#pragma unroll
                for (int i = 0; i < 4; ++i) { const int t = rt * 16 + lq * 4 + i, jj = ctile * 16 + l15; ATT[t * 72 + jj] = f2bf(jj <= t ? acc[i] : 0.f); } } }
        __syncthreads();
        f32x4 oacc[4];
        { bf16x8 at[2], qf[2], kd[2];
#pragma unroll
            for (int ks = 0; ks < 2; ++ks) { at[ks] = *(const LAS bf16x8*)(ATT + (rt * 16 + l15) * 72 + ks * 32 + lq * 8); qf[ks] = *(const LAS bf16x8*)(QE + (rt * 16 + l15) * 72 + ks * 32 + lq * 8);
                kd[ks] = *(const LAS bf16x8*)(KDT + (rt * 16 + l15) * 72 + ks * 32 + lq * 8); }
            const f32x4 dec = *(const LAS f32x4*)(DEC + rt * 16 + lq * 4);
#pragma unroll
            for (int c = 0; c < 4; ++c) { const int dvt = dv0t + c; f32x4 acc = {0.f, 0.f, 0.f, 0.f};
                Sacc[c] *= dec;
#pragma unroll
                for (int ks = 0; ks < 2; ++ks) { const bf16x8 vf = *(const LAS bf16x8*)(VT + (dvt * 16 + l15) * 72 + ks * 32 + lq * 8), sf = *(const LAS bf16x8*)(ST + (dvt * 16 + l15) * 72 + ks * 32 + lq * 8);
                    acc = mfma16(at[ks], vf, acc); acc = mfma16(qf[ks], sf, acc); Sacc[c] = mfma16(kd[ks], vf, Sacc[c]); }
                oacc[c] = acc; } }
        __syncthreads();
#pragma unroll
        for (int c = 0; c < 4; ++c) { const int dv = (dv0t + c) * 16 + l15;
#pragma unroll
            for (int i = 0; i < 4; ++i) OB[(rt * 16 + lq * 4 + i) * 132 + dv] = oacc[c][i];
            u32x2 sv; sv.x = cvt_pk_bf16(Sacc[c][0], Sacc[c][1]); sv.y = cvt_pk_bf16(Sacc[c][2], Sacc[c][3]);
            *(LAS u32x2*)(ST + dv * 72 + rt * 16 + lq * 4) = sv; }
        __syncthreads();
        { const int t = tid >> 3, dvb = (tid & 7) * 16;
            f32x4 o4[4]; float ss = 0.f;
#pragma unroll
            for (int i = 0; i < 4; ++i) { o4[i] = *(const LAS f32x4*)(OB + t * 132 + dvb + 4 * i); ss += o4[i].x * o4[i].x + o4[i].y * o4[i].y + o4[i].z * o4[i].z + o4[i].w * o4[i].w; }
            ss = red8_sum(ss);
            const float rs = rsqrtf(ss * (1.f / 128.f) + 1e-6f);
            const float g[16] = {bflo(c_g0.x), bfhi(c_g0.x), bflo(c_g0.y), bfhi(c_g0.y), bflo(c_g0.z), bfhi(c_g0.z), bflo(c_g0.w), bfhi(c_g0.w),
                                 bflo(c_g1.x), bfhi(c_g1.x), bflo(c_g1.y), bfhi(c_g1.y), bflo(c_g1.z), bfhi(c_g1.z), bflo(c_g1.w), bfhi(c_g1.w)};
            float r[16];
#pragma unroll
            for (int e = 0; e < 16; ++e) r[e] = o4[e >> 2][e & 3] * rs * GNW[dvb + e] * siluf_(g[e]);
            u32x4 w0, w1; w0.x = cvt_pk_bf16(r[0], r[1]); w0.y = cvt_pk_bf16(r[2], r[3]); w0.z = cvt_pk_bf16(r[4], r[5]); w0.w = cvt_pk_bf16(r[6], r[7]);
            w1.x = cvt_pk_bf16(r[8], r[9]); w1.y = cvt_pk_bf16(r[10], r[11]); w1.z = cvt_pk_bf16(r[12], r[13]); w1.w = cvt_pk_bf16(r[14], r[15]);
            u16* op = p.H + (tokb + t) * DM + 1536 + h * 128 + dvb;
            *(u32x4*)op = w0; *(u32x4*)(op + 8) = w1; }
        __syncthreads();
    }
}

#define XB_TMO      128
#define XB_XCNT(j)  (256  + 64 * (j))
#define XB_XSUB(j)  (1280 + 64 * (j))
#define XB_XGEN(j)  (2304 + 64 * (j))
#define XB_TOP      3328
#define XB_TOPGEN   3392
#define XCD_BAR_WORDS 3456
#define XB_SPIN_CAP (1u << 18)

__device__ __forceinline__ unsigned xb_ld(unsigned* p)              { return __hip_atomic_load(p, __ATOMIC_RELAXED, __HIP_MEMORY_SCOPE_AGENT); }
__device__ __forceinline__ unsigned xb_add(unsigned* p, unsigned v) { return __hip_atomic_fetch_add(p, v, __ATOMIC_RELAXED, __HIP_MEMORY_SCOPE_AGENT); }
__device__ __forceinline__ unsigned xb_xcc_id() { return (unsigned)__builtin_amdgcn_s_getreg((3 << 11) | 20) & 0xFu; }
#define XB_SPIN(cond, bar) do { unsigned _sp = 0; while (cond) { __builtin_amdgcn_s_sleep(1); \
    if ((++_sp & 255u) == 0u) { if (xb_ld(&(bar)[XB_TMO])) break; if (_sp > XB_SPIN_CAP) { atomicAdd(&(bar)[XB_TMO], 1u); break; } } } } while (0)

struct XcdBarrier {
    unsigned* bar; unsigned x;
    volatile LAS unsigned* st;
};

__device__ __forceinline__ XcdBarrier xcd_barrier_post(unsigned* bar, volatile LAS unsigned* st) {
    XcdBarrier b; b.bar = bar; b.x = xb_xcc_id(); b.st = st;
    if (threadIdx.x == 0) (void)xb_add(&bar[XB_XCNT(b.x)], 1u);
    return b;
}
__device__ __forceinline__ void xcd_barrier_complete(unsigned* bar, unsigned x, unsigned& nloc, unsigned& nx) {
    const unsigned G = gridDim.x * gridDim.y * gridDim.z;
    unsigned sum, cnt, mine, sp = 0u;
    for (;;) {
        sum = 0u; cnt = 0u; mine = 0u;
#pragma unroll
        for (unsigned j = 0; j < 16; ++j) { const unsigned c = xb_ld(&bar[XB_XCNT(j)]); sum += c; cnt += (c > 0u) ? 1u : 0u; mine = (j == x) ? c : mine; }
        if (sum == G) break;
        __builtin_amdgcn_s_sleep(1);
        if ((++sp & 255u) == 0u) { if (xb_ld(&bar[XB_TMO])) break; if (sp > XB_SPIN_CAP) { atomicAdd(&bar[XB_TMO], 1u); break; } }
    }
    nloc = mine > 0u ? mine : 1u; nx = cnt > 0u ? cnt : 1u;
}

__device__ __forceinline__ void xcd_barrier(const XcdBarrier& b) {
    asm volatile("s_waitcnt vmcnt(0)" ::: "memory");
    __syncthreads();
    if (threadIdx.x == 0) {
        unsigned* bar = b.bar;
        __builtin_amdgcn_s_waitcnt(0);
        unsigned nloc = b.st[0], nx = b.st[1];
        if (nloc == 0u) { xcd_barrier_complete(bar, b.x, nloc, nx); b.st[0] = nloc; b.st[1] = nx; }
        const unsigned old = xb_add(&bar[XB_XSUB(b.x)], 1u);
        const unsigned gen = old / nloc;
        if (old + 1u == (gen + 1u) * nloc) {
            __builtin_amdgcn_fence(__ATOMIC_RELEASE, "agent");
            asm volatile("s_waitcnt vmcnt(0)" ::: "memory");
            const unsigned og = xb_add(&bar[XB_TOP], 1u);
            const unsigned tg = og / nx;
            if (og + 1u == (tg + 1u) * nx) xb_add(&bar[XB_TOPGEN], 1u);
            else XB_SPIN(xb_ld(&bar[XB_TOPGEN]) == tg, bar);
            __builtin_amdgcn_fence(__ATOMIC_ACQUIRE, "agent");
            xb_add(&bar[XB_XGEN(b.x)], 1u);
            asm volatile("s_waitcnt vmcnt(0)" ::: "memory");
        } else {
            XB_SPIN(xb_ld(&bar[XB_XGEN(b.x)]) == gen, bar);
            __builtin_amdgcn_fence(__ATOMIC_ACQUIRE, "agent");
            asm volatile("s_waitcnt vmcnt(0)" ::: "memory");
        }
    }
    __syncthreads();
}

constexpr int N_PHASES = 11;
__device__ __forceinline__ void run_phase(const Params& p, int ph, LAS unsigned char* lds, LAS unsigned* qslot, int bid, int nb) {
    if (ph == 0) {
        for (int l = 0; l < 2; ++l) {
            transpose_cvt(lds, p.w_in + (size_t)l * DM * DIN, p.WtIn + (size_t)l * NP * DM, DM, DIN, NP, bid, nb);
            transpose_cvt(lds, p.w_out + (size_t)l * DM * DM, p.WtOut + (size_t)l * DM * DM, DM, DM, DM, bid, nb);
            transpose_cvt(lds, p.w2 + (size_t)l * 64 * 1024, p.W2t + (size_t)l * 1024 * 64, 64, 1024, 1024, bid, nb);
            transpose_cvt(lds, p.a2 + (size_t)l * 64 * 1024, p.A2t + (size_t)l * 1024 * 64, 64, 1024, 1024, bid, nb);
        }
        rmsnorm_phase(p.x, p.norm_w, p.H, nullptr, bid, nb);
        return;
    }
    const int l = (ph - 1) / 5, s = (ph - 1) % 5;
    if (s == 0) {
        Gemm g; g.A = p.H; g.Bt = p.WtIn + (size_t)l * NP * DM; g.M = MTOK; g.N = NP; g.K = DM;
        StaticOrder S; S.init(MTOK, NP, nb, bid);
        EpiP E; E.O = p.P; E.ldc = NP;
#ifndef SKIP_GEMM
        gemm_phase<EpiP, StaticOrder, false>(lds, g, S, E, nullptr);
#endif
    } else if (s == 1) {
        kmean_phase(p, lds, bid, nb);
#ifndef SKIP_RWKV
        rwkv_scan_phase(p, l, lds, bid, nb);
#endif
    } else if (s == 2) {
#if ONE_LAUNCH && !defined(STATIC_Q)
        LAS int* slot = (LAS int*)qslot;
        for (;;) {
            __syncthreads();
            if (tid_() == 0) *slot = (int)atomicAdd(p.bar + 64 * l, 1u);
            __syncthreads();
            const int tk = *slot;
            if (tk >= 32 + 512 + 512) break;
            if (tk < 32) gla_task(p, l, lds, tk);
            else if (tk < 544) moba_task(p, lds, tk - 32);
            else { for (int it = 0; it < 16; ++it) rwkv_post_item(p, l, (tk - 544) * 16 + it); }
        }
#else
        for (int tk = bid; tk < 32 + 512 + 8192; tk += nb) {
            if (tk < 32) gla_task(p, l, lds, tk);
            else if (tk < 544) moba_task(p, lds, tk - 32);
            else rwkv_post_item(p, l, tk - 544);
        }
#endif
    } else if (s == 3) {
        Gemm g; g.A = p.H; g.Bt = p.WtOut + (size_t)l * DM * DM; g.M = MTOK; g.N = DM; g.K = DM;
        StaticOrder S; S.init(MTOK, DM, nb, bid);
        EpiRes E; E.R = (l == 0) ? p.x : p.out; E.C = p.out; E.ldc = DM;
#ifndef SKIP_GEMM
        gemm_phase<EpiRes, StaticOrder, false>(lds, g, S, E, nullptr);
#endif
    } else {
        if (l == 0) rmsnorm_phase(p.out, p.norm_w + DM, p.H, nullptr, bid, nb);
        else rmsnorm_phase(p.out, p.fnw, nullptr, p.out, bid, nb);
    }
}

__global__ void __launch_bounds__(512, 2) hybrid_fwd(Params p) {
    extern __shared__ __attribute__((aligned(16))) unsigned char shm[];
    LAS unsigned char* lds = (LAS unsigned char*)shm;
    const int bid = blockIdx.x, nb = gridDim.x;
#if defined(TEST_GEMM)
    { Gemm g; g.A = p.H; g.Bt = p.WtIn; g.M = MTOK; g.N = NP; g.K = DM;
      StaticOrder S; S.init(MTOK, NP, nb, bid);
      EpiP E; E.O = p.P; E.ldc = NP;
      gemm_phase<EpiP, StaticOrder, false>(lds, g, S, E, nullptr);
#if TEST_GEMM >= 2
      if (p.phase_lo) {
      Gemm g2; g2.A = p.H; g2.Bt = p.WtOut; g2.M = MTOK; g2.N = DM; g2.K = DM;
      StaticOrder S2; S2.init(MTOK, DM, nb, bid);
      EpiRes E2; E2.R = p.x; E2.C = p.out; E2.ldc = DM;
      gemm_phase<EpiRes, StaticOrder, false>(lds, g2, S2, E2, nullptr); }
#endif
    }
#elif ONE_LAUNCH
    cg::grid_group grid = cg::this_grid();
    __shared__ uint4 xb_words;
    if (threadIdx.x == 0) xb_words = make_uint4(0u, 0u, 0u, 0u);
    __syncthreads();
    const XcdBarrier xb = xcd_barrier_post(p.bar, (volatile LAS unsigned*)&xb_words);
    for (int ph = p.phase_lo; ph < p.phase_hi; ++ph) {
        run_phase(p, ph, lds, (LAS unsigned*)&xb_words.z, bid, nb);
#ifdef REPEAT_PH
        if (ph == REPEAT_PH) { xcd_barrier(xb); run_phase(p, ph, lds, (LAS unsigned*)&xb_words.z, bid, nb); }
#endif
        if (ph + 1 < p.phase_hi) { if (ph == 0) grid.sync(); else xcd_barrier(xb); }
    }
#else
    run_phase(p, p.phase_lo, lds, nullptr, bid, nb);
#endif
}

extern "C" void kernel_launch(void* const* d_in, const int* in_sizes, int n_in, void* d_out, int out_size, void* d_ws, size_t ws_size, hipStream_t stream) {
    static int grid = 0;
    if (grid == 0) {
        int dev = 0, cus = 0, per_cu = 0;
        hipGetDevice(&dev);
        hipDeviceGetAttribute(&cus, hipDeviceAttributeMultiprocessorCount, dev);
        hipFuncSetAttribute((const void*)hybrid_fwd, hipFuncAttributeMaxDynamicSharedMemorySize, LDS_BYTES);
        hipOccupancyMaxActiveBlocksPerMultiprocessor(&per_cu, (const void*)hybrid_fwd, 512, LDS_BYTES);
        if (per_cu < 1) { fprintf(stderr, "kernel_launch: occupancy query says %d blocks per CU\n", per_cu); per_cu = 1; }
        (void)hipGetLastError();
        grid = cus;
    }
    Params p{};
    const float* const* in = (const float* const*)d_in;
    p.x = in[0]; p.norm_w = in[1]; p.w_in = in[2]; p.w_out = in[3]; p.mu = in[4]; p.w0 = in[5]; p.w2 = in[6]; p.a0 = in[7]; p.a2 = in[8];
    p.k_k = in[9]; p.k_a = in[10]; p.r_k = in[11]; p.ln_w = in[12]; p.ln_b = in[13]; p.a_up = in[14]; p.a_b = in[15]; p.gnw = in[16]; p.fnw = in[17];
    p.out = (float*)d_out;
    unsigned char* ws = (unsigned char*)d_ws; size_t off = 0;
    auto take = [&](size_t bytes) { unsigned char* r = ws + off; off += (bytes + 255) & ~(size_t)255; return r; };
    p.WtIn = (u16*)take((size_t)2 * NP * DM * 2); p.WtOut = (u16*)take((size_t)2 * DM * DM * 2);
    p.W2t = (u16*)take((size_t)2 * 1024 * 64 * 2); p.A2t = (u16*)take((size_t)2 * 1024 * 64 * 2);
    p.H = (u16*)take((size_t)MTOK * DM * 2); p.P = (u16*)take((size_t)MTOK * NP * 2);
    p.yraw = (float*)take((size_t)MTOK * 1024 * 4); p.ybonus = (float*)take((size_t)MTOK * 16 * 4); p.kmean = (float*)take((size_t)256 * 128 * 4);
    p.bar = (unsigned*)take((size_t)XCD_BAR_WORDS * 4);
    if (off > ws_size) { fprintf(stderr, "kernel_launch: workspace too small (%zu > %zu)\n", off, ws_size); return; }
#if ONE_LAUNCH
    hipMemsetAsync(p.bar, 0, (size_t)XCD_BAR_WORDS * 4, stream);
    p.phase_lo = 0; p.phase_hi = N_PHASES;
    void* args[] = {&p};
    hipError_t e = hipLaunchCooperativeKernel((const void*)hybrid_fwd, dim3(grid), dim3(512), args, LDS_BYTES, stream);
    if (e != hipSuccess) fprintf(stderr, "cooperative launch failed: %s (grid %d)\n", hipGetErrorString(e), grid);
#else
    for (int ph = 0; ph < N_PHASES; ++ph) { p.phase_lo = ph; p.phase_hi = ph + 1; hipLaunchKernelGGL(hybrid_fwd, dim3(grid), dim3(512), LDS_BYTES, stream, p); }
#endif
}
```

```cpp
#include <hip/hip_runtime.h>
#include <hip/hip_cooperative_groups.h>
#include <cstdio>
namespace cg = cooperative_groups;

#ifndef ONE_LAUNCH
#define ONE_LAUNCH 1
#endif

namespace pg8 {
#define PG8_LAS __attribute__((address_space(3)))
typedef unsigned short bf16_t;
typedef short bf16x8 __attribute__((ext_vector_type(8)));
typedef float f32x4 __attribute__((ext_vector_type(4)));
typedef unsigned u32x4 __attribute__((ext_vector_type(4)));
constexpr int BM = 256, BK = 64, HALF = 128, HTB = HALF * BK * 2  , STAGE_BYTES = 8 * HTB, NXCD = 8, WGM = 8;

__host__ __device__ __forceinline__ int lds_byte(int r, int c) { const int st = (r >> 4) * 2 + (c >> 5), rr = r & 15, cc = c & 31, ob = rr * 64 + cc * 2; return st * 1024 + (ob ^ (((ob >> 9) & 1) << 5)); }
__host__ __device__ __forceinline__ void stage_rc(int b, int& R, int& C) { const int st = b / 1024, sb = b % 1024, swz = sb ^ (((sb >> 9) & 1) << 5); R = (st >> 1) * 16 + swz / 64; C = (st & 1) * 32 + (swz % 64) / 2; }
__host__ __device__ __forceinline__ int perm32(int rho) { const int n = rho >> 4, i = rho & 15; return 8 * (i >> 2) + 4 * n + (i & 3); }

struct Unit { int pm, pn; };
struct Gemm { const bf16_t* A; const bf16_t* Bt; int M, N, K; };

struct StaticOrder {
    int nM, nN, nwg, G, c;
    __host__ __device__ void init(int M, int N, int G_, int c_) { nM = M / BM; nN = N / BM; nwg = nM * nN; G = G_; c = c_; }
    __host__ __device__ bool next(int i, Unit& u) const {
        const long L = (long)i * G + c; if (L >= nwg) return false;
        int wgid = (int)L; { const int q = nwg / NXCD, r = nwg % NXCD, xcd = wgid % NXCD, off = wgid / NXCD; wgid = (xcd < r ? xcd * (q + 1) : r * (q + 1) + (xcd - r) * q) + off; }
        const int nig = WGM * nN, gid = wgid / nig, fm = gid * WGM, gsz = (nM - fm) < WGM ? (nM - fm) : WGM;
        u.pm = fm + ((wgid % nig) % gsz); u.pn = (wgid % nig) / gsz; return true;
    }
    __device__ __forceinline__ void a_ready(const Unit&) const {}
    __device__ __forceinline__ void done(const Unit&) const {}
};
__device__ __forceinline__ unsigned cvt_pk_bf16(float lo, float hi) { unsigned r; asm volatile("v_cvt_pk_bf16_f32 %0, %1, %2" : "=v"(r) : "v"(lo), "v"(hi)); return r; }
template <class Epi, class Sched, bool STAMP = false>
__device__ __forceinline__ void gemm_phase(PG8_LAS unsigned char* lds, const Gemm g, const Sched& S, const Epi& E, unsigned long long* stamps) {
    int tid = threadIdx.x; asm volatile("" : "+v"(tid)); const int wid = __builtin_amdgcn_readfirstlane(tid >> 6), lane = tid & 63, wr = wid >> 2, wc = wid & 3, fr = lane & 15, fq = lane >> 4;
    const int K = g.K, nt = K / BK;
    int ts_lo = 0, ts_hi = 0, nts = 0; const unsigned long long rt_entry = STAMP ? (unsigned long long)wall_clock64() : 0ull;
#define PG8_STAMP() do { if (STAMP && wid == 0 && nts < 64) { const unsigned long long _c = (unsigned long long)clock64(); \
        ts_lo = (lane == nts) ? (int)(unsigned)_c : ts_lo; ts_hi = (lane == nts) ? (int)(unsigned)(_c >> 32) : ts_hi; ++nts; } } while (0)
    PG8_STAMP();
    unsigned voffA[2], voffB[2];
#pragma unroll
    for (int i = 0; i < 2; ++i) { int R, C; stage_rc(tid * 16 + i * 8192, R, C); const int Rb = Epi::PERM ? ((R & ~31) + perm32(R & 31)) : R;
        voffA[i] = (unsigned)(R * K + C) * 2u; voffB[i] = (unsigned)(Rb * K + C) * 2u; }
    const size_t kstep = (size_t)(BK * 2);
    const size_t hstep = (size_t)HALF * K * 2;
    const size_t tstep = 2 * hstep;
    const unsigned ldsw = (unsigned)wid * 1024u;
    const int aoff = lds_byte(wr * 64 + fr, fq * 8), boff = lds_byte(wc * 32 + fr, fq * 8);
#define PG8_SA(b, h) (((b) * 2 + (h)) * HTB)
#define PG8_SB(b, h) ((4 + (b) * 2 + (h)) * HTB)
#define PG8_STAGE(bufoff, gbase, voff) do { _Pragma("unroll") for (int _i = 0; _i < 2; ++_i) \
        __builtin_amdgcn_global_load_lds((const unsigned*)((const char*)(gbase) + (voff)[_i]), (PG8_LAS unsigned*)(lds + (bufoff) + ldsw + _i * 8192), 16, 0, 0); } while (0)
#define PG8_LDA(dst, b, h) do { _Pragma("unroll") for (int m = 0; m < 4; ++m) _Pragma("unroll") for (int k = 0; k < 2; ++k) dst[m][k] = *(const PG8_LAS bf16x8*)(lds + PG8_SA(b, h) + aoff + m * 2048 + k * 1024); } while (0)
#define PG8_LDB(dst, b, h) do { _Pragma("unroll") for (int n = 0; n < 2; ++n) _Pragma("unroll") for (int k = 0; k < 2; ++k) dst[n][k] = *(const PG8_LAS bf16x8*)(lds + PG8_SB(b, h) + boff + n * 2048 + k * 1024); } while (0)
#define PG8_MMA(ai, bj, At, Bt) do { __builtin_amdgcn_s_setprio(1); _Pragma("unroll") for (int m = 0; m < 4; ++m) _Pragma("unroll") for (int n = 0; n < 2; ++n) _Pragma("unroll") for (int k = 0; k < 2; ++k) \
        acc[ai][bj][m][n] = __builtin_amdgcn_mfma_f32_16x16x32_bf16(Bt[n][k], At[m][k], acc[ai][bj][m][n], 0, 0, 0); __builtin_amdgcn_s_setprio(0); } while (0)
#define PG8_WAIT_V(n) asm volatile("s_waitcnt vmcnt(" #n ")" ::: "memory")
#define PG8_WAIT_L(n) asm volatile("s_waitcnt lgkmcnt(" #n ")" ::: "memory")
#define PG8_BAR __builtin_amdgcn_s_barrier()
#define PG8_SCHED __builtin_amdgcn_sched_barrier(0)
    Unit cur, nxt; int ui = 0;
    if (!S.next(0, cur)) return;
    f32x4 acc[2][2][4][2];
#pragma unroll
    for (int a = 0; a < 2; ++a)
#pragma unroll
        for (int b = 0; b < 2; ++b)
#pragma unroll
            for (int m = 0; m < 4; ++m)
#pragma unroll
                for (int n = 0; n < 2; ++n) acc[a][b][m][n] = (f32x4){0.f, 0.f, 0.f, 0.f};
    bf16x8 At[4][2], B0[2][2], B1[2][2];
    const char* cA = (const char*)g.A + (size_t)cur.pm * tstep; const char* cB = (const char*)g.Bt + (size_t)cur.pn * tstep;
    S.a_ready(cur);
    PG8_STAGE(PG8_SB(0, 0), cB, voffB); PG8_STAGE(PG8_SA(0, 0), cA, voffA); PG8_STAGE(PG8_SB(0, 1), cB + hstep, voffB); PG8_STAGE(PG8_SA(0, 1), cA + hstep, voffA);
    if (wr == 1) PG8_BAR;
    PG8_WAIT_V(4); PG8_BAR;
    PG8_STAGE(PG8_SB(1, 0), cB + kstep, voffB); PG8_STAGE(PG8_SA(1, 0), cA + kstep, voffA); PG8_STAGE(PG8_SB(1, 1), cB + hstep + kstep, voffB);
    PG8_WAIT_V(6); PG8_BAR;
    PG8_STAMP();
    for (;;) {
        const bool has_next = S.next(ui + 1, nxt);
        const char* nA = has_next ? (const char*)g.A + (size_t)nxt.pm * tstep : cA; const char* nB = has_next ? (const char*)g.Bt + (size_t)nxt.pn * tstep : cB;
        for (int t = 0; t < nt; t += 2) {
            const bool last = (t == nt - 2);
            const char* a1 = cA + (size_t)(t + 1) * kstep;
            const char* a2 = last ? nA : cA + (size_t)(t + 2) * kstep; const char* b2 = last ? nB : cB + (size_t)(t + 2) * kstep;
            const char* a3 = a2 + kstep; const char* b3 = b2 + kstep;
            if (last && has_next) S.a_ready(nxt);
            PG8_LDB(B0, 0, 0); PG8_SCHED; PG8_LDA(At, 0, 0); PG8_STAGE(PG8_SA(1, 1), a1 + hstep, voffA);
            PG8_WAIT_L(8); PG8_BAR; PG8_WAIT_L(0); PG8_MMA(0, 0, At, B0); PG8_BAR; PG8_SCHED;
            PG8_LDB(B1, 0, 1); PG8_STAGE(PG8_SB(0, 0), b2, voffB);
            PG8_BAR; PG8_WAIT_L(0); PG8_MMA(0, 1, At, B1); PG8_BAR;
            PG8_LDA(At, 0, 1); PG8_STAGE(PG8_SA(0, 0), a2, voffA);
            PG8_BAR; PG8_WAIT_L(0); PG8_MMA(1, 0, At, B0); PG8_BAR; PG8_SCHED;
            PG8_STAGE(PG8_SB(0, 1), b2 + hstep, voffB);
            PG8_WAIT_V(6); PG8_BAR; PG8_MMA(1, 1, At, B1); PG8_BAR;
            PG8_LDB(B0, 1, 0); PG8_SCHED; PG8_LDA(At, 1, 0); PG8_STAGE(PG8_SA(0, 1), a2 + hstep, voffA);
            PG8_WAIT_L(8); PG8_BAR; PG8_WAIT_L(0); PG8_MMA(0, 0, At, B0); PG8_BAR; PG8_SCHED;
            PG8_LDB(B1, 1, 1); PG8_STAGE(PG8_SB(1, 0), b3, voffB);
            PG8_BAR; PG8_WAIT_L(0); PG8_MMA(0, 1, At, B1); PG8_BAR;
            PG8_LDA(At, 1, 1); PG8_STAGE(PG8_SA(1, 0), a3, voffA);
            PG8_BAR; PG8_WAIT_L(0); PG8_MMA(1, 0, At, B0); PG8_BAR; PG8_SCHED;
            PG8_STAGE(PG8_SB(1, 1), b3 + hstep, voffB);
            PG8_WAIT_V(6); PG8_BAR; PG8_MMA(1, 1, At, B1); PG8_BAR;
        }
        PG8_STAMP();
        if constexpr (!Epi::AFTER_DRAIN) { E(acc, cur, wr, wc, fr, fq); S.done(cur); }
        PG8_STAMP();
        if (!has_next) break;
#pragma unroll
        for (int a = 0; a < 2; ++a)
#pragma unroll
            for (int b = 0; b < 2; ++b)
#pragma unroll
                for (int m = 0; m < 4; ++m)
#pragma unroll
                    for (int n = 0; n < 2; ++n) acc[a][b][m][n] = (f32x4){0.f, 0.f, 0.f, 0.f};
        cur = nxt; cA = nA; cB = nB; ++ui;
    }
    PG8_WAIT_V(0);
    if (wr == 0) PG8_BAR;
    PG8_BAR;
    if constexpr (Epi::AFTER_DRAIN) { E.fused(acc, cur, wr, wc, fr, fq, lds, wid, lane); S.done(cur); }
    PG8_STAMP();
    if (STAMP && wid == 0) { stamps[lane] = lane < nts ? (((unsigned long long)(unsigned)ts_hi << 32) | (unsigned)ts_lo) : 0ull;
        if (lane == 62) stamps[62] = rt_entry; if (lane == 63) stamps[63] = (unsigned long long)wall_clock64(); }
#undef PG8_STAMP
#undef PG8_SA
#undef PG8_SB
#undef PG8_STAGE
#undef PG8_LDA
#undef PG8_LDB
#undef PG8_MMA
#undef PG8_WAIT_V
#undef PG8_WAIT_L
#undef PG8_BAR
#undef PG8_SCHED
}
}
using namespace pg8;
#define LAS PG8_LAS
typedef unsigned short u16;
typedef unsigned u32x2 __attribute__((ext_vector_type(2)));
typedef float f32x2 __attribute__((ext_vector_type(2)));

constexpr int NBATCH = 8, SEQ = 2048, DM = 2048, MTOK = NBATCH * SEQ, DIN = 7824, NP = 7936;
constexpr int C_R = 0, C_K = 1024, C_V = 2048, C_WD = 3072, C_GA = 3200, C_QB = 4224, C_KB = 4736, C_VB = 5248, C_GB = 5760,
              C_QC = 6272, C_KC = 6528, C_VC = 6784, C_GC = 7296, C_LOW = 7808;
constexpr int LDS_BYTES = 143360;

struct Params {
    const float *x, *norm_w, *w_in, *w_out, *mu, *w0, *w2, *a0, *a2, *k_k, *k_a, *r_k, *ln_w, *ln_b, *a_up, *a_b, *gnw, *fnw;
    float* out;
    u16 *WtIn, *WtOut, *W2t, *A2t, *H, *P;
    float *yraw, *ybonus, *kmean, *gst, *gdec;
    unsigned* bar;
    int phase_lo, phase_hi;
};

__device__ __forceinline__ int tid_() { int t = threadIdx.x; asm volatile("" : "+v"(t)); return t; }
__device__ __forceinline__ float bf2f(u16 v) { return __uint_as_float(((unsigned)v) << 16); }
__device__ __forceinline__ float bflo(unsigned w) { return __uint_as_float(w << 16); }
__device__ __forceinline__ float bfhi(unsigned w) { return __uint_as_float(w & 0xffff0000u); }
__device__ __forceinline__ u16 f2bf(float f) { return (u16)(cvt_pk_bf16(f, 0.f) & 0xffffu); }
template <int CTRL> __device__ __forceinline__ float dpp_f(float v) { return __int_as_float(__builtin_amdgcn_update_dpp(0, __float_as_int(v), CTRL, 0xF, 0xF, true)); }
__device__ __forceinline__ float red16_sum(float v) { v += dpp_f<0xB1>(v); v += dpp_f<0x4E>(v); v += dpp_f<0x141>(v); v += dpp_f<0x140>(v); return v; }
__device__ __forceinline__ float red8_sum(float v) { v += dpp_f<0xB1>(v); v += dpp_f<0x4E>(v); v += dpp_f<0x141>(v); return v; }
__device__ __forceinline__ float red16_max(float v) { v = fmaxf(v, dpp_f<0xB1>(v)); v = fmaxf(v, dpp_f<0x4E>(v)); v = fmaxf(v, dpp_f<0x141>(v)); v = fmaxf(v, dpp_f<0x140>(v)); return v; }
__device__ __forceinline__ float wave_sum(float v) {
#pragma unroll
    for (int o = 1; o < 64; o <<= 1) v += __shfl_xor(v, o);
    return v;
}
__device__ __forceinline__ float sigmoidf_(float x) { return 1.f / (1.f + __expf(-x)); }
__device__ __forceinline__ float siluf_(float x) { return x / (1.f + __expf(-x)); }
__device__ __forceinline__ float logsigmoidf_(float z) { return fminf(z, 0.f) - log1pf(__expf(-fabsf(z))); }
__device__ __forceinline__ f32x4 mfma16(bf16x8 a, bf16x8 b, f32x4 c) { return __builtin_amdgcn_mfma_f32_16x16x32_bf16(a, b, c, 0, 0, 0); }

struct EpiP {
    static constexpr bool PERM = true, AFTER_DRAIN = false;
    bf16_t* O; int ldc;
    __device__ __forceinline__ void operator()(const f32x4 (&acc)[2][2][4][2], const Unit& u, int wr, int wc, int fr, int fq) const {
        const int row0 = u.pm * BM + wr * 64 + fr, col0 = u.pn * BM + wc * 32 + 8 * fq;
#pragma unroll
        for (int ai = 0; ai < 2; ++ai)
#pragma unroll
            for (int m = 0; m < 4; ++m) { bf16_t* rowp = O + (size_t)(row0 + ai * HALF + m * 16) * ldc + col0;
#pragma unroll
                for (int bj = 0; bj < 2; ++bj) { const f32x4 v0 = acc[ai][bj][m][0], v1 = acc[ai][bj][m][1];
                    u32x4 w; w.x = cvt_pk_bf16(v0[0], v0[1]); w.y = cvt_pk_bf16(v0[2], v0[3]); w.z = cvt_pk_bf16(v1[0], v1[1]); w.w = cvt_pk_bf16(v1[2], v1[3]);
                    *(u32x4*)(rowp + bj * HALF) = w; } }
    }
};
struct EpiRes {
    static constexpr bool PERM = false, AFTER_DRAIN = false;
    const float* R; float* C; int ldc;
    __device__ __forceinline__ void operator()(const f32x4 (&acc)[2][2][4][2], const Unit& u, int wr, int wc, int fr, int fq) const {
        const int row0 = u.pm * BM + wr * 64 + fr, col0 = u.pn * BM + wc * 32 + 4 * fq;
#pragma unroll
        for (int ai = 0; ai < 2; ++ai)
#pragma unroll
            for (int m = 0; m < 4; ++m) { const size_t off = (size_t)(row0 + ai * HALF + m * 16) * ldc + col0;
#pragma unroll
                for (int bj = 0; bj < 2; ++bj)
#pragma unroll
                    for (int n = 0; n < 2; ++n) { const f32x4 r = *(const f32x4*)(R + off + bj * HALF + n * 16); *(f32x4*)(C + off + bj * HALF + n * 16) = acc[ai][bj][m][n] + r; }
                asm volatile("" ::: "memory"); }
    }
};

__device__ void transpose_cvt(LAS unsigned char* lds, const float* src, u16* dst, int K, int N, int Npad, int bid, int nb) {
    LAS float* tile = (LAS float*)lds;
    const int tilesN = Npad / 64, tilesK = K / 64, tid = tid_();
    for (int t = bid; t < tilesN * tilesK; t += nb) {
        const int tn = t % tilesN, tk = t / tilesN, n0 = tn * 64, k0 = tk * 64;
#pragma unroll
        for (int i = 0; i < 2; ++i) { const int idx = tid + i * 512, kk = idx >> 4, n4 = (idx & 15) * 4;
            float4 v = make_float4(0.f, 0.f, 0.f, 0.f);
            if (n0 + n4 < N) v = *(const float4*)(src + (size_t)(k0 + kk) * N + n0 + n4);
            tile[(n4 + 0) * 65 + kk] = v.x; tile[(n4 + 1) * 65 + kk] = v.y; tile[(n4 + 2) * 65 + kk] = v.z; tile[(n4 + 3) * 65 + kk] = v.w; }
        __syncthreads();
        { const int n = tid >> 3, k8 = (tid & 7) * 8; const LAS float* r = tile + n * 65 + k8;
            u32x4 o; o.x = cvt_pk_bf16(r[0], r[1]); o.y = cvt_pk_bf16(r[2], r[3]); o.z = cvt_pk_bf16(r[4], r[5]); o.w = cvt_pk_bf16(r[6], r[7]);
            *(u32x4*)(dst + (size_t)(n0 + n) * K + k0 + k8) = o; }
        __syncthreads();
    }
}

__device__ void rmsnorm_phase(const float* x, const float* w, u16* hb, float* of, int bid, int nb) {
    const int tid0 = tid_(), wid = tid0 >> 6, lane = tid0 & 63;
    for (int row = bid * 8 + wid; row < MTOK; row += nb * 8) {
        const float4* xr = (const float4*)(x + (size_t)row * DM);
        float4 v[8]; float s = 0.f;
#pragma unroll
        for (int i = 0; i < 8; ++i) { v[i] = xr[i * 64 + lane]; s += v[i].x * v[i].x + v[i].y * v[i].y + v[i].z * v[i].z + v[i].w * v[i].w; }
        s = wave_sum(s);
        const float rs = rsqrtf(s * (1.f / DM) + 1e-6f);
#pragma unroll
        for (int i = 0; i < 8; ++i) { const float4 wv = ((const float4*)w)[i * 64 + lane];
            const float a = v[i].x * rs * wv.x, b = v[i].y * rs * wv.y, c = v[i].z * rs * wv.z, d = v[i].w * rs * wv.w;
            if (hb) { uint2 o; o.x = cvt_pk_bf16(a, b); o.y = cvt_pk_bf16(c, d); *(uint2*)(hb + (size_t)row * DM + (i * 64 + lane) * 4) = o; }
            else { ((float4*)(of + (size_t)row * DM))[i * 64 + lane] = make_float4(a, b, c, d); } }
    }
}

__device__ void kmean_phase(const Params& p, LAS unsigned char* lds, int bid, int nb) {
    LAS float* part = (LAS float*)lds;
    const int tid = tid_();
    for (int task = bid; task < 256; task += nb) {
        const int b = task >> 5, h = (task >> 3) & 3, blk = task & 7;
        const int d8 = (tid & 15) * 8, kg = tid >> 4;
        float s[8];
#pragma unroll
        for (int e = 0; e < 8; ++e) s[e] = 0.f;
        for (int kk = 0; kk < 8; ++kk) {
            const int tok = b * SEQ + blk * 256 + kg * 8 + kk;
            const uint4 v = *(const uint4*)(p.P + (size_t)tok * NP + C_KB + h * 128 + d8);
            s[0] += bflo(v.x); s[1] += bfhi(v.x); s[2] += bflo(v.y); s[3] += bfhi(v.y); s[4] += bflo(v.z); s[5] += bfhi(v.z); s[6] += bflo(v.w); s[7] += bfhi(v.w);
        }
        __syncthreads();
#pragma unroll
        for (int e = 0; e < 8; ++e) part[kg * 128 + d8 + e] = s[e];
        __syncthreads();
        if (tid < 128) { float a = 0.f; for (int g = 0; g < 32; ++g) a += part[g * 128 + tid]; p.kmean[(size_t)task * 128 + tid] = a * (1.f / 256.f); }
    }
    __syncthreads();
}

constexpr int RW_T = 32;
constexpr int RW_XB = 45056;
constexpr int RW_RAW = 90112, RW_A1 = 111616, RW_A2 = 116224, RW_KS = 120832, RW_AS = 129024, RW_MU = 137216, RW_PAR = 138496, RW_FLG = 139776;
__device__ __forceinline__ void rw_issue(const Params& p, int pt, int b, int h, int t0, u32x4 (&rg)[6]) {
#pragma unroll
    for (int i = 0; i < 6; ++i) { const int piece = pt + 256 * i; rg[i] = (u32x4){0u, 0u, 0u, 0u};
        if (piece < 33 * 40) { const int row = piece / 40, pc = piece % 40; const int t = t0 - 1 + row;
            const int col = pc < 8 ? C_R + h * 64 + pc * 8 : pc < 16 ? C_K + h * 64 + (pc - 8) * 8 : pc < 24 ? C_V + h * 64 + (pc - 16) * 8 : C_WD + (pc - 24) * 8;
            if (t >= 0) rg[i] = *(const u32x4*)(p.P + (size_t)(b * SEQ + t) * NP + col); } }
}
__device__ __forceinline__ void prep_bar(volatile LAS unsigned* flg, int pw, int lane, unsigned& ep) {
    ++ep;
    asm volatile("s_waitcnt lgkmcnt(0)" ::: "memory");
    if (lane == 0) flg[pw] = ep;
    for (;;) { const unsigned f0 = flg[0], f1 = flg[1], f2 = flg[2], f3 = flg[3]; if (f0 >= ep && f1 >= ep && f2 >= ep && f3 >= ep) break; __builtin_amdgcn_s_sleep(1); }
    asm volatile("s_waitcnt lgkmcnt(0)" ::: "memory");
}
__device__ void rwkv_scan_phase(const Params& p, int l, LAS unsigned char* lds, int bid, int nb) {
    const int tid = tid_(), wid = tid >> 6, lane = tid & 63;
    LAS u16* raw = (LAS u16*)(lds + RW_RAW); LAS u16* A1 = (LAS u16*)(lds + RW_A1); LAS u16* A2 = (LAS u16*)(lds + RW_A2);
    LAS float* kS = (LAS float*)(lds + RW_KS); LAS float* aS = (LAS float*)(lds + RW_AS);
    LAS float* muS = (LAS float*)(lds + RW_MU); LAS float* parS = (LAS float*)(lds + RW_PAR);
    volatile LAS unsigned* flg = (volatile LAS unsigned*)(lds + RW_FLG);
    for (int task = bid; task < 256; task += nb) {
        const int b = task >> 5, h = (task >> 1) & 15, half = task & 1;
        __syncthreads();
        if (tid >= 256 && tid < 260) flg[tid - 256] = 0u;
        __syncthreads();
        if (wid < 4) {
            const int srow = tid >> 3, ssub = tid & 7;
            f32x2 S01 = {0.f, 0.f}, S23 = {0.f, 0.f}, S45 = {0.f, 0.f}, S67 = {0.f, 0.f};
            float* yout = p.yraw + (size_t)(b * SEQ + ssub) * 1024 + h * 64 + half * 32 + srow;
            for (int c = 0; c < SEQ / RW_T; ++c) {
                __syncthreads();
                const LAS float* ob = (const LAS float*)(lds + (c & 1) * RW_XB) + ssub * 8;
                const LAS float* ov = (const LAS float*)(lds + (c & 1) * RW_XB + 40960) + srow;
                f32x4 nw0 = *(const LAS f32x4*)(ob), nw1 = *(const LAS f32x4*)(ob + 4), na0 = *(const LAS f32x4*)(ob + 2048), na1 = *(const LAS f32x4*)(ob + 2052);
                f32x4 nb0 = *(const LAS f32x4*)(ob + 4096), nb1 = *(const LAS f32x4*)(ob + 4100), nk0 = *(const LAS f32x4*)(ob + 6144), nk1 = *(const LAS f32x4*)(ob + 6148);
                f32x4 nr0 = *(const LAS f32x4*)(ob + 8192), nr1 = *(const LAS f32x4*)(ob + 8196);
                float nv = ov[0];
                float ykeep = 0.f;
#pragma unroll
                for (int t = 0; t < RW_T; ++t) {
                    const f32x4 w0 = nw0, w1 = nw1, a0 = na0, a1 = na1, b0 = nb0, b1 = nb1, k0 = nk0, k1 = nk1, r0 = nr0, r1 = nr1; const float vv = nv;
                    if (t + 1 < RW_T) { const LAS float* o2 = ob + (t + 1) * 64;
                        nw0 = *(const LAS f32x4*)(o2); nw1 = *(const LAS f32x4*)(o2 + 4); na0 = *(const LAS f32x4*)(o2 + 2048); na1 = *(const LAS f32x4*)(o2 + 2052);
                        nb0 = *(const LAS f32x4*)(o2 + 4096); nb1 = *(const LAS f32x4*)(o2 + 4100); nk0 = *(const LAS f32x4*)(o2 + 6144); nk1 = *(const LAS f32x4*)(o2 + 6148);
                        nr0 = *(const LAS f32x4*)(o2 + 8192); nr1 = *(const LAS f32x4*)(o2 + 8196);
                        nv = ov[(t + 1) * 32]; }
                    const f32x2 sa2 = (S01 * a0.lo + S23 * a0.hi) + (S45 * a1.lo + S67 * a1.hi);
                    const float sa = red8_sum(sa2.x + sa2.y);
                    const f32x2 sav = {sa, sa}, vv2 = {vv, vv};
                    S01 = S01 * w0.lo + sav * b0.lo + vv2 * k0.lo;
                    S23 = S23 * w0.hi + sav * b0.hi + vv2 * k0.hi;
                    S45 = S45 * w1.lo + sav * b1.lo + vv2 * k1.lo;
                    S67 = S67 * w1.hi + sav * b1.hi + vv2 * k1.hi;
                    const f32x2 y2 = (S01 * r0.lo + S23 * r0.hi) + (S45 * r1.lo + S67 * r1.hi);
                    const float y = red8_sum(y2.x + y2.y);
                    ykeep = (ssub == (t & 7)) ? y : ykeep;
                    if ((t & 7) == 7) yout[(size_t)(c * RW_T + (t & ~7)) * 1024] = ykeep;
                }
            }
        } else {
            const int pt = tid - 256, pw = wid - 4;
            unsigned ep = 0u;
            for (int c2 = pt; c2 < 320; c2 += 256) { const int mi = c2 < 64 ? h * 64 + c2 : c2 < 128 ? 1024 + h * 64 + (c2 - 64) : c2 < 192 ? 2048 + h * 64 + (c2 - 128) : 3072 + (c2 - 192);
                muS[c2] = p.mu[(size_t)l * 3200 + mi]; }
            if (pt < 64) { const size_t o = (size_t)l * 1024 + h * 64 + pt;
                parS[pt] = p.w0[o]; parS[64 + pt] = p.a0[o]; parS[128 + pt] = p.k_k[o]; parS[192 + pt] = p.k_a[o]; parS[256 + pt] = p.r_k[o]; }
            const int mat = pw >> 1, ct0 = (pw & 1) * 2;
            bf16x8 bfr[2][2];
#pragma unroll
            for (int ci = 0; ci < 2; ++ci) { const u16* Bt = (mat ? p.A2t : p.W2t) + (size_t)l * 1024 * 64 + (size_t)(h * 64 + (ct0 + ci) * 16 + (lane & 15)) * 64 + (lane >> 4) * 8;
                bfr[ci][0] = *(const bf16x8*)(Bt); bfr[ci][1] = *(const bf16x8*)(Bt + 32); }
            u32x4 rg[6];
            rw_issue(p, pt, b, h, 0, rg);
            for (int c = 0; c < SEQ / RW_T; ++c) {
                const int t0 = c * RW_T;
                LAS float* opW = (LAS float*)(lds + (c & 1) * RW_XB); LAS float* opA = opW + 2048; LAS float* opB = opW + 4096; LAS float* opK = opW + 6144; LAS float* opR = opW + 8192; LAS float* opV = opW + 10240;
#pragma unroll
                for (int i = 0; i < 6; ++i) { const int piece = pt + 256 * i; if (piece < 33 * 40) *(LAS u32x4*)(raw + (piece / 40) * 320 + (piece % 40) * 8) = rg[i]; }
                prep_bar(flg, pw, lane, ep);
                if (c + 1 < SEQ / RW_T) rw_issue(p, pt, b, h, t0 + RW_T, rg);
#pragma unroll
                for (int reg = 0; reg < 5; ++reg)
#pragma unroll
                    for (int i = 0; i < 4; ++i) { const int e = pt + 256 * i, t = e >> 5, pr = e & 31, cc = reg * 64 + 2 * pr;
                        const unsigned cu = *(const LAS unsigned*)(raw + (t + 1) * 320 + cc), pu = *(const LAS unsigned*)(raw + t * 320 + cc);
                        const f32x2 mu2 = *(const LAS f32x2*)(muS + cc);
                        const f32x2 cur = {bflo(cu), bfhi(cu)}, prv = {bflo(pu), bfhi(pu)};
                        const f32x2 xs = cur + mu2 * (prv - cur);
                        if (reg == 0) *(LAS f32x2*)(opR + t * 64 + 2 * pr) = xs;
                        else if (reg == 1) *(LAS f32x2*)(kS + t * 64 + 2 * pr) = xs;
                        else if (reg == 2) { if ((pr >> 4) == half) *(LAS f32x2*)(opV + t * 32 + ((2 * pr) & 31)) = xs; }
                        else if (reg == 3) { const float e0 = __expf(2.f * xs.x), e1 = __expf(2.f * xs.y);
                            *(LAS unsigned*)(A1 + t * 72 + 2 * pr) = cvt_pk_bf16(1.f - 2.f * __builtin_amdgcn_rcpf(e0 + 1.f), 1.f - 2.f * __builtin_amdgcn_rcpf(e1 + 1.f)); }
                        else *(LAS unsigned*)(A2 + t * 72 + 2 * pr) = cvt_pk_bf16(xs.x, xs.y); }
                prep_bar(flg, pw, lane, ep);
                { LAS u16* Ab = mat ? A2 : A1;
#pragma unroll
                    for (int ci = 0; ci < 2; ++ci)
#pragma unroll
                        for (int rt = 0; rt < 2; ++rt) { f32x4 acc = {0.f, 0.f, 0.f, 0.f};
#pragma unroll
                            for (int ks = 0; ks < 2; ++ks) { const bf16x8 af = *(const LAS bf16x8*)(Ab + (rt * 16 + (lane & 15)) * 72 + ks * 32 + (lane >> 4) * 8); acc = mfma16(af, bfr[ci][ks], acc); }
                            const int cc = (ct0 + ci) * 16 + (lane & 15);
#pragma unroll
                            for (int i = 0; i < 4; ++i) { const int t = rt * 16 + (lane >> 4) * 4 + i;
                                if (mat == 0) { float wv = parS[cc] + acc[i]; wv = fminf(wv, 0.f) - __logf(1.f + __expf(-fabsf(wv))) - 0.5f; opW[t * 64 + cc] = __expf(-__expf(wv)); }
                                else aS[t * 64 + cc] = __builtin_amdgcn_rcpf(1.f + __expf(-(parS[64 + cc] + acc[i]))); } } }
                prep_bar(flg, pw, lane, ep);
#pragma unroll
                for (int j = 0; j < 2; ++j) { const int item = pt + 256 * j, t = item >> 4, sub = item & 15, c4 = sub * 4;
                    const f32x4 kr = *(const LAS f32x4*)(kS + t * 64 + c4), av = *(const LAS f32x4*)(aS + t * 64 + c4), rr = *(const LAS f32x4*)(opR + t * 64 + c4);
                    const f32x4 kkp = *(const LAS f32x4*)(parS + 128 + c4), kap = *(const LAS f32x4*)(parS + 192 + c4), rkp = *(const LAS f32x4*)(parS + 256 + c4);
                    f32x4 kk = kr * kkp;
                    float ss = kk.x * kk.x + kk.y * kk.y + kk.z * kk.z + kk.w * kk.w; ss = red16_sum(ss);
                    const float inv = rsqrtf(fmaxf(ss, 1e-24f));
                    kk.x *= inv; kk.y *= inv; kk.z *= inv; kk.w *= inv;
                    const f32x4 km = kr * (1.f + (av - 1.f) * kap);
                    *(LAS f32x4*)(opA + t * 64 + c4) = -kk;
                    *(LAS f32x4*)(opB + t * 64 + c4) = kk * av;
                    *(LAS f32x4*)(opK + t * 64 + c4) = km;
                    float bo = rr.x * km.x * rkp.x + rr.y * km.y * rkp.y + rr.z * km.z * rkp.z + rr.w * km.w * rkp.w; bo = red16_sum(bo);
                    if (half == 0 && sub == 0) p.ybonus[(size_t)(b * SEQ + t0 + t) * 16 + h] = bo; }
                __syncthreads();
            }
        }
    }
    __syncthreads();
}

__device__ void rwkv_post_item(const Params& p, int l, int item) {
    const int tid = tid_(), pair = item * 32 + (tid >> 4), tok = pair >> 4, h = pair & 15, c4 = (tid & 15) * 4;
    const float4 y = *(const float4*)(p.yraw + (size_t)tok * 1024 + h * 64 + c4);
    const float mean = red16_sum(y.x + y.y + y.z + y.w) * (1.f / 64.f);
    const float d0 = y.x - mean, d1 = y.y - mean, d2 = y.z - mean, d3 = y.w - mean;
    const float var = red16_sum(d0 * d0 + d1 * d1 + d2 * d2 + d3 * d3) * (1.f / 64.f);
    const float rs = rsqrtf(var + 64e-5f);
    const size_t po = (size_t)l * 1024 + h * 64 + c4;
    const float4 lw = *(const float4*)(p.ln_w + po), lb = *(const float4*)(p.ln_b + po), muv = *(const float4*)(p.mu + (size_t)l * 3200 + 2048 + h * 64 + c4);
    const uint2 vc = *(const uint2*)(p.P + (size_t)tok * NP + C_V + h * 64 + c4);
    uint2 vp = make_uint2(0u, 0u);
    if ((tok & (SEQ - 1)) != 0) vp = *(const uint2*)(p.P + (size_t)(tok - 1) * NP + C_V + h * 64 + c4);
    const uint2 gg = *(const uint2*)(p.P + (size_t)tok * NP + C_GA + h * 64 + c4);
    const float bo = p.ybonus[(size_t)tok * 16 + h];
    float v0 = bflo(vc.x), v1 = bfhi(vc.x), v2 = bflo(vc.y), v3 = bfhi(vc.y);
    v0 += muv.x * (bflo(vp.x) - v0); v1 += muv.y * (bfhi(vp.x) - v1); v2 += muv.z * (bflo(vp.y) - v2); v3 += muv.w * (bfhi(vp.y) - v3);
    const float o0 = (d0 * rs * lw.x + lb.x + bo * v0) * siluf_(bflo(gg.x)), o1 = (d1 * rs * lw.y + lb.y + bo * v1) * siluf_(bfhi(gg.x));
    const float o2 = (d2 * rs * lw.z + lb.z + bo * v2) * siluf_(bflo(gg.y)), o3 = (d3 * rs * lw.w + lb.w + bo * v3) * siluf_(bfhi(gg.y));
    uint2 o; o.x = cvt_pk_bf16(o0, o1); o.y = cvt_pk_bf16(o2, o3);
    *(uint2*)(p.H + (size_t)tok * DM + h * 64 + c4) = o;
}

__device__ void rwkv_post_task(const Params& p, int l, int task) {
    const int tid = tid_(), h = (tid >> 4) & 15, c4 = (tid & 15) * 4;
    const size_t po = (size_t)l * 1024 + h * 64 + c4;
    const f32x4 lw = *(const f32x4*)(p.ln_w + po), lb = *(const f32x4*)(p.ln_b + po), muv = *(const f32x4*)(p.mu + (size_t)l * 3200 + 2048 + h * 64 + c4);
#pragma unroll 1
    for (int bt = 0; bt < 4; ++bt) {
        f32x4 y[4]; u32x2 vc[4], vp[4], gg[4]; float bo[4];
#pragma unroll
        for (int q = 0; q < 4; ++q) { const int tok = (task * 16 + bt * 4 + q) * 2 + (tid >> 8);
            y[q] = *(const f32x4*)(p.yraw + (size_t)tok * 1024 + h * 64 + c4);
            vc[q] = *(const u32x2*)(p.P + (size_t)tok * NP + C_V + h * 64 + c4);
            vp[q] = (u32x2){0u, 0u};
            if ((tok & (SEQ - 1)) != 0) vp[q] = *(const u32x2*)(p.P + (size_t)(tok - 1) * NP + C_V + h * 64 + c4);
            gg[q] = *(const u32x2*)(p.P + (size_t)tok * NP + C_GA + h * 64 + c4);
            bo[q] = p.ybonus[(size_t)tok * 16 + h]; }
#pragma unroll
        for (int q = 0; q < 4; ++q) { const int tok = (task * 16 + bt * 4 + q) * 2 + (tid >> 8);
            const float mean = red16_sum(y[q].x + y[q].y + y[q].z + y[q].w) * (1.f / 64.f);
            const f32x4 d = y[q] - mean;
            const float var = red16_sum(d.x * d.x + d.y * d.y + d.z * d.z + d.w * d.w) * (1.f / 64.f);
            const float rs = rsqrtf(var + 64e-5f);
            f32x4 v = {bflo(vc[q].x), bfhi(vc[q].x), bflo(vc[q].y), bfhi(vc[q].y)};
            const f32x4 pv = {bflo(vp[q].x), bfhi(vp[q].x), bflo(vp[q].y), bfhi(vp[q].y)};
            v += muv * (pv - v);
            const f32x4 r = d * rs * lw + lb + bo[q] * v;
            u32x2 o; o.x = cvt_pk_bf16(r.x * siluf_(bflo(gg[q].x)), r.y * siluf_(bfhi(gg[q].x))); o.y = cvt_pk_bf16(r.z * siluf_(bflo(gg[q].y)), r.w * siluf_(bfhi(gg[q].y)));
            *(u32x2*)(p.H + (size_t)tok * DM + h * 64 + c4) = o; }
    }
}

constexpr int MB_K = 0, MB_VT = 17408, MB_PW = 35840, MB_KM = 54272, MB_SEL = 57856, MB_TM = 58368;
__device__ void moba_task(const Params& p, LAS unsigned char* lds, int task) {
    const int tid = tid_(), wid = tid >> 6, lane = tid & 63, l15 = lane & 15, lq = lane >> 4;
    const int qt = 15 - (task >> 5), bh = task & 31, b = bh >> 2, h = bh & 3, qblk = qt >> 1, q0 = qt * 128;
    LAS u16* Kt = (LAS u16*)(lds + MB_K); LAS u16* VT = (LAS u16*)(lds + MB_VT); LAS u16* Pw = (LAS u16*)(lds + MB_PW) + wid * 16 * 72;
    LAS float* kmS = (LAS float*)(lds + MB_KM); LAS int* selS = (LAS int*)(lds + MB_SEL); LAS int* tmS = (LAS int*)(lds + MB_TM);
    __syncthreads();
    for (int i = tid; i < qblk * 128; i += 512) kmS[i] = p.kmean[(size_t)(bh * 8) * 128 + i];
    if (tid == 0) *tmS = 0;
    __syncthreads();
    if (tid < 128) {
        const u16* qp = p.P + (size_t)(b * SEQ + q0 + tid) * NP + C_QB + h * 128;
        float g[7];
#pragma unroll
        for (int j = 0; j < 7; ++j) g[j] = 0.f;
        for (int d8 = 0; d8 < 128; d8 += 8) {
            const uint4 v = *(const uint4*)(qp + d8);
            const float q[8] = {bflo(v.x), bfhi(v.x), bflo(v.y), bfhi(v.y), bflo(v.z), bfhi(v.z), bflo(v.w), bfhi(v.w)};
#pragma unroll
            for (int j = 0; j < 7; ++j) if (j < qblk) {
#pragma unroll
                for (int e = 0; e < 8; ++e) g[j] += q[e] * kmS[j * 128 + d8 + e]; }
        }
        int mask = 0;
#pragma unroll
        for (int r = 0; r < 3; ++r) { float best = -INFINITY; int bi = -1;
#pragma unroll
            for (int j = 0; j < 7; ++j) if (j < qblk && !((mask >> j) & 1) && g[j] > best) { best = g[j]; bi = j; }
            if (bi >= 0) mask |= 1 << bi; }
        mask |= 1 << qblk;
        selS[tid] = mask; atomicOr((int*)tmS, mask);
    }
    __syncthreads();
    const int tmask = *tmS;
    bf16x8 qf[4];
    { const u16* qp = p.P + (size_t)(b * SEQ + q0 + wid * 16 + l15) * NP + C_QB + h * 128 + lq * 8;
#pragma unroll
        for (int ks = 0; ks < 4; ++ks) qf[ks] = *(const bf16x8*)(qp + ks * 32); }
    int rm[4]; int wmask = 0;
#pragma unroll
    for (int i = 0; i < 4; ++i) rm[i] = selS[wid * 16 + lq * 4 + i];
    for (int i = 0; i < 16; ++i) wmask |= selS[wid * 16 + i];
    float m[4], ls[4]; f32x4 O[8];
#pragma unroll
    for (int i = 0; i < 4; ++i) { m[i] = -1e30f; ls[i] = 0.f; }
#pragma unroll
    for (int dt = 0; dt < 8; ++dt) O[dt] = (f32x4){0.f, 0.f, 0.f, 0.f};
    const float scale = 0.08838834764831845f;
    const int last = (q0 + 127) >> 6;
    const int kp = lane & 31, vd8 = (wid * 2 + (lane >> 5)) * 8;
    struct Stage { u32x4 k0, k1, v0, v1; };
    auto issue = [&](Stage& R, int tt) {
        const size_t kb_ = (size_t)(b * SEQ + tt * 64);
        R.k0 = *(const u32x4*)(p.P + (kb_ + (tid >> 4)) * NP + C_KB + h * 128 + (tid & 15) * 8); R.k1 = *(const u32x4*)(p.P + (kb_ + 32 + (tid >> 4)) * NP + C_KB + h * 128 + (tid & 15) * 8);
        R.v0 = *(const u32x4*)(p.P + (kb_ + 2 * kp) * NP + C_VB + h * 128 + vd8); R.v1 = *(const u32x4*)(p.P + (kb_ + 2 * kp + 1) * NP + C_VB + h * 128 + vd8); };
    auto nextv = [&](int t) { ++t; while (t <= last && !((tmask >> (t >> 2)) & 1)) ++t; return t; };
    auto stage = [&](const Stage& R) {
        *(LAS u32x4*)(Kt + (tid >> 4) * 136 + (tid & 15) * 8) = R.k0; *(LAS u32x4*)(Kt + (32 + (tid >> 4)) * 136 + (tid & 15) * 8) = R.k1;
        LAS unsigned* vt = (LAS unsigned*)(VT + vd8 * 72 + 2 * kp);
        vt[0] = (R.v0.x & 0xffffu) | (R.v1.x << 16); vt[36] = (R.v0.x >> 16) | (R.v1.x & 0xffff0000u);
        vt[72] = (R.v0.y & 0xffffu) | (R.v1.y << 16); vt[108] = (R.v0.y >> 16) | (R.v1.y & 0xffff0000u);
        vt[144] = (R.v0.z & 0xffffu) | (R.v1.z << 16); vt[180] = (R.v0.z >> 16) | (R.v1.z & 0xffff0000u);
        vt[216] = (R.v0.w & 0xffffu) | (R.v1.w << 16); vt[252] = (R.v0.w >> 16) | (R.v1.w & 0xffff0000u); };
    auto compute = [&](int ti) {
        const int j = ti >> 2, key0 = ti * 64;
        if ((wmask >> j) & 1) {
            f32x4 s[4];
#pragma unroll
            for (int nt = 0; nt < 4; ++nt) { s[nt] = (f32x4){0.f, 0.f, 0.f, 0.f};
#pragma unroll
                for (int ks = 0; ks < 4; ++ks) { const bf16x8 kf = *(const LAS bf16x8*)(Kt + (nt * 16 + l15) * 136 + ks * 32 + lq * 8); s[nt] = mfma16(qf[ks], kf, s[nt]); } }
#pragma unroll
            for (int i = 0; i < 4; ++i) {
                const int qpos = q0 + wid * 16 + lq * 4 + i; const bool rsel = (rm[i] >> j) & 1;
                float mx = -1e30f;
#pragma unroll
                for (int nt = 0; nt < 4; ++nt) { const int kpos = key0 + nt * 16 + l15;
                    const bool valid = (j == qblk) ? (kpos <= qpos) : rsel;
                    const float sv = valid ? s[nt][i] * scale : -1e30f; s[nt][i] = sv; mx = fmaxf(mx, sv); }
                mx = red16_max(mx);
                const float mnew = fmaxf(m[i], mx), alpha = __expf(m[i] - mnew);
                float rs = 0.f;
#pragma unroll
                for (int nt = 0; nt < 4; ++nt) { const float pv = s[nt][i] > -1e29f ? __expf(s[nt][i] - mnew) : 0.f; rs += pv; Pw[(lq * 4 + i) * 72 + nt * 16 + l15] = f2bf(pv); }
                rs = red16_sum(rs);
                ls[i] = ls[i] * alpha + rs; m[i] = mnew;
#pragma unroll
                for (int dt = 0; dt < 8; ++dt) O[dt][i] *= alpha;
            }
            __builtin_amdgcn_wave_barrier();
            bf16x8 pf[2];
#pragma unroll
            for (int ks = 0; ks < 2; ++ks) pf[ks] = *(const LAS bf16x8*)(Pw + l15 * 72 + ks * 32 + lq * 8);
#pragma unroll
            for (int dt = 0; dt < 8; ++dt)
#pragma unroll
                for (int ks = 0; ks < 2; ++ks) { const bf16x8 vf = *(const LAS bf16x8*)(VT + (dt * 16 + l15) * 72 + ks * 32 + lq * 8); O[dt] = mfma16(pf[ks], vf, O[dt]); }
            __builtin_amdgcn_wave_barrier();
        } };
    Stage R0, R1;
    int ta = 0;
    while (ta <= last && !((tmask >> (ta >> 2)) & 1)) ++ta;
    int tb = nextv(ta);
    if (ta <= last) issue(R0, ta);
    if (tb <= last) issue(R1, tb);
    while (ta <= last) {
        int tc = nextv(tb);
        __syncthreads(); stage(R0); __syncthreads();
        if (tc <= last) issue(R0, tc);
        compute(ta);
        if (tb > last) break;
        int td = nextv(tc);
        __syncthreads(); stage(R1); __syncthreads();
        if (td <= last) issue(R1, td);
        compute(tb);
        ta = tc; tb = td;
    }
#pragma unroll
    for (int i = 0; i < 4; ++i) { const float inv = 1.f / ls[i]; const size_t tok = (size_t)(b * SEQ + q0 + wid * 16 + lq * 4 + i);
#pragma unroll
        for (int dt = 0; dt < 8; ++dt) { const int d = dt * 16 + l15;
            const float g = bf2f(p.P[tok * NP + C_GB + h * 128 + d]);
            p.H[tok * DM + 1024 + h * 128 + d] = f2bf(O[dt][i] * inv * siluf_(g)); } }
}

constexpr int GL_QE = 0, GL_KE = 9216, GL_KDT = 18432, GL_VT = 27648, GL_ATT = 46080, GL_ST = 55296, GL_LA = 73728, GL_TOT = 90112,
              GL_AUP = 92160, GL_LOW = 96256, GL_DEC = 100352, GL_ABS = 100608, GL_GNW = 100864, GL_OB = 0;
__device__ void gla_chunk(const Params& p, int l, LAS unsigned char* lds, int bh, int n, int pass) {
    const int tid = tid_(), wid = tid >> 6, lane = tid & 63, l15 = lane & 15, lq = lane >> 4;
    const int b = bh >> 2, h = bh & 3;
    LAS u16* QE = (LAS u16*)(lds + GL_QE); LAS u16* KE = (LAS u16*)(lds + GL_KE); LAS u16* KDT = (LAS u16*)(lds + GL_KDT); LAS u16* VT = (LAS u16*)(lds + GL_VT);
    LAS u16* ATT = (LAS u16*)(lds + GL_ATT); LAS u16* ST = (LAS u16*)(lds + GL_ST); LAS float* LA = (LAS float*)(lds + GL_LA); LAS float* TOT = (LAS float*)(lds + GL_TOT);
    LAS float* AUP = (LAS float*)(lds + GL_AUP); LAS float* LOW = (LAS float*)(lds + GL_LOW); LAS float* DEC = (LAS float*)(lds + GL_DEC); LAS float* OB = (LAS float*)(lds + GL_OB); LAS float* ABS = (LAS float*)(lds + GL_ABS); LAS float* GNW = (LAS float*)(lds + GL_GNW);
    __syncthreads();
    for (int i = tid; i < 1024; i += 512) AUP[i] = p.a_up[(size_t)l * 16 * 256 + (i >> 6) * 256 + h * 64 + (i & 63)];
    if (tid < 64) ABS[tid] = p.a_b[(size_t)l * 256 + h * 64 + tid];
    if (tid >= 64 && tid < 192) GNW[tid - 64] = p.gnw[(size_t)l * 128 + tid - 64];
    const int rt = wid >> 1, dv0t = (wid & 1) * 4;
    const int tp = lane & 31, dg = wid * 2 + (lane >> 5);
    {
        const size_t tokb = (size_t)(b * SEQ + n * 64);
        const u16* rowp = p.P + (tokb + (tid >> 3)) * NP;
        const u16* rp0 = p.P + (tokb + 2 * tp) * NP; const u16* rp1 = rp0 + NP;
        const unsigned c_low = *(const unsigned*)(rowp + C_LOW + (tid & 7) * 2);
        const u32x2 c_q0 = *(const u32x2*)(rp0 + C_QC + h * 64 + dg * 4), c_q1 = *(const u32x2*)(rp1 + C_QC + h * 64 + dg * 4);
        const u32x2 c_k0 = *(const u32x2*)(rp0 + C_KC + h * 64 + dg * 4), c_k1 = *(const u32x2*)(rp1 + C_KC + h * 64 + dg * 4);
        const u32x4 c_v0 = *(const u32x4*)(rp0 + C_VC + h * 128 + dg * 8), c_v1 = *(const u32x4*)(rp1 + C_VC + h * 128 + dg * 8);
        const u32x4 c_g0 = *(const u32x4*)(rowp + C_GC + h * 128 + (tid & 7) * 16), c_g1 = *(const u32x4*)(rowp + C_GC + h * 128 + (tid & 7) * 16 + 8);
        { const int e2 = tid * 2, t = e2 >> 4, r = e2 & 15; LOW[t * 16 + r] = bflo(c_low); LOW[t * 16 + r + 1] = bfhi(c_low); }
        __syncthreads();
        { const int t = tid >> 3, d0 = (tid & 7) * 8;
            f32x4 lo[4];
#pragma unroll
            for (int i = 0; i < 4; ++i) lo[i] = *(const LAS f32x4*)(LOW + t * 16 + 4 * i);
            f32x4 z0 = *(const LAS f32x4*)(ABS + d0), z1 = *(const LAS f32x4*)(ABS + d0 + 4);
#pragma unroll
            for (int r = 0; r < 16; ++r) { const f32x4 u0 = *(const LAS f32x4*)(AUP + r * 64 + d0), u1 = *(const LAS f32x4*)(AUP + r * 64 + d0 + 4);
                const float lv = lo[r >> 2][r & 3]; z0 += lv * u0; z1 += lv * u1; }
#pragma unroll
            for (int e = 0; e < 4; ++e) { z0[e] = (fminf(z0[e], 0.f) - __logf(1.f + __expf(-fabsf(z0[e])))) * (1.f / 16.f); z1[e] = (fminf(z1[e], 0.f) - __logf(1.f + __expf(-fabsf(z1[e])))) * (1.f / 16.f); }
            *(LAS f32x4*)(LA + t * 64 + d0) = z0; *(LAS f32x4*)(LA + t * 64 + d0 + 4) = z1; }
        __syncthreads();
        { float a = 0.f;
#pragma unroll
            for (int tt = 0; tt < 8; ++tt) { a += LA[(wid * 8 + tt) * 64 + lane]; LA[(wid * 8 + tt) * 64 + lane] = a; }
            TOT[wid * 64 + lane] = a; }
        __syncthreads();
        { const int t0 = 2 * tp, wt = tp >> 2, d0 = dg * 4;
            f32x4 off = {0.f, 0.f, 0.f, 0.f}, tot = {0.f, 0.f, 0.f, 0.f};
#pragma unroll
            for (int w2 = 0; w2 < 8; ++w2) { const f32x4 tv = *(const LAS f32x4*)(TOT + w2 * 64 + d0); tot += tv; off += (w2 < wt) ? tv : (f32x4){0.f, 0.f, 0.f, 0.f}; }
            const f32x4 b0 = *(const LAS f32x4*)(LA + t0 * 64 + d0) + off, b1 = *(const LAS f32x4*)(LA + (t0 + 1) * 64 + d0) + off;
            const float q0[4] = {bflo(c_q0.x), bfhi(c_q0.x), bflo(c_q0.y), bfhi(c_q0.y)}, q1[4] = {bflo(c_q1.x), bfhi(c_q1.x), bflo(c_q1.y), bfhi(c_q1.y)};
            const float k0[4] = {bflo(c_k0.x), bfhi(c_k0.x), bflo(c_k0.y), bfhi(c_k0.y)}, k1[4] = {bflo(c_k1.x), bfhi(c_k1.x), bflo(c_k1.y), bfhi(c_k1.y)};
            float qe0[4], qe1[4], ke0[4], ke1[4];
#pragma unroll
            for (int e = 0; e < 4; ++e) {
                qe0[e] = q0[e] * 0.125f * __expf(b0[e]); qe1[e] = q1[e] * 0.125f * __expf(b1[e]);
                ke0[e] = k0[e] * __expf(-b0[e]); ke1[e] = k1[e] * __expf(-b1[e]);
                *(LAS unsigned*)(KDT + (d0 + e) * 72 + t0) = cvt_pk_bf16(k0[e] * __expf(tot[e] - b0[e]), k1[e] * __expf(tot[e] - b1[e]));
                if (tp == 0) DEC[d0 + e] = __expf(tot[e]); }
            u32x2 o; o.x = cvt_pk_bf16(qe0[0], qe0[1]); o.y = cvt_pk_bf16(qe0[2], qe0[3]); *(LAS u32x2*)(QE + t0 * 72 + d0) = o;
            o.x = cvt_pk_bf16(qe1[0], qe1[1]); o.y = cvt_pk_bf16(qe1[2], qe1[3]); *(LAS u32x2*)(QE + (t0 + 1) * 72 + d0) = o;
            o.x = cvt_pk_bf16(ke0[0], ke0[1]); o.y = cvt_pk_bf16(ke0[2], ke0[3]); *(LAS u32x2*)(KE + t0 * 72 + d0) = o;
            o.x = cvt_pk_bf16(ke1[0], ke1[1]); o.y = cvt_pk_bf16(ke1[2], ke1[3]); *(LAS u32x2*)(KE + (t0 + 1) * 72 + d0) = o;
            { LAS unsigned* vt = (LAS unsigned*)(VT + dg * 8 * 72 + t0);
                vt[0] = (c_v0.x & 0xffffu) | (c_v1.x << 16); vt[36] = (c_v0.x >> 16) | (c_v1.x & 0xffff0000u);
                vt[72] = (c_v0.y & 0xffffu) | (c_v1.y << 16); vt[108] = (c_v0.y >> 16) | (c_v1.y & 0xffff0000u);
                vt[144] = (c_v0.z & 0xffffu) | (c_v1.z << 16); vt[180] = (c_v0.z >> 16) | (c_v1.z & 0xffff0000u);
                vt[216] = (c_v0.w & 0xffffu) | (c_v1.w << 16); vt[252] = (c_v0.w >> 16) | (c_v1.w & 0xffff0000u); } }
        __syncthreads();
        if (pass == 1) {
            bf16x8 kd[2];
#pragma unroll
            for (int ks = 0; ks < 2; ++ks) kd[ks] = *(const LAS bf16x8*)(KDT + (rt * 16 + l15) * 72 + ks * 32 + lq * 8);
            f32x4* gout = (f32x4*)(p.gst + ((size_t)(bh * 32 + n) * 512 + tid) * 16);
#pragma unroll
            for (int c = 0; c < 4; ++c) { const int dvt = dv0t + c; f32x4 acc = {0.f, 0.f, 0.f, 0.f};
#pragma unroll
                for (int ks = 0; ks < 2; ++ks) { const bf16x8 vf = *(const LAS bf16x8*)(VT + (dvt * 16 + l15) * 72 + ks * 32 + lq * 8); acc = mfma16(kd[ks], vf, acc); }
                gout[c] = acc; }
            if (tid < 64) p.gdec[(size_t)(bh * 32 + n) * 64 + tid] = DEC[tid];
            return;
        }
        { bf16x8 af[2];
#pragma unroll
            for (int ks = 0; ks < 2; ++ks) af[ks] = *(const LAS bf16x8*)(QE + (rt * 16 + l15) * 72 + ks * 32 + lq * 8);
#pragma unroll
            for (int c2 = 0; c2 < 2; ++c2) { const int ctile = (wid & 1) * 2 + c2; f32x4 acc = {0.f, 0.f, 0.f, 0.f};
#pragma unroll
                for (int ks = 0; ks < 2; ++ks) { const bf16x8 bf = *(const LAS bf16x8*)(KE + (ctile * 16 + l15) * 72 + ks * 32 + lq * 8); acc = mfma16(af[ks], bf, acc); }
#pragma unroll
                for (int i = 0; i < 4; ++i) { const int t = rt * 16 + lq * 4 + i, jj = ctile * 16 + l15; ATT[t * 72 + jj] = f2bf(jj <= t ? acc[i] : 0.f); } } }
        { f32x4 S[4];
#pragma unroll
            for (int c = 0; c < 4; ++c) S[c] = (f32x4){0.f, 0.f, 0.f, 0.f};
#pragma unroll 2
            for (int m = 0; m < n; ++m) { const f32x4* gin = (const f32x4*)(p.gst + ((size_t)(bh * 32 + m) * 512 + tid) * 16);
                const f32x4 dm = *(const f32x4*)(p.gdec + (size_t)(bh * 32 + m) * 64 + rt * 16 + lq * 4);
#pragma unroll
                for (int c = 0; c < 4; ++c) S[c] = S[c] * dm + gin[c]; }
#pragma unroll
            for (int c = 0; c < 4; ++c) { const int dv = (dv0t + c) * 16 + l15;
                u32x2 sv; sv.x = cvt_pk_bf16(S[c][0], S[c][1]); sv.y = cvt_pk_bf16(S[c][2], S[c][3]);
                *(LAS u32x2*)(ST + dv * 72 + rt * 16 + lq * 4) = sv; } }
        __syncthreads();
        f32x4 oacc[4];
        { bf16x8 at[2], qf[2];
#pragma unroll
            for (int ks = 0; ks < 2; ++ks) { at[ks] = *(const LAS bf16x8*)(ATT + (rt * 16 + l15) * 72 + ks * 32 + lq * 8); qf[ks] = *(const LAS bf16x8*)(QE + (rt * 16 + l15) * 72 + ks * 32 + lq * 8); }
#pragma unroll
            for (int c = 0; c < 4; ++c) { const int dvt = dv0t + c; f32x4 acc = {0.f, 0.f, 0.f, 0.f};
#pragma unroll
                for (int ks = 0; ks < 2; ++ks) { const bf16x8 vf = *(const LAS bf16x8*)(VT + (dvt * 16 + l15) * 72 + ks * 32 + lq * 8), sf = *(const LAS bf16x8*)(ST + (dvt * 16 + l15) * 72 + ks * 32 + lq * 8);
                    acc = mfma16(at[ks], vf, acc); acc = mfma16(qf[ks], sf, acc); }
                oacc[c] = acc; } }
        __syncthreads();
#pragma unroll
        for (int c = 0; c < 4; ++c) { const int dv = (dv0t + c) * 16 + l15;
#pragma unroll
            for (int i = 0; i < 4; ++i) OB[(rt * 16 + lq * 4 + i) * 132 + dv] = oacc[c][i]; }
        __syncthreads();
        { const int t = tid >> 3, dvb = (tid & 7) * 16;
            f32x4 o4[4]; float ss = 0.f;
#pragma unroll
            for (int i = 0; i < 4; ++i) { o4[i] = *(const LAS f32x4*)(OB + t * 132 + dvb + 4 * i); ss += o4[i].x * o4[i].x + o4[i].y * o4[i].y + o4[i].z * o4[i].z + o4[i].w * o4[i].w; }
            ss = red8_sum(ss);
            const float rs = rsqrtf(ss * (1.f / 128.f) + 1e-6f);
            const float g[16] = {bflo(c_g0.x), bfhi(c_g0.x), bflo(c_g0.y), bfhi(c_g0.y), bflo(c_g0.z), bfhi(c_g0.z), bflo(c_g0.w), bfhi(c_g0.w),
                                 bflo(c_g1.x), bfhi(c_g1.x), bflo(c_g1.y), bfhi(c_g1.y), bflo(c_g1.z), bfhi(c_g1.z), bflo(c_g1.w), bfhi(c_g1.w)};
            float r[16];
#pragma unroll
            for (int e = 0; e < 16; ++e) r[e] = o4[e >> 2][e & 3] * rs * GNW[dvb + e] * siluf_(g[e]);
            u32x4 w0, w1; w0.x = cvt_pk_bf16(r[0], r[1]); w0.y = cvt_pk_bf16(r[2], r[3]); w0.z = cvt_pk_bf16(r[4], r[5]); w0.w = cvt_pk_bf16(r[6], r[7]);
            w1.x = cvt_pk_bf16(r[8], r[9]); w1.y = cvt_pk_bf16(r[10], r[11]); w1.z = cvt_pk_bf16(r[12], r[13]); w1.w = cvt_pk_bf16(r[14], r[15]);
            u16* op = p.H + (tokb + t) * DM + 1536 + h * 128 + dvb;
            *(u32x4*)op = w0; *(u32x4*)(op + 8) = w1; }
    }
}

__device__ void gla_task(const Params& p, int l, LAS unsigned char* lds, int bh, int hs) {
    const int tid = tid_(), wid = tid >> 6, lane = tid & 63, l15 = lane & 15, lq = lane >> 4;
    const int b = bh >> 2, h = bh & 3;
    LAS u16* QE = (LAS u16*)(lds + GL_QE); LAS u16* KE = (LAS u16*)(lds + GL_KE); LAS u16* KDT = (LAS u16*)(lds + GL_KDT); LAS u16* VT = (LAS u16*)(lds + GL_VT);
    LAS u16* ATT = (LAS u16*)(lds + GL_ATT); LAS u16* ST = (LAS u16*)(lds + GL_ST); LAS float* LA = (LAS float*)(lds + GL_LA); LAS float* TOT = (LAS float*)(lds + GL_TOT);
    LAS float* AUP = (LAS float*)(lds + GL_AUP); LAS float* LOW = (LAS float*)(lds + GL_LOW); LAS float* DEC = (LAS float*)(lds + GL_DEC); LAS float* OB = (LAS float*)(lds + GL_OB); LAS float* ABS = (LAS float*)(lds + GL_ABS); LAS float* GNW = (LAS float*)(lds + GL_GNW);
    __syncthreads();
    for (int i = tid; i < 1024; i += 512) AUP[i] = p.a_up[(size_t)l * 16 * 256 + (i >> 6) * 256 + h * 64 + (i & 63)];
    for (int i = tid; i < 128 * 72 / 2; i += 512) ((LAS unsigned*)ST)[i] = 0u;
    if (tid < 64) ABS[tid] = p.a_b[(size_t)l * 256 + h * 64 + tid];
    if (tid >= 64 && tid < 192) GNW[tid - 64] = p.gnw[(size_t)l * 128 + tid - 64];
    f32x4 Sacc[4];
#pragma unroll
    for (int c = 0; c < 4; ++c) Sacc[c] = (f32x4){0.f, 0.f, 0.f, 0.f};
    const int rt = wid >> 1, dv0t = (wid & 1) * 4;
    const int tp = lane & 31, dg = wid * 2 + (lane >> 5);
    if (hs) {
#pragma unroll 2
        for (int m = 0; m < 16; ++m) { const f32x4* gin = (const f32x4*)(p.gst + ((size_t)(bh * 32 + m) * 512 + tid) * 16);
            const f32x4 dm = *(const f32x4*)(p.gdec + (size_t)(bh * 32 + m) * 64 + rt * 16 + lq * 4);
#pragma unroll
            for (int c = 0; c < 4; ++c) Sacc[c] = Sacc[c] * dm + gin[c]; }
        __syncthreads();
#pragma unroll
        for (int c = 0; c < 4; ++c) { const int dv = (dv0t + c) * 16 + l15;
            u32x2 sv; sv.x = cvt_pk_bf16(Sacc[c][0], Sacc[c][1]); sv.y = cvt_pk_bf16(Sacc[c][2], Sacc[c][3]);
            *(LAS u32x2*)(ST + dv * 72 + rt * 16 + lq * 4) = sv; }
    }
    for (int n = hs * 16; n < hs * 16 + 16; ++n) {
        const size_t tokb = (size_t)(b * SEQ + n * 64);
        const u16* rowp = p.P + (tokb + (tid >> 3)) * NP;
        const u16* rp0 = p.P + (tokb + 2 * tp) * NP; const u16* rp1 = rp0 + NP;
        const unsigned c_low = *(const unsigned*)(rowp + C_LOW + (tid & 7) * 2);
        const u32x2 c_q0 = *(const u32x2*)(rp0 + C_QC + h * 64 + dg * 4), c_q1 = *(const u32x2*)(rp1 + C_QC + h * 64 + dg * 4);
        const u32x2 c_k0 = *(const u32x2*)(rp0 + C_KC + h * 64 + dg * 4), c_k1 = *(const u32x2*)(rp1 + C_KC + h * 64 + dg * 4);
        const u32x4 c_v0 = *(const u32x4*)(rp0 + C_VC + h * 128 + dg * 8), c_v1 = *(const u32x4*)(rp1 + C_VC + h * 128 + dg * 8);
        const u32x4 c_g0 = *(const u32x4*)(rowp + C_GC + h * 128 + (tid & 7) * 16), c_g1 = *(const u32x4*)(rowp + C_GC + h * 128 + (tid & 7) * 16 + 8);
        { const int e2 = tid * 2, t = e2 >> 4, r = e2 & 15; LOW[t * 16 + r] = bflo(c_low); LOW[t * 16 + r + 1] = bfhi(c_low); }
        __syncthreads();
        { const int t = tid >> 3, d0 = (tid & 7) * 8;
            f32x4 lo[4];
#pragma unroll
            for (int i = 0; i < 4; ++i) lo[i] = *(const LAS f32x4*)(LOW + t * 16 + 4 * i);
            f32x4 z0 = *(const LAS f32x4*)(ABS + d0), z1 = *(const LAS f32x4*)(ABS + d0 + 4);
#pragma unroll
            for (int r = 0; r < 16; ++r) { const f32x4 u0 = *(const LAS f32x4*)(AUP + r * 64 + d0), u1 = *(const LAS f32x4*)(AUP + r * 64 + d0 + 4);
                const float lv = lo[r >> 2][r & 3]; z0 += lv * u0; z1 += lv * u1; }
#pragma unroll
            for (int e = 0; e < 4; ++e) { z0[e] = (fminf(z0[e], 0.f) - __logf(1.f + __expf(-fabsf(z0[e])))) * (1.f / 16.f); z1[e] = (fminf(z1[e], 0.f) - __logf(1.f + __expf(-fabsf(z1[e])))) * (1.f / 16.f); }
            *(LAS f32x4*)(LA + t * 64 + d0) = z0; *(LAS f32x4*)(LA + t * 64 + d0 + 4) = z1; }
        __syncthreads();
        { float a = 0.f;
#pragma unroll
            for (int tt = 0; tt < 8; ++tt) { a += LA[(wid * 8 + tt) * 64 + lane]; LA[(wid * 8 + tt) * 64 + lane] = a; }
            TOT[wid * 64 + lane] = a; }
        __syncthreads();
        { const int t0 = 2 * tp, wt = tp >> 2, d0 = dg * 4;
            f32x4 off = {0.f, 0.f, 0.f, 0.f}, tot = {0.f, 0.f, 0.f, 0.f};
#pragma unroll
            for (int w2 = 0; w2 < 8; ++w2) { const f32x4 tv = *(const LAS f32x4*)(TOT + w2 * 64 + d0); tot += tv; off += (w2 < wt) ? tv : (f32x4){0.f, 0.f, 0.f, 0.f}; }
            const f32x4 b0 = *(const LAS f32x4*)(LA + t0 * 64 + d0) + off, b1 = *(const LAS f32x4*)(LA + (t0 + 1) * 64 + d0) + off;
            const float q0[4] = {bflo(c_q0.x), bfhi(c_q0.x), bflo(c_q0.y), bfhi(c_q0.y)}, q1[4] = {bflo(c_q1.x), bfhi(c_q1.x), bflo(c_q1.y), bfhi(c_q1.y)};
            const float k0[4] = {bflo(c_k0.x), bfhi(c_k0.x), bflo(c_k0.y), bfhi(c_k0.y)}, k1[4] = {bflo(c_k1.x), bfhi(c_k1.x), bflo(c_k1.y), bfhi(c_k1.y)};
            float qe0[4], qe1[4], ke0[4], ke1[4];
#pragma unroll
            for (int e = 0; e < 4; ++e) {
                qe0[e] = q0[e] * 0.125f * __expf(b0[e]); qe1[e] = q1[e] * 0.125f * __expf(b1[e]);
                ke0[e] = k0[e] * __expf(-b0[e]); ke1[e] = k1[e] * __expf(-b1[e]);
                *(LAS unsigned*)(KDT + (d0 + e) * 72 + t0) = cvt_pk_bf16(k0[e] * __expf(tot[e] - b0[e]), k1[e] * __expf(tot[e] - b1[e]));
                if (tp == 0) DEC[d0 + e] = __expf(tot[e]); }
            u32x2 o; o.x = cvt_pk_bf16(qe0[0], qe0[1]); o.y = cvt_pk_bf16(qe0[2], qe0[3]); *(LAS u32x2*)(QE + t0 * 72 + d0) = o;
            o.x = cvt_pk_bf16(qe1[0], qe1[1]); o.y = cvt_pk_bf16(qe1[2], qe1[3]); *(LAS u32x2*)(QE + (t0 + 1) * 72 + d0) = o;
            o.x = cvt_pk_bf16(ke0[0], ke0[1]); o.y = cvt_pk_bf16(ke0[2], ke0[3]); *(LAS u32x2*)(KE + t0 * 72 + d0) = o;
            o.x = cvt_pk_bf16(ke1[0], ke1[1]); o.y = cvt_pk_bf16(ke1[2], ke1[3]); *(LAS u32x2*)(KE + (t0 + 1) * 72 + d0) = o;
            { LAS unsigned* vt = (LAS unsigned*)(VT + dg * 8 * 72 + t0);
                vt[0] = (c_v0.x & 0xffffu) | (c_v1.x << 16); vt[36] = (c_v0.x >> 16) | (c_v1.x & 0xffff0000u);
                vt[72] = (c_v0.y & 0xffffu) | (c_v1.y << 16); vt[108] = (c_v0.y >> 16) | (c_v1.y & 0xffff0000u);
                vt[144] = (c_v0.z & 0xffffu) | (c_v1.z << 16); vt[180] = (c_v0.z >> 16) | (c_v1.z & 0xffff0000u);
                vt[216] = (c_v0.w & 0xffffu) | (c_v1.w << 16); vt[252] = (c_v0.w >> 16) | (c_v1.w & 0xffff0000u); } }
        __syncthreads();
        { bf16x8 af[2];
#pragma unroll
            for (int ks = 0; ks < 2; ++ks) af[ks] = *(const LAS bf16x8*)(QE + (rt * 16 + l15) * 72 + ks * 32 + lq * 8);
#pragma unroll
            for (int c2 = 0; c2 < 2; ++c2) { const int ctile = (wid & 1) * 2 + c2; f32x4 acc = {0.f, 0.f, 0.f, 0.f};
#pragma unroll
                for (int ks = 0; ks < 2; ++ks) { const bf16x8 bf = *(const LAS bf16x8*)(KE + (ctile * 16 + l15) * 72 + ks * 32 + lq * 8); acc = mfma16(af[ks], bf, acc); }
#pragma unroll
                for (int i = 0; i < 4; ++i) { const int t = rt * 16 + lq * 4 + i, jj = ctile * 16 + l15; ATT[t * 72 + jj] = f2bf(jj <= t ? acc[i] : 0.f); } } }
        __syncthreads();
        f32x4 oacc[4];
        { bf16x8 at[2], qf[2], kd[2];
#pragma unroll
            for (int ks = 0; ks < 2; ++ks) { at[ks] = *(const LAS bf16x8*)(ATT + (rt * 16 + l15) * 72 + ks * 32 + lq * 8); qf[ks] = *(const LAS bf16x8*)(QE + (rt * 16 + l15) * 72 + ks * 32 + lq * 8);
                kd[ks] = *(const LAS bf16x8*)(KDT + (rt * 16 + l15) * 72 + ks * 32 + lq * 8); }
            const f32x4 dec = *(const LAS f32x4*)(DEC + rt * 16 + lq * 4);
#pragma unroll
            for (int c = 0; c < 4; ++c) { const int dvt = dv0t + c; f32x4 acc = {0.f, 0.f, 0.f, 0.f};
                Sacc[c] *= dec;
#pragma unroll
                for (int ks = 0; ks < 2; ++ks) { const bf16x8 vf = *(const LAS bf16x8*)(VT + (dvt * 16 + l15) * 72 + ks * 32 + lq * 8), sf = *(const LAS bf16x8*)(ST + (dvt * 16 + l15) * 72 + ks * 32 + lq * 8);
                    acc = mfma16(at[ks], vf, acc); acc = mfma16(qf[ks], sf, acc); Sacc[c] = mfma16(kd[ks], vf, Sacc[c]); }
                oacc[c] = acc; } }
        __syncthreads();
#pragma unroll
        for (int c = 0; c < 4; ++c) { const int dv = (dv0t + c) * 16 + l15;
#pragma unroll
            for (int i = 0; i < 4; ++i) OB[(rt * 16 + lq * 4 + i) * 132 + dv] = oacc[c][i];
            u32x2 sv; sv.x = cvt_pk_bf16(Sacc[c][0], Sacc[c][1]); sv.y = cvt_pk_bf16(Sacc[c][2], Sacc[c][3]);
            *(LAS u32x2*)(ST + dv * 72 + rt * 16 + lq * 4) = sv; }
        __syncthreads();
        { const int t = tid >> 3, dvb = (tid & 7) * 16;
            f32x4 o4[4]; float ss = 0.f;
#pragma unroll
            for (int i = 0; i < 4; ++i) { o4[i] = *(const LAS f32x4*)(OB + t * 132 + dvb + 4 * i); ss += o4[i].x * o4[i].x + o4[i].y * o4[i].y + o4[i].z * o4[i].z + o4[i].w * o4[i].w; }
            ss = red8_sum(ss);
            const float rs = rsqrtf(ss * (1.f / 128.f) + 1e-6f);
            const float g[16] = {bflo(c_g0.x), bfhi(c_g0.x), bflo(c_g0.y), bfhi(c_g0.y), bflo(c_g0.z), bfhi(c_g0.z), bflo(c_g0.w), bfhi(c_g0.w),
                                 bflo(c_g1.x), bfhi(c_g1.x), bflo(c_g1.y), bfhi(c_g1.y), bflo(c_g1.z), bfhi(c_g1.z), bflo(c_g1.w), bfhi(c_g1.w)};
            float r[16];
#pragma unroll
            for (int e = 0; e < 16; ++e) r[e] = o4[e >> 2][e & 3] * rs * GNW[dvb + e] * siluf_(g[e]);
            u32x4 w0, w1; w0.x = cvt_pk_bf16(r[0], r[1]); w0.y = cvt_pk_bf16(r[2], r[3]); w0.z = cvt_pk_bf16(r[4], r[5]); w0.w = cvt_pk_bf16(r[6], r[7]);
            w1.x = cvt_pk_bf16(r[8], r[9]); w1.y = cvt_pk_bf16(r[10], r[11]); w1.z = cvt_pk_bf16(r[12], r[13]); w1.w = cvt_pk_bf16(r[14], r[15]);
            u16* op = p.H + (tokb + t) * DM + 1536 + h * 128 + dvb;
            *(u32x4*)op = w0; *(u32x4*)(op + 8) = w1; }
        __syncthreads();
    }
}

#define XB_TMO      128
#define XB_XCNT(j)  (256  + 64 * (j))
#define XB_XSUB(j)  (1280 + 64 * (j))
#define XB_XGEN(j)  (2304 + 64 * (j))
#define XB_TOP      3328
#define XB_TOPGEN   3392
#define XCD_BAR_WORDS 3456
#define XB_SPIN_CAP (1u << 18)

__device__ __forceinline__ unsigned xb_ld(unsigned* p)              { return __hip_atomic_load(p, __ATOMIC_RELAXED, __HIP_MEMORY_SCOPE_AGENT); }
__device__ __forceinline__ unsigned xb_add(unsigned* p, unsigned v) { return __hip_atomic_fetch_add(p, v, __ATOMIC_RELAXED, __HIP_MEMORY_SCOPE_AGENT); }
__device__ __forceinline__ unsigned xb_xcc_id() { return (unsigned)__builtin_amdgcn_s_getreg((3 << 11) | 20) & 0xFu; }
#define XB_SPIN(cond, bar) do { unsigned _sp = 0; while (cond) { __builtin_amdgcn_s_sleep(1); \
    if ((++_sp & 255u) == 0u) { if (xb_ld(&(bar)[XB_TMO])) break; if (_sp > XB_SPIN_CAP) { atomicAdd(&(bar)[XB_TMO], 1u); break; } } } } while (0)

struct XcdBarrier {
    unsigned* bar; unsigned x;
    volatile LAS unsigned* st;
};

__device__ __forceinline__ XcdBarrier xcd_barrier_post(unsigned* bar, volatile LAS unsigned* st) {
    XcdBarrier b; b.bar = bar; b.x = xb_xcc_id(); b.st = st;
    if (threadIdx.x == 0) (void)xb_add(&bar[XB_XCNT(b.x)], 1u);
    return b;
}
__device__ __forceinline__ void xcd_barrier_complete(unsigned* bar, unsigned x, unsigned& nloc, unsigned& nx) {
    const unsigned G = gridDim.x * gridDim.y * gridDim.z;
    unsigned sum, cnt, mine, sp = 0u;
    for (;;) {
        sum = 0u; cnt = 0u; mine = 0u;
#pragma unroll
        for (unsigned j = 0; j < 16; ++j) { const unsigned c = xb_ld(&bar[XB_XCNT(j)]); sum += c; cnt += (c > 0u) ? 1u : 0u; mine = (j == x) ? c : mine; }
        if (sum == G) break;
        __builtin_amdgcn_s_sleep(1);
        if ((++sp & 255u) == 0u) { if (xb_ld(&bar[XB_TMO])) break; if (sp > XB_SPIN_CAP) { atomicAdd(&bar[XB_TMO], 1u); break; } }
    }
    nloc = mine > 0u ? mine : 1u; nx = cnt > 0u ? cnt : 1u;
}

__device__ __forceinline__ void xcd_barrier(const XcdBarrier& b) {
    asm volatile("s_waitcnt vmcnt(0)" ::: "memory");
    __syncthreads();
    if (threadIdx.x == 0) {
        unsigned* bar = b.bar;
        __builtin_amdgcn_s_waitcnt(0);
        unsigned nloc = b.st[0], nx = b.st[1];
        if (nloc == 0u) { xcd_barrier_complete(bar, b.x, nloc, nx); b.st[0] = nloc; b.st[1] = nx; }
        const unsigned old = xb_add(&bar[XB_XSUB(b.x)], 1u);
        const unsigned gen = old / nloc;
        if (old + 1u == (gen + 1u) * nloc) {
            __builtin_amdgcn_fence(__ATOMIC_RELEASE, "agent");
            asm volatile("s_waitcnt vmcnt(0)" ::: "memory");
            const unsigned og = xb_add(&bar[XB_TOP], 1u);
            const unsigned tg = og / nx;
            if (og + 1u == (tg + 1u) * nx) xb_add(&bar[XB_TOPGEN], 1u);
            else XB_SPIN(xb_ld(&bar[XB_TOPGEN]) == tg, bar);
            __builtin_amdgcn_fence(__ATOMIC_ACQUIRE, "agent");
            xb_add(&bar[XB_XGEN(b.x)], 1u);
            asm volatile("s_waitcnt vmcnt(0)" ::: "memory");
        } else {
            XB_SPIN(xb_ld(&bar[XB_XGEN(b.x)]) == gen, bar);
            __builtin_amdgcn_fence(__ATOMIC_ACQUIRE, "agent");
            asm volatile("s_waitcnt vmcnt(0)" ::: "memory");
        }
    }
    __syncthreads();
}

constexpr int N_PHASES = 11;
__device__ __forceinline__ void run_phase(const Params& p, int ph, LAS unsigned char* lds, LAS unsigned* qslot, int bid, int nb) {
    if (ph == 0) {
        for (int l = 0; l < 2; ++l) {
            transpose_cvt(lds, p.w_in + (size_t)l * DM * DIN, p.WtIn + (size_t)l * NP * DM, DM, DIN, NP, bid, nb);
            transpose_cvt(lds, p.w_out + (size_t)l * DM * DM, p.WtOut + (size_t)l * DM * DM, DM, DM, DM, bid, nb);
            transpose_cvt(lds, p.w2 + (size_t)l * 64 * 1024, p.W2t + (size_t)l * 1024 * 64, 64, 1024, 1024, bid, nb);
            transpose_cvt(lds, p.a2 + (size_t)l * 64 * 1024, p.A2t + (size_t)l * 1024 * 64, 64, 1024, 1024, bid, nb);
        }
        rmsnorm_phase(p.x, p.norm_w, p.H, nullptr, bid, nb);
        return;
    }
    const int l = (ph - 1) / 5, s = (ph - 1) % 5;
    if (s == 0) {
        Gemm g; g.A = p.H; g.Bt = p.WtIn + (size_t)l * NP * DM; g.M = MTOK; g.N = NP; g.K = DM;
        StaticOrder S; S.init(MTOK, NP, nb, bid);
        EpiP E; E.O = p.P; E.ldc = NP;
#ifndef SKIP_GEMM
        gemm_phase<EpiP, StaticOrder, false>(lds, g, S, E, nullptr);
#endif
    } else if (s == 1) {
        for (int tk = bid; tk < 512; tk += nb) gla_chunk(p, l, lds, tk >> 4, tk & 15, 1);
        kmean_phase(p, lds, bid, nb);
#ifndef SKIP_RWKV
        rwkv_scan_phase(p, l, lds, bid, nb);
#endif
    } else if (s == 2) {
#if ONE_LAUNCH && !defined(STATIC_Q)
        LAS int* slot = (LAS int*)qslot;
        for (;;) {
            __syncthreads();
            if (tid_() == 0) *slot = (int)atomicAdd(p.bar + 64 * l, 1u);
            __syncthreads();
            const int tk = *slot;
#ifdef PROBE_MOBA2
            if (tk >= 64 + 1024 + 512) break;
            if (tk < 64) gla_task(p, l, lds, tk & 31, tk >> 5);
            else if (tk < 1088) moba_task(p, lds, (tk - 64) >> 1);
            else { for (int it = 0; it < 16; ++it) rwkv_post_item(p, l, (tk - 1088) * 16 + it); }
#elif defined(PROBE_POST2)
            if (tk >= 64 + 512 + 1024) break;
            if (tk < 64) gla_task(p, l, lds, tk & 31, tk >> 5);
            else if (tk < 576) moba_task(p, lds, tk - 64);
            else { for (int it = 0; it < 16; ++it) rwkv_post_item(p, l, ((tk - 576) >> 1) * 16 + it); }
#else
            if (tk >= 64 + 512 + 512) break;
            if (tk < 64) gla_task(p, l, lds, tk & 31, tk >> 5);
            else if (tk < 576) moba_task(p, lds, tk - 64);
            else rwkv_post_task(p, l, tk - 576);
#endif
        }
#else
        for (int tk = bid; tk < 64 + 512 + 8192; tk += nb) {
            if (tk < 64) gla_task(p, l, lds, tk & 31, tk >> 5);
            else if (tk < 576) moba_task(p, lds, tk - 64);
            else rwkv_post_item(p, l, tk - 576);
        }
#endif
    } else if (s == 3) {
        Gemm g; g.A = p.H; g.Bt = p.WtOut + (size_t)l * DM * DM; g.M = MTOK; g.N = DM; g.K = DM;
        StaticOrder S; S.init(MTOK, DM, nb, bid);
        EpiRes E; E.R = (l == 0) ? p.x : p.out; E.C = p.out; E.ldc = DM;
#ifndef SKIP_GEMM
        gemm_phase<EpiRes, StaticOrder, false>(lds, g, S, E, nullptr);
#endif
    } else {
        if (l == 0) rmsnorm_phase(p.out, p.norm_w + DM, p.H, nullptr, bid, nb);
        else rmsnorm_phase(p.out, p.fnw, nullptr, p.out, bid, nb);
    }
}

__global__ void __launch_bounds__(512, 2) hybrid_fwd(Params p) {
    extern __shared__ __attribute__((aligned(16))) unsigned char shm[];
    LAS unsigned char* lds = (LAS unsigned char*)shm;
    const int bid = blockIdx.x, nb = gridDim.x;
#if defined(TEST_GEMM)
    { Gemm g; g.A = p.H; g.Bt = p.WtIn; g.M = MTOK; g.N = NP; g.K = DM;
      StaticOrder S; S.init(MTOK, NP, nb, bid);
      EpiP E; E.O = p.P; E.ldc = NP;
      gemm_phase<EpiP, StaticOrder, false>(lds, g, S, E, nullptr);
#if TEST_GEMM >= 2
      if (p.phase_lo) {
      Gemm g2; g2.A = p.H; g2.Bt = p.WtOut; g2.M = MTOK; g2.N = DM; g2.K = DM;
      StaticOrder S2; S2.init(MTOK, DM, nb, bid);
      EpiRes E2; E2.R = p.x; E2.C = p.out; E2.ldc = DM;
      gemm_phase<EpiRes, StaticOrder, false>(lds, g2, S2, E2, nullptr); }
#endif
    }
#elif ONE_LAUNCH
    cg::grid_group grid = cg::this_grid();
    __shared__ uint4 xb_words;
    if (threadIdx.x == 0) xb_words = make_uint4(0u, 0u, 0u, 0u);
    __syncthreads();
    const XcdBarrier xb = xcd_barrier_post(p.bar, (volatile LAS unsigned*)&xb_words);
    for (int ph = p.phase_lo; ph < p.phase_hi; ++ph) {
        run_phase(p, ph, lds, (LAS unsigned*)&xb_words.z, bid, nb);
#ifdef REPEAT_PH
        if (ph == REPEAT_PH) { xcd_barrier(xb); run_phase(p, ph, lds, (LAS unsigned*)&xb_words.z, bid, nb); }
#endif
        if (ph + 1 < p.phase_hi) { if (ph == 0) grid.sync(); else xcd_barrier(xb); }
    }
#else
    run_phase(p, p.phase_lo, lds, nullptr, bid, nb);
#endif
}

extern "C" void kernel_launch(void* const* d_in, const int* in_sizes, int n_in, void* d_out, int out_size, void* d_ws, size_t ws_size, hipStream_t stream) {
    static int grid = 0;
    if (grid == 0) {
        int dev = 0, cus = 0, per_cu = 0;
        hipGetDevice(&dev);
        hipDeviceGetAttribute(&cus, hipDeviceAttributeMultiprocessorCount, dev);
        hipFuncSetAttribute((const void*)hybrid_fwd, hipFuncAttributeMaxDynamicSharedMemorySize, LDS_BYTES);
        hipOccupancyMaxActiveBlocksPerMultiprocessor(&per_cu, (const void*)hybrid_fwd, 512, LDS_BYTES);
        if (per_cu < 1) { fprintf(stderr, "kernel_launch: occupancy query says %d blocks per CU\n", per_cu); per_cu = 1; }
        (void)hipGetLastError();
        grid = cus;
    }
    Params p{};
    const float* const* in = (const float* const*)d_in;
    p.x = in[0]; p.norm_w = in[1]; p.w_in = in[2]; p.w_out = in[3]; p.mu = in[4]; p.w0 = in[5]; p.w2 = in[6]; p.a0 = in[7]; p.a2 = in[8];
    p.k_k = in[9]; p.k_a = in[10]; p.r_k = in[11]; p.ln_w = in[12]; p.ln_b = in[13]; p.a_up = in[14]; p.a_b = in[15]; p.gnw = in[16]; p.fnw = in[17];
    p.out = (float*)d_out;
    unsigned char* ws = (unsigned char*)d_ws; size_t off = 0;
    auto take = [&](size_t bytes) { unsigned char* r = ws + off; off += (bytes + 255) & ~(size_t)255; return r; };
    p.WtIn = (u16*)take((size_t)2 * NP * DM * 2); p.WtOut = (u16*)take((size_t)2 * DM * DM * 2);
    p.W2t = (u16*)take((size_t)2 * 1024 * 64 * 2); p.A2t = (u16*)take((size_t)2 * 1024 * 64 * 2);
    p.H = (u16*)take((size_t)MTOK * DM * 2); p.P = (u16*)take((size_t)MTOK * NP * 2);
    p.yraw = (float*)take((size_t)MTOK * 1024 * 4); p.ybonus = (float*)take((size_t)MTOK * 16 * 4); p.kmean = (float*)take((size_t)256 * 128 * 4);
    p.bar = (unsigned*)take((size_t)XCD_BAR_WORDS * 4);
    p.gst = (float*)take((size_t)1024 * 8192 * 4); p.gdec = (float*)take((size_t)1024 * 64 * 4);
    if (off > ws_size) { fprintf(stderr, "kernel_launch: workspace too small (%zu > %zu)\n", off, ws_size); return; }
#if ONE_LAUNCH
    hipMemsetAsync(p.bar, 0, (size_t)XCD_BAR_WORDS * 4, stream);
    p.phase_lo = 0; p.phase_hi = N_PHASES;
    void* args[] = {&p};
    hipError_t e = hipLaunchCooperativeKernel((const void*)hybrid_fwd, dim3(grid), dim3(512), args, LDS_BYTES, stream);
    if (e != hipSuccess) fprintf(stderr, "cooperative launch failed: %s (grid %d)\n", hipGetErrorString(e), grid);
#else
    for (int ph = 0; ph < N_PHASES; ++ph) { p.phase_lo = ph; p.phase_hi = ph + 1; hipLaunchKernelGGL(hybrid_fwd, dim3(grid), dim3(512), LDS_BYTES, stream, p); }
#endif
}
```

```cpp
#include <hip/hip_runtime.h>
#include <hip/hip_cooperative_groups.h>
#include <cstdio>
namespace cg = cooperative_groups;

#ifndef ONE_LAUNCH
#define ONE_LAUNCH 1
#endif

namespace pg8 {
#define PG8_LAS __attribute__((address_space(3)))
typedef unsigned short bf16_t;
typedef short bf16x8 __attribute__((ext_vector_type(8)));
typedef float f32x4 __attribute__((ext_vector_type(4)));
typedef unsigned u32x4 __attribute__((ext_vector_type(4)));
constexpr int BM = 256, BK = 64, HALF = 128, HTB = HALF * BK * 2  , STAGE_BYTES = 8 * HTB, NXCD = 8, WGM = 8;

__host__ __device__ __forceinline__ int lds_byte(int r, int c) { const int st = (r >> 4) * 2 + (c >> 5), rr = r & 15, cc = c & 31, ob = rr * 64 + cc * 2; return st * 1024 + (ob ^ (((ob >> 9) & 1) << 5)); }
__host__ __device__ __forceinline__ void stage_rc(int b, int& R, int& C) { const int st = b / 1024, sb = b % 1024, swz = sb ^ (((sb >> 9) & 1) << 5); R = (st >> 1) * 16 + swz / 64; C = (st & 1) * 32 + (swz % 64) / 2; }
__host__ __device__ __forceinline__ int perm32(int rho) { const int n = rho >> 4, i = rho & 15; return 8 * (i >> 2) + 4 * n + (i & 3); }

struct Unit { int pm, pn; };
struct Gemm { const bf16_t* A; const bf16_t* Bt; int M, N, K; };

struct StaticOrder {
    int nM, nN, nwg, G, c;
    __host__ __device__ void init(int M, int N, int G_, int c_) { nM = M / BM; nN = N / BM; nwg = nM * nN; G = G_; c = c_; }
    __host__ __device__ bool next(int i, Unit& u) const {
        const long L = (long)i * G + c; if (L >= nwg) return false;
        int wgid = (int)L; { const int q = nwg / NXCD, r = nwg % NXCD, xcd = wgid % NXCD, off = wgid / NXCD; wgid = (xcd < r ? xcd * (q + 1) : r * (q + 1) + (xcd - r) * q) + off; }
        const int nig = WGM * nN, gid = wgid / nig, fm = gid * WGM, gsz = (nM - fm) < WGM ? (nM - fm) : WGM;
        u.pm = fm + ((wgid % nig) % gsz); u.pn = (wgid % nig) / gsz; return true;
    }
    __device__ __forceinline__ void a_ready(const Unit&) const {}
    __device__ __forceinline__ void done(const Unit&) const {}
};
__device__ __forceinline__ unsigned cvt_pk_bf16(float lo, float hi) { unsigned r; asm volatile("v_cvt_pk_bf16_f32 %0, %1, %2" : "=v"(r) : "v"(lo), "v"(hi)); return r; }
template <class Epi, class Sched, bool STAMP = false>
__device__ __forceinline__ void gemm_phase(PG8_LAS unsigned char* lds, const Gemm g, const Sched& S, const Epi& E, unsigned long long* stamps) {
    int tid = threadIdx.x; asm volatile("" : "+v"(tid)); const int wid = __builtin_amdgcn_readfirstlane(tid >> 6), lane = tid & 63, wr = wid >> 2, wc = wid & 3, fr = lane & 15, fq = lane >> 4;
    const int K = g.K, nt = K / BK;
    int ts_lo = 0, ts_hi = 0, nts = 0; const unsigned long long rt_entry = STAMP ? (unsigned long long)wall_clock64() : 0ull;
#define PG8_STAMP() do { if (STAMP && wid == 0 && nts < 64) { const unsigned long long _c = (unsigned long long)clock64(); \
        ts_lo = (lane == nts) ? (int)(unsigned)_c : ts_lo; ts_hi = (lane == nts) ? (int)(unsigned)(_c >> 32) : ts_hi; ++nts; } } while (0)
    PG8_STAMP();
    unsigned voffA[2], voffB[2];
#pragma unroll
    for (int i = 0; i < 2; ++i) { int R, C; stage_rc(tid * 16 + i * 8192, R, C); const int Rb = Epi::PERM ? ((R & ~31) + perm32(R & 31)) : R;
        voffA[i] = (unsigned)(R * K + C) * 2u; voffB[i] = (unsigned)(Rb * K + C) * 2u; }
    const size_t kstep = (size_t)(BK * 2);
    const size_t hstep = (size_t)HALF * K * 2;
    const size_t tstep = 2 * hstep;
    const unsigned ldsw = (unsigned)wid * 1024u;
    const int aoff = lds_byte(wr * 64 + fr, fq * 8), boff = lds_byte(wc * 32 + fr, fq * 8);
#define PG8_SA(b, h) (((b) * 2 + (h)) * HTB)
#define PG8_SB(b, h) ((4 + (b) * 2 + (h)) * HTB)
#define PG8_STAGE(bufoff, gbase, voff) do { _Pragma("unroll") for (int _i = 0; _i < 2; ++_i) \
        __builtin_amdgcn_global_load_lds((const unsigned*)((const char*)(gbase) + (voff)[_i]), (PG8_LAS unsigned*)(lds + (bufoff) + ldsw + _i * 8192), 16, 0, 0); } while (0)
#define PG8_LDA(dst, b, h) do { _Pragma("unroll") for (int m = 0; m < 4; ++m) _Pragma("unroll") for (int k = 0; k < 2; ++k) dst[m][k] = *(const PG8_LAS bf16x8*)(lds + PG8_SA(b, h) + aoff + m * 2048 + k * 1024); } while (0)
#define PG8_LDB(dst, b, h) do { _Pragma("unroll") for (int n = 0; n < 2; ++n) _Pragma("unroll") for (int k = 0; k < 2; ++k) dst[n][k] = *(const PG8_LAS bf16x8*)(lds + PG8_SB(b, h) + boff + n * 2048 + k * 1024); } while (0)
#define PG8_MMA(ai, bj, At, Bt) do { __builtin_amdgcn_s_setprio(1); _Pragma("unroll") for (int m = 0; m < 4; ++m) _Pragma("unroll") for (int n = 0; n < 2; ++n) _Pragma("unroll") for (int k = 0; k < 2; ++k) \
        acc[ai][bj][m][n] = __builtin_amdgcn_mfma_f32_16x16x32_bf16(Bt[n][k], At[m][k], acc[ai][bj][m][n], 0, 0, 0); __builtin_amdgcn_s_setprio(0); } while (0)
#define PG8_WAIT_V(n) asm volatile("s_waitcnt vmcnt(" #n ")" ::: "memory")
#define PG8_WAIT_L(n) asm volatile("s_waitcnt lgkmcnt(" #n ")" ::: "memory")
#define PG8_BAR __builtin_amdgcn_s_barrier()
#define PG8_SCHED __builtin_amdgcn_sched_barrier(0)
    Unit cur, nxt; int ui = 0;
    if (!S.next(0, cur)) return;
    f32x4 acc[2][2][4][2];
#pragma unroll
    for (int a = 0; a < 2; ++a)
#pragma unroll
        for (int b = 0; b < 2; ++b)
#pragma unroll
            for (int m = 0; m < 4; ++m)
#pragma unroll
                for (int n = 0; n < 2; ++n) acc[a][b][m][n] = (f32x4){0.f, 0.f, 0.f, 0.f};
    bf16x8 At[4][2], B0[2][2], B1[2][2];
    const char* cA = (const char*)g.A + (size_t)cur.pm * tstep; const char* cB = (const char*)g.Bt + (size_t)cur.pn * tstep;
    S.a_ready(cur);
    PG8_STAGE(PG8_SB(0, 0), cB, voffB); PG8_STAGE(PG8_SA(0, 0), cA, voffA); PG8_STAGE(PG8_SB(0, 1), cB + hstep, voffB); PG8_STAGE(PG8_SA(0, 1), cA + hstep, voffA);
    if (wr == 1) PG8_BAR;
    PG8_WAIT_V(4); PG8_BAR;
    PG8_STAGE(PG8_SB(1, 0), cB + kstep, voffB); PG8_STAGE(PG8_SA(1, 0), cA + kstep, voffA); PG8_STAGE(PG8_SB(1, 1), cB + hstep + kstep, voffB);
    PG8_WAIT_V(6); PG8_BAR;
    PG8_STAMP();
    for (;;) {
        const bool has_next = S.next(ui + 1, nxt);
        const char* nA = has_next ? (const char*)g.A + (size_t)nxt.pm * tstep : cA; const char* nB = has_next ? (const char*)g.Bt + (size_t)nxt.pn * tstep : cB;
        for (int t = 0; t < nt; t += 2) {
            const bool last = (t == nt - 2);
            const char* a1 = cA + (size_t)(t + 1) * kstep;
            const char* a2 = last ? nA : cA + (size_t)(t + 2) * kstep; const char* b2 = last ? nB : cB + (size_t)(t + 2) * kstep;
            const char* a3 = a2 + kstep; const char* b3 = b2 + kstep;
            if (last && has_next) S.a_ready(nxt);
            PG8_LDB(B0, 0, 0); PG8_SCHED; PG8_LDA(At, 0, 0); PG8_STAGE(PG8_SA(1, 1), a1 + hstep, voffA);
            PG8_WAIT_L(8); PG8_BAR; PG8_WAIT_L(0); PG8_MMA(0, 0, At, B0); PG8_BAR; PG8_SCHED;
            PG8_LDB(B1, 0, 1); PG8_STAGE(PG8_SB(0, 0), b2, voffB);
            PG8_BAR; PG8_WAIT_L(0); PG8_MMA(0, 1, At, B1); PG8_BAR;
            PG8_LDA(At, 0, 1); PG8_STAGE(PG8_SA(0, 0), a2, voffA);
            PG8_BAR; PG8_WAIT_L(0); PG8_MMA(1, 0, At, B0); PG8_BAR; PG8_SCHED;
            PG8_STAGE(PG8_SB(0, 1), b2 + hstep, voffB);
            PG8_WAIT_V(6); PG8_BAR; PG8_MMA(1, 1, At, B1); PG8_BAR;
            PG8_LDB(B0, 1, 0); PG8_SCHED; PG8_LDA(At, 1, 0); PG8_STAGE(PG8_SA(0, 1), a2 + hstep, voffA);
            PG8_WAIT_L(8); PG8_BAR; PG8_WAIT_L(0); PG8_MMA(0, 0, At, B0); PG8_BAR; PG8_SCHED;
            PG8_LDB(B1, 1, 1); PG8_STAGE(PG8_SB(1, 0), b3, voffB);
            PG8_BAR; PG8_WAIT_L(0); PG8_MMA(0, 1, At, B1); PG8_BAR;
            PG8_LDA(At, 1, 1); PG8_STAGE(PG8_SA(1, 0), a3, voffA);
            PG8_BAR; PG8_WAIT_L(0); PG8_MMA(1, 0, At, B0); PG8_BAR; PG8_SCHED;
            PG8_STAGE(PG8_SB(1, 1), b3 + hstep, voffB);
            PG8_WAIT_V(6); PG8_BAR; PG8_MMA(1, 1, At, B1); PG8_BAR;
        }
        PG8_STAMP();
        if constexpr (!Epi::AFTER_DRAIN) { E(acc, cur, wr, wc, fr, fq); S.done(cur); }
        PG8_STAMP();
        if (!has_next) break;
#pragma unroll
        for (int a = 0; a < 2; ++a)
#pragma unroll
            for (int b = 0; b < 2; ++b)
#pragma unroll
                for (int m = 0; m < 4; ++m)
#pragma unroll
                    for (int n = 0; n < 2; ++n) acc[a][b][m][n] = (f32x4){0.f, 0.f, 0.f, 0.f};
        cur = nxt; cA = nA; cB = nB; ++ui;
    }
    PG8_WAIT_V(0);
    if (wr == 0) PG8_BAR;
    PG8_BAR;
    if constexpr (Epi::AFTER_DRAIN) { E.fused(acc, cur, wr, wc, fr, fq, lds, wid, lane); S.done(cur); }
    PG8_STAMP();
    if (STAMP && wid == 0) { stamps[lane] = lane < nts ? (((unsigned long long)(unsigned)ts_hi << 32) | (unsigned)ts_lo) : 0ull;
        if (lane == 62) stamps[62] = rt_entry; if (lane == 63) stamps[63] = (unsigned long long)wall_clock64(); }
#undef PG8_STAMP
#undef PG8_SA
#undef PG8_SB
#undef PG8_STAGE
#undef PG8_LDA
#undef PG8_LDB
#undef PG8_MMA
#undef PG8_WAIT_V
#undef PG8_WAIT_L
#undef PG8_BAR
#undef PG8_SCHED
}
}
using namespace pg8;
#define LAS PG8_LAS
typedef unsigned short u16;
typedef unsigned u32x2 __attribute__((ext_vector_type(2)));
typedef float f32x2 __attribute__((ext_vector_type(2)));

constexpr int NBATCH = 8, SEQ = 2048, DM = 2048, MTOK = NBATCH * SEQ, DIN = 7824, NP = 7936;
constexpr int C_R = 0, C_K = 1024, C_V = 2048, C_WD = 3072, C_GA = 3200, C_QB = 4224, C_KB = 4736, C_VB = 5248, C_GB = 5760,
              C_QC = 6272, C_KC = 6528, C_VC = 6784, C_GC = 7296, C_LOW = 7808;
constexpr int LDS_BYTES = 148480;

struct Params {
    const float *x, *norm_w, *w_in, *w_out, *mu, *w0, *w2, *a0, *a2, *k_k, *k_a, *r_k, *ln_w, *ln_b, *a_up, *a_b, *gnw, *fnw;
    float* out;
    u16 *WtIn, *WtOut, *W2t, *A2t, *H, *P;
    float *yraw, *ybonus, *kmean, *gst, *gdec;
    unsigned* bar;
    int phase_lo, phase_hi;
};

__device__ __forceinline__ int tid_() { int t = threadIdx.x; asm volatile("" : "+v"(t)); return t; }
__device__ __forceinline__ float bf2f(u16 v) { return __uint_as_float(((unsigned)v) << 16); }
__device__ __forceinline__ float bflo(unsigned w) { return __uint_as_float(w << 16); }
__device__ __forceinline__ float bfhi(unsigned w) { return __uint_as_float(w & 0xffff0000u); }
__device__ __forceinline__ u16 f2bf(float f) { return (u16)(cvt_pk_bf16(f, 0.f) & 0xffffu); }
template <int CTRL> __device__ __forceinline__ float dpp_f(float v) { return __int_as_float(__builtin_amdgcn_update_dpp(0, __float_as_int(v), CTRL, 0xF, 0xF, true)); }
__device__ __forceinline__ float red16_sum(float v) { v += dpp_f<0xB1>(v); v += dpp_f<0x4E>(v); v += dpp_f<0x141>(v); v += dpp_f<0x140>(v); return v; }
__device__ __forceinline__ float red8_sum(float v) { v += dpp_f<0xB1>(v); v += dpp_f<0x4E>(v); v += dpp_f<0x141>(v); return v; }
__device__ __forceinline__ float red16_max(float v) { v = fmaxf(v, dpp_f<0xB1>(v)); v = fmaxf(v, dpp_f<0x4E>(v)); v = fmaxf(v, dpp_f<0x141>(v)); v = fmaxf(v, dpp_f<0x140>(v)); return v; }
__device__ __forceinline__ float wave_sum(float v) {
#pragma unroll
    for (int o = 1; o < 64; o <<= 1) v += __shfl_xor(v, o);
    return v;
}
__device__ __forceinline__ float sigmoidf_(float x) { return 1.f / (1.f + __expf(-x)); }
__device__ __forceinline__ float siluf_(float x) { return x / (1.f + __expf(-x)); }
__device__ __forceinline__ float logsigmoidf_(float z) { return fminf(z, 0.f) - log1pf(__expf(-fabsf(z))); }
__device__ __forceinline__ f32x4 mfma16(bf16x8 a, bf16x8 b, f32x4 c) { return __builtin_amdgcn_mfma_f32_16x16x32_bf16(a, b, c, 0, 0, 0); }

struct EpiP {
    static constexpr bool PERM = true, AFTER_DRAIN = false;
    bf16_t* O; int ldc;
    __device__ __forceinline__ void operator()(const f32x4 (&acc)[2][2][4][2], const Unit& u, int wr, int wc, int fr, int fq) const {
        const int row0 = u.pm * BM + wr * 64 + fr, col0 = u.pn * BM + wc * 32 + 8 * fq;
#pragma unroll
        for (int ai = 0; ai < 2; ++ai)
#pragma unroll
            for (int m = 0; m < 4; ++m) { bf16_t* rowp = O + (size_t)(row0 + ai * HALF + m * 16) * ldc + col0;
#pragma unroll
                for (int bj = 0; bj < 2; ++bj) { const f32x4 v0 = acc[ai][bj][m][0], v1 = acc[ai][bj][m][1];
                    u32x4 w; w.x = cvt_pk_bf16(v0[0], v0[1]); w.y = cvt_pk_bf16(v0[2], v0[3]); w.z = cvt_pk_bf16(v1[0], v1[1]); w.w = cvt_pk_bf16(v1[2], v1[3]);
                    *(u32x4*)(rowp + bj * HALF) = w; } }
    }
};
struct EpiRes {
    static constexpr bool PERM = false, AFTER_DRAIN = false;
    const float* R; float* C; int ldc;
    __device__ __forceinline__ void operator()(const f32x4 (&acc)[2][2][4][2], const Unit& u, int wr, int wc, int fr, int fq) const {
        const int row0 = u.pm * BM + wr * 64 + fr, col0 = u.pn * BM + wc * 32 + 4 * fq;
#pragma unroll
        for (int ai = 0; ai < 2; ++ai)
#pragma unroll
            for (int m = 0; m < 4; ++m) { const size_t off = (size_t)(row0 + ai * HALF + m * 16) * ldc + col0;
#pragma unroll
                for (int bj = 0; bj < 2; ++bj)
#pragma unroll
                    for (int n = 0; n < 2; ++n) { const f32x4 r = *(const f32x4*)(R + off + bj * HALF + n * 16); *(f32x4*)(C + off + bj * HALF + n * 16) = acc[ai][bj][m][n] + r; }
                asm volatile("" ::: "memory"); }
    }
};

__device__ void transpose_cvt(LAS unsigned char* lds, const float* src, u16* dst, int K, int N, int Npad, int bid, int nb) {
    LAS float* tile = (LAS float*)lds;
    const int tilesN = Npad / 64, tilesK = K / 64, tid = tid_();
    for (int t = bid; t < tilesN * tilesK; t += nb) {
        const int tn = t % tilesN, tk = t / tilesN, n0 = tn * 64, k0 = tk * 64;
#pragma unroll
        for (int i = 0; i < 2; ++i) { const int idx = tid + i * 512, kk = idx >> 4, n4 = (idx & 15) * 4;
            float4 v = make_float4(0.f, 0.f, 0.f, 0.f);
            if (n0 + n4 < N) v = *(const float4*)(src + (size_t)(k0 + kk) * N + n0 + n4);
            tile[(n4 + 0) * 65 + kk] = v.x; tile[(n4 + 1) * 65 + kk] = v.y; tile[(n4 + 2) * 65 + kk] = v.z; tile[(n4 + 3) * 65 + kk] = v.w; }
        __syncthreads();
        { const int n = tid >> 3, k8 = (tid & 7) * 8; const LAS float* r = tile + n * 65 + k8;
            u32x4 o; o.x = cvt_pk_bf16(r[0], r[1]); o.y = cvt_pk_bf16(r[2], r[3]); o.z = cvt_pk_bf16(r[4], r[5]); o.w = cvt_pk_bf16(r[6], r[7]);
            *(u32x4*)(dst + (size_t)(n0 + n) * K + k0 + k8) = o; }
        __syncthreads();
    }
}

__device__ void rmsnorm_phase(const float* x, const float* w, u16* hb, float* of, int bid, int nb) {
    const int tid0 = tid_(), wid = tid0 >> 6, lane = tid0 & 63;
    for (int row = bid * 8 + wid; row < MTOK; row += nb * 8) {
        const float4* xr = (const float4*)(x + (size_t)row * DM);
        float4 v[8]; float s = 0.f;
#pragma unroll
        for (int i = 0; i < 8; ++i) { v[i] = xr[i * 64 + lane]; s += v[i].x * v[i].x + v[i].y * v[i].y + v[i].z * v[i].z + v[i].w * v[i].w; }
        s = wave_sum(s);
        const float rs = rsqrtf(s * (1.f / DM) + 1e-6f);
#pragma unroll
        for (int i = 0; i < 8; ++i) { const float4 wv = ((const float4*)w)[i * 64 + lane];
            const float a = v[i].x * rs * wv.x, b = v[i].y * rs * wv.y, c = v[i].z * rs * wv.z, d = v[i].w * rs * wv.w;
            if (hb) { uint2 o; o.x = cvt_pk_bf16(a, b); o.y = cvt_pk_bf16(c, d); *(uint2*)(hb + (size_t)row * DM + (i * 64 + lane) * 4) = o; }
            else { ((float4*)(of + (size_t)row * DM))[i * 64 + lane] = make_float4(a, b, c, d); } }
    }
}

__device__ void kmean_phase(const Params& p, LAS unsigned char* lds, int bid, int nb) {
    LAS float* part = (LAS float*)lds;
    const int tid = tid_();
    for (int task = bid; task < 256; task += nb) {
        const int b = task >> 5, h = (task >> 3) & 3, blk = task & 7;
        const int d8 = (tid & 15) * 8, kg = tid >> 4;
        float s[8];
#pragma unroll
        for (int e = 0; e < 8; ++e) s[e] = 0.f;
        for (int kk = 0; kk < 8; ++kk) {
            const int tok = b * SEQ + blk * 256 + kg * 8 + kk;
            const uint4 v = *(const uint4*)(p.P + (size_t)tok * NP + C_KB + h * 128 + d8);
            s[0] += bflo(v.x); s[1] += bfhi(v.x); s[2] += bflo(v.y); s[3] += bfhi(v.y); s[4] += bflo(v.z); s[5] += bfhi(v.z); s[6] += bflo(v.w); s[7] += bfhi(v.w);
        }
        __syncthreads();
#pragma unroll
        for (int e = 0; e < 8; ++e) part[kg * 128 + d8 + e] = s[e];
        __syncthreads();
        if (tid < 128) { float a = 0.f; for (int g = 0; g < 32; ++g) a += part[g * 128 + tid]; p.kmean[(size_t)task * 128 + tid] = a * (1.f / 256.f); }
    }
    __syncthreads();
}

constexpr int RW_T = 32;
constexpr int RW_XB = 49152;
constexpr int RW_RAW = 98304, RW_A1 = 119808, RW_A2 = 124416, RW_KS = 129024, RW_AS = 137216, RW_MU = 145408, RW_PAR = 146688, RW_FLG = 147968;
__device__ __forceinline__ void rw_issue(const Params& p, int pt, int b, int h, int t0, u32x4 (&rg)[6]) {
#pragma unroll
    for (int i = 0; i < 6; ++i) { const int piece = pt + 256 * i; rg[i] = (u32x4){0u, 0u, 0u, 0u};
        if (piece < 33 * 40) { const int row = piece / 40, pc = piece % 40; const int t = t0 - 1 + row;
            const int col = pc < 8 ? C_R + h * 64 + pc * 8 : pc < 16 ? C_K + h * 64 + (pc - 8) * 8 : pc < 24 ? C_V + h * 64 + (pc - 16) * 8 : C_WD + (pc - 24) * 8;
            if (t >= 0) rg[i] = *(const u32x4*)(p.P + (size_t)(b * SEQ + t) * NP + col); } }
}
__device__ __forceinline__ void prep_bar(volatile LAS unsigned* flg, int pw, int lane, unsigned& ep) {
    ++ep;
    asm volatile("s_waitcnt lgkmcnt(0)" ::: "memory");
    if (lane == 0) flg[pw] = ep;
    for (;;) { const unsigned f0 = flg[0], f1 = flg[1], f2 = flg[2], f3 = flg[3]; if (f0 >= ep && f1 >= ep && f2 >= ep && f3 >= ep) break; __builtin_amdgcn_s_sleep(1); }
    asm volatile("s_waitcnt lgkmcnt(0)" ::: "memory");
}
__device__ __forceinline__ float red4_sum(float v) { v += dpp_f<0xB1>(v); v += dpp_f<0x4E>(v); return v; }
__device__ void rwkv_scan_task(const Params& p, int l, LAS unsigned char* lds, int task) {
    const int tid = tid_(), wid = tid >> 6, lane = tid & 63;
    LAS u16* raw = (LAS u16*)(lds + RW_RAW); LAS u16* A1 = (LAS u16*)(lds + RW_A1); LAS u16* A2 = (LAS u16*)(lds + RW_A2);
    LAS float* kS = (LAS float*)(lds + RW_KS); LAS float* aS = (LAS float*)(lds + RW_AS);
    LAS float* muS = (LAS float*)(lds + RW_MU); LAS float* parS = (LAS float*)(lds + RW_PAR);
    volatile LAS unsigned* flg = (volatile LAS unsigned*)(lds + RW_FLG);
    {
        const int b = task >> 4, h = task & 15;
        __syncthreads();
        if (tid >= 256 && tid < 260) flg[tid - 256] = 0u;
        __syncthreads();
        if (wid < 4) {
            const int rp = wid * 8 + (lane >> 3), ssub = lane & 7;
            f32x2 SA[4], SB[4];
#pragma unroll
            for (int q = 0; q < 4; ++q) { SA[q] = (f32x2){0.f, 0.f}; SB[q] = (f32x2){0.f, 0.f}; }
            float* yout = p.yraw + (size_t)(b * SEQ + ssub) * 1024 + h * 64 + 2 * rp;
            for (int c = 0; c < SEQ / RW_T; ++c) {
                __syncthreads();
                const LAS float* ob = (const LAS float*)(lds + (c & 1) * RW_XB) + ssub * 8;
                const LAS float* ov = (const LAS float*)(lds + (c & 1) * RW_XB + 40960) + 2 * rp;
                f32x4 nw0 = *(const LAS f32x4*)(ob), nw1 = *(const LAS f32x4*)(ob + 4), na0 = *(const LAS f32x4*)(ob + 2048), na1 = *(const LAS f32x4*)(ob + 2052);
                f32x4 nb0 = *(const LAS f32x4*)(ob + 4096), nb1 = *(const LAS f32x4*)(ob + 4100), nk0 = *(const LAS f32x4*)(ob + 6144), nk1 = *(const LAS f32x4*)(ob + 6148);
                f32x4 nr0 = *(const LAS f32x4*)(ob + 8192), nr1 = *(const LAS f32x4*)(ob + 8196);
                f32x2 nv = *(const LAS f32x2*)(ov);
                float ykA = 0.f, ykB = 0.f;
#pragma unroll
                for (int t = 0; t < RW_T; ++t) {
                    const f32x4 w0 = nw0, w1 = nw1, a0 = na0, a1 = na1, b0 = nb0, b1 = nb1, k0 = nk0, k1 = nk1, r0 = nr0, r1 = nr1; const f32x2 vv = nv;
                    if (t + 1 < RW_T) { const LAS float* o2 = ob + (t + 1) * 64;
                        nw0 = *(const LAS f32x4*)(o2); nw1 = *(const LAS f32x4*)(o2 + 4); na0 = *(const LAS f32x4*)(o2 + 2048); na1 = *(const LAS f32x4*)(o2 + 2052);
                        nb0 = *(const LAS f32x4*)(o2 + 4096); nb1 = *(const LAS f32x4*)(o2 + 4100); nk0 = *(const LAS f32x4*)(o2 + 6144); nk1 = *(const LAS f32x4*)(o2 + 6148);
                        nr0 = *(const LAS f32x4*)(o2 + 8192); nr1 = *(const LAS f32x4*)(o2 + 8196);
                        nv = *(const LAS f32x2*)(ov + (t + 1) * 64); }
                    const f32x2 sA2 = (SA[0] * a0.lo + SA[1] * a0.hi) + (SA[2] * a1.lo + SA[3] * a1.hi);
                    const f32x2 sB2 = (SB[0] * a0.lo + SB[1] * a0.hi) + (SB[2] * a1.lo + SB[3] * a1.hi);
                    const float saA = red8_sum(sA2.x + sA2.y), saB = red8_sum(sB2.x + sB2.y);
                    const f32x2 svA = {saA, saA}, svB = {saB, saB}, vA = {vv.x, vv.x}, vB = {vv.y, vv.y};
                    SA[0] = SA[0] * w0.lo + svA * b0.lo + vA * k0.lo; SA[1] = SA[1] * w0.hi + svA * b0.hi + vA * k0.hi;
                    SA[2] = SA[2] * w1.lo + svA * b1.lo + vA * k1.lo; SA[3] = SA[3] * w1.hi + svA * b1.hi + vA * k1.hi;
                    SB[0] = SB[0] * w0.lo + svB * b0.lo + vB * k0.lo; SB[1] = SB[1] * w0.hi + svB * b0.hi + vB * k0.hi;
                    SB[2] = SB[2] * w1.lo + svB * b1.lo + vB * k1.lo; SB[3] = SB[3] * w1.hi + svB * b1.hi + vB * k1.hi;
                    const f32x2 yA2 = (SA[0] * r0.lo + SA[1] * r0.hi) + (SA[2] * r1.lo + SA[3] * r1.hi);
                    const f32x2 yB2 = (SB[0] * r0.lo + SB[1] * r0.hi) + (SB[2] * r1.lo + SB[3] * r1.hi);
                    const float yA = red8_sum(yA2.x + yA2.y), yB = red8_sum(yB2.x + yB2.y);
                    ykA = (ssub == (t & 7)) ? yA : ykA; ykB = (ssub == (t & 7)) ? yB : ykB;
                    if ((t & 7) == 7) { f32x2 o = {ykA, ykB}; *(f32x2*)(yout + (size_t)(c * RW_T + (t & ~7)) * 1024) = o; }
                }
            }
        } else {
            const int pt = tid - 256, pw = wid - 4;
            unsigned ep = 0u;
            for (int c2 = pt; c2 < 320; c2 += 256) { const int mi = c2 < 64 ? h * 64 + c2 : c2 < 128 ? 1024 + h * 64 + (c2 - 64) : c2 < 192 ? 2048 + h * 64 + (c2 - 128) : 3072 + (c2 - 192);
                muS[c2] = p.mu[(size_t)l * 3200 + mi]; }
            if (pt < 64) { const size_t o = (size_t)l * 1024 + h * 64 + pt;
                parS[pt] = p.w0[o]; parS[64 + pt] = p.a0[o]; parS[128 + pt] = p.k_k[o]; parS[192 + pt] = p.k_a[o]; parS[256 + pt] = p.r_k[o]; }
            const int mat = pw >> 1, ct0 = (pw & 1) * 2;
            bf16x8 bfr[2][2];
#pragma unroll
            for (int ci = 0; ci < 2; ++ci) { const u16* Bt = (mat ? p.A2t : p.W2t) + (size_t)l * 1024 * 64 + (size_t)(h * 64 + (ct0 + ci) * 16 + (lane & 15)) * 64 + (lane >> 4) * 8;
                bfr[ci][0] = *(const bf16x8*)(Bt); bfr[ci][1] = *(const bf16x8*)(Bt + 32); }
            u32x4 rg[6];
            rw_issue(p, pt, b, h, 0, rg);
            for (int c = 0; c < SEQ / RW_T; ++c) {
                const int t0 = c * RW_T;
                LAS float* opW = (LAS float*)(lds + (c & 1) * RW_XB); LAS float* opA = opW + 2048; LAS float* opB = opW + 4096; LAS float* opK = opW + 6144; LAS float* opR = opW + 8192; LAS float* opV = opW + 10240;
#pragma unroll
                for (int i = 0; i < 6; ++i) { const int piece = pt + 256 * i; if (piece < 33 * 40) *(LAS u32x4*)(raw + (piece / 40) * 320 + (piece % 40) * 8) = rg[i]; }
                prep_bar(flg, pw, lane, ep);
                if (c + 1 < SEQ / RW_T) rw_issue(p, pt, b, h, t0 + RW_T, rg);
#pragma unroll
                for (int reg = 0; reg < 5; ++reg)
#pragma unroll
                    for (int i = 0; i < 4; ++i) { const int e = pt + 256 * i, t = e >> 5, pr = e & 31, cc = reg * 64 + 2 * pr;
                        const unsigned cu = *(const LAS unsigned*)(raw + (t + 1) * 320 + cc), pu = *(const LAS unsigned*)(raw + t * 320 + cc);
                        const f32x2 mu2 = *(const LAS f32x2*)(muS + cc);
                        const f32x2 cur = {bflo(cu), bfhi(cu)}, prv = {bflo(pu), bfhi(pu)};
                        const f32x2 xs = cur + mu2 * (prv - cur);
                        if (reg == 0) *(LAS f32x2*)(opR + t * 64 + 2 * pr) = xs;
                        else if (reg == 1) *(LAS f32x2*)(kS + t * 64 + 2 * pr) = xs;
                        else if (reg == 2) *(LAS f32x2*)(opV + t * 64 + 2 * pr) = xs;
                        else if (reg == 3) { const float e0 = __expf(2.f * xs.x), e1 = __expf(2.f * xs.y);
                            *(LAS unsigned*)(A1 + t * 72 + 2 * pr) = cvt_pk_bf16(1.f - 2.f * __builtin_amdgcn_rcpf(e0 + 1.f), 1.f - 2.f * __builtin_amdgcn_rcpf(e1 + 1.f)); }
                        else *(LAS unsigned*)(A2 + t * 72 + 2 * pr) = cvt_pk_bf16(xs.x, xs.y); }
                prep_bar(flg, pw, lane, ep);
                { LAS u16* Ab = mat ? A2 : A1;
#pragma unroll
                    for (int ci = 0; ci < 2; ++ci)
#pragma unroll
                        for (int rt = 0; rt < 2; ++rt) { f32x4 acc = {0.f, 0.f, 0.f, 0.f};
#pragma unroll
                            for (int ks = 0; ks < 2; ++ks) { const bf16x8 af = *(const LAS bf16x8*)(Ab + (rt * 16 + (lane & 15)) * 72 + ks * 32 + (lane >> 4) * 8); acc = mfma16(af, bfr[ci][ks], acc); }
                            const int cc = (ct0 + ci) * 16 + (lane & 15);
#pragma unroll
                            for (int i = 0; i < 4; ++i) { const int t = rt * 16 + (lane >> 4) * 4 + i;
                                if (mat == 0) { float wv = parS[cc] + acc[i]; wv = fminf(wv, 0.f) - __logf(1.f + __expf(-fabsf(wv))) - 0.5f; opW[t * 64 + cc] = __expf(-__expf(wv)); }
                                else aS[t * 64 + cc] = __builtin_amdgcn_rcpf(1.f + __expf(-(parS[64 + cc] + acc[i]))); } } }
                prep_bar(flg, pw, lane, ep);
#pragma unroll
                for (int j = 0; j < 2; ++j) { const int item = pt + 256 * j, t = item >> 4, sub = item & 15, c4 = sub * 4;
                    const f32x4 kr = *(const LAS f32x4*)(kS + t * 64 + c4), av = *(const LAS f32x4*)(aS + t * 64 + c4), rr = *(const LAS f32x4*)(opR + t * 64 + c4);
                    const f32x4 kkp = *(const LAS f32x4*)(parS + 128 + c4), kap = *(const LAS f32x4*)(parS + 192 + c4), rkp = *(const LAS f32x4*)(parS + 256 + c4);
                    f32x4 kk = kr * kkp;
                    float ss = kk.x * kk.x + kk.y * kk.y + kk.z * kk.z + kk.w * kk.w; ss = red16_sum(ss);
                    const float inv = rsqrtf(fmaxf(ss, 1e-24f));
                    kk.x *= inv; kk.y *= inv; kk.z *= inv; kk.w *= inv;
                    const f32x4 km = kr * (1.f + (av - 1.f) * kap);
                    *(LAS f32x4*)(opA + t * 64 + c4) = -kk;
                    *(LAS f32x4*)(opB + t * 64 + c4) = kk * av;
                    *(LAS f32x4*)(opK + t * 64 + c4) = km;
                    float bo = rr.x * km.x * rkp.x + rr.y * km.y * rkp.y + rr.z * km.z * rkp.z + rr.w * km.w * rkp.w; bo = red16_sum(bo);
                    if (sub == 0) p.ybonus[(size_t)(b * SEQ + t0 + t) * 16 + h] = bo; }
                __syncthreads();
            }
        }
    }
    __syncthreads();
}

__device__ void rwkv_post_item(const Params& p, int l, int item) {
    const int tid = tid_(), pair = item * 32 + (tid >> 4), tok = pair >> 4, h = pair & 15, c4 = (tid & 15) * 4;
    const float4 y = *(const float4*)(p.yraw + (size_t)tok * 1024 + h * 64 + c4);
    const float mean = red16_sum(y.x + y.y + y.z + y.w) * (1.f / 64.f);
    const float d0 = y.x - mean, d1 = y.y - mean, d2 = y.z - mean, d3 = y.w - mean;
    const float var = red16_sum(d0 * d0 + d1 * d1 + d2 * d2 + d3 * d3) * (1.f / 64.f);
    const float rs = rsqrtf(var + 64e-5f);
    const size_t po = (size_t)l * 1024 + h * 64 + c4;
    const float4 lw = *(const float4*)(p.ln_w + po), lb = *(const float4*)(p.ln_b + po), muv = *(const float4*)(p.mu + (size_t)l * 3200 + 2048 + h * 64 + c4);
    const uint2 vc = *(const uint2*)(p.P + (size_t)tok * NP + C_V + h * 64 + c4);
    uint2 vp = make_uint2(0u, 0u);
    if ((tok & (SEQ - 1)) != 0) vp = *(const uint2*)(p.P + (size_t)(tok - 1) * NP + C_V + h * 64 + c4);
    const uint2 gg = *(const uint2*)(p.P + (size_t)tok * NP + C_GA + h * 64 + c4);
    const float bo = p.ybonus[(size_t)tok * 16 + h];
    float v0 = bflo(vc.x), v1 = bfhi(vc.x), v2 = bflo(vc.y), v3 = bfhi(vc.y);
    v0 += muv.x * (bflo(vp.x) - v0); v1 += muv.y * (bfhi(vp.x) - v1); v2 += muv.z * (bflo(vp.y) - v2); v3 += muv.w * (bfhi(vp.y) - v3);
    const float o0 = (d0 * rs * lw.x + lb.x + bo * v0) * siluf_(bflo(gg.x)), o1 = (d1 * rs * lw.y + lb.y + bo * v1) * siluf_(bfhi(gg.x));
    const float o2 = (d2 * rs * lw.z + lb.z + bo * v2) * siluf_(bflo(gg.y)), o3 = (d3 * rs * lw.w + lb.w + bo * v3) * siluf_(bfhi(gg.y));
    uint2 o; o.x = cvt_pk_bf16(o0, o1); o.y = cvt_pk_bf16(o2, o3);
    *(uint2*)(p.H + (size_t)tok * DM + h * 64 + c4) = o;
}

__device__ void rwkv_post_task(const Params& p, int l, int task) {
    const int tid = tid_(), h = (tid >> 4) & 15, c4 = (tid & 15) * 4;
    const size_t po = (size_t)l * 1024 + h * 64 + c4;
    const f32x4 lw = *(const f32x4*)(p.ln_w + po), lb = *(const f32x4*)(p.ln_b + po), muv = *(const f32x4*)(p.mu + (size_t)l * 3200 + 2048 + h * 64 + c4);
#pragma unroll 1
    for (int bt = 0; bt < 4; ++bt) {
        f32x4 y[4]; u32x2 vc[4], vp[4], gg[4]; float bo[4];
#pragma unroll
        for (int q = 0; q < 4; ++q) { const int tok = (task * 16 + bt * 4 + q) * 2 + (tid >> 8);
            y[q] = *(const f32x4*)(p.yraw + (size_t)tok * 1024 + h * 64 + c4);
            vc[q] = *(const u32x2*)(p.P + (size_t)tok * NP + C_V + h * 64 + c4);
            vp[q] = (u32x2){0u, 0u};
            if ((tok & (SEQ - 1)) != 0) vp[q] = *(const u32x2*)(p.P + (size_t)(tok - 1) * NP + C_V + h * 64 + c4);
            gg[q] = *(const u32x2*)(p.P + (size_t)tok * NP + C_GA + h * 64 + c4);
            bo[q] = p.ybonus[(size_t)tok * 16 + h]; }
#pragma unroll
        for (int q = 0; q < 4; ++q) { const int tok = (task * 16 + bt * 4 + q) * 2 + (tid >> 8);
            const float mean = red16_sum(y[q].x + y[q].y + y[q].z + y[q].w) * (1.f / 64.f);
            const f32x4 d = y[q] - mean;
            const float var = red16_sum(d.x * d.x + d.y * d.y + d.z * d.z + d.w * d.w) * (1.f / 64.f);
            const float rs = rsqrtf(var + 64e-5f);
            f32x4 v = {bflo(vc[q].x), bfhi(vc[q].x), bflo(vc[q].y), bfhi(vc[q].y)};
            const f32x4 pv = {bflo(vp[q].x), bfhi(vp[q].x), bflo(vp[q].y), bfhi(vp[q].y)};
            v += muv * (pv - v);
            const f32x4 r = d * rs * lw + lb + bo[q] * v;
            u32x2 o; o.x = cvt_pk_bf16(r.x * siluf_(bflo(gg[q].x)), r.y * siluf_(bfhi(gg[q].x))); o.y = cvt_pk_bf16(r.z * siluf_(bflo(gg[q].y)), r.w * siluf_(bfhi(gg[q].y)));
            *(u32x2*)(p.H + (size_t)tok * DM + h * 64 + c4) = o; }
    }
}

constexpr int MB_K = 0, MB_VT = 17408, MB_PW = 35840, MB_KM = 54272, MB_SEL = 57856, MB_TM = 58368;
__device__ void moba_task(const Params& p, LAS unsigned char* lds, int task) {
    const int tid = tid_(), wid = tid >> 6, lane = tid & 63, l15 = lane & 15, lq = lane >> 4;
    const int qt = 15 - (task >> 5), bh = task & 31, b = bh >> 2, h = bh & 3, qblk = qt >> 1, q0 = qt * 128;
    LAS u16* Kt = (LAS u16*)(lds + MB_K); LAS u16* VT = (LAS u16*)(lds + MB_VT); LAS u16* Pw = (LAS u16*)(lds + MB_PW) + wid * 16 * 72;
    LAS float* kmS = (LAS float*)(lds + MB_KM); LAS int* selS = (LAS int*)(lds + MB_SEL); LAS int* tmS = (LAS int*)(lds + MB_TM);
    __syncthreads();
    for (int i = tid; i < qblk * 128; i += 512) kmS[i] = p.kmean[(size_t)(bh * 8) * 128 + i];
    if (tid == 0) *tmS = 0;
    __syncthreads();
    if (tid < 128) {
        const u16* qp = p.P + (size_t)(b * SEQ + q0 + tid) * NP + C_QB + h * 128;
        float g[7];
#pragma unroll
        for (int j = 0; j < 7; ++j) g[j] = 0.f;
        for (int d8 = 0; d8 < 128; d8 += 8) {
            const uint4 v = *(const uint4*)(qp + d8);
            const float q[8] = {bflo(v.x), bfhi(v.x), bflo(v.y), bfhi(v.y), bflo(v.z), bfhi(v.z), bflo(v.w), bfhi(v.w)};
#pragma unroll
            for (int j = 0; j < 7; ++j) if (j < qblk) {
#pragma unroll
                for (int e = 0; e < 8; ++e) g[j] += q[e] * kmS[j * 128 + d8 + e]; }
        }
        int mask = 0;
#pragma unroll
        for (int r = 0; r < 3; ++r) { float best = -INFINITY; int bi = -1;
#pragma unroll
            for (int j = 0; j < 7; ++j) if (j < qblk && !((mask >> j) & 1) && g[j] > best) { best = g[j]; bi = j; }
            if (bi >= 0) mask |= 1 << bi; }
        mask |= 1 << qblk;
        selS[tid] = mask; atomicOr((int*)tmS, mask);
    }
    __syncthreads();
    const int tmask = *tmS;
    bf16x8 qf[4];
    { const u16* qp = p.P + (size_t)(b * SEQ + q0 + wid * 16 + l15) * NP + C_QB + h * 128 + lq * 8;
#pragma unroll
        for (int ks = 0; ks < 4; ++ks) qf[ks] = *(const bf16x8*)(qp + ks * 32); }
    int rm[4]; int wmask = 0;
#pragma unroll
    for (int i = 0; i < 4; ++i) rm[i] = selS[wid * 16 + lq * 4 + i];
    for (int i = 0; i < 16; ++i) wmask |= selS[wid * 16 + i];
    float m[4], ls[4]; f32x4 O[8];
#pragma unroll
    for (int i = 0; i < 4; ++i) { m[i] = -1e30f; ls[i] = 0.f; }
#pragma unroll
    for (int dt = 0; dt < 8; ++dt) O[dt] = (f32x4){0.f, 0.f, 0.f, 0.f};
    const float sc2 = 0.08838834764831845f * 1.4426950408889634f;
    const int last = (q0 + 127) >> 6;
    const int kp = lane & 31, vd8 = (wid * 2 + (lane >> 5)) * 8;
    struct Stage { u32x4 k0, k1, v0, v1; };
    auto issue = [&](Stage& R, int tt) {
        const size_t kb_ = (size_t)(b * SEQ + tt * 64);
        R.k0 = *(const u32x4*)(p.P + (kb_ + (tid >> 4)) * NP + C_KB + h * 128 + (tid & 15) * 8); R.k1 = *(const u32x4*)(p.P + (kb_ + 32 + (tid >> 4)) * NP + C_KB + h * 128 + (tid & 15) * 8);
        R.v0 = *(const u32x4*)(p.P + (kb_ + 2 * kp) * NP + C_VB + h * 128 + vd8); R.v1 = *(const u32x4*)(p.P + (kb_ + 2 * kp + 1) * NP + C_VB + h * 128 + vd8); };
    auto nextv = [&](int t) { ++t; while (t <= last && !((tmask >> (t >> 2)) & 1)) ++t; return t; };
    auto stage = [&](const Stage& R) {
        { const int ka = tid >> 4, kb2 = 32 + (tid >> 4);
          *(LAS u32x4*)(Kt + ((ka & 3) * 16 + (ka >> 2)) * 136 + (tid & 15) * 8) = R.k0; *(LAS u32x4*)(Kt + ((kb2 & 3) * 16 + (kb2 >> 2)) * 136 + (tid & 15) * 8) = R.k1; }
        LAS unsigned* vt = (LAS unsigned*)(VT + vd8 * 72 + 2 * kp);
        vt[0] = (R.v0.x & 0xffffu) | (R.v1.x << 16); vt[36] = (R.v0.x >> 16) | (R.v1.x & 0xffff0000u);
        vt[72] = (R.v0.y & 0xffffu) | (R.v1.y << 16); vt[108] = (R.v0.y >> 16) | (R.v1.y & 0xffff0000u);
        vt[144] = (R.v0.z & 0xffffu) | (R.v1.z << 16); vt[180] = (R.v0.z >> 16) | (R.v1.z & 0xffff0000u);
        vt[216] = (R.v0.w & 0xffffu) | (R.v1.w << 16); vt[252] = (R.v0.w >> 16) | (R.v1.w & 0xffff0000u); };
    auto compute = [&](int ti) {
        const int j = ti >> 2, key0 = ti * 64, qw0 = q0 + wid * 16;
        const bool own = (j == qblk);
        if (((wmask >> j) & 1) && !(own && key0 > qw0 + 15)) {
            f32x4 s[4];
#pragma unroll
            for (int nt = 0; nt < 4; ++nt) { s[nt] = (f32x4){0.f, 0.f, 0.f, 0.f};
#pragma unroll
                for (int ks = 0; ks < 4; ++ks) { const bf16x8 kf = *(const LAS bf16x8*)(Kt + (nt * 16 + l15) * 136 + ks * 32 + lq * 8); s[nt] = mfma16(qf[ks], kf, s[nt]); } }
            const bool diag = own && (key0 + 63 > qw0);
#pragma unroll
            for (int i = 0; i < 4; ++i) {
                const int qpos = qw0 + lq * 4 + i;
                const float bias = (own || ((rm[i] >> j) & 1)) ? 0.f : -3e30f;
                float sv[4];
#pragma unroll
                for (int nt = 0; nt < 4; ++nt) sv[nt] = s[nt][i] * sc2 + bias;
                if (diag) {
#pragma unroll
                    for (int nt = 0; nt < 4; ++nt) sv[nt] = (key0 + l15 * 4 + nt <= qpos) ? sv[nt] : -3e30f; }
                float mx = fmaxf(fmaxf(sv[0], sv[1]), fmaxf(sv[2], sv[3]));
                mx = red16_max(mx);
                const float mnew = fmaxf(m[i], mx), alpha = __builtin_amdgcn_exp2f(m[i] - mnew);
                const float p0 = __builtin_amdgcn_exp2f(sv[0] - mnew), p1 = __builtin_amdgcn_exp2f(sv[1] - mnew), p2 = __builtin_amdgcn_exp2f(sv[2] - mnew), p3 = __builtin_amdgcn_exp2f(sv[3] - mnew);
                u32x2 pw; pw.x = cvt_pk_bf16(p0, p1); pw.y = cvt_pk_bf16(p2, p3);
                *(LAS u32x2*)(Pw + (lq * 4 + i) * 72 + l15 * 4) = pw;
                const float rs = red16_sum((p0 + p1) + (p2 + p3));
                ls[i] = ls[i] * alpha + rs; m[i] = mnew;
#pragma unroll
                for (int dt = 0; dt < 8; ++dt) O[dt][i] *= alpha;
            }
            __builtin_amdgcn_wave_barrier();
            bf16x8 pf[2];
#pragma unroll
            for (int ks = 0; ks < 2; ++ks) pf[ks] = *(const LAS bf16x8*)(Pw + l15 * 72 + ks * 32 + lq * 8);
#pragma unroll
            for (int dt = 0; dt < 8; ++dt)
#pragma unroll
                for (int ks = 0; ks < 2; ++ks) { const bf16x8 vf = *(const LAS bf16x8*)(VT + (dt * 16 + l15) * 72 + ks * 32 + lq * 8); O[dt] = mfma16(pf[ks], vf, O[dt]); }
            __builtin_amdgcn_wave_barrier();
        } };
    Stage R0, R1;
    int ta = 0;
    while (ta <= last && !((tmask >> (ta >> 2)) & 1)) ++ta;
    int tb = nextv(ta);
    if (ta <= last) issue(R0, ta);
    if (tb <= last) issue(R1, tb);
    while (ta <= last) {
        int tc = nextv(tb);
        __syncthreads(); stage(R0); __syncthreads();
        if (tc <= last) issue(R0, tc);
        compute(ta);
        if (tb > last) break;
        int td = nextv(tc);
        __syncthreads(); stage(R1); __syncthreads();
        if (td <= last) issue(R1, td);
        compute(tb);
        ta = tc; tb = td;
    }
#pragma unroll
    for (int i = 0; i < 4; ++i) { const float inv = 1.f / ls[i]; const size_t tok = (size_t)(b * SEQ + q0 + wid * 16 + lq * 4 + i);
#pragma unroll
        for (int dt = 0; dt < 8; ++dt) { const int d = dt * 16 + l15;
            const float g = bf2f(p.P[tok * NP + C_GB + h * 128 + d]);
            p.H[tok * DM + 1024 + h * 128 + d] = f2bf(O[dt][i] * inv * siluf_(g)); } }
}

constexpr int GL_QE = 0, GL_KE = 9216, GL_KDT = 18432, GL_VT = 27648, GL_ATT = 46080, GL_ST = 55296, GL_LA = 73728, GL_TOT = 90112,
              GL_AUP = 92160, GL_LOW = 96256, GL_DEC = 100352, GL_ABS = 100608, GL_GNW = 100864, GL_OB = 0;
__device__ void gla_chunk(const Params& p, int l, LAS unsigned char* lds, int bh, int n, int pass) {
    const int tid = tid_(), wid = tid >> 6, lane = tid & 63, l15 = lane & 15, lq = lane >> 4;
    const int b = bh >> 2, h = bh & 3;
    LAS u16* QE = (LAS u16*)(lds + GL_QE); LAS u16* KE = (LAS u16*)(lds + GL_KE); LAS u16* KDT = (LAS u16*)(lds + GL_KDT); LAS u16* VT = (LAS u16*)(lds + GL_VT);
    LAS u16* ATT = (LAS u16*)(lds + GL_ATT); LAS u16* ST = (LAS u16*)(lds + GL_ST); LAS float* LA = (LAS float*)(lds + GL_LA); LAS float* TOT = (LAS float*)(lds + GL_TOT);
    LAS float* AUP = (LAS float*)(lds + GL_AUP); LAS float* LOW = (LAS float*)(lds + GL_LOW); LAS float* DEC = (LAS float*)(lds + GL_DEC); LAS float* OB = (LAS float*)(lds + GL_OB); LAS float* ABS = (LAS float*)(lds + GL_ABS); LAS float* GNW = (LAS float*)(lds + GL_GNW);
    __syncthreads();
    for (int i = tid; i < 1024; i += 512) AUP[i] = p.a_up[(size_t)l * 16 * 256 + (i >> 6) * 256 + h * 64 + (i & 63)];
    if (tid < 64) ABS[tid] = p.a_b[(size_t)l * 256 + h * 64 + tid];
    if (tid >= 64 && tid < 192) GNW[tid - 64] = p.gnw[(size_t)l * 128 + tid - 64];
    const int rt = wid >> 1, dv0t = (wid & 1) * 4;
    const int tp = lane & 31, dg = wid * 2 + (lane >> 5);
    {
        const size_t tokb = (size_t)(b * SEQ + n * 64);
        const u16* rowp = p.P + (tokb + (tid >> 3)) * NP;
        const u16* rp0 = p.P + (tokb + 2 * tp) * NP; const u16* rp1 = rp0 + NP;
        const unsigned c_low = *(const unsigned*)(rowp + C_LOW + (tid & 7) * 2);
        const u32x2 c_q0 = *(const u32x2*)(rp0 + C_QC + h * 64 + dg * 4), c_q1 = *(const u32x2*)(rp1 + C_QC + h * 64 + dg * 4);
        const u32x2 c_k0 = *(const u32x2*)(rp0 + C_KC + h * 64 + dg * 4), c_k1 = *(const u32x2*)(rp1 + C_KC + h * 64 + dg * 4);
        const u32x4 c_v0 = *(const u32x4*)(rp0 + C_VC + h * 128 + dg * 8), c_v1 = *(const u32x4*)(rp1 + C_VC + h * 128 + dg * 8);
        const u32x4 c_g0 = *(const u32x4*)(rowp + C_GC + h * 128 + (tid & 7) * 16), c_g1 = *(const u32x4*)(rowp + C_GC + h * 128 + (tid & 7) * 16 + 8);
        { const int e2 = tid * 2, t = e2 >> 4, r = e2 & 15; LOW[t * 16 + r] = bflo(c_low); LOW[t * 16 + r + 1] = bfhi(c_low); }
        __syncthreads();
        { const int t = tid >> 3, d0 = (tid & 7) * 8;
            f32x4 lo[4];
#pragma unroll
            for (int i = 0; i < 4; ++i) lo[i] = *(const LAS f32x4*)(LOW + t * 16 + 4 * i);
            f32x4 z0 = *(const LAS f32x4*)(ABS + d0), z1 = *(const LAS f32x4*)(ABS + d0 + 4);
#pragma unroll
            for (int r = 0; r < 16; ++r) { const f32x4 u0 = *(const LAS f32x4*)(AUP + r * 64 + d0), u1 = *(const LAS f32x4*)(AUP + r * 64 + d0 + 4);
                const float lv = lo[r >> 2][r & 3]; z0 += lv * u0; z1 += lv * u1; }
#pragma unroll
            for (int e = 0; e < 4; ++e) { z0[e] = (fminf(z0[e], 0.f) - __logf(1.f + __expf(-fabsf(z0[e])))) * (1.f / 16.f); z1[e] = (fminf(z1[e], 0.f) - __logf(1.f + __expf(-fabsf(z1[e])))) * (1.f / 16.f); }
            *(LAS f32x4*)(LA + t * 64 + d0) = z0; *(LAS f32x4*)(LA + t * 64 + d0 + 4) = z1; }
        __syncthreads();
        { float a = 0.f;
#pragma unroll
            for (int tt = 0; tt < 8; ++tt) { a += LA[(wid * 8 + tt) * 64 + lane]; LA[(wid * 8 + tt) * 64 + lane] = a; }
            TOT[wid * 64 + lane] = a; }
        __syncthreads();
        { const int t0 = 2 * tp, wt = tp >> 2, d0 = dg * 4;
            f32x4 off = {0.f, 0.f, 0.f, 0.f}, tot = {0.f, 0.f, 0.f, 0.f};
#pragma unroll
            for (int w2 = 0; w2 < 8; ++w2) { const f32x4 tv = *(const LAS f32x4*)(TOT + w2 * 64 + d0); tot += tv; off += (w2 < wt) ? tv : (f32x4){0.f, 0.f, 0.f, 0.f}; }
            const f32x4 b0 = *(const LAS f32x4*)(LA + t0 * 64 + d0) + off, b1 = *(const LAS f32x4*)(LA + (t0 + 1) * 64 + d0) + off;
            const float q0[4] = {bflo(c_q0.x), bfhi(c_q0.x), bflo(c_q0.y), bfhi(c_q0.y)}, q1[4] = {bflo(c_q1.x), bfhi(c_q1.x), bflo(c_q1.y), bfhi(c_q1.y)};
            const float k0[4] = {bflo(c_k0.x), bfhi(c_k0.x), bflo(c_k0.y), bfhi(c_k0.y)}, k1[4] = {bflo(c_k1.x), bfhi(c_k1.x), bflo(c_k1.y), bfhi(c_k1.y)};
            float qe0[4], qe1[4], ke0[4], ke1[4];
#pragma unroll
            for (int e = 0; e < 4; ++e) {
                qe0[e] = q0[e] * 0.125f * __expf(b0[e]); qe1[e] = q1[e] * 0.125f * __expf(b1[e]);
                ke0[e] = k0[e] * __expf(-b0[e]); ke1[e] = k1[e] * __expf(-b1[e]);
                *(LAS unsigned*)(KDT + (d0 + e) * 72 + t0) = cvt_pk_bf16(k0[e] * __expf(tot[e] - b0[e]), k1[e] * __expf(tot[e] - b1[e]));
                if (tp == 0) DEC[d0 + e] = __expf(tot[e]); }
            u32x2 o; o.x = cvt_pk_bf16(qe0[0], qe0[1]); o.y = cvt_pk_bf16(qe0[2], qe0[3]); *(LAS u32x2*)(QE + t0 * 72 + d0) = o;
            o.x = cvt_pk_bf16(qe1[0], qe1[1]); o.y = cvt_pk_bf16(qe1[2], qe1[3]); *(LAS u32x2*)(QE + (t0 + 1) * 72 + d0) = o;
            o.x = cvt_pk_bf16(ke0[0], ke0[1]); o.y = cvt_pk_bf16(ke0[2], ke0[3]); *(LAS u32x2*)(KE + t0 * 72 + d0) = o;
            o.x = cvt_pk_bf16(ke1[0], ke1[1]); o.y = cvt_pk_bf16(ke1[2], ke1[3]); *(LAS u32x2*)(KE + (t0 + 1) * 72 + d0) = o;
            { LAS unsigned* vt = (LAS unsigned*)(VT + dg * 8 * 72 + t0);
                vt[0] = (c_v0.x & 0xffffu) | (c_v1.x << 16); vt[36] = (c_v0.x >> 16) | (c_v1.x & 0xffff0000u);
                vt[72] = (c_v0.y & 0xffffu) | (c_v1.y << 16); vt[108] = (c_v0.y >> 16) | (c_v1.y & 0xffff0000u);
                vt[144] = (c_v0.z & 0xffffu) | (c_v1.z << 16); vt[180] = (c_v0.z >> 16) | (c_v1.z & 0xffff0000u);
                vt[216] = (c_v0.w & 0xffffu) | (c_v1.w << 16); vt[252] = (c_v0.w >> 16) | (c_v1.w & 0xffff0000u); } }
        __syncthreads();
        if (pass == 1) {
            bf16x8 kd[2];
#pragma unroll
            for (int ks = 0; ks < 2; ++ks) kd[ks] = *(const LAS bf16x8*)(KDT + (rt * 16 + l15) * 72 + ks * 32 + lq * 8);
            f32x4* gout = (f32x4*)(p.gst + ((size_t)(bh * 32 + n) * 512 + tid) * 16);
#pragma unroll
            for (int c = 0; c < 4; ++c) { const int dvt = dv0t + c; f32x4 acc = {0.f, 0.f, 0.f, 0.f};
#pragma unroll
                for (int ks = 0; ks < 2; ++ks) { const bf16x8 vf = *(const LAS bf16x8*)(VT + (dvt * 16 + l15) * 72 + ks * 32 + lq * 8); acc = mfma16(kd[ks], vf, acc); }
                gout[c] = acc; }
            if (tid < 64) p.gdec[(size_t)(bh * 32 + n) * 64 + tid] = DEC[tid];
            return;
        }
        { bf16x8 af[2];
#pragma unroll
            for (int ks = 0; ks < 2; ++ks) af[ks] = *(const LAS bf16x8*)(QE + (rt * 16 + l15) * 72 + ks * 32 + lq * 8);
#pragma unroll
            for (int c2 = 0; c2 < 2; ++c2) { const int ctile = (wid & 1) * 2 + c2; f32x4 acc = {0.f, 0.f, 0.f, 0.f};
#pragma unroll
                for (int ks = 0; ks < 2; ++ks) { const bf16x8 bf = *(const LAS bf16x8*)(KE + (ctile * 16 + l15) * 72 + ks * 32 + lq * 8); acc = mfma16(af[ks], bf, acc); }
#pragma unroll
                for (int i = 0; i < 4; ++i) { const int t = rt * 16 + lq * 4 + i, jj = ctile * 16 + l15; ATT[t * 72 + jj] = f2bf(jj <= t ? acc[i] : 0.f); } } }
        { f32x4 S[4];
#pragma unroll
            for (int c = 0; c < 4; ++c) S[c] = (f32x4){0.f, 0.f, 0.f, 0.f};
#pragma unroll 2
            for (int m = 0; m < n; ++m) { const f32x4* gin = (const f32x4*)(p.gst + ((size_t)(bh * 32 + m) * 512 + tid) * 16);
                const f32x4 dm = *(const f32x4*)(p.gdec + (size_t)(bh * 32 + m) * 64 + rt * 16 + lq * 4);
#pragma unroll
                for (int c = 0; c < 4; ++c) S[c] = S[c] * dm + gin[c]; }
#pragma unroll
            for (int c = 0; c < 4; ++c) { const int dv = (dv0t + c) * 16 + l15;
                u32x2 sv; sv.x = cvt_pk_bf16(S[c][0], S[c][1]); sv.y = cvt_pk_bf16(S[c][2], S[c][3]);
                *(LAS u32x2*)(ST + dv * 72 + rt * 16 + lq * 4) = sv; } }
        __syncthreads();
        f32x4 oacc[4];
        { bf16x8 at[2], qf[2];
#pragma unroll
            for (int ks = 0; ks < 2; ++ks) { at[ks] = *(const LAS bf16x8*)(ATT + (rt * 16 + l15) * 72 + ks * 32 + lq * 8); qf[ks] = *(const LAS bf16x8*)(QE + (rt * 16 + l15) * 72 + ks * 32 + lq * 8); }
#pragma unroll
            for (int c = 0; c < 4; ++c) { const int dvt = dv0t + c; f32x4 acc = {0.f, 0.f, 0.f, 0.f};
#pragma unroll
                for (int ks = 0; ks < 2; ++ks) { const bf16x8 vf = *(const LAS bf16x8*)(VT + (dvt * 16 + l15) * 72 + ks * 32 + lq * 8), sf = *(const LAS bf16x8*)(ST + (dvt * 16 + l15) * 72 + ks * 32 + lq * 8);
                    acc = mfma16(at[ks], vf, acc); acc = mfma16(qf[ks], sf, acc); }
                oacc[c] = acc; } }
        __syncthreads();
#pragma unroll
        for (int c = 0; c < 4; ++c) { const int dv = (dv0t + c) * 16 + l15;
#pragma unroll
            for (int i = 0; i < 4; ++i) OB[(rt * 16 + lq * 4 + i) * 132 + dv] = oacc[c][i]; }
        __syncthreads();
        { const int t = tid >> 3, dvb = (tid & 7) * 16;
            f32x4 o4[4]; float ss = 0.f;
#pragma unroll
            for (int i = 0; i < 4; ++i) { o4[i] = *(const LAS f32x4*)(OB + t * 132 + dvb + 4 * i); ss += o4[i].x * o4[i].x + o4[i].y * o4[i].y + o4[i].z * o4[i].z + o4[i].w * o4[i].w; }
            ss = red8_sum(ss);
            const float rs = rsqrtf(ss * (1.f / 128.f) + 1e-6f);
            const float g[16] = {bflo(c_g0.x), bfhi(c_g0.x), bflo(c_g0.y), bfhi(c_g0.y), bflo(c_g0.z), bfhi(c_g0.z), bflo(c_g0.w), bfhi(c_g0.w),
                                 bflo(c_g1.x), bfhi(c_g1.x), bflo(c_g1.y), bfhi(c_g1.y), bflo(c_g1.z), bfhi(c_g1.z), bflo(c_g1.w), bfhi(c_g1.w)};
            float r[16];
#pragma unroll
            for (int e = 0; e < 16; ++e) r[e] = o4[e >> 2][e & 3] * rs * GNW[dvb + e] * siluf_(g[e]);
            u32x4 w0, w1; w0.x = cvt_pk_bf16(r[0], r[1]); w0.y = cvt_pk_bf16(r[2], r[3]); w0.z = cvt_pk_bf16(r[4], r[5]); w0.w = cvt_pk_bf16(r[6], r[7]);
            w1.x = cvt_pk_bf16(r[8], r[9]); w1.y = cvt_pk_bf16(r[10], r[11]); w1.z = cvt_pk_bf16(r[12], r[13]); w1.w = cvt_pk_bf16(r[14], r[15]);
            u16* op = p.H + (tokb + t) * DM + 1536 + h * 128 + dvb;
            *(u32x4*)op = w0; *(u32x4*)(op + 8) = w1; }
    }
}

__device__ void gla_task(const Params& p, int l, LAS unsigned char* lds, int bh, int hs, int nlen) {
    const int tid = tid_(), wid = tid >> 6, lane = tid & 63, l15 = lane & 15, lq = lane >> 4;
    const int b = bh >> 2, h = bh & 3;
    LAS u16* QE = (LAS u16*)(lds + GL_QE); LAS u16* KE = (LAS u16*)(lds + GL_KE); LAS u16* KDT = (LAS u16*)(lds + GL_KDT); LAS u16* VT = (LAS u16*)(lds + GL_VT);
    LAS u16* ATT = (LAS u16*)(lds + GL_ATT); LAS u16* ST = (LAS u16*)(lds + GL_ST); LAS float* LA = (LAS float*)(lds + GL_LA); LAS float* TOT = (LAS float*)(lds + GL_TOT);
    LAS float* AUP = (LAS float*)(lds + GL_AUP); LAS float* LOW = (LAS float*)(lds + GL_LOW); LAS float* DEC = (LAS float*)(lds + GL_DEC); LAS float* OB = (LAS float*)(lds + GL_OB); LAS float* ABS = (LAS float*)(lds + GL_ABS); LAS float* GNW = (LAS float*)(lds + GL_GNW);
    __syncthreads();
    for (int i = tid; i < 1024; i += 512) AUP[i] = p.a_up[(size_t)l * 16 * 256 + (i >> 6) * 256 + h * 64 + (i & 63)];
    for (int i = tid; i < 128 * 72 / 2; i += 512) ((LAS unsigned*)ST)[i] = 0u;
    if (tid < 64) ABS[tid] = p.a_b[(size_t)l * 256 + h * 64 + tid];
    if (tid >= 64 && tid < 192) GNW[tid - 64] = p.gnw[(size_t)l * 128 + tid - 64];
    f32x4 Sacc[4];
#pragma unroll
    for (int c = 0; c < 4; ++c) Sacc[c] = (f32x4){0.f, 0.f, 0.f, 0.f};
    const int rt = wid >> 1, dv0t = (wid & 1) * 4;
    const int tp = lane & 31, dg = wid * 2 + (lane >> 5);
    if (hs) {
#pragma unroll 2
        for (int m = 0; m < 16; ++m) { const f32x4* gin = (const f32x4*)(p.gst + ((size_t)(bh * 32 + m) * 512 + tid) * 16);
            const f32x4 dm = *(const f32x4*)(p.gdec + (size_t)(bh * 32 + m) * 64 + rt * 16 + lq * 4);
#pragma unroll
            for (int c = 0; c < 4; ++c) Sacc[c] = Sacc[c] * dm + gin[c]; }
        __syncthreads();
#pragma unroll
        for (int c = 0; c < 4; ++c) { const int dv = (dv0t + c) * 16 + l15;
            u32x2 sv; sv.x = cvt_pk_bf16(Sacc[c][0], Sacc[c][1]); sv.y = cvt_pk_bf16(Sacc[c][2], Sacc[c][3]);
            *(LAS u32x2*)(ST + dv * 72 + rt * 16 + lq * 4) = sv; }
    }
    for (int n = hs * 16; n < hs * 16 + nlen; ++n) {
        const size_t tokb = (size_t)(b * SEQ + n * 64);
        const u16* rowp = p.P + (tokb + (tid >> 3)) * NP;
        const u16* rp0 = p.P + (tokb + 2 * tp) * NP; const u16* rp1 = rp0 + NP;
        const unsigned c_low = *(const unsigned*)(rowp + C_LOW + (tid & 7) * 2);
        const u32x2 c_q0 = *(const u32x2*)(rp0 + C_QC + h * 64 + dg * 4), c_q1 = *(const u32x2*)(rp1 + C_QC + h * 64 + dg * 4);
        const u32x2 c_k0 = *(const u32x2*)(rp0 + C_KC + h * 64 + dg * 4), c_k1 = *(const u32x2*)(rp1 + C_KC + h * 64 + dg * 4);
        const u32x4 c_v0 = *(const u32x4*)(rp0 + C_VC + h * 128 + dg * 8), c_v1 = *(const u32x4*)(rp1 + C_VC + h * 128 + dg * 8);
        const u32x4 c_g0 = *(const u32x4*)(rowp + C_GC + h * 128 + (tid & 7) * 16), c_g1 = *(const u32x4*)(rowp + C_GC + h * 128 + (tid & 7) * 16 + 8);
        { const int e2 = tid * 2, t = e2 >> 4, r = e2 & 15; LOW[t * 16 + r] = bflo(c_low); LOW[t * 16 + r + 1] = bfhi(c_low); }
        __syncthreads();
        { const int t = tid >> 3, d0 = (tid & 7) * 8;
            f32x4 lo[4];
#pragma unroll
            for (int i = 0; i < 4; ++i) lo[i] = *(const LAS f32x4*)(LOW + t * 16 + 4 * i);
            f32x4 z0 = *(const LAS f32x4*)(ABS + d0), z1 = *(const LAS f32x4*)(ABS + d0 + 4);
#pragma unroll
            for (int r = 0; r < 16; ++r) { const f32x4 u0 = *(const LAS f32x4*)(AUP + r * 64 + d0), u1 = *(const LAS f32x4*)(AUP + r * 64 + d0 + 4);
                const float lv = lo[r >> 2][r & 3]; z0 += lv * u0; z1 += lv * u1; }
#pragma unroll
            for (int e = 0; e < 4; ++e) { z0[e] = (fminf(z0[e], 0.f) - __logf(1.f + __expf(-fabsf(z0[e])))) * (1.f / 16.f); z1[e] = (fminf(z1[e], 0.f) - __logf(1.f + __expf(-fabsf(z1[e])))) * (1.f / 16.f); }
            *(LAS f32x4*)(LA + t * 64 + d0) = z0; *(LAS f32x4*)(LA + t * 64 + d0 + 4) = z1; }
        __syncthreads();
        { float a = 0.f;
#pragma unroll
            for (int tt = 0; tt < 8; ++tt) { a += LA[(wid * 8 + tt) * 64 + lane]; LA[(wid * 8 + tt) * 64 + lane] = a; }
            TOT[wid * 64 + lane] = a; }
        __syncthreads();
        { const int t0 = 2 * tp, wt = tp >> 2, d0 = dg * 4;
            f32x4 off = {0.f, 0.f, 0.f, 0.f}, tot = {0.f, 0.f, 0.f, 0.f};
#pragma unroll
            for (int w2 = 0; w2 < 8; ++w2) { const f32x4 tv = *(const LAS f32x4*)(TOT + w2 * 64 + d0); tot += tv; off += (w2 < wt) ? tv : (f32x4){0.f, 0.f, 0.f, 0.f}; }
            const f32x4 b0 = *(const LAS f32x4*)(LA + t0 * 64 + d0) + off, b1 = *(const LAS f32x4*)(LA + (t0 + 1) * 64 + d0) + off;
            const float q0[4] = {bflo(c_q0.x), bfhi(c_q0.x), bflo(c_q0.y), bfhi(c_q0.y)}, q1[4] = {bflo(c_q1.x), bfhi(c_q1.x), bflo(c_q1.y), bfhi(c_q1.y)};
            const float k0[4] = {bflo(c_k0.x), bfhi(c_k0.x), bflo(c_k0.y), bfhi(c_k0.y)}, k1[4] = {bflo(c_k1.x), bfhi(c_k1.x), bflo(c_k1.y), bfhi(c_k1.y)};
            float qe0[4], qe1[4], ke0[4], ke1[4];
#pragma unroll
            for (int e = 0; e < 4; ++e) {
                qe0[e] = q0[e] * 0.125f * __expf(b0[e]); qe1[e] = q1[e] * 0.125f * __expf(b1[e]);
                ke0[e] = k0[e] * __expf(-b0[e]); ke1[e] = k1[e] * __expf(-b1[e]);
                *(LAS unsigned*)(KDT + (d0 + e) * 72 + t0) = cvt_pk_bf16(k0[e] * __expf(tot[e] - b0[e]), k1[e] * __expf(tot[e] - b1[e]));
                if (tp == 0) DEC[d0 + e] = __expf(tot[e]); }
            u32x2 o; o.x = cvt_pk_bf16(qe0[0], qe0[1]); o.y = cvt_pk_bf16(qe0[2], qe0[3]); *(LAS u32x2*)(QE + t0 * 72 + d0) = o;
            o.x = cvt_pk_bf16(qe1[0], qe1[1]); o.y = cvt_pk_bf16(qe1[2], qe1[3]); *(LAS u32x2*)(QE + (t0 + 1) * 72 + d0) = o;
            o.x = cvt_pk_bf16(ke0[0], ke0[1]); o.y = cvt_pk_bf16(ke0[2], ke0[3]); *(LAS u32x2*)(KE + t0 * 72 + d0) = o;
            o.x = cvt_pk_bf16(ke1[0], ke1[1]); o.y = cvt_pk_bf16(ke1[2], ke1[3]); *(LAS u32x2*)(KE + (t0 + 1) * 72 + d0) = o;
            { LAS unsigned* vt = (LAS unsigned*)(VT + dg * 8 * 72 + t0);
                vt[0] = (c_v0.x & 0xffffu) | (c_v1.x << 16); vt[36] = (c_v0.x >> 16) | (c_v1.x & 0xffff0000u);
                vt[72] = (c_v0.y & 0xffffu) | (c_v1.y << 16); vt[108] = (c_v0.y >> 16) | (c_v1.y & 0xffff0000u);
                vt[144] = (c_v0.z & 0xffffu) | (c_v1.z << 16); vt[180] = (c_v0.z >> 16) | (c_v1.z & 0xffff0000u);
                vt[216] = (c_v0.w & 0xffffu) | (c_v1.w << 16); vt[252] = (c_v0.w >> 16) | (c_v1.w & 0xffff0000u); } }
        __syncthreads();
        { bf16x8 af[2];
#pragma unroll
            for (int ks = 0; ks < 2; ++ks) af[ks] = *(const LAS bf16x8*)(QE + (rt * 16 + l15) * 72 + ks * 32 + lq * 8);
#pragma unroll
            for (int c2 = 0; c2 < 2; ++c2) { const int ctile = (wid & 1) * 2 + c2; f32x4 acc = {0.f, 0.f, 0.f, 0.f};
#pragma unroll
                for (int ks = 0; ks < 2; ++ks) { const bf16x8 bf = *(const LAS bf16x8*)(KE + (ctile * 16 + l15) * 72 + ks * 32 + lq * 8); acc = mfma16(af[ks], bf, acc); }
#pragma unroll
                for (int i = 0; i < 4; ++i) { const int t = rt * 16 + lq * 4 + i, jj = ctile * 16 + l15; ATT[t * 72 + jj] = f2bf(jj <= t ? acc[i] : 0.f); } } }
        __syncthreads();
        f32x4 oacc[4];
        { bf16x8 at[2], qf[2], kd[2];
#pragma unroll
            for (int ks = 0; ks < 2; ++ks) { at[ks] = *(const LAS bf16x8*)(ATT + (rt * 16 + l15) * 72 + ks * 32 + lq * 8); qf[ks] = *(const LAS bf16x8*)(QE + (rt * 16 + l15) * 72 + ks * 32 + lq * 8);
                kd[ks] = *(const LAS bf16x8*)(KDT + (rt * 16 + l15) * 72 + ks * 32 + lq * 8); }
            const f32x4 dec = *(const LAS f32x4*)(DEC + rt * 16 + lq * 4);
#pragma unroll
            for (int c = 0; c < 4; ++c) { const int dvt = dv0t + c; f32x4 acc = {0.f, 0.f, 0.f, 0.f};
                Sacc[c] *= dec;
#pragma unroll
                for (int ks = 0; ks < 2; ++ks) { const bf16x8 vf = *(const LAS bf16x8*)(VT + (dvt * 16 + l15) * 72 + ks * 32 + lq * 8), sf = *(const LAS bf16x8*)(ST + (dvt * 16 + l15) * 72 + ks * 32 + lq * 8);
                    acc = mfma16(at[ks], vf, acc); acc = mfma16(qf[ks], sf, acc); Sacc[c] = mfma16(kd[ks], vf, Sacc[c]); }
                oacc[c] = acc; } }
        __syncthreads();
#pragma unroll
        for (int c = 0; c < 4; ++c) { const int dv = (dv0t + c) * 16 + l15;
#pragma unroll
            for (int i = 0; i < 4; ++i) OB[(rt * 16 + lq * 4 + i) * 132 + dv] = oacc[c][i];
            u32x2 sv; sv.x = cvt_pk_bf16(Sacc[c][0], Sacc[c][1]); sv.y = cvt_pk_bf16(Sacc[c][2], Sacc[c][3]);
            *(LAS u32x2*)(ST + dv * 72 + rt * 16 + lq * 4) = sv; }
        __syncthreads();
        { const int t = tid >> 3, dvb = (tid & 7) * 16;
            f32x4 o4[4]; float ss = 0.f;
#pragma unroll
            for (int i = 0; i < 4; ++i) { o4[i] = *(const LAS f32x4*)(OB + t * 132 + dvb + 4 * i); ss += o4[i].x * o4[i].x + o4[i].y * o4[i].y + o4[i].z * o4[i].z + o4[i].w * o4[i].w; }
            ss = red8_sum(ss);
            const float rs = rsqrtf(ss * (1.f / 128.f) + 1e-6f);
            const float g[16] = {bflo(c_g0.x), bfhi(c_g0.x), bflo(c_g0.y), bfhi(c_g0.y), bflo(c_g0.z), bfhi(c_g0.z), bflo(c_g0.w), bfhi(c_g0.w),
                                 bflo(c_g1.x), bfhi(c_g1.x), bflo(c_g1.y), bfhi(c_g1.y), bflo(c_g1.z), bfhi(c_g1.z), bflo(c_g1.w), bfhi(c_g1.w)};
            float r[16];
#pragma unroll
            for (int e = 0; e < 16; ++e) r[e] = o4[e >> 2][e & 3] * rs * GNW[dvb + e] * siluf_(g[e]);
            u32x4 w0, w1; w0.x = cvt_pk_bf16(r[0], r[1]); w0.y = cvt_pk_bf16(r[2], r[3]); w0.z = cvt_pk_bf16(r[4], r[5]); w0.w = cvt_pk_bf16(r[6], r[7]);
            w1.x = cvt_pk_bf16(r[8], r[9]); w1.y = cvt_pk_bf16(r[10], r[11]); w1.z = cvt_pk_bf16(r[12], r[13]); w1.w = cvt_pk_bf16(r[14], r[15]);
            u16* op = p.H + (tokb + t) * DM + 1536 + h * 128 + dvb;
            *(u32x4*)op = w0; *(u32x4*)(op + 8) = w1; }
        __syncthreads();
    }
}

#define XB_TMO      128
#define XB_XCNT(j)  (256  + 64 * (j))
#define XB_XSUB(j)  (1280 + 64 * (j))
#define XB_XGEN(j)  (2304 + 64 * (j))
#define XB_TOP      3328
#define XB_TOPGEN   3392
#define XCD_BAR_WORDS 3456
#define XB_SPIN_CAP (1u << 18)

__device__ __forceinline__ unsigned xb_ld(unsigned* p)              { return __hip_atomic_load(p, __ATOMIC_RELAXED, __HIP_MEMORY_SCOPE_AGENT); }
__device__ __forceinline__ unsigned xb_add(unsigned* p, unsigned v) { return __hip_atomic_fetch_add(p, v, __ATOMIC_RELAXED, __HIP_MEMORY_SCOPE_AGENT); }
__device__ __forceinline__ unsigned xb_xcc_id() { return (unsigned)__builtin_amdgcn_s_getreg((3 << 11) | 20) & 0xFu; }
#define XB_SPIN(cond, bar) do { unsigned _sp = 0; while (cond) { __builtin_amdgcn_s_sleep(1); \
    if ((++_sp & 255u) == 0u) { if (xb_ld(&(bar)[XB_TMO])) break; if (_sp > XB_SPIN_CAP) { atomicAdd(&(bar)[XB_TMO], 1u); break; } } } } while (0)

struct XcdBarrier {
    unsigned* bar; unsigned x;
    volatile LAS unsigned* st;
};

__device__ __forceinline__ XcdBarrier xcd_barrier_post(unsigned* bar, volatile LAS unsigned* st) {
    XcdBarrier b; b.bar = bar; b.x = xb_xcc_id(); b.st = st;
    if (threadIdx.x == 0) (void)xb_add(&bar[XB_XCNT(b.x)], 1u);
    return b;
}
__device__ __forceinline__ void xcd_barrier_complete(unsigned* bar, unsigned x, unsigned& nloc, unsigned& nx) {
    const unsigned G = gridDim.x * gridDim.y * gridDim.z;
    unsigned sum, cnt, mine, sp = 0u;
    for (;;) {
        sum = 0u; cnt = 0u; mine = 0u;
#pragma unroll
        for (unsigned j = 0; j < 16; ++j) { const unsigned c = xb_ld(&bar[XB_XCNT(j)]); sum += c; cnt += (c > 0u) ? 1u : 0u; mine = (j == x) ? c : mine; }
        if (sum == G) break;
        __builtin_amdgcn_s_sleep(1);
        if ((++sp & 255u) == 0u) { if (xb_ld(&bar[XB_TMO])) break; if (sp > XB_SPIN_CAP) { atomicAdd(&bar[XB_TMO], 1u); break; } }
    }
    nloc = mine > 0u ? mine : 1u; nx = cnt > 0u ? cnt : 1u;
}

__device__ __forceinline__ void xcd_barrier(const XcdBarrier& b) {
    asm volatile("s_waitcnt vmcnt(0)" ::: "memory");
    __syncthreads();
    if (threadIdx.x == 0) {
        unsigned* bar = b.bar;
        __builtin_amdgcn_s_waitcnt(0);
        unsigned nloc = b.st[0], nx = b.st[1];
        if (nloc == 0u) { xcd_barrier_complete(bar, b.x, nloc, nx); b.st[0] = nloc; b.st[1] = nx; }
        const unsigned old = xb_add(&bar[XB_XSUB(b.x)], 1u);
        const unsigned gen = old / nloc;
        if (old + 1u == (gen + 1u) * nloc) {
            __builtin_amdgcn_fence(__ATOMIC_RELEASE, "agent");
            asm volatile("s_waitcnt vmcnt(0)" ::: "memory");
            const unsigned og = xb_add(&bar[XB_TOP], 1u);
            const unsigned tg = og / nx;
            if (og + 1u == (tg + 1u) * nx) xb_add(&bar[XB_TOPGEN], 1u);
            else XB_SPIN(xb_ld(&bar[XB_TOPGEN]) == tg, bar);
            __builtin_amdgcn_fence(__ATOMIC_ACQUIRE, "agent");
            xb_add(&bar[XB_XGEN(b.x)], 1u);
            asm volatile("s_waitcnt vmcnt(0)" ::: "memory");
        } else {
            XB_SPIN(xb_ld(&bar[XB_XGEN(b.x)]) == gen, bar);
            __builtin_amdgcn_fence(__ATOMIC_ACQUIRE, "agent");
            asm volatile("s_waitcnt vmcnt(0)" ::: "memory");
        }
    }
    __syncthreads();
}

constexpr int N_PHASES = 13;
__device__ __forceinline__ void run_phase(const Params& p, int ph, LAS unsigned char* lds, LAS unsigned* qslot, int bid, int nb) {
    if (ph == 0) {
        for (int l = 0; l < 2; ++l) {
            transpose_cvt(lds, p.w_in + (size_t)l * DM * DIN, p.WtIn + (size_t)l * NP * DM, DM, DIN, NP, bid, nb);
            transpose_cvt(lds, p.w_out + (size_t)l * DM * DM, p.WtOut + (size_t)l * DM * DM, DM, DM, DM, bid, nb);
            transpose_cvt(lds, p.w2 + (size_t)l * 64 * 1024, p.W2t + (size_t)l * 1024 * 64, 64, 1024, 1024, bid, nb);
            transpose_cvt(lds, p.a2 + (size_t)l * 64 * 1024, p.A2t + (size_t)l * 1024 * 64, 64, 1024, 1024, bid, nb);
        }
        rmsnorm_phase(p.x, p.norm_w, p.H, nullptr, bid, nb);
        return;
    }
    const int l = (ph - 1) / 6, s = (ph - 1) % 6;
    if (s == 0) {
        Gemm g; g.A = p.H; g.Bt = p.WtIn + (size_t)l * NP * DM; g.M = MTOK; g.N = NP; g.K = DM;
        StaticOrder S; S.init(MTOK, NP, nb, bid);
        EpiP E; E.O = p.P; E.ldc = NP;
        gemm_phase<EpiP, StaticOrder, false>(lds, g, S, E, nullptr);
    } else if (s == 1) {
        kmean_phase(p, lds, bid, nb);
    } else if (s == 2) {
        const int nscan = nb >> 1;
        if (bid < nscan) {
            for (int task = bid; task < 128; task += nscan) rwkv_scan_task(p, l, lds, task);
        } else {
            LAS int* slot = (LAS int*)qslot;
            for (;;) {
                __syncthreads();
                if (tid_() == 0) *slot = (int)atomicAdd(p.bar + 64 * l, 1u);
                __syncthreads();
                const int tk = *slot;
#ifdef PROBE_MOBA2
                if (tk >= 32 + 768) break;
                if (tk < 32) gla_task(p, l, lds, tk, 0, 32);
                else moba_task(p, lds, (tk - 32) % 512);
#else
                if (tk >= 32 + 512) break;
                if (tk < 32) gla_task(p, l, lds, tk, 0, 32);
                else moba_task(p, lds, tk - 32);
#endif
            }
        }
    } else if (s == 3) {
        for (int tk = bid; tk < 512; tk += nb) rwkv_post_task(p, l, tk);
    } else if (s == 4) {
        Gemm g; g.A = p.H; g.Bt = p.WtOut + (size_t)l * DM * DM; g.M = MTOK; g.N = DM; g.K = DM;
        StaticOrder S; S.init(MTOK, DM, nb, bid);
        EpiRes E; E.R = (l == 0) ? p.x : p.out; E.C = p.out; E.ldc = DM;
        gemm_phase<EpiRes, StaticOrder, false>(lds, g, S, E, nullptr);
    } else {
        if (l == 0) rmsnorm_phase(p.out, p.norm_w + DM, p.H, nullptr, bid, nb);
        else rmsnorm_phase(p.out, p.fnw, nullptr, p.out, bid, nb);
    }
}

__global__ void __launch_bounds__(512, 2) hybrid_fwd(Params p) {
    extern __shared__ __attribute__((aligned(16))) unsigned char shm[];
    LAS unsigned char* lds = (LAS unsigned char*)shm;
    const int bid = blockIdx.x, nb = gridDim.x;
#if defined(TEST_GEMM)
    { Gemm g; g.A = p.H; g.Bt = p.WtIn; g.M = MTOK; g.N = NP; g.K = DM;
      StaticOrder S; S.init(MTOK, NP, nb, bid);
      EpiP E; E.O = p.P; E.ldc = NP;
      gemm_phase<EpiP, StaticOrder, false>(lds, g, S, E, nullptr);
#if TEST_GEMM >= 2
      if (p.phase_lo) {
      Gemm g2; g2.A = p.H; g2.Bt = p.WtOut; g2.M = MTOK; g2.N = DM; g2.K = DM;
      StaticOrder S2; S2.init(MTOK, DM, nb, bid);
      EpiRes E2; E2.R = p.x; E2.C = p.out; E2.ldc = DM;
      gemm_phase<EpiRes, StaticOrder, false>(lds, g2, S2, E2, nullptr); }
#endif
    }
#elif ONE_LAUNCH
    cg::grid_group grid = cg::this_grid();
    __shared__ uint4 xb_words;
    if (threadIdx.x == 0) xb_words = make_uint4(0u, 0u, 0u, 0u);
    __syncthreads();
    const XcdBarrier xb = xcd_barrier_post(p.bar, (volatile LAS unsigned*)&xb_words);
    for (int ph = p.phase_lo; ph < p.phase_hi; ++ph) {
        run_phase(p, ph, lds, (LAS unsigned*)&xb_words.z, bid, nb);
#ifdef REPEAT_PH
        if (ph == REPEAT_PH) { xcd_barrier(xb); run_phase(p, ph, lds, (LAS unsigned*)&xb_words.z, bid, nb); }
#endif
        if (ph + 1 < p.phase_hi) { if (ph == 0) grid.sync(); else xcd_barrier(xb); }
    }
#else
    run_phase(p, p.phase_lo, lds, nullptr, bid, nb);
#endif
}

extern "C" void kernel_launch(void* const* d_in, const int* in_sizes, int n_in, void* d_out, int out_size, void* d_ws, size_t ws_size, hipStream_t stream) {
    static int grid = 0;
    if (grid == 0) {
        int dev = 0, cus = 0, per_cu = 0;
        hipGetDevice(&dev);
        hipDeviceGetAttribute(&cus, hipDeviceAttributeMultiprocessorCount, dev);
        hipFuncSetAttribute((const void*)hybrid_fwd, hipFuncAttributeMaxDynamicSharedMemorySize, LDS_BYTES);
        hipOccupancyMaxActiveBlocksPerMultiprocessor(&per_cu, (const void*)hybrid_fwd, 512, LDS_BYTES);
        if (per_cu < 1) { fprintf(stderr, "kernel_launch: occupancy query says %d blocks per CU\n", per_cu); per_cu = 1; }
        (void)hipGetLastError();
        grid = cus;
    }
    Params p{};
    const float* const* in = (const float* const*)d_in;
    p.x = in[0]; p.norm_w = in[1]; p.w_in = in[2]; p.w_out = in[3]; p.mu = in[4]; p.w0 = in[5]; p.w2 = in[6]; p.a0 = in[7]; p.a2 = in[8];
    p.k_k = in[9]; p.k_a = in[10]; p.r_k = in[11]; p.ln_w = in[12]; p.ln_b = in[13]; p.a_up = in[14]; p.a_b = in[15]; p.gnw = in[16]; p.fnw = in[17];
    p.out = (float*)d_out;
    unsigned char* ws = (unsigned char*)d_ws; size_t off = 0;
    auto take = [&](size_t bytes) { unsigned char* r = ws + off; off += (bytes + 255) & ~(size_t)255; return r; };
    p.WtIn = (u16*)take((size_t)2 * NP * DM * 2); p.WtOut = (u16*)take((size_t)2 * DM * DM * 2);
    p.W2t = (u16*)take((size_t)2 * 1024 * 64 * 2); p.A2t = (u16*)take((size_t)2 * 1024 * 64 * 2);
    p.H = (u16*)take((size_t)MTOK * DM * 2); p.P = (u16*)take((size_t)MTOK * NP * 2);
    p.yraw = (float*)take((size_t)MTOK * 1024 * 4); p.ybonus = (float*)take((size_t)MTOK * 16 * 4); p.kmean = (float*)take((size_t)256 * 128 * 4);
    p.bar = (unsigned*)take((size_t)XCD_BAR_WORDS * 4);
    p.gst = (float*)take((size_t)1024 * 8192 * 4); p.gdec = (float*)take((size_t)1024 * 64 * 4);
    if (off > ws_size) { fprintf(stderr, "kernel_launch: workspace too small (%zu > %zu)\n", off, ws_size); return; }
#if ONE_LAUNCH
    hipMemsetAsync(p.bar, 0, (size_t)XCD_BAR_WORDS * 4, stream);
    p.phase_lo = 0; p.phase_hi = N_PHASES;
    void* args[] = {&p};
    hipError_t e = hipLaunchCooperativeKernel((const void*)hybrid_fwd, dim3(grid), dim3(512), args, LDS_BYTES, stream);
    if (e != hipSuccess) fprintf(stderr, "cooperative launch failed: %s (grid %d)\n", hipGetErrorString(e), grid);
#else
    for (int ph = 0; ph < N_PHASES; ++ph) { p.phase_lo = ph; p.phase_hi = ph + 1; hipLaunchKernelGGL(hybrid_fwd, dim3(grid), dim3(512), LDS_BYTES, stream, p); }
#endif
}
```

```cpp
#include <hip/hip_runtime.h>
#include <hip/hip_cooperative_groups.h>
#include <cstdio>
namespace cg = cooperative_groups;

#ifndef ONE_LAUNCH
#define ONE_LAUNCH 1
#endif

namespace pg8 {
#define PG8_LAS __attribute__((address_space(3)))
typedef unsigned short bf16_t;
typedef short bf16x8 __attribute__((ext_vector_type(8)));
typedef float f32x4 __attribute__((ext_vector_type(4)));
typedef unsigned u32x4 __attribute__((ext_vector_type(4)));
constexpr int BM = 256, BK = 64, HALF = 128, HTB = HALF * BK * 2  , STAGE_BYTES = 8 * HTB, NXCD = 8, WGM = 8;

__host__ __device__ __forceinline__ int lds_byte(int r, int c) { const int st = (r >> 4) * 2 + (c >> 5), rr = r & 15, cc = c & 31, ob = rr * 64 + cc * 2; return st * 1024 + (ob ^ (((ob >> 9) & 1) << 5)); }
__host__ __device__ __forceinline__ void stage_rc(int b, int& R, int& C) { const int st = b / 1024, sb = b % 1024, swz = sb ^ (((sb >> 9) & 1) << 5); R = (st >> 1) * 16 + swz / 64; C = (st & 1) * 32 + (swz % 64) / 2; }
__host__ __device__ __forceinline__ int perm32(int rho) { const int n = rho >> 4, i = rho & 15; return 8 * (i >> 2) + 4 * n + (i & 3); }

struct Unit { int pm, pn; };
struct Gemm { const bf16_t* A; const bf16_t* Bt; int M, N, K; };

struct StaticOrder {
    int nM, nN, nwg, G, c;
    __host__ __device__ void init(int M, int N, int G_, int c_) { nM = M / BM; nN = N / BM; nwg = nM * nN; G = G_; c = c_; }
    __host__ __device__ bool next(int i, Unit& u) const {
        const long L = (long)i * G + c; if (L >= nwg) return false;
        int wgid = (int)L; { const int q = nwg / NXCD, r = nwg % NXCD, xcd = wgid % NXCD, off = wgid / NXCD; wgid = (xcd < r ? xcd * (q + 1) : r * (q + 1) + (xcd - r) * q) + off; }
        const int nig = WGM * nN, gid = wgid / nig, fm = gid * WGM, gsz = (nM - fm) < WGM ? (nM - fm) : WGM;
        u.pm = fm + ((wgid % nig) % gsz); u.pn = (wgid % nig) / gsz; return true;
    }
    __device__ __forceinline__ void a_ready(const Unit&) const {}
    __device__ __forceinline__ void done(const Unit&) const {}
};
__device__ __forceinline__ unsigned cvt_pk_bf16(float lo, float hi) { unsigned r; asm volatile("v_cvt_pk_bf16_f32 %0, %1, %2" : "=v"(r) : "v"(lo), "v"(hi)); return r; }
template <class Epi, class Sched, bool STAMP = false>
__device__ __forceinline__ void gemm_phase(PG8_LAS unsigned char* lds, const Gemm g, const Sched& S, const Epi& E, unsigned long long* stamps) {
    int tid = threadIdx.x; asm volatile("" : "+v"(tid)); const int wid = __builtin_amdgcn_readfirstlane(tid >> 6), lane = tid & 63, wr = wid >> 2, wc = wid & 3, fr = lane & 15, fq = lane >> 4;
    const int K = g.K, nt = K / BK;
    int ts_lo = 0, ts_hi = 0, nts = 0; const unsigned long long rt_entry = STAMP ? (unsigned long long)wall_clock64() : 0ull;
#define PG8_STAMP() do { if (STAMP && wid == 0 && nts < 64) { const unsigned long long _c = (unsigned long long)clock64(); \
        ts_lo = (lane == nts) ? (int)(unsigned)_c : ts_lo; ts_hi = (lane == nts) ? (int)(unsigned)(_c >> 32) : ts_hi; ++nts; } } while (0)
    PG8_STAMP();
    unsigned voffA[2], voffB[2];
#pragma unroll
    for (int i = 0; i < 2; ++i) { int R, C; stage_rc(tid * 16 + i * 8192, R, C); const int Rb = Epi::PERM ? ((R & ~31) + perm32(R & 31)) : R;
        voffA[i] = (unsigned)(R * K + C) * 2u; voffB[i] = (unsigned)(Rb * K + C) * 2u; }
    const size_t kstep = (size_t)(BK * 2);
    const size_t hstep = (size_t)HALF * K * 2;
    const size_t tstep = 2 * hstep;
    const unsigned ldsw = (unsigned)wid * 1024u;
    const int aoff = lds_byte(wr * 64 + fr, fq * 8), boff = lds_byte(wc * 32 + fr, fq * 8);
#define PG8_SA(b, h) (((b) * 2 + (h)) * HTB)
#define PG8_SB(b, h) ((4 + (b) * 2 + (h)) * HTB)
#define PG8_STAGE(bufoff, gbase, voff) do { _Pragma("unroll") for (int _i = 0; _i < 2; ++_i) \
        __builtin_amdgcn_global_load_lds((const unsigned*)((const char*)(gbase) + (voff)[_i]), (PG8_LAS unsigned*)(lds + (bufoff) + ldsw + _i * 8192), 16, 0, 0); } while (0)
#define PG8_LDA(dst, b, h) do { _Pragma("unroll") for (int m = 0; m < 4; ++m) _Pragma("unroll") for (int k = 0; k < 2; ++k) dst[m][k] = *(const PG8_LAS bf16x8*)(lds + PG8_SA(b, h) + aoff + m * 2048 + k * 1024); } while (0)
#define PG8_LDB(dst, b, h) do { _Pragma("unroll") for (int n = 0; n < 2; ++n) _Pragma("unroll") for (int k = 0; k < 2; ++k) dst[n][k] = *(const PG8_LAS bf16x8*)(lds + PG8_SB(b, h) + boff + n * 2048 + k * 1024); } while (0)
#define PG8_MMA(ai, bj, At, Bt) do { __builtin_amdgcn_s_setprio(1); _Pragma("unroll") for (int m = 0; m < 4; ++m) _Pragma("unroll") for (int n = 0; n < 2; ++n) _Pragma("unroll") for (int k = 0; k < 2; ++k) \
        acc[ai][bj][m][n] = __builtin_amdgcn_mfma_f32_16x16x32_bf16(Bt[n][k], At[m][k], acc[ai][bj][m][n], 0, 0, 0); __builtin_amdgcn_s_setprio(0); } while (0)
#define PG8_WAIT_V(n) asm volatile("s_waitcnt vmcnt(" #n ")" ::: "memory")
#define PG8_WAIT_L(n) asm volatile("s_waitcnt lgkmcnt(" #n ")" ::: "memory")
#define PG8_BAR __builtin_amdgcn_s_barrier()
#define PG8_SCHED __builtin_amdgcn_sched_barrier(0)
    Unit cur, nxt; int ui = 0;
    if (!S.next(0, cur)) return;
    f32x4 acc[2][2][4][2];
#pragma unroll
    for (int a = 0; a < 2; ++a)
#pragma unroll
        for (int b = 0; b < 2; ++b)
#pragma unroll
            for (int m = 0; m < 4; ++m)
#pragma unroll
                for (int n = 0; n < 2; ++n) acc[a][b][m][n] = (f32x4){0.f, 0.f, 0.f, 0.f};
    bf16x8 At[4][2], B0[2][2], B1[2][2];
    const char* cA = (const char*)g.A + (size_t)cur.pm * tstep; const char* cB = (const char*)g.Bt + (size_t)cur.pn * tstep;
    S.a_ready(cur);
    PG8_STAGE(PG8_SB(0, 0), cB, voffB); PG8_STAGE(PG8_SA(0, 0), cA, voffA); PG8_STAGE(PG8_SB(0, 1), cB + hstep, voffB); PG8_STAGE(PG8_SA(0, 1), cA + hstep, voffA);
    if (wr == 1) PG8_BAR;
    PG8_WAIT_V(4); PG8_BAR;
    PG8_STAGE(PG8_SB(1, 0), cB + kstep, voffB); PG8_STAGE(PG8_SA(1, 0), cA + kstep, voffA); PG8_STAGE(PG8_SB(1, 1), cB + hstep + kstep, voffB);
    PG8_WAIT_V(6); PG8_BAR;
    PG8_STAMP();
    for (;;) {
        const bool has_next = S.next(ui + 1, nxt);
        const char* nA = has_next ? (const char*)g.A + (size_t)nxt.pm * tstep : cA; const char* nB = has_next ? (const char*)g.Bt + (size_t)nxt.pn * tstep : cB;
        for (int t = 0; t < nt; t += 2) {
            const bool last = (t == nt - 2);
            const char* a1 = cA + (size_t)(t + 1) * kstep;
            const char* a2 = last ? nA : cA + (size_t)(t + 2) * kstep; const char* b2 = last ? nB : cB + (size_t)(t + 2) * kstep;
            const char* a3 = a2 + kstep; const char* b3 = b2 + kstep;
            if (last && has_next) S.a_ready(nxt);
            PG8_LDB(B0, 0, 0); PG8_SCHED; PG8_LDA(At, 0, 0); PG8_STAGE(PG8_SA(1, 1), a1 + hstep, voffA);
            PG8_WAIT_L(8); PG8_BAR; PG8_WAIT_L(0); PG8_MMA(0, 0, At, B0); PG8_BAR; PG8_SCHED;
            PG8_LDB(B1, 0, 1); PG8_STAGE(PG8_SB(0, 0), b2, voffB);
            PG8_BAR; PG8_WAIT_L(0); PG8_MMA(0, 1, At, B1); PG8_BAR;
            PG8_LDA(At, 0, 1); PG8_STAGE(PG8_SA(0, 0), a2, voffA);
            PG8_BAR; PG8_WAIT_L(0); PG8_MMA(1, 0, At, B0); PG8_BAR; PG8_SCHED;
            PG8_STAGE(PG8_SB(0, 1), b2 + hstep, voffB);
            PG8_WAIT_V(6); PG8_BAR; PG8_MMA(1, 1, At, B1); PG8_BAR;
            PG8_LDB(B0, 1, 0); PG8_SCHED; PG8_LDA(At, 1, 0); PG8_STAGE(PG8_SA(0, 1), a2 + hstep, voffA);
            PG8_WAIT_L(8); PG8_BAR; PG8_WAIT_L(0); PG8_MMA(0, 0, At, B0); PG8_BAR; PG8_SCHED;
            PG8_LDB(B1, 1, 1); PG8_STAGE(PG8_SB(1, 0), b3, voffB);
            PG8_BAR; PG8_WAIT_L(0); PG8_MMA(0, 1, At, B1); PG8_BAR;
            PG8_LDA(At, 1, 1); PG8_STAGE(PG8_SA(1, 0), a3, voffA);
            PG8_BAR; PG8_WAIT_L(0); PG8_MMA(1, 0, At, B0); PG8_BAR; PG8_SCHED;
            PG8_STAGE(PG8_SB(1, 1), b3 + hstep, voffB);
            PG8_WAIT_V(6); PG8_BAR; PG8_MMA(1, 1, At, B1); PG8_BAR;
        }
        PG8_STAMP();
        if constexpr (!Epi::AFTER_DRAIN) { E(acc, cur, wr, wc, fr, fq); S.done(cur); }
        PG8_STAMP();
        if (!has_next) break;
#pragma unroll
        for (int a = 0; a < 2; ++a)
#pragma unroll
            for (int b = 0; b < 2; ++b)
#pragma unroll
                for (int m = 0; m < 4; ++m)
#pragma unroll
                    for (int n = 0; n < 2; ++n) acc[a][b][m][n] = (f32x4){0.f, 0.f, 0.f, 0.f};
        cur = nxt; cA = nA; cB = nB; ++ui;
    }
    PG8_WAIT_V(0);
    if (wr == 0) PG8_BAR;
    PG8_BAR;
    if constexpr (Epi::AFTER_DRAIN) { E.fused(acc, cur, wr, wc, fr, fq, lds, wid, lane); S.done(cur); }
    PG8_STAMP();
    if (STAMP && wid == 0) { stamps[lane] = lane < nts ? (((unsigned long long)(unsigned)ts_hi << 32) | (unsigned)ts_lo) : 0ull;
        if (lane == 62) stamps[62] = rt_entry; if (lane == 63) stamps[63] = (unsigned long long)wall_clock64(); }
#undef PG8_STAMP
#undef PG8_SA
#undef PG8_SB
#undef PG8_STAGE
#undef PG8_LDA
#undef PG8_LDB
#undef PG8_MMA
#undef PG8_WAIT_V
#undef PG8_WAIT_L
#undef PG8_BAR
#undef PG8_SCHED
}
}
using namespace pg8;
#define LAS PG8_LAS
typedef unsigned short u16;
typedef unsigned u32x2 __attribute__((ext_vector_type(2)));
typedef float f32x2 __attribute__((ext_vector_type(2)));

constexpr int NBATCH = 8, SEQ = 2048, DM = 2048, MTOK = NBATCH * SEQ, DIN = 7824, NP = 7936;
constexpr int C_R = 0, C_K = 1024, C_V = 2048, C_WD = 3072, C_GA = 3200, C_QB = 4224, C_KB = 4736, C_VB = 5248, C_GB = 5760,
              C_QC = 6272, C_KC = 6528, C_VC = 6784, C_GC = 7296, C_LOW = 7808;
constexpr int LDS_BYTES = 148480;

struct Params {
    const float *x, *norm_w, *w_in, *w_out, *mu, *w0, *w2, *a0, *a2, *k_k, *k_a, *r_k, *ln_w, *ln_b, *a_up, *a_b, *gnw, *fnw;
    float* out;
    u16 *WtIn, *WtOut, *W2t, *A2t, *H, *P;
    float *yraw, *ybonus, *kmean, *gst, *gdec;
    unsigned* bar;
    int phase_lo, phase_hi;
};

__device__ __forceinline__ int tid_() { int t = threadIdx.x; asm volatile("" : "+v"(t)); return t; }
__device__ __forceinline__ float bf2f(u16 v) { return __uint_as_float(((unsigned)v) << 16); }
__device__ __forceinline__ float bflo(unsigned w) { return __uint_as_float(w << 16); }
__device__ __forceinline__ float bfhi(unsigned w) { return __uint_as_float(w & 0xffff0000u); }
__device__ __forceinline__ u16 f2bf(float f) { return (u16)(cvt_pk_bf16(f, 0.f) & 0xffffu); }
template <int CTRL> __device__ __forceinline__ float dpp_f(float v) { return __int_as_float(__builtin_amdgcn_update_dpp(0, __float_as_int(v), CTRL, 0xF, 0xF, true)); }
__device__ __forceinline__ float red16_sum(float v) { v += dpp_f<0xB1>(v); v += dpp_f<0x4E>(v); v += dpp_f<0x141>(v); v += dpp_f<0x140>(v); return v; }
__device__ __forceinline__ float red8_sum(float v) { v += dpp_f<0xB1>(v); v += dpp_f<0x4E>(v); v += dpp_f<0x141>(v); return v; }
__device__ __forceinline__ float red16_max(float v) { v = fmaxf(v, dpp_f<0xB1>(v)); v = fmaxf(v, dpp_f<0x4E>(v)); v = fmaxf(v, dpp_f<0x141>(v)); v = fmaxf(v, dpp_f<0x140>(v)); return v; }
__device__ __forceinline__ float wave_sum(float v) {
#pragma unroll
    for (int o = 1; o < 64; o <<= 1) v += __shfl_xor(v, o);
    return v;
}
__device__ __forceinline__ float sigmoidf_(float x) { return 1.f / (1.f + __expf(-x)); }
__device__ __forceinline__ float siluf_(float x) { return x / (1.f + __expf(-x)); }
__device__ __forceinline__ float logsigmoidf_(float z) { return fminf(z, 0.f) - log1pf(__expf(-fabsf(z))); }
__device__ __forceinline__ f32x4 mfma16(bf16x8 a, bf16x8 b, f32x4 c) { return __builtin_amdgcn_mfma_f32_16x16x32_bf16(a, b, c, 0, 0, 0); }

struct EpiP {
    static constexpr bool PERM = true, AFTER_DRAIN = false;
    bf16_t* O; int ldc;
    __device__ __forceinline__ void operator()(const f32x4 (&acc)[2][2][4][2], const Unit& u, int wr, int wc, int fr, int fq) const {
        const int row0 = u.pm * BM + wr * 64 + fr, col0 = u.pn * BM + wc * 32 + 8 * fq;
#pragma unroll
        for (int ai = 0; ai < 2; ++ai)
#pragma unroll
            for (int m = 0; m < 4; ++m) { bf16_t* rowp = O + (size_t)(row0 + ai * HALF + m * 16) * ldc + col0;
#pragma unroll
                for (int bj = 0; bj < 2; ++bj) { const f32x4 v0 = acc[ai][bj][m][0], v1 = acc[ai][bj][m][1];
                    u32x4 w; w.x = cvt_pk_bf16(v0[0], v0[1]); w.y = cvt_pk_bf16(v0[2], v0[3]); w.z = cvt_pk_bf16(v1[0], v1[1]); w.w = cvt_pk_bf16(v1[2], v1[3]);
                    *(u32x4*)(rowp + bj * HALF) = w; } }
    }
};
struct EpiRes {
    static constexpr bool PERM = false, AFTER_DRAIN = false;
    const float* R; float* C; int ldc;
    __device__ __forceinline__ void operator()(const f32x4 (&acc)[2][2][4][2], const Unit& u, int wr, int wc, int fr, int fq) const {
        const int row0 = u.pm * BM + wr * 64 + fr, col0 = u.pn * BM + wc * 32 + 4 * fq;
#pragma unroll
        for (int ai = 0; ai < 2; ++ai)
#pragma unroll
            for (int m = 0; m < 4; ++m) { const size_t off = (size_t)(row0 + ai * HALF + m * 16) * ldc + col0;
#pragma unroll
                for (int bj = 0; bj < 2; ++bj)
#pragma unroll
                    for (int n = 0; n < 2; ++n) { const f32x4 r = *(const f32x4*)(R + off + bj * HALF + n * 16); *(f32x4*)(C + off + bj * HALF + n * 16) = acc[ai][bj][m][n] + r; }
                asm volatile("" ::: "memory"); }
    }
};

__device__ void transpose_cvt_range(LAS unsigned char* lds, const float* src, u16* dst, int K, int N, int Npad, int t_begin, int t_end, int t_step) {
    LAS float* tile = (LAS float*)lds;
    const int tilesN = Npad / 64, tid = tid_();
    for (int t = t_begin; t < t_end; t += t_step) {
        const int tn = t % tilesN, tk = t / tilesN, n0 = tn * 64, k0 = tk * 64;
#pragma unroll
        for (int i = 0; i < 2; ++i) { const int idx = tid + i * 512, kk = idx >> 4, n4 = (idx & 15) * 4;
            float4 v = make_float4(0.f, 0.f, 0.f, 0.f);
            if (n0 + n4 < N) v = *(const float4*)(src + (size_t)(k0 + kk) * N + n0 + n4);
            tile[(n4 + 0) * 65 + kk] = v.x; tile[(n4 + 1) * 65 + kk] = v.y; tile[(n4 + 2) * 65 + kk] = v.z; tile[(n4 + 3) * 65 + kk] = v.w; }
        __syncthreads();
        { const int n = tid >> 3, k8 = (tid & 7) * 8; const LAS float* r = tile + n * 65 + k8;
            u32x4 o; o.x = cvt_pk_bf16(r[0], r[1]); o.y = cvt_pk_bf16(r[2], r[3]); o.z = cvt_pk_bf16(r[4], r[5]); o.w = cvt_pk_bf16(r[6], r[7]);
            *(u32x4*)(dst + (size_t)(n0 + n) * K + k0 + k8) = o; }
        __syncthreads();
    }
}
__device__ __forceinline__ void transpose_cvt(LAS unsigned char* lds, const float* src, u16* dst, int K, int N, int Npad, int bid, int nb) {
    transpose_cvt_range(lds, src, dst, K, N, Npad, bid, (Npad / 64) * (K / 64), nb);
}

__device__ void rmsnorm_phase(const float* x, const float* w, u16* hb, float* of, int bid, int nb) {
    const int tid0 = tid_(), wid = tid0 >> 6, lane = tid0 & 63;
    for (int row = bid * 8 + wid; row < MTOK; row += nb * 8) {
        const float4* xr = (const float4*)(x + (size_t)row * DM);
        float4 v[8]; float s = 0.f;
#pragma unroll
        for (int i = 0; i < 8; ++i) { v[i] = xr[i * 64 + lane]; s += v[i].x * v[i].x + v[i].y * v[i].y + v[i].z * v[i].z + v[i].w * v[i].w; }
        s = wave_sum(s);
        const float rs = rsqrtf(s * (1.f / DM) + 1e-6f);
#pragma unroll
        for (int i = 0; i < 8; ++i) { const float4 wv = ((const float4*)w)[i * 64 + lane];
            const float a = v[i].x * rs * wv.x, b = v[i].y * rs * wv.y, c = v[i].z * rs * wv.z, d = v[i].w * rs * wv.w;
            if (hb) { uint2 o; o.x = cvt_pk_bf16(a, b); o.y = cvt_pk_bf16(c, d); *(uint2*)(hb + (size_t)row * DM + (i * 64 + lane) * 4) = o; }
            else { ((float4*)(of + (size_t)row * DM))[i * 64 + lane] = make_float4(a, b, c, d); } }
    }
}

__device__ void kmean_phase(const Params& p, LAS unsigned char* lds, int bid, int nb) {
    LAS float* part = (LAS float*)lds;
    const int tid = tid_();
    for (int task = bid; task < 256; task += nb) {
        const int b = task >> 5, h = (task >> 3) & 3, blk = task & 7;
        const int d8 = (tid & 15) * 8, kg = tid >> 4;
        float s[8];
#pragma unroll
        for (int e = 0; e < 8; ++e) s[e] = 0.f;
        for (int kk = 0; kk < 8; ++kk) {
            const int tok = b * SEQ + blk * 256 + kg * 8 + kk;
            const uint4 v = *(const uint4*)(p.P + (size_t)tok * NP + C_KB + h * 128 + d8);
            s[0] += bflo(v.x); s[1] += bfhi(v.x); s[2] += bflo(v.y); s[3] += bfhi(v.y); s[4] += bflo(v.z); s[5] += bfhi(v.z); s[6] += bflo(v.w); s[7] += bfhi(v.w);
        }
        __syncthreads();
#pragma unroll
        for (int e = 0; e < 8; ++e) part[kg * 128 + d8 + e] = s[e];
        __syncthreads();
        if (tid < 128) { float a = 0.f; for (int g = 0; g < 32; ++g) a += part[g * 128 + tid]; p.kmean[(size_t)task * 128 + tid] = a * (1.f / 256.f); }
    }
    __syncthreads();
}

constexpr int RW_T = 32;
constexpr int RW_XB = 49152;
constexpr int RW_RAW = 98304, RW_A1 = 119808, RW_A2 = 124416, RW_KS = 129024, RW_AS = 137216, RW_MU = 145408, RW_PAR = 146688, RW_FLG = 147968;
__device__ __forceinline__ void rw_issue(const Params& p, int pt, int b, int h, int t0, u32x4 (&rg)[6]) {
#pragma unroll
    for (int i = 0; i < 6; ++i) { const int piece = pt + 256 * i; rg[i] = (u32x4){0u, 0u, 0u, 0u};
        if (piece < 33 * 40) { const int row = piece / 40, pc = piece % 40; const int t = t0 - 1 + row;
            const int col = pc < 8 ? C_R + h * 64 + pc * 8 : pc < 16 ? C_K + h * 64 + (pc - 8) * 8 : pc < 24 ? C_V + h * 64 + (pc - 16) * 8 : C_WD + (pc - 24) * 8;
            if (t >= 0) rg[i] = *(const u32x4*)(p.P + (size_t)(b * SEQ + t) * NP + col); } }
}
__device__ __forceinline__ void prep_bar(volatile LAS unsigned* flg, int pw, int lane, unsigned& ep) {
    ++ep;
    asm volatile("s_waitcnt lgkmcnt(0)" ::: "memory");
    if (lane == 0) flg[pw] = ep;
    for (;;) { const u32x4 f = *(volatile LAS u32x4*)flg; if (f.x >= ep && f.y >= ep && f.z >= ep && f.w >= ep) break; __builtin_amdgcn_s_sleep(2); }
    asm volatile("s_waitcnt lgkmcnt(0)" ::: "memory");
}
__device__ __forceinline__ float red4_sum(float v) { v += dpp_f<0xB1>(v); v += dpp_f<0x4E>(v); return v; }
__device__ __forceinline__ float rs8_sum(const float (&y)[8], bool b2, bool b1, bool b0) {
    float n[4], n2[2];
#pragma unroll
    for (int j = 0; j < 4; ++j) { const float k = b2 ? y[4 + j] : y[j], sd = b2 ? y[j] : y[4 + j]; n[j] = k + dpp_f<0x141>(sd); }
#pragma unroll
    for (int j = 0; j < 2; ++j) { const float k = b1 ? n[2 + j] : n[j], sd = b1 ? n[j] : n[2 + j]; n2[j] = k + dpp_f<0x1B>(sd); }
    const float k = b0 ? n2[1] : n2[0], sd = b0 ? n2[0] : n2[1];
    return k + dpp_f<0xB1>(sd);
}
__device__ void rwkv_scan_task(const Params& p, int l, LAS unsigned char* lds, int task) {
    const int tid = tid_(), wid = tid >> 6, lane = tid & 63;
    LAS u16* raw = (LAS u16*)(lds + RW_RAW); LAS u16* A1 = (LAS u16*)(lds + RW_A1); LAS u16* A2 = (LAS u16*)(lds + RW_A2);
    LAS float* kS = (LAS float*)(lds + RW_KS); LAS float* aS = (LAS float*)(lds + RW_AS);
    LAS float* muS = (LAS float*)(lds + RW_MU); LAS float* parS = (LAS float*)(lds + RW_PAR);
    volatile LAS unsigned* flg = (volatile LAS unsigned*)(lds + RW_FLG);
    {
        const int b = task >> 4, h = task & 15;
        __syncthreads();
        if (tid >= 256 && tid < 260) flg[tid - 256] = 0u;
        __syncthreads();
        if (wid < 4) {
            const int rp = wid * 8 + (lane >> 3), ssub = lane & 7; const bool sb2 = (ssub & 4) != 0, sb1 = (ssub & 2) != 0, sb0 = (ssub & 1) != 0;
            f32x2 SA[4], SB[4];
#pragma unroll
            for (int q = 0; q < 4; ++q) { SA[q] = (f32x2){0.f, 0.f}; SB[q] = (f32x2){0.f, 0.f}; }
            float* yout = p.yraw + (size_t)(b * SEQ + ssub) * 1024 + h * 64 + 2 * rp;
            for (int c = 0; c < SEQ / RW_T; ++c) {
                __syncthreads();
                const LAS float* ob = (const LAS float*)(lds + (c & 1) * RW_XB) + ssub * 8;
                const LAS float* ov = (const LAS float*)(lds + (c & 1) * RW_XB + 40960) + 2 * rp;
                f32x4 nw0 = *(const LAS f32x4*)(ob), nw1 = *(const LAS f32x4*)(ob + 4), na0 = *(const LAS f32x4*)(ob + 2048), na1 = *(const LAS f32x4*)(ob + 2052);
                f32x4 nb0 = *(const LAS f32x4*)(ob + 4096), nb1 = *(const LAS f32x4*)(ob + 4100), nk0 = *(const LAS f32x4*)(ob + 6144), nk1 = *(const LAS f32x4*)(ob + 6148);
                f32x4 nr0 = *(const LAS f32x4*)(ob + 8192), nr1 = *(const LAS f32x4*)(ob + 8196);
                f32x2 nv = *(const LAS f32x2*)(ov);
                float ypA[8], ypB[8];
#pragma unroll
                for (int t = 0; t < RW_T; ++t) {
                    const f32x4 w0 = nw0, w1 = nw1, a0 = na0, a1 = na1, b0 = nb0, b1 = nb1, k0 = nk0, k1 = nk1, r0 = nr0, r1 = nr1; const f32x2 vv = nv;
                    if (t + 1 < RW_T) { const LAS float* o2 = ob + (t + 1) * 64;
                        nw0 = *(const LAS f32x4*)(o2); nw1 = *(const LAS f32x4*)(o2 + 4); na0 = *(const LAS f32x4*)(o2 + 2048); na1 = *(const LAS f32x4*)(o2 + 2052);
                        nb0 = *(const LAS f32x4*)(o2 + 4096); nb1 = *(const LAS f32x4*)(o2 + 4100); nk0 = *(const LAS f32x4*)(o2 + 6144); nk1 = *(const LAS f32x4*)(o2 + 6148);
                        nr0 = *(const LAS f32x4*)(o2 + 8192); nr1 = *(const LAS f32x4*)(o2 + 8196);
                        nv = *(const LAS f32x2*)(ov + (t + 1) * 64); }
                    const f32x2 sA2 = (SA[0] * a0.lo + SA[1] * a0.hi) + (SA[2] * a1.lo + SA[3] * a1.hi);
                    const f32x2 sB2 = (SB[0] * a0.lo + SB[1] * a0.hi) + (SB[2] * a1.lo + SB[3] * a1.hi);
                    const float saA = red8_sum(sA2.x + sA2.y), saB = red8_sum(sB2.x + sB2.y);
                    const f32x2 svA = {saA, saA}, svB = {saB, saB}, vA = {vv.x, vv.x}, vB = {vv.y, vv.y};
                    SA[0] = SA[0] * w0.lo + svA * b0.lo + vA * k0.lo; SA[1] = SA[1] * w0.hi + svA * b0.hi + vA * k0.hi;
                    SA[2] = SA[2] * w1.lo + svA * b1.lo + vA * k1.lo; SA[3] = SA[3] * w1.hi + svA * b1.hi + vA * k1.hi;
                    SB[0] = SB[0] * w0.lo + svB * b0.lo + vB * k0.lo; SB[1] = SB[1] * w0.hi + svB * b0.hi + vB * k0.hi;
                    SB[2] = SB[2] * w1.lo + svB * b1.lo + vB * k1.lo; SB[3] = SB[3] * w1.hi + svB * b1.hi + vB * k1.hi;
                    const f32x2 yA2 = (SA[0] * r0.lo + SA[1] * r0.hi) + (SA[2] * r1.lo + SA[3] * r1.hi);
                    const f32x2 yB2 = (SB[0] * r0.lo + SB[1] * r0.hi) + (SB[2] * r1.lo + SB[3] * r1.hi);
                    ypA[t & 7] = yA2.x + yA2.y; ypB[t & 7] = yB2.x + yB2.y;
                    if ((t & 7) == 7) { f32x2 o = {rs8_sum(ypA, sb2, sb1, sb0), rs8_sum(ypB, sb2, sb1, sb0)}; *(f32x2*)(yout + (size_t)(c * RW_T + (t & ~7)) * 1024) = o; }
                }
            }
        } else {
            const int pt = tid - 256, pw = wid - 4;
            unsigned ep = 0u;
            for (int c2 = pt; c2 < 320; c2 += 256) { const int mi = c2 < 64 ? h * 64 + c2 : c2 < 128 ? 1024 + h * 64 + (c2 - 64) : c2 < 192 ? 2048 + h * 64 + (c2 - 128) : 3072 + (c2 - 192);
                muS[c2] = p.mu[(size_t)l * 3200 + mi]; }
            if (pt < 64) { const size_t o = (size_t)l * 1024 + h * 64 + pt;
                parS[pt] = p.w0[o]; parS[64 + pt] = p.a0[o]; parS[128 + pt] = p.k_k[o]; parS[192 + pt] = p.k_a[o]; parS[256 + pt] = p.r_k[o]; }
            const int mat = pw >> 1, ct0 = (pw & 1) * 2;
            bf16x8 bfr[2][2];
#pragma unroll
            for (int ci = 0; ci < 2; ++ci) { const u16* Bt = (mat ? p.A2t : p.W2t) + (size_t)l * 1024 * 64 + (size_t)(h * 64 + (ct0 + ci) * 16 + (lane & 15)) * 64 + (lane >> 4) * 8;
                bfr[ci][0] = *(const bf16x8*)(Bt); bfr[ci][1] = *(const bf16x8*)(Bt + 32); }
            u32x4 rg[6];
            int goff[6], loff[6];
#pragma unroll
            for (int i = 0; i < 6; ++i) { const int piece = pt + 256 * i, row = piece / 40, pc = piece % 40;
                const int col = pc < 8 ? C_R + h * 64 + pc * 8 : pc < 16 ? C_K + h * 64 + (pc - 8) * 8 : pc < 24 ? C_V + h * 64 + (pc - 16) * 8 : C_WD + (pc - 24) * 8;
                goff[i] = piece < 33 * 40 ? row * NP + col : -1; loff[i] = row * 320 + pc * 8; }
            const u16* pbase = p.P + (size_t)b * SEQ * NP;
#define RW_ISSUE(t0_) do { _Pragma("unroll") for (int i = 0; i < 6; ++i) { rg[i] = (u32x4){0u, 0u, 0u, 0u}; \
                if (goff[i] >= 0 && ((t0_) > 0 || goff[i] >= NP)) rg[i] = *(const u32x4*)(pbase + (ptrdiff_t)((t0_) - 1) * NP + goff[i]); } } while (0)
            RW_ISSUE(0);
            for (int c = 0; c < SEQ / RW_T; ++c) {
                const int t0 = c * RW_T;
                LAS float* opW = (LAS float*)(lds + (c & 1) * RW_XB); LAS float* opA = opW + 2048; LAS float* opB = opW + 4096; LAS float* opK = opW + 6144; LAS float* opR = opW + 8192; LAS float* opV = opW + 10240;
#pragma unroll
                for (int i = 0; i < 6; ++i) { if (goff[i] >= 0) *(LAS u32x4*)(raw + loff[i]) = rg[i]; }
                prep_bar(flg, pw, lane, ep);
                if (c + 1 < SEQ / RW_T) RW_ISSUE(t0 + RW_T);
#pragma unroll
                for (int reg = 0; reg < 5; ++reg)
#pragma unroll
                    for (int i = 0; i < 2; ++i) { const int e = pt + 256 * i, t = e >> 4, qd = e & 15, cc = reg * 64 + 4 * qd;
                        const u32x2 cu = *(const LAS u32x2*)(raw + (t + 1) * 320 + cc), pu = *(const LAS u32x2*)(raw + t * 320 + cc);
                        const f32x4 mu4 = *(const LAS f32x4*)(muS + cc);
                        const f32x4 cur = {bflo(cu.x), bfhi(cu.x), bflo(cu.y), bfhi(cu.y)}, prv = {bflo(pu.x), bfhi(pu.x), bflo(pu.y), bfhi(pu.y)};
                        const f32x4 xs = cur + mu4 * (prv - cur);
                        if (reg == 0) *(LAS f32x4*)(opR + t * 64 + 4 * qd) = xs;
                        else if (reg == 1) *(LAS f32x4*)(kS + t * 64 + 4 * qd) = xs;
                        else if (reg == 2) *(LAS f32x4*)(opV + t * 64 + 4 * qd) = xs;
                        else if (reg == 3) { float th[4];
#pragma unroll
                            for (int q = 0; q < 4; ++q) th[q] = 1.f - 2.f * __builtin_amdgcn_rcpf(__expf(2.f * xs[q]) + 1.f);
                            u32x2 o; o.x = cvt_pk_bf16(th[0], th[1]); o.y = cvt_pk_bf16(th[2], th[3]); *(LAS u32x2*)(A1 + t * 72 + 4 * qd) = o; }
                        else { u32x2 o; o.x = cvt_pk_bf16(xs.x, xs.y); o.y = cvt_pk_bf16(xs.z, xs.w); *(LAS u32x2*)(A2 + t * 72 + 4 * qd) = o; } }
                prep_bar(flg, pw, lane, ep);
                { LAS u16* Ab = mat ? A2 : A1;
#pragma unroll
                    for (int ci = 0; ci < 2; ++ci)
#pragma unroll
                        for (int rt = 0; rt < 2; ++rt) { f32x4 acc = {0.f, 0.f, 0.f, 0.f};
#pragma unroll
                            for (int ks = 0; ks < 2; ++ks) { const bf16x8 af = *(const LAS bf16x8*)(Ab + (rt * 16 + (lane & 15)) * 72 + ks * 32 + (lane >> 4) * 8); acc = mfma16(af, bfr[ci][ks], acc); }
                            const int cc = (ct0 + ci) * 16 + (lane & 15);
#pragma unroll
                            for (int i = 0; i < 4; ++i) { const int t = rt * 16 + (lane >> 4) * 4 + i;
                                if (mat == 0) { float wv = parS[cc] + acc[i]; wv = fminf(wv, 0.f) - __logf(1.f + __expf(-fabsf(wv))) - 0.5f; opW[t * 64 + cc] = __expf(-__expf(wv)); }
                                else aS[t * 64 + cc] = __builtin_amdgcn_rcpf(1.f + __expf(-(parS[64 + cc] + acc[i]))); } } }
                prep_bar(flg, pw, lane, ep);
#pragma unroll
                for (int j = 0; j < 2; ++j) { const int item = pt + 256 * j, t = item >> 4, sub = item & 15, c4 = sub * 4;
                    const f32x4 kr = *(const LAS f32x4*)(kS + t * 64 + c4), av = *(const LAS f32x4*)(aS + t * 64 + c4), rr = *(const LAS f32x4*)(opR + t * 64 + c4);
                    const f32x4 kkp = *(const LAS f32x4*)(parS + 128 + c4), kap = *(const LAS f32x4*)(parS + 192 + c4), rkp = *(const LAS f32x4*)(parS + 256 + c4);
                    f32x4 kk = kr * kkp;
                    float ss = kk.x * kk.x + kk.y * kk.y + kk.z * kk.z + kk.w * kk.w; ss = red16_sum(ss);
                    const float inv = rsqrtf(fmaxf(ss, 1e-24f));
                    kk.x *= inv; kk.y *= inv; kk.z *= inv; kk.w *= inv;
                    const f32x4 km = kr * (1.f + (av - 1.f) * kap);
                    *(LAS f32x4*)(opA + t * 64 + c4) = -kk;
                    *(LAS f32x4*)(opB + t * 64 + c4) = kk * av;
                    *(LAS f32x4*)(opK + t * 64 + c4) = km;
                    float bo = rr.x * km.x * rkp.x + rr.y * km.y * rkp.y + rr.z * km.z * rkp.z + rr.w * km.w * rkp.w; bo = red16_sum(bo);
                    if (sub == 0) p.ybonus[(size_t)(b * SEQ + t0 + t) * 16 + h] = bo; }
                __syncthreads();
            }
        }
    }
    __syncthreads();
}

__device__ void rwkv_post_item(const Params& p, int l, int item) {
    const int tid = tid_(), pair = item * 32 + (tid >> 4), tok = pair >> 4, h = pair & 15, c4 = (tid & 15) * 4;
    const float4 y = *(const float4*)(p.yraw + (size_t)tok * 1024 + h * 64 + c4);
    const float mean = red16_sum(y.x + y.y + y.z + y.w) * (1.f / 64.f);
    const float d0 = y.x - mean, d1 = y.y - mean, d2 = y.z - mean, d3 = y.w - mean;
    const float var = red16_sum(d0 * d0 + d1 * d1 + d2 * d2 + d3 * d3) * (1.f / 64.f);
    const float rs = rsqrtf(var + 64e-5f);
    const size_t po = (size_t)l * 1024 + h * 64 + c4;
    const float4 lw = *(const float4*)(p.ln_w + po), lb = *(const float4*)(p.ln_b + po), muv = *(const float4*)(p.mu + (size_t)l * 3200 + 2048 + h * 64 + c4);
    const uint2 vc = *(const uint2*)(p.P + (size_t)tok * NP + C_V + h * 64 + c4);
    uint2 vp = make_uint2(0u, 0u);
    if ((tok & (SEQ - 1)) != 0) vp = *(const uint2*)(p.P + (size_t)(tok - 1) * NP + C_V + h * 64 + c4);
    const uint2 gg = *(const uint2*)(p.P + (size_t)tok * NP + C_GA + h * 64 + c4);
    const float bo = p.ybonus[(size_t)tok * 16 + h];
    float v0 = bflo(vc.x), v1 = bfhi(vc.x), v2 = bflo(vc.y), v3 = bfhi(vc.y);
    v0 += muv.x * (bflo(vp.x) - v0); v1 += muv.y * (bfhi(vp.x) - v1); v2 += muv.z * (bflo(vp.y) - v2); v3 += muv.w * (bfhi(vp.y) - v3);
    const float o0 = (d0 * rs * lw.x + lb.x + bo * v0) * siluf_(bflo(gg.x)), o1 = (d1 * rs * lw.y + lb.y + bo * v1) * siluf_(bfhi(gg.x));
    const float o2 = (d2 * rs * lw.z + lb.z + bo * v2) * siluf_(bflo(gg.y)), o3 = (d3 * rs * lw.w + lb.w + bo * v3) * siluf_(bfhi(gg.y));
    uint2 o; o.x = cvt_pk_bf16(o0, o1); o.y = cvt_pk_bf16(o2, o3);
    *(uint2*)(p.H + (size_t)tok * DM + h * 64 + c4) = o;
}

__device__ void rwkv_post_task(const Params& p, int l, int task) {
    const int tid = tid_(), h = (tid >> 4) & 15, c4 = (tid & 15) * 4;
    const size_t po = (size_t)l * 1024 + h * 64 + c4;
    const f32x4 lw = *(const f32x4*)(p.ln_w + po), lb = *(const f32x4*)(p.ln_b + po), muv = *(const f32x4*)(p.mu + (size_t)l * 3200 + 2048 + h * 64 + c4);
#pragma unroll 1
    for (int bt = 0; bt < 4; ++bt) {
        f32x4 y[4]; u32x2 vc[4], vp[4], gg[4]; float bo[4];
#pragma unroll
        for (int q = 0; q < 4; ++q) { const int tok = (task * 16 + bt * 4 + q) * 2 + (tid >> 8);
            y[q] = *(const f32x4*)(p.yraw + (size_t)tok * 1024 + h * 64 + c4);
            vc[q] = *(const u32x2*)(p.P + (size_t)tok * NP + C_V + h * 64 + c4);
            vp[q] = (u32x2){0u, 0u};
            if ((tok & (SEQ - 1)) != 0) vp[q] = *(const u32x2*)(p.P + (size_t)(tok - 1) * NP + C_V + h * 64 + c4);
            gg[q] = *(const u32x2*)(p.P + (size_t)tok * NP + C_GA + h * 64 + c4);
            bo[q] = p.ybonus[(size_t)tok * 16 + h]; }
#pragma unroll
        for (int q = 0; q < 4; ++q) { const int tok = (task * 16 + bt * 4 + q) * 2 + (tid >> 8);
            const float mean = red16_sum(y[q].x + y[q].y + y[q].z + y[q].w) * (1.f / 64.f);
            const f32x4 d = y[q] - mean;
            const float var = red16_sum(d.x * d.x + d.y * d.y + d.z * d.z + d.w * d.w) * (1.f / 64.f);
            const float rs = rsqrtf(var + 64e-5f);
            f32x4 v = {bflo(vc[q].x), bfhi(vc[q].x), bflo(vc[q].y), bfhi(vc[q].y)};
            const f32x4 pv = {bflo(vp[q].x), bfhi(vp[q].x), bflo(vp[q].y), bfhi(vp[q].y)};
            v += muv * (pv - v);
            const f32x4 r = d * rs * lw + lb + bo[q] * v;
            u32x2 o; o.x = cvt_pk_bf16(r.x * siluf_(bflo(gg[q].x)), r.y * siluf_(bfhi(gg[q].x))); o.y = cvt_pk_bf16(r.z * siluf_(bflo(gg[q].y)), r.w * siluf_(bfhi(gg[q].y)));
            *(u32x2*)(p.H + (size_t)tok * DM + h * 64 + c4) = o; }
    }
}

constexpr int MB_K = 0, MB_VT = 17408, MB_PW = 35840, MB_KM = 54272, MB_SEL = 57856, MB_TM = 58368;
__device__ void moba_task(const Params& p, LAS unsigned char* lds, int task) {
    const int tid = tid_(), wid = tid >> 6, lane = tid & 63, l15 = lane & 15, lq = lane >> 4;
    const int qt = 15 - (task >> 5), bh = task & 31, b = bh >> 2, h = bh & 3, qblk = qt >> 1, q0 = qt * 128;
    LAS u16* Kt = (LAS u16*)(lds + MB_K); LAS u16* VT = (LAS u16*)(lds + MB_VT); LAS u16* Pw = (LAS u16*)(lds + MB_PW) + wid * 16 * 72;
    LAS float* kmS = (LAS float*)(lds + MB_KM); LAS int* selS = (LAS int*)(lds + MB_SEL); LAS int* tmS = (LAS int*)(lds + MB_TM);
    __syncthreads();
    for (int i = tid; i < qblk * 128; i += 512) kmS[i] = p.kmean[(size_t)(bh * 8) * 128 + i];
    if (tid == 0) *tmS = 0;
    __syncthreads();
    if (tid < 128) {
        const u16* qp = p.P + (size_t)(b * SEQ + q0 + tid) * NP + C_QB + h * 128;
        float g[7];
#pragma unroll
        for (int j = 0; j < 7; ++j) g[j] = 0.f;
        for (int d8 = 0; d8 < 128; d8 += 8) {
            const uint4 v = *(const uint4*)(qp + d8);
            const float q[8] = {bflo(v.x), bfhi(v.x), bflo(v.y), bfhi(v.y), bflo(v.z), bfhi(v.z), bflo(v.w), bfhi(v.w)};
#pragma unroll
            for (int j = 0; j < 7; ++j) if (j < qblk) {
#pragma unroll
                for (int e = 0; e < 8; ++e) g[j] += q[e] * kmS[j * 128 + d8 + e]; }
        }
        int mask = 0;
#pragma unroll
        for (int r = 0; r < 3; ++r) { float best = -INFINITY; int bi = -1;
#pragma unroll
            for (int j = 0; j < 7; ++j) if (j < qblk && !((mask >> j) & 1) && g[j] > best) { best = g[j]; bi = j; }
            if (bi >= 0) mask |= 1 << bi; }
        mask |= 1 << qblk;
        selS[tid] = mask; atomicOr((int*)tmS, mask);
    }
    __syncthreads();
    const int tmask = *tmS;
    bf16x8 qf[4];
    { const u16* qp = p.P + (size_t)(b * SEQ + q0 + wid * 16 + l15) * NP + C_QB + h * 128 + lq * 8;
#pragma unroll
        for (int ks = 0; ks < 4; ++ks) qf[ks] = *(const bf16x8*)(qp + ks * 32); }
    int rm[4]; int wmask = 0;
#pragma unroll
    for (int i = 0; i < 4; ++i) rm[i] = selS[wid * 16 + lq * 4 + i];
    for (int i = 0; i < 16; ++i) wmask |= selS[wid * 16 + i];
    float m[4], ls[4]; f32x4 O[8];
#pragma unroll
    for (int i = 0; i < 4; ++i) { m[i] = -1e30f; ls[i] = 0.f; }
#pragma unroll
    for (int dt = 0; dt < 8; ++dt) O[dt] = (f32x4){0.f, 0.f, 0.f, 0.f};
    const float sc2 = 0.08838834764831845f * 1.4426950408889634f;
    const int last = (q0 + 127) >> 6;
    const int kp = lane & 31, vd8 = (wid * 2 + (lane >> 5)) * 8;
    struct Stage { u32x4 k0, k1, v0, v1; };
    auto issue = [&](Stage& R, int tt) {
        const size_t kb_ = (size_t)(b * SEQ + tt * 64);
        R.k0 = *(const u32x4*)(p.P + (kb_ + (tid >> 4)) * NP + C_KB + h * 128 + (tid & 15) * 8); R.k1 = *(const u32x4*)(p.P + (kb_ + 32 + (tid >> 4)) * NP + C_KB + h * 128 + (tid & 15) * 8);
        R.v0 = *(const u32x4*)(p.P + (kb_ + 2 * kp) * NP + C_VB + h * 128 + vd8); R.v1 = *(const u32x4*)(p.P + (kb_ + 2 * kp + 1) * NP + C_VB + h * 128 + vd8); };
    auto nextv = [&](int t) { ++t; while (t <= last && !((tmask >> (t >> 2)) & 1)) ++t; return t; };
    auto stage = [&](const Stage& R) {
        { const int ka = tid >> 4, kb2 = 32 + (tid >> 4);
          *(LAS u32x4*)(Kt + ((ka & 3) * 16 + (ka >> 2)) * 136 + (tid & 15) * 8) = R.k0; *(LAS u32x4*)(Kt + ((kb2 & 3) * 16 + (kb2 >> 2)) * 136 + (tid & 15) * 8) = R.k1; }
        LAS unsigned* vt = (LAS unsigned*)(VT + vd8 * 72 + 2 * kp);
        vt[0] = (R.v0.x & 0xffffu) | (R.v1.x << 16); vt[36] = (R.v0.x >> 16) | (R.v1.x & 0xffff0000u);
        vt[72] = (R.v0.y & 0xffffu) | (R.v1.y << 16); vt[108] = (R.v0.y >> 16) | (R.v1.y & 0xffff0000u);
        vt[144] = (R.v0.z & 0xffffu) | (R.v1.z << 16); vt[180] = (R.v0.z >> 16) | (R.v1.z & 0xffff0000u);
        vt[216] = (R.v0.w & 0xffffu) | (R.v1.w << 16); vt[252] = (R.v0.w >> 16) | (R.v1.w & 0xffff0000u); };
    auto compute = [&](int ti) {
        const int j = ti >> 2, key0 = ti * 64, qw0 = q0 + wid * 16;
        const bool own = (j == qblk);
        if (((wmask >> j) & 1) && !(own && key0 > qw0 + 15)) {
            f32x4 s[4];
#pragma unroll
            for (int nt = 0; nt < 4; ++nt) { s[nt] = (f32x4){0.f, 0.f, 0.f, 0.f};
#pragma unroll
                for (int ks = 0; ks < 4; ++ks) { const bf16x8 kf = *(const LAS bf16x8*)(Kt + (nt * 16 + l15) * 136 + ks * 32 + lq * 8); s[nt] = mfma16(qf[ks], kf, s[nt]); } }
            const bool diag = own && (key0 + 63 > qw0);
#pragma unroll
            for (int i = 0; i < 4; ++i) {
                const int qpos = qw0 + lq * 4 + i;
                const float bias = (own || ((rm[i] >> j) & 1)) ? 0.f : -3e30f;
                float sv[4];
#pragma unroll
                for (int nt = 0; nt < 4; ++nt) sv[nt] = s[nt][i] * sc2 + bias;
                if (diag) {
#pragma unroll
                    for (int nt = 0; nt < 4; ++nt) sv[nt] = (key0 + l15 * 4 + nt <= qpos) ? sv[nt] : -3e30f; }
                float mx = fmaxf(fmaxf(sv[0], sv[1]), fmaxf(sv[2], sv[3]));
                mx = red16_max(mx);
                const float mnew = fmaxf(m[i], mx), alpha = __builtin_amdgcn_exp2f(m[i] - mnew);
                const float p0 = __builtin_amdgcn_exp2f(sv[0] - mnew), p1 = __builtin_amdgcn_exp2f(sv[1] - mnew), p2 = __builtin_amdgcn_exp2f(sv[2] - mnew), p3 = __builtin_amdgcn_exp2f(sv[3] - mnew);
                u32x2 pw; pw.x = cvt_pk_bf16(p0, p1); pw.y = cvt_pk_bf16(p2, p3);
                *(LAS u32x2*)(Pw + (lq * 4 + i) * 72 + l15 * 4) = pw;
                const float rs = red16_sum((p0 + p1) + (p2 + p3));
                ls[i] = ls[i] * alpha + rs; m[i] = mnew;
#pragma unroll
                for (int dt = 0; dt < 8; ++dt) O[dt][i] *= alpha;
            }
            __builtin_amdgcn_wave_barrier();
            bf16x8 pf[2];
#pragma unroll
            for (int ks = 0; ks < 2; ++ks) pf[ks] = *(const LAS bf16x8*)(Pw + l15 * 72 + ks * 32 + lq * 8);
#pragma unroll
            for (int dt = 0; dt < 8; ++dt)
#pragma unroll
                for (int ks = 0; ks < 2; ++ks) { const bf16x8 vf = *(const LAS bf16x8*)(VT + (dt * 16 + l15) * 72 + ks * 32 + lq * 8); O[dt] = mfma16(pf[ks], vf, O[dt]); }
            __builtin_amdgcn_wave_barrier();
        } };
    Stage R0, R1;
    int ta = 0;
    while (ta <= last && !((tmask >> (ta >> 2)) & 1)) ++ta;
    int tb = nextv(ta);
    if (ta <= last) issue(R0, ta);
    if (tb <= last) issue(R1, tb);
    while (ta <= last) {
        int tc = nextv(tb);
        __syncthreads(); stage(R0); __syncthreads();
        if (tc <= last) issue(R0, tc);
        compute(ta);
        if (tb > last) break;
        int td = nextv(tc);
        __syncthreads(); stage(R1); __syncthreads();
        if (td <= last) issue(R1, td);
        compute(tb);
        ta = tc; tb = td;
    }
#pragma unroll
    for (int i = 0; i < 4; ++i) { const float inv = 1.f / ls[i]; const size_t tok = (size_t)(b * SEQ + q0 + wid * 16 + lq * 4 + i);
#pragma unroll
        for (int dt = 0; dt < 8; ++dt) { const int d = dt * 16 + l15;
            const float g = bf2f(p.P[tok * NP + C_GB + h * 128 + d]);
            p.H[tok * DM + 1024 + h * 128 + d] = f2bf(O[dt][i] * inv * siluf_(g)); } }
}

constexpr int GL_QE = 0, GL_KE = 9216, GL_KDT = 18432, GL_VT = 27648, GL_ATT = 46080, GL_ST = 55296, GL_LA = 73728, GL_TOT = 90112,
              GL_AUP = 92160, GL_LOW = 96256, GL_DEC = 100352, GL_ABS = 100608, GL_GNW = 100864, GL_OB = 0;
__device__ void gla_chunk(const Params& p, int l, LAS unsigned char* lds, int bh, int n, int pass) {
    const int tid = tid_(), wid = tid >> 6, lane = tid & 63, l15 = lane & 15, lq = lane >> 4;
    const int b = bh >> 2, h = bh & 3;
    LAS u16* QE = (LAS u16*)(lds + GL_QE); LAS u16* KE = (LAS u16*)(lds + GL_KE); LAS u16* KDT = (LAS u16*)(lds + GL_KDT); LAS u16* VT = (LAS u16*)(lds + GL_VT);
    LAS u16* ATT = (LAS u16*)(lds + GL_ATT); LAS u16* ST = (LAS u16*)(lds + GL_ST); LAS float* LA = (LAS float*)(lds + GL_LA); LAS float* TOT = (LAS float*)(lds + GL_TOT);
    LAS float* AUP = (LAS float*)(lds + GL_AUP); LAS float* LOW = (LAS float*)(lds + GL_LOW); LAS float* DEC = (LAS float*)(lds + GL_DEC); LAS float* OB = (LAS float*)(lds + GL_OB); LAS float* ABS = (LAS float*)(lds + GL_ABS); LAS float* GNW = (LAS float*)(lds + GL_GNW);
    __syncthreads();
    for (int i = tid; i < 1024; i += 512) AUP[i] = p.a_up[(size_t)l * 16 * 256 + (i >> 6) * 256 + h * 64 + (i & 63)];
    if (tid < 64) ABS[tid] = p.a_b[(size_t)l * 256 + h * 64 + tid];
    if (tid >= 64 && tid < 192) GNW[tid - 64] = p.gnw[(size_t)l * 128 + tid - 64];
    const int rt = wid >> 1, dv0t = (wid & 1) * 4;
    const int tp = lane & 31, dg = wid * 2 + (lane >> 5);
    {
        const size_t tokb = (size_t)(b * SEQ + n * 64);
        const u16* rowp = p.P + (tokb + (tid >> 3)) * NP;
        const u16* rp0 = p.P + (tokb + 2 * tp) * NP; const u16* rp1 = rp0 + NP;
        const unsigned c_low = *(const unsigned*)(rowp + C_LOW + (tid & 7) * 2);
        const u32x2 c_q0 = *(const u32x2*)(rp0 + C_QC + h * 64 + dg * 4), c_q1 = *(const u32x2*)(rp1 + C_QC + h * 64 + dg * 4);
        const u32x2 c_k0 = *(const u32x2*)(rp0 + C_KC + h * 64 + dg * 4), c_k1 = *(const u32x2*)(rp1 + C_KC + h * 64 + dg * 4);
        const u32x4 c_v0 = *(const u32x4*)(rp0 + C_VC + h * 128 + dg * 8), c_v1 = *(const u32x4*)(rp1 + C_VC + h * 128 + dg * 8);
        const u32x4 c_g0 = *(const u32x4*)(rowp + C_GC + h * 128 + (tid & 7) * 16), c_g1 = *(const u32x4*)(rowp + C_GC + h * 128 + (tid & 7) * 16 + 8);
        { const int e2 = tid * 2, t = e2 >> 4, r = e2 & 15; LOW[t * 16 + r] = bflo(c_low); LOW[t * 16 + r + 1] = bfhi(c_low); }
        __syncthreads();
        { const int t = tid >> 3, d0 = (tid & 7) * 8;
            f32x4 lo[4];
#pragma unroll
            for (int i = 0; i < 4; ++i) lo[i] = *(const LAS f32x4*)(LOW + t * 16 + 4 * i);
            f32x4 z0 = *(const LAS f32x4*)(ABS + d0), z1 = *(const LAS f32x4*)(ABS + d0 + 4);
#pragma unroll
            for (int r = 0; r < 16; ++r) { const f32x4 u0 = *(const LAS f32x4*)(AUP + r * 64 + d0), u1 = *(const LAS f32x4*)(AUP + r * 64 + d0 + 4);
                const float lv = lo[r >> 2][r & 3]; z0 += lv * u0; z1 += lv * u1; }
#pragma unroll
            for (int e = 0; e < 4; ++e) { z0[e] = (fminf(z0[e], 0.f) - __logf(1.f + __expf(-fabsf(z0[e])))) * (1.f / 16.f); z1[e] = (fminf(z1[e], 0.f) - __logf(1.f + __expf(-fabsf(z1[e])))) * (1.f / 16.f); }
            *(LAS f32x4*)(LA + t * 64 + d0) = z0; *(LAS f32x4*)(LA + t * 64 + d0 + 4) = z1; }
        __syncthreads();
        { float a = 0.f;
#pragma unroll
            for (int tt = 0; tt < 8; ++tt) { a += LA[(wid * 8 + tt) * 64 + lane]; LA[(wid * 8 + tt) * 64 + lane] = a; }
            TOT[wid * 64 + lane] = a; }
        __syncthreads();
        { const int t0 = 2 * tp, wt = tp >> 2, d0 = dg * 4;
            f32x4 off = {0.f, 0.f, 0.f, 0.f}, tot = {0.f, 0.f, 0.f, 0.f};
#pragma unroll
            for (int w2 = 0; w2 < 8; ++w2) { const f32x4 tv = *(const LAS f32x4*)(TOT + w2 * 64 + d0); tot += tv; off += (w2 < wt) ? tv : (f32x4){0.f, 0.f, 0.f, 0.f}; }
            const f32x4 b0 = *(const LAS f32x4*)(LA + t0 * 64 + d0) + off, b1 = *(const LAS f32x4*)(LA + (t0 + 1) * 64 + d0) + off;
            const float q0[4] = {bflo(c_q0.x), bfhi(c_q0.x), bflo(c_q0.y), bfhi(c_q0.y)}, q1[4] = {bflo(c_q1.x), bfhi(c_q1.x), bflo(c_q1.y), bfhi(c_q1.y)};
            const float k0[4] = {bflo(c_k0.x), bfhi(c_k0.x), bflo(c_k0.y), bfhi(c_k0.y)}, k1[4] = {bflo(c_k1.x), bfhi(c_k1.x), bflo(c_k1.y), bfhi(c_k1.y)};
            float qe0[4], qe1[4], ke0[4], ke1[4];
#pragma unroll
            for (int e = 0; e < 4; ++e) {
                qe0[e] = q0[e] * 0.125f * __expf(b0[e]); qe1[e] = q1[e] * 0.125f * __expf(b1[e]);
                ke0[e] = k0[e] * __expf(-b0[e]); ke1[e] = k1[e] * __expf(-b1[e]);
                *(LAS unsigned*)(KDT + (d0 + e) * 72 + t0) = cvt_pk_bf16(k0[e] * __expf(tot[e] - b0[e]), k1[e] * __expf(tot[e] - b1[e]));
                if (tp == 0) DEC[d0 + e] = __expf(tot[e]); }
            u32x2 o; o.x = cvt_pk_bf16(qe0[0], qe0[1]); o.y = cvt_pk_bf16(qe0[2], qe0[3]); *(LAS u32x2*)(QE + t0 * 72 + d0) = o;
            o.x = cvt_pk_bf16(qe1[0], qe1[1]); o.y = cvt_pk_bf16(qe1[2], qe1[3]); *(LAS u32x2*)(QE + (t0 + 1) * 72 + d0) = o;
            o.x = cvt_pk_bf16(ke0[0], ke0[1]); o.y = cvt_pk_bf16(ke0[2], ke0[3]); *(LAS u32x2*)(KE + t0 * 72 + d0) = o;
            o.x = cvt_pk_bf16(ke1[0], ke1[1]); o.y = cvt_pk_bf16(ke1[2], ke1[3]); *(LAS u32x2*)(KE + (t0 + 1) * 72 + d0) = o;
            { LAS unsigned* vt = (LAS unsigned*)(VT + dg * 8 * 72 + t0);
                vt[0] = (c_v0.x & 0xffffu) | (c_v1.x << 16); vt[36] = (c_v0.x >> 16) | (c_v1.x & 0xffff0000u);
                vt[72] = (c_v0.y & 0xffffu) | (c_v1.y << 16); vt[108] = (c_v0.y >> 16) | (c_v1.y & 0xffff0000u);
                vt[144] = (c_v0.z & 0xffffu) | (c_v1.z << 16); vt[180] = (c_v0.z >> 16) | (c_v1.z & 0xffff0000u);
                vt[216] = (c_v0.w & 0xffffu) | (c_v1.w << 16); vt[252] = (c_v0.w >> 16) | (c_v1.w & 0xffff0000u); } }
        __syncthreads();
        if (pass == 1) {
            bf16x8 kd[2];
#pragma unroll
            for (int ks = 0; ks < 2; ++ks) kd[ks] = *(const LAS bf16x8*)(KDT + (rt * 16 + l15) * 72 + ks * 32 + lq * 8);
            f32x4* gout = (f32x4*)(p.gst + ((size_t)(bh * 32 + n) * 512 + tid) * 16);
#pragma unroll
            for (int c = 0; c < 4; ++c) { const int dvt = dv0t + c; f32x4 acc = {0.f, 0.f, 0.f, 0.f};
#pragma unroll
                for (int ks = 0; ks < 2; ++ks) { const bf16x8 vf = *(const LAS bf16x8*)(VT + (dvt * 16 + l15) * 72 + ks * 32 + lq * 8); acc = mfma16(kd[ks], vf, acc); }
                gout[c] = acc; }
            if (tid < 64) p.gdec[(size_t)(bh * 32 + n) * 64 + tid] = DEC[tid];
            return;
        }
        { bf16x8 af[2];
#pragma unroll
            for (int ks = 0; ks < 2; ++ks) af[ks] = *(const LAS bf16x8*)(QE + (rt * 16 + l15) * 72 + ks * 32 + lq * 8);
#pragma unroll
            for (int c2 = 0; c2 < 2; ++c2) { const int ctile = (wid & 1) * 2 + c2; f32x4 acc = {0.f, 0.f, 0.f, 0.f};
#pragma unroll
                for (int ks = 0; ks < 2; ++ks) { const bf16x8 bf = *(const LAS bf16x8*)(KE + (ctile * 16 + l15) * 72 + ks * 32 + lq * 8); acc = mfma16(af[ks], bf, acc); }
#pragma unroll
                for (int i = 0; i < 4; ++i) { const int t = rt * 16 + lq * 4 + i, jj = ctile * 16 + l15; ATT[t * 72 + jj] = f2bf(jj <= t ? acc[i] : 0.f); } } }
        { f32x4 S[4];
#pragma unroll
            for (int c = 0; c < 4; ++c) S[c] = (f32x4){0.f, 0.f, 0.f, 0.f};
#pragma unroll 2
            for (int m = 0; m < n; ++m) { const f32x4* gin = (const f32x4*)(p.gst + ((size_t)(bh * 32 + m) * 512 + tid) * 16);
                const f32x4 dm = *(const f32x4*)(p.gdec + (size_t)(bh * 32 + m) * 64 + rt * 16 + lq * 4);
#pragma unroll
                for (int c = 0; c < 4; ++c) S[c] = S[c] * dm + gin[c]; }
#pragma unroll
            for (int c = 0; c < 4; ++c) { const int dv = (dv0t + c) * 16 + l15;
                u32x2 sv; sv.x = cvt_pk_bf16(S[c][0], S[c][1]); sv.y = cvt_pk_bf16(S[c][2], S[c][3]);
                *(LAS u32x2*)(ST + dv * 72 + rt * 16 + lq * 4) = sv; } }
        __syncthreads();
        f32x4 oacc[4];
        { bf16x8 at[2], qf[2];
#pragma unroll
            for (int ks = 0; ks < 2; ++ks) { at[ks] = *(const LAS bf16x8*)(ATT + (rt * 16 + l15) * 72 + ks * 32 + lq * 8); qf[ks] = *(const LAS bf16x8*)(QE + (rt * 16 + l15) * 72 + ks * 32 + lq * 8); }
#pragma unroll
            for (int c = 0; c < 4; ++c) { const int dvt = dv0t + c; f32x4 acc = {0.f, 0.f, 0.f, 0.f};
#pragma unroll
                for (int ks = 0; ks < 2; ++ks) { const bf16x8 vf = *(const LAS bf16x8*)(VT + (dvt * 16 + l15) * 72 + ks * 32 + lq * 8), sf = *(const LAS bf16x8*)(ST + (dvt * 16 + l15) * 72 + ks * 32 + lq * 8);
                    acc = mfma16(at[ks], vf, acc); acc = mfma16(qf[ks], sf, acc); }
                oacc[c] = acc; } }
        __syncthreads();
#pragma unroll
        for (int c = 0; c < 4; ++c) { const int dv = (dv0t + c) * 16 + l15;
#pragma unroll
            for (int i = 0; i < 4; ++i) OB[(rt * 16 + lq * 4 + i) * 132 + dv] = oacc[c][i]; }
        __syncthreads();
        { const int t = tid >> 3, dvb = (tid & 7) * 16;
            f32x4 o4[4]; float ss = 0.f;
#pragma unroll
            for (int i = 0; i < 4; ++i) { o4[i] = *(const LAS f32x4*)(OB + t * 132 + dvb + 4 * i); ss += o4[i].x * o4[i].x + o4[i].y * o4[i].y + o4[i].z * o4[i].z + o4[i].w * o4[i].w; }
            ss = red8_sum(ss);
            const float rs = rsqrtf(ss * (1.f / 128.f) + 1e-6f);
            const float g[16] = {bflo(c_g0.x), bfhi(c_g0.x), bflo(c_g0.y), bfhi(c_g0.y), bflo(c_g0.z), bfhi(c_g0.z), bflo(c_g0.w), bfhi(c_g0.w),
                                 bflo(c_g1.x), bfhi(c_g1.x), bflo(c_g1.y), bfhi(c_g1.y), bflo(c_g1.z), bfhi(c_g1.z), bflo(c_g1.w), bfhi(c_g1.w)};
            float r[16];
#pragma unroll
            for (int e = 0; e < 16; ++e) r[e] = o4[e >> 2][e & 3] * rs * GNW[dvb + e] * siluf_(g[e]);
            u32x4 w0, w1; w0.x = cvt_pk_bf16(r[0], r[1]); w0.y = cvt_pk_bf16(r[2], r[3]); w0.z = cvt_pk_bf16(r[4], r[5]); w0.w = cvt_pk_bf16(r[6], r[7]);
            w1.x = cvt_pk_bf16(r[8], r[9]); w1.y = cvt_pk_bf16(r[10], r[11]); w1.z = cvt_pk_bf16(r[12], r[13]); w1.w = cvt_pk_bf16(r[14], r[15]);
            u16* op = p.H + (tokb + t) * DM + 1536 + h * 128 + dvb;
            *(u32x4*)op = w0; *(u32x4*)(op + 8) = w1; }
    }
}

__device__ void gla_task(const Params& p, int l, LAS unsigned char* lds, int bh, int hs, int nlen) {
    const int tid = tid_(), wid = tid >> 6, lane = tid & 63, l15 = lane & 15, lq = lane >> 4;
    const int b = bh >> 2, h = bh & 3;
    LAS u16* QE = (LAS u16*)(lds + GL_QE); LAS u16* KE = (LAS u16*)(lds + GL_KE); LAS u16* KDT = (LAS u16*)(lds + GL_KDT); LAS u16* VT = (LAS u16*)(lds + GL_VT);
    LAS u16* ATT = (LAS u16*)(lds + GL_ATT); LAS u16* ST = (LAS u16*)(lds + GL_ST); LAS float* LA = (LAS float*)(lds + GL_LA); LAS float* TOT = (LAS float*)(lds + GL_TOT);
    LAS float* AUP = (LAS float*)(lds + GL_AUP); LAS float* LOW = (LAS float*)(lds + GL_LOW); LAS float* DEC = (LAS float*)(lds + GL_DEC); LAS float* OB = (LAS float*)(lds + GL_OB); LAS float* ABS = (LAS float*)(lds + GL_ABS); LAS float* GNW = (LAS float*)(lds + GL_GNW);
    __syncthreads();
    for (int i = tid; i < 1024; i += 512) AUP[i] = p.a_up[(size_t)l * 16 * 256 + (i >> 6) * 256 + h * 64 + (i & 63)];
    for (int i = tid; i < 128 * 72 / 2; i += 512) ((LAS unsigned*)ST)[i] = 0u;
    if (tid < 64) ABS[tid] = p.a_b[(size_t)l * 256 + h * 64 + tid];
    if (tid >= 64 && tid < 192) GNW[tid - 64] = p.gnw[(size_t)l * 128 + tid - 64];
    f32x4 Sacc[4];
#pragma unroll
    for (int c = 0; c < 4; ++c) Sacc[c] = (f32x4){0.f, 0.f, 0.f, 0.f};
    const int rt = wid >> 1, dv0t = (wid & 1) * 4;
    const int tp = lane & 31, dg = wid * 2 + (lane >> 5);
    if (hs) {
#pragma unroll 2
        for (int m = 0; m < 16; ++m) { const f32x4* gin = (const f32x4*)(p.gst + ((size_t)(bh * 32 + m) * 512 + tid) * 16);
            const f32x4 dm = *(const f32x4*)(p.gdec + (size_t)(bh * 32 + m) * 64 + rt * 16 + lq * 4);
#pragma unroll
            for (int c = 0; c < 4; ++c) Sacc[c] = Sacc[c] * dm + gin[c]; }
        __syncthreads();
#pragma unroll
        for (int c = 0; c < 4; ++c) { const int dv = (dv0t + c) * 16 + l15;
            u32x2 sv; sv.x = cvt_pk_bf16(Sacc[c][0], Sacc[c][1]); sv.y = cvt_pk_bf16(Sacc[c][2], Sacc[c][3]);
            *(LAS u32x2*)(ST + dv * 72 + rt * 16 + lq * 4) = sv; }
    }
    for (int n = hs * 16; n < hs * 16 + nlen; ++n) {
        const size_t tokb = (size_t)(b * SEQ + n * 64);
        const u16* rowp = p.P + (tokb + (tid >> 3)) * NP;
        const u16* rp0 = p.P + (tokb + 2 * tp) * NP; const u16* rp1 = rp0 + NP;
        const unsigned c_low = *(const unsigned*)(rowp + C_LOW + (tid & 7) * 2);
        const u32x2 c_q0 = *(const u32x2*)(rp0 + C_QC + h * 64 + dg * 4), c_q1 = *(const u32x2*)(rp1 + C_QC + h * 64 + dg * 4);
        const u32x2 c_k0 = *(const u32x2*)(rp0 + C_KC + h * 64 + dg * 4), c_k1 = *(const u32x2*)(rp1 + C_KC + h * 64 + dg * 4);
        const u32x4 c_v0 = *(const u32x4*)(rp0 + C_VC + h * 128 + dg * 8), c_v1 = *(const u32x4*)(rp1 + C_VC + h * 128 + dg * 8);
        const u32x4 c_g0 = *(const u32x4*)(rowp + C_GC + h * 128 + (tid & 7) * 16), c_g1 = *(const u32x4*)(rowp + C_GC + h * 128 + (tid & 7) * 16 + 8);
        { const int e2 = tid * 2, t = e2 >> 4, r = e2 & 15; LOW[t * 16 + r] = bflo(c_low); LOW[t * 16 + r + 1] = bfhi(c_low); }
        __syncthreads();
        { const int t = tid >> 3, d0 = (tid & 7) * 8;
            f32x4 lo[4];
#pragma unroll
            for (int i = 0; i < 4; ++i) lo[i] = *(const LAS f32x4*)(LOW + t * 16 + 4 * i);
            f32x4 z0 = *(const LAS f32x4*)(ABS + d0), z1 = *(const LAS f32x4*)(ABS + d0 + 4);
#pragma unroll
            for (int r = 0; r < 16; ++r) { const f32x4 u0 = *(const LAS f32x4*)(AUP + r * 64 + d0), u1 = *(const LAS f32x4*)(AUP + r * 64 + d0 + 4);
                const float lv = lo[r >> 2][r & 3]; z0 += lv * u0; z1 += lv * u1; }
#pragma unroll
            for (int e = 0; e < 4; ++e) { z0[e] = (fminf(z0[e], 0.f) - __logf(1.f + __expf(-fabsf(z0[e])))) * (1.f / 16.f); z1[e] = (fminf(z1[e], 0.f) - __logf(1.f + __expf(-fabsf(z1[e])))) * (1.f / 16.f); }
            *(LAS f32x4*)(LA + t * 64 + d0) = z0; *(LAS f32x4*)(LA + t * 64 + d0 + 4) = z1; }
        __syncthreads();
        { float a = 0.f;
#pragma unroll
            for (int tt = 0; tt < 8; ++tt) { a += LA[(wid * 8 + tt) * 64 + lane]; LA[(wid * 8 + tt) * 64 + lane] = a; }
            TOT[wid * 64 + lane] = a; }
        __syncthreads();
        { const int t0 = 2 * tp, wt = tp >> 2, d0 = dg * 4;
            f32x4 off = {0.f, 0.f, 0.f, 0.f}, tot = {0.f, 0.f, 0.f, 0.f};
#pragma unroll
            for (int w2 = 0; w2 < 8; ++w2) { const f32x4 tv = *(const LAS f32x4*)(TOT + w2 * 64 + d0); tot += tv; off += (w2 < wt) ? tv : (f32x4){0.f, 0.f, 0.f, 0.f}; }
            const f32x4 b0 = *(const LAS f32x4*)(LA + t0 * 64 + d0) + off, b1 = *(const LAS f32x4*)(LA + (t0 + 1) * 64 + d0) + off;
            const float q0[4] = {bflo(c_q0.x), bfhi(c_q0.x), bflo(c_q0.y), bfhi(c_q0.y)}, q1[4] = {bflo(c_q1.x), bfhi(c_q1.x), bflo(c_q1.y), bfhi(c_q1.y)};
            const float k0[4] = {bflo(c_k0.x), bfhi(c_k0.x), bflo(c_k0.y), bfhi(c_k0.y)}, k1[4] = {bflo(c_k1.x), bfhi(c_k1.x), bflo(c_k1.y), bfhi(c_k1.y)};
            float qe0[4], qe1[4], ke0[4], ke1[4];
#pragma unroll
            for (int e = 0; e < 4; ++e) {
                qe0[e] = q0[e] * 0.125f * __expf(b0[e]); qe1[e] = q1[e] * 0.125f * __expf(b1[e]);
                ke0[e] = k0[e] * __expf(-b0[e]); ke1[e] = k1[e] * __expf(-b1[e]);
                *(LAS unsigned*)(KDT + (d0 + e) * 72 + t0) = cvt_pk_bf16(k0[e] * __expf(tot[e] - b0[e]), k1[e] * __expf(tot[e] - b1[e]));
                if (tp == 0) DEC[d0 + e] = __expf(tot[e]); }
            u32x2 o; o.x = cvt_pk_bf16(qe0[0], qe0[1]); o.y = cvt_pk_bf16(qe0[2], qe0[3]); *(LAS u32x2*)(QE + t0 * 72 + d0) = o;
            o.x = cvt_pk_bf16(qe1[0], qe1[1]); o.y = cvt_pk_bf16(qe1[2], qe1[3]); *(LAS u32x2*)(QE + (t0 + 1) * 72 + d0) = o;
            o.x = cvt_pk_bf16(ke0[0], ke0[1]); o.y = cvt_pk_bf16(ke0[2], ke0[3]); *(LAS u32x2*)(KE + t0 * 72 + d0) = o;
            o.x = cvt_pk_bf16(ke1[0], ke1[1]); o.y = cvt_pk_bf16(ke1[2], ke1[3]); *(LAS u32x2*)(KE + (t0 + 1) * 72 + d0) = o;
            { LAS unsigned* vt = (LAS unsigned*)(VT + dg * 8 * 72 + t0);
                vt[0] = (c_v0.x & 0xffffu) | (c_v1.x << 16); vt[36] = (c_v0.x >> 16) | (c_v1.x & 0xffff0000u);
                vt[72] = (c_v0.y & 0xffffu) | (c_v1.y << 16); vt[108] = (c_v0.y >> 16) | (c_v1.y & 0xffff0000u);
                vt[144] = (c_v0.z & 0xffffu) | (c_v1.z << 16); vt[180] = (c_v0.z >> 16) | (c_v1.z & 0xffff0000u);
                vt[216] = (c_v0.w & 0xffffu) | (c_v1.w << 16); vt[252] = (c_v0.w >> 16) | (c_v1.w & 0xffff0000u); } }
        __syncthreads();
        { bf16x8 af[2];
#pragma unroll
            for (int ks = 0; ks < 2; ++ks) af[ks] = *(const LAS bf16x8*)(QE + (rt * 16 + l15) * 72 + ks * 32 + lq * 8);
#pragma unroll
            for (int c2 = 0; c2 < 2; ++c2) { const int ctile = (wid & 1) * 2 + c2; f32x4 acc = {0.f, 0.f, 0.f, 0.f};
#pragma unroll
                for (int ks = 0; ks < 2; ++ks) { const bf16x8 bf = *(const LAS bf16x8*)(KE + (ctile * 16 + l15) * 72 + ks * 32 + lq * 8); acc = mfma16(af[ks], bf, acc); }
#pragma unroll
                for (int i = 0; i < 4; ++i) { const int t = rt * 16 + lq * 4 + i, jj = ctile * 16 + l15; ATT[t * 72 + jj] = f2bf(jj <= t ? acc[i] : 0.f); } } }
        __syncthreads();
        f32x4 oacc[4];
        { bf16x8 at[2], qf[2], kd[2];
#pragma unroll
            for (int ks = 0; ks < 2; ++ks) { at[ks] = *(const LAS bf16x8*)(ATT + (rt * 16 + l15) * 72 + ks * 32 + lq * 8); qf[ks] = *(const LAS bf16x8*)(QE + (rt * 16 + l15) * 72 + ks * 32 + lq * 8);
                kd[ks] = *(const LAS bf16x8*)(KDT + (rt * 16 + l15) * 72 + ks * 32 + lq * 8); }
            const f32x4 dec = *(const LAS f32x4*)(DEC + rt * 16 + lq * 4);
#pragma unroll
            for (int c = 0; c < 4; ++c) { const int dvt = dv0t + c; f32x4 acc = {0.f, 0.f, 0.f, 0.f};
                Sacc[c] *= dec;
#pragma unroll
                for (int ks = 0; ks < 2; ++ks) { const bf16x8 vf = *(const LAS bf16x8*)(VT + (dvt * 16 + l15) * 72 + ks * 32 + lq * 8), sf = *(const LAS bf16x8*)(ST + (dvt * 16 + l15) * 72 + ks * 32 + lq * 8);
                    acc = mfma16(at[ks], vf, acc); acc = mfma16(qf[ks], sf, acc); Sacc[c] = mfma16(kd[ks], vf, Sacc[c]); }
                oacc[c] = acc; } }
        __syncthreads();
#pragma unroll
        for (int c = 0; c < 4; ++c) { const int dv = (dv0t + c) * 16 + l15;
#pragma unroll
            for (int i = 0; i < 4; ++i) OB[(rt * 16 + lq * 4 + i) * 132 + dv] = oacc[c][i];
            u32x2 sv; sv.x = cvt_pk_bf16(Sacc[c][0], Sacc[c][1]); sv.y = cvt_pk_bf16(Sacc[c][2], Sacc[c][3]);
            *(LAS u32x2*)(ST + dv * 72 + rt * 16 + lq * 4) = sv; }
        __syncthreads();
        { const int t = tid >> 3, dvb = (tid & 7) * 16;
            f32x4 o4[4]; float ss = 0.f;
#pragma unroll
            for (int i = 0; i < 4; ++i) { o4[i] = *(const LAS f32x4*)(OB + t * 132 + dvb + 4 * i); ss += o4[i].x * o4[i].x + o4[i].y * o4[i].y + o4[i].z * o4[i].z + o4[i].w * o4[i].w; }
            ss = red8_sum(ss);
            const float rs = rsqrtf(ss * (1.f / 128.f) + 1e-6f);
            const float g[16] = {bflo(c_g0.x), bfhi(c_g0.x), bflo(c_g0.y), bfhi(c_g0.y), bflo(c_g0.z), bfhi(c_g0.z), bflo(c_g0.w), bfhi(c_g0.w),
                                 bflo(c_g1.x), bfhi(c_g1.x), bflo(c_g1.y), bfhi(c_g1.y), bflo(c_g1.z), bfhi(c_g1.z), bflo(c_g1.w), bfhi(c_g1.w)};
            float r[16];
#pragma unroll
            for (int e = 0; e < 16; ++e) r[e] = o4[e >> 2][e & 3] * rs * GNW[dvb + e] * siluf_(g[e]);
            u32x4 w0, w1; w0.x = cvt_pk_bf16(r[0], r[1]); w0.y = cvt_pk_bf16(r[2], r[3]); w0.z = cvt_pk_bf16(r[4], r[5]); w0.w = cvt_pk_bf16(r[6], r[7]);
            w1.x = cvt_pk_bf16(r[8], r[9]); w1.y = cvt_pk_bf16(r[10], r[11]); w1.z = cvt_pk_bf16(r[12], r[13]); w1.w = cvt_pk_bf16(r[14], r[15]);
            u16* op = p.H + (tokb + t) * DM + 1536 + h * 128 + dvb;
            *(u32x4*)op = w0; *(u32x4*)(op + 8) = w1; }
        __syncthreads();
    }
}

#define XB_TMO      128
#define XB_XCNT(j)  (256  + 64 * (j))
#define XB_XSUB(j)  (1280 + 64 * (j))
#define XB_XGEN(j)  (2304 + 64 * (j))
#define XB_TOP      3328
#define XB_TOPGEN   3392
#define XCD_BAR_WORDS 3456
#define XB_SPIN_CAP (1u << 18)

__device__ __forceinline__ unsigned xb_ld(unsigned* p)              { return __hip_atomic_load(p, __ATOMIC_RELAXED, __HIP_MEMORY_SCOPE_AGENT); }
__device__ __forceinline__ unsigned xb_add(unsigned* p, unsigned v) { return __hip_atomic_fetch_add(p, v, __ATOMIC_RELAXED, __HIP_MEMORY_SCOPE_AGENT); }
__device__ __forceinline__ unsigned xb_xcc_id() { return (unsigned)__builtin_amdgcn_s_getreg((3 << 11) | 20) & 0xFu; }
#define XB_SPIN(cond, bar) do { unsigned _sp = 0; while (cond) { __builtin_amdgcn_s_sleep(1); \
    if ((++_sp & 255u) == 0u) { if (xb_ld(&(bar)[XB_TMO])) break; if (_sp > XB_SPIN_CAP) { atomicAdd(&(bar)[XB_TMO], 1u); break; } } } } while (0)

struct XcdBarrier {
    unsigned* bar; unsigned x;
    volatile LAS unsigned* st;
};

__device__ __forceinline__ XcdBarrier xcd_barrier_post(unsigned* bar, volatile LAS unsigned* st) {
    XcdBarrier b; b.bar = bar; b.x = xb_xcc_id(); b.st = st;
    if (threadIdx.x == 0) (void)xb_add(&bar[XB_XCNT(b.x)], 1u);
    return b;
}
__device__ __forceinline__ void xcd_barrier_complete(unsigned* bar, unsigned x, unsigned& nloc, unsigned& nx) {
    const unsigned G = gridDim.x * gridDim.y * gridDim.z;
    unsigned sum, cnt, mine, sp = 0u;
    for (;;) {
        sum = 0u; cnt = 0u; mine = 0u;
#pragma unroll
        for (unsigned j = 0; j < 16; ++j) { const unsigned c = xb_ld(&bar[XB_XCNT(j)]); sum += c; cnt += (c > 0u) ? 1u : 0u; mine = (j == x) ? c : mine; }
        if (sum == G) break;
        __builtin_amdgcn_s_sleep(1);
        if ((++sp & 255u) == 0u) { if (xb_ld(&bar[XB_TMO])) break; if (sp > XB_SPIN_CAP) { atomicAdd(&bar[XB_TMO], 1u); break; } }
    }
    nloc = mine > 0u ? mine : 1u; nx = cnt > 0u ? cnt : 1u;
}

__device__ __forceinline__ void xcd_barrier(const XcdBarrier& b) {
    asm volatile("s_waitcnt vmcnt(0)" ::: "memory");
    __syncthreads();
    if (threadIdx.x == 0) {
        unsigned* bar = b.bar;
        __builtin_amdgcn_s_waitcnt(0);
        unsigned nloc = b.st[0], nx = b.st[1];
        if (nloc == 0u) { xcd_barrier_complete(bar, b.x, nloc, nx); b.st[0] = nloc; b.st[1] = nx; }
        const unsigned old = xb_add(&bar[XB_XSUB(b.x)], 1u);
        const unsigned gen = old / nloc;
        if (old + 1u == (gen + 1u) * nloc) {
            __builtin_amdgcn_fence(__ATOMIC_RELEASE, "agent");
            asm volatile("s_waitcnt vmcnt(0)" ::: "memory");
            const unsigned og = xb_add(&bar[XB_TOP], 1u);
            const unsigned tg = og / nx;
            if (og + 1u == (tg + 1u) * nx) xb_add(&bar[XB_TOPGEN], 1u);
            else XB_SPIN(xb_ld(&bar[XB_TOPGEN]) == tg, bar);
            __builtin_amdgcn_fence(__ATOMIC_ACQUIRE, "agent");
            xb_add(&bar[XB_XGEN(b.x)], 1u);
            asm volatile("s_waitcnt vmcnt(0)" ::: "memory");
        } else {
            XB_SPIN(xb_ld(&bar[XB_XGEN(b.x)]) == gen, bar);
            __builtin_amdgcn_fence(__ATOMIC_ACQUIRE, "agent");
            asm volatile("s_waitcnt vmcnt(0)" ::: "memory");
        }
    }
    __syncthreads();
}

constexpr int N_PHASES = 13;
__device__ __forceinline__ void run_phase(const Params& p, int ph, LAS unsigned char* lds, LAS unsigned* qslot, int bid, int nb) {
    if (ph == 0) {
        transpose_cvt(lds, p.w_in, p.WtIn, DM, DIN, NP, bid, nb);
        transpose_cvt(lds, p.w_out, p.WtOut, DM, DM, DM, bid, nb);
        for (int l = 0; l < 2; ++l) {
            transpose_cvt(lds, p.w2 + (size_t)l * 64 * 1024, p.W2t + (size_t)l * 1024 * 64, 64, 1024, 1024, bid, nb);
            transpose_cvt(lds, p.a2 + (size_t)l * 64 * 1024, p.A2t + (size_t)l * 1024 * 64, 64, 1024, 1024, bid, nb);
        }
        rmsnorm_phase(p.x, p.norm_w, p.H, nullptr, bid, nb);
        return;
    }
    const int l = (ph - 1) / 6, s = (ph - 1) % 6;
    if (s == 0) {
        Gemm g; g.A = p.H; g.Bt = p.WtIn + (size_t)l * NP * DM; g.M = MTOK; g.N = NP; g.K = DM;
        StaticOrder S; S.init(MTOK, NP, nb, bid);
        EpiP E; E.O = p.P; E.ldc = NP;
        gemm_phase<EpiP, StaticOrder, false>(lds, g, S, E, nullptr);
    } else if (s == 1) {
        kmean_phase(p, lds, bid, nb);
    } else if (s == 2) {
        const int nscan = nb >> 1;
        if (bid < nscan) {
            for (int task = bid; task < 128; task += nscan) rwkv_scan_task(p, l, lds, task);
        } else {
            LAS int* slot = (LAS int*)qslot;
            for (;;) {
                __syncthreads();
                if (tid_() == 0) *slot = (int)atomicAdd(p.bar + 64 * l, 1u);
                __syncthreads();
                const int tk = *slot;
#ifdef PROBE_MOBA2
                if (tk >= 32 + 768) break;
                if (tk < 32) gla_task(p, l, lds, tk, 0, 32);
                else moba_task(p, lds, (tk - 32) % 512);
#else
                if (tk >= 32 + 512 + (l == 0 ? 312 : 0)) break;
                if (tk < 32) gla_task(p, l, lds, tk, 0, 32);
                else if (tk < 544) moba_task(p, lds, tk - 32);
                else { const int ct = tk - 544;
                    __syncthreads();
                    if (ct < 248) transpose_cvt_range(lds, p.w_in + (size_t)DM * DIN, p.WtIn + (size_t)NP * DM, DM, DIN, NP, ct * 16, ct * 16 + 16, 1);
                    else transpose_cvt_range(lds, p.w_out + (size_t)DM * DM, p.WtOut + (size_t)DM * DM, DM, DM, DM, (ct - 248) * 16, (ct - 248) * 16 + 16, 1); }
#endif
            }
        }
    } else if (s == 3) {
        for (int tk = bid; tk < 512; tk += nb) rwkv_post_task(p, l, tk);
    } else if (s == 4) {
        Gemm g; g.A = p.H; g.Bt = p.WtOut + (size_t)l * DM * DM; g.M = MTOK; g.N = DM; g.K = DM;
        StaticOrder S; S.init(MTOK, DM, nb, bid);
        EpiRes E; E.R = (l == 0) ? p.x : p.out; E.C = p.out; E.ldc = DM;
        gemm_phase<EpiRes, StaticOrder, false>(lds, g, S, E, nullptr);
    } else {
        if (l == 0) rmsnorm_phase(p.out, p.norm_w + DM, p.H, nullptr, bid, nb);
        else rmsnorm_phase(p.out, p.fnw, nullptr, p.out, bid, nb);
    }
}

__global__ void __launch_bounds__(512, 2) hybrid_fwd(Params p) {
    extern __shared__ __attribute__((aligned(16))) unsigned char shm[];
    LAS unsigned char* lds = (LAS unsigned char*)shm;
    const int bid = blockIdx.x, nb = gridDim.x;
#if defined(TEST_GEMM)
    { Gemm g; g.A = p.H; g.Bt = p.WtIn; g.M = MTOK; g.N = NP; g.K = DM;
      StaticOrder S; S.init(MTOK, NP, nb, bid);
      EpiP E; E.O = p.P; E.ldc = NP;
      gemm_phase<EpiP, StaticOrder, false>(lds, g, S, E, nullptr);
#if TEST_GEMM >= 2
      if (p.phase_lo) {
      Gemm g2; g2.A = p.H; g2.Bt = p.WtOut; g2.M = MTOK; g2.N = DM; g2.K = DM;
      StaticOrder S2; S2.init(MTOK, DM, nb, bid);
      EpiRes E2; E2.R = p.x; E2.C = p.out; E2.ldc = DM;
      gemm_phase<EpiRes, StaticOrder, false>(lds, g2, S2, E2, nullptr); }
#endif
    }
#elif ONE_LAUNCH
    cg::grid_group grid = cg::this_grid();
    __shared__ uint4 xb_words;
    if (threadIdx.x == 0) xb_words = make_uint4(0u, 0u, 0u, 0u);
    __syncthreads();
    const XcdBarrier xb = xcd_barrier_post(p.bar, (volatile LAS unsigned*)&xb_words);
    for (int ph = p.phase_lo; ph < p.phase_hi; ++ph) {
        run_phase(p, ph, lds, (LAS unsigned*)&xb_words.z, bid, nb);
#ifdef REPEAT_PH
        if (ph == REPEAT_PH) { xcd_barrier(xb); run_phase(p, ph, lds, (LAS unsigned*)&xb_words.z, bid, nb); }
#endif
        if (ph + 1 < p.phase_hi) { if (ph == 0) grid.sync(); else xcd_barrier(xb); }
    }
#else
    run_phase(p, p.phase_lo, lds, nullptr, bid, nb);
#endif
}

extern "C" void kernel_launch(void* const* d_in, const int* in_sizes, int n_in, void* d_out, int out_size, void* d_ws, size_t ws_size, hipStream_t stream) {
    static int grid = 0;
    if (grid == 0) {
        int dev = 0, cus = 0, per_cu = 0;
        hipGetDevice(&dev);
        hipDeviceGetAttribute(&cus, hipDeviceAttributeMultiprocessorCount, dev);
        hipFuncSetAttribute((const void*)hybrid_fwd, hipFuncAttributeMaxDynamicSharedMemorySize, LDS_BYTES);
        hipOccupancyMaxActiveBlocksPerMultiprocessor(&per_cu, (const void*)hybrid_fwd, 512, LDS_BYTES);
        if (per_cu < 1) { fprintf(stderr, "kernel_launch: occupancy query says %d blocks per CU\n", per_cu); per_cu = 1; }
        (void)hipGetLastError();
        grid = cus;
    }
    Params p{};
    const float* const* in = (const float* const*)d_in;
    p.x = in[0]; p.norm_w = in[1]; p.w_in = in[2]; p.w_out = in[3]; p.mu = in[4]; p.w0 = in[5]; p.w2 = in[6]; p.a0 = in[7]; p.a2 = in[8];
    p.k_k = in[9]; p.k_a = in[10]; p.r_k = in[11]; p.ln_w = in[12]; p.ln_b = in[13]; p.a_up = in[14]; p.a_b = in[15]; p.gnw = in[16]; p.fnw = in[17];
    p.out = (float*)d_out;
    unsigned char* ws = (unsigned char*)d_ws; size_t off = 0;
    auto take = [&](size_t bytes) { unsigned char* r = ws + off; off += (bytes + 255) & ~(size_t)255; return r; };
    p.WtIn = (u16*)take((size_t)2 * NP * DM * 2); p.WtOut = (u16*)take((size_t)2 * DM * DM * 2);
    p.W2t = (u16*)take((size_t)2 * 1024 * 64 * 2); p.A2t = (u16*)take((size_t)2 * 1024 * 64 * 2);
    p.H = (u16*)take((size_t)MTOK * DM * 2); p.P = (u16*)take((size_t)MTOK * NP * 2);
    p.yraw = (float*)take((size_t)MTOK * 1024 * 4); p.ybonus = (float*)take((size_t)MTOK * 16 * 4); p.kmean = (float*)take((size_t)256 * 128 * 4);
    p.bar = (unsigned*)take((size_t)XCD_BAR_WORDS * 4);
    p.gst = (float*)take((size_t)1024 * 8192 * 4); p.gdec = (float*)take((size_t)1024 * 64 * 4);
    if (off > ws_size) { fprintf(stderr, "kernel_launch: workspace too small (%zu > %zu)\n", off, ws_size); return; }
#if ONE_LAUNCH
    hipMemsetAsync(p.bar, 0, (size_t)XCD_BAR_WORDS * 4, stream);
    p.phase_lo = 0; p.phase_hi = N_PHASES;
    void* args[] = {&p};
    hipError_t e = hipLaunchCooperativeKernel((const void*)hybrid_fwd, dim3(grid), dim3(512), args, LDS_BYTES, stream);
    if (e != hipSuccess) fprintf(stderr, "cooperative launch failed: %s (grid %d)\n", hipGetErrorString(e), grid);
#else
    for (int ph = 0; ph < N_PHASES; ++ph) { p.phase_lo = ph; p.phase_hi = ph + 1; hipLaunchKernelGGL(hybrid_fwd, dim3(grid), dim3(512), LDS_BYTES, stream, p); }
#endif
}
```

```cpp
#include <hip/hip_runtime.h>
#include <hip/hip_cooperative_groups.h>
#include <cstdio>
namespace cg = cooperative_groups;

#ifndef ONE_LAUNCH
#define ONE_LAUNCH 1
#endif

namespace pg8 {
#define PG8_LAS __attribute__((address_space(3)))
typedef unsigned short bf16_t;
typedef short bf16x8 __attribute__((ext_vector_type(8)));
typedef float f32x4 __attribute__((ext_vector_type(4)));
typedef unsigned u32x4 __attribute__((ext_vector_type(4)));
constexpr int BM = 256, BK = 64, HALF = 128, HTB = HALF * BK * 2  , STAGE_BYTES = 8 * HTB, NXCD = 8, WGM = 8;

__host__ __device__ __forceinline__ int lds_byte(int r, int c) { const int st = (r >> 4) * 2 + (c >> 5), rr = r & 15, cc = c & 31, ob = rr * 64 + cc * 2; return st * 1024 + (ob ^ (((ob >> 9) & 1) << 5)); }
__host__ __device__ __forceinline__ void stage_rc(int b, int& R, int& C) { const int st = b / 1024, sb = b % 1024, swz = sb ^ (((sb >> 9) & 1) << 5); R = (st >> 1) * 16 + swz / 64; C = (st & 1) * 32 + (swz % 64) / 2; }
__host__ __device__ __forceinline__ int perm32(int rho) { const int n = rho >> 4, i = rho & 15; return 8 * (i >> 2) + 4 * n + (i & 3); }

struct Unit { int pm, pn; };
struct Gemm { const bf16_t* A; const bf16_t* Bt; int M, N, K; };

struct StaticOrder {
    int nM, nN, nwg, G, c;
    __host__ __device__ void init(int M, int N, int G_, int c_) { nM = M / BM; nN = N / BM; nwg = nM * nN; G = G_; c = c_; }
    __host__ __device__ bool next(int i, Unit& u) const {
        const long L = (long)i * G + c; if (L >= nwg) return false;
        int wgid = (int)L; { const int q = nwg / NXCD, r = nwg % NXCD, xcd = wgid % NXCD, off = wgid / NXCD; wgid = (xcd < r ? xcd * (q + 1) : r * (q + 1) + (xcd - r) * q) + off; }
        const int nig = WGM * nN, gid = wgid / nig, fm = gid * WGM, gsz = (nM - fm) < WGM ? (nM - fm) : WGM;
        u.pm = fm + ((wgid % nig) % gsz); u.pn = (wgid % nig) / gsz; return true;
    }
    __device__ __forceinline__ void a_ready(const Unit&) const {}
    __device__ __forceinline__ void done(const Unit&) const {}
};
__device__ __forceinline__ unsigned cvt_pk_bf16(float lo, float hi) { unsigned r; asm volatile("v_cvt_pk_bf16_f32 %0, %1, %2" : "=v"(r) : "v"(lo), "v"(hi)); return r; }
template <class Epi, class Sched, bool STAMP = false>
__device__ __forceinline__ void gemm_phase(PG8_LAS unsigned char* lds, const Gemm g, const Sched& S, const Epi& E, unsigned long long* stamps) {
    int tid = threadIdx.x; asm volatile("" : "+v"(tid)); const int wid = __builtin_amdgcn_readfirstlane(tid >> 6), lane = tid & 63, wr = wid >> 2, wc = wid & 3, fr = lane & 15, fq = lane >> 4;
    const int K = g.K, nt = K / BK;
    int ts_lo = 0, ts_hi = 0, nts = 0; const unsigned long long rt_entry = STAMP ? (unsigned long long)wall_clock64() : 0ull;
#define PG8_STAMP() do { if (STAMP && wid == 0 && nts < 64) { const unsigned long long _c = (unsigned long long)clock64(); \
        ts_lo = (lane == nts) ? (int)(unsigned)_c : ts_lo; ts_hi = (lane == nts) ? (int)(unsigned)(_c >> 32) : ts_hi; ++nts; } } while (0)
    PG8_STAMP();
    unsigned voffA[2], voffB[2];
#pragma unroll
    for (int i = 0; i < 2; ++i) { int R, C; stage_rc(tid * 16 + i * 8192, R, C); const int Rb = Epi::PERM ? ((R & ~31) + perm32(R & 31)) : R;
        voffA[i] = (unsigned)(R * K + C) * 2u; voffB[i] = (unsigned)(Rb * K + C) * 2u; }
    const size_t kstep = (size_t)(BK * 2);
    const size_t hstep = (size_t)HALF * K * 2;
    const size_t tstep = 2 * hstep;
    const unsigned ldsw = (unsigned)wid * 1024u;
    const int aoff = lds_byte(wr * 64 + fr, fq * 8), boff = lds_byte(wc * 32 + fr, fq * 8);
#define PG8_SA(b, h) (((b) * 2 + (h)) * HTB)
#define PG8_SB(b, h) ((4 + (b) * 2 + (h)) * HTB)
#define PG8_STAGE(bufoff, gbase, voff) do { _Pragma("unroll") for (int _i = 0; _i < 2; ++_i) \
        __builtin_amdgcn_global_load_lds((const unsigned*)((const char*)(gbase) + (voff)[_i]), (PG8_LAS unsigned*)(lds + (bufoff) + ldsw + _i * 8192), 16, 0, 0); } while (0)
#define PG8_LDA(dst, b, h) do { _Pragma("unroll") for (int m = 0; m < 4; ++m) _Pragma("unroll") for (int k = 0; k < 2; ++k) dst[m][k] = *(const PG8_LAS bf16x8*)(lds + PG8_SA(b, h) + aoff + m * 2048 + k * 1024); } while (0)
#define PG8_LDB(dst, b, h) do { _Pragma("unroll") for (int n = 0; n < 2; ++n) _Pragma("unroll") for (int k = 0; k < 2; ++k) dst[n][k] = *(const PG8_LAS bf16x8*)(lds + PG8_SB(b, h) + boff + n * 2048 + k * 1024); } while (0)
#define PG8_MMA(ai, bj, At, Bt) do { __builtin_amdgcn_s_setprio(1); _Pragma("unroll") for (int m = 0; m < 4; ++m) _Pragma("unroll") for (int n = 0; n < 2; ++n) _Pragma("unroll") for (int k = 0; k < 2; ++k) \
        acc[ai][bj][m][n] = __builtin_amdgcn_mfma_f32_16x16x32_bf16(Bt[n][k], At[m][k], acc[ai][bj][m][n], 0, 0, 0); __builtin_amdgcn_s_setprio(0); } while (0)
#define PG8_WAIT_V(n) asm volatile("s_waitcnt vmcnt(" #n ")" ::: "memory")
#define PG8_WAIT_L(n) asm volatile("s_waitcnt lgkmcnt(" #n ")" ::: "memory")
#define PG8_BAR __builtin_amdgcn_s_barrier()
#define PG8_SCHED __builtin_amdgcn_sched_barrier(0)
    Unit cur, nxt; int ui = 0;
    if (!S.next(0, cur)) return;
    f32x4 acc[2][2][4][2];
#pragma unroll
    for (int a = 0; a < 2; ++a)
#pragma unroll
        for (int b = 0; b < 2; ++b)
#pragma unroll
            for (int m = 0; m < 4; ++m)
#pragma unroll
                for (int n = 0; n < 2; ++n) acc[a][b][m][n] = (f32x4){0.f, 0.f, 0.f, 0.f};
    bf16x8 At[4][2], B0[2][2], B1[2][2];
    const char* cA = (const char*)g.A + (size_t)cur.pm * tstep; const char* cB = (const char*)g.Bt + (size_t)cur.pn * tstep;
    S.a_ready(cur);
    PG8_STAGE(PG8_SB(0, 0), cB, voffB); PG8_STAGE(PG8_SA(0, 0), cA, voffA); PG8_STAGE(PG8_SB(0, 1), cB + hstep, voffB); PG8_STAGE(PG8_SA(0, 1), cA + hstep, voffA);
    if (wr == 1) PG8_BAR;
    PG8_WAIT_V(4); PG8_BAR;
    PG8_STAGE(PG8_SB(1, 0), cB + kstep, voffB); PG8_STAGE(PG8_SA(1, 0), cA + kstep, voffA); PG8_STAGE(PG8_SB(1, 1), cB + hstep + kstep, voffB);
    PG8_WAIT_V(6); PG8_BAR;
    PG8_STAMP();
    for (;;) {
        const bool has_next = S.next(ui + 1, nxt);
        const char* nA = has_next ? (const char*)g.A + (size_t)nxt.pm * tstep : cA; const char* nB = has_next ? (const char*)g.Bt + (size_t)nxt.pn * tstep : cB;
        for (int t = 0; t < nt; t += 2) {
            const bool last = (t == nt - 2);
            const char* a1 = cA + (size_t)(t + 1) * kstep;
            const char* a2 = last ? nA : cA + (size_t)(t + 2) * kstep; const char* b2 = last ? nB : cB + (size_t)(t + 2) * kstep;
            const char* a3 = a2 + kstep; const char* b3 = b2 + kstep;
            if (last && has_next) S.a_ready(nxt);
            PG8_LDB(B0, 0, 0); PG8_SCHED; PG8_LDA(At, 0, 0); PG8_STAGE(PG8_SA(1, 1), a1 + hstep, voffA);
            PG8_WAIT_L(8); PG8_BAR; PG8_WAIT_L(0); PG8_MMA(0, 0, At, B0); PG8_BAR; PG8_SCHED;
            PG8_LDB(B1, 0, 1); PG8_STAGE(PG8_SB(0, 0), b2, voffB);
            PG8_BAR; PG8_WAIT_L(0); PG8_MMA(0, 1, At, B1); PG8_BAR;
            PG8_LDA(At, 0, 1); PG8_STAGE(PG8_SA(0, 0), a2, voffA);
            PG8_BAR; PG8_WAIT_L(0); PG8_MMA(1, 0, At, B0); PG8_BAR; PG8_SCHED;
            PG8_STAGE(PG8_SB(0, 1), b2 + hstep, voffB);
            PG8_WAIT_V(6); PG8_BAR; PG8_MMA(1, 1, At, B1); PG8_BAR;
            PG8_LDB(B0, 1, 0); PG8_SCHED; PG8_LDA(At, 1, 0); PG8_STAGE(PG8_SA(0, 1), a2 + hstep, voffA);
            PG8_WAIT_L(8); PG8_BAR; PG8_WAIT_L(0); PG8_MMA(0, 0, At, B0); PG8_BAR; PG8_SCHED;
            PG8_LDB(B1, 1, 1); PG8_STAGE(PG8_SB(1, 0), b3, voffB);
            PG8_BAR; PG8_WAIT_L(0); PG8_MMA(0, 1, At, B1); PG8_BAR;
            PG8_LDA(At, 1, 1); PG8_STAGE(PG8_SA(1, 0), a3, voffA);
            PG8_BAR; PG8_WAIT_L(0); PG8_MMA(1, 0, At, B0); PG8_BAR; PG8_SCHED;
            PG8_STAGE(PG8_SB(1, 1), b3 + hstep, voffB);
            PG8_WAIT_V(6); PG8_BAR; PG8_MMA(1, 1, At, B1); PG8_BAR;
        }
        PG8_STAMP();
        if constexpr (!Epi::AFTER_DRAIN) { E(acc, cur, wr, wc, fr, fq); S.done(cur); }
        PG8_STAMP();
        if (!has_next) break;
#pragma unroll
        for (int a = 0; a < 2; ++a)
#pragma unroll
            for (int b = 0; b < 2; ++b)
#pragma unroll
                for (int m = 0; m < 4; ++m)
#pragma unroll
                    for (int n = 0; n < 2; ++n) acc[a][b][m][n] = (f32x4){0.f, 0.f, 0.f, 0.f};
        cur = nxt; cA = nA; cB = nB; ++ui;
    }
    PG8_WAIT_V(0);
    if (wr == 0) PG8_BAR;
    PG8_BAR;
    if constexpr (Epi::AFTER_DRAIN) { E.fused(acc, cur, wr, wc, fr, fq, lds, wid, lane); S.done(cur); }
    PG8_STAMP();
    if (STAMP && wid == 0) { stamps[lane] = lane < nts ? (((unsigned long long)(unsigned)ts_hi << 32) | (unsigned)ts_lo) : 0ull;
        if (lane == 62) stamps[62] = rt_entry; if (lane == 63) stamps[63] = (unsigned long long)wall_clock64(); }
#undef PG8_STAMP
#undef PG8_SA
#undef PG8_SB
#undef PG8_STAGE
#undef PG8_LDA
#undef PG8_LDB
#undef PG8_MMA
#undef PG8_WAIT_V
#undef PG8_WAIT_L
#undef PG8_BAR
#undef PG8_SCHED
}
}
using namespace pg8;
#define LAS PG8_LAS
typedef unsigned short u16;
typedef unsigned u32x2 __attribute__((ext_vector_type(2)));
typedef float f32x2 __attribute__((ext_vector_type(2)));

constexpr int NBATCH = 8, SEQ = 2048, DM = 2048, MTOK = NBATCH * SEQ, DIN = 7824, NP = 7936;
constexpr int C_R = 0, C_K = 1024, C_V = 2048, C_WD = 3072, C_GA = 3200, C_QB = 4224, C_KB = 4736, C_VB = 5248, C_GB = 5760,
              C_QC = 6272, C_KC = 6528, C_VC = 6784, C_GC = 7296, C_LOW = 7808;
constexpr int LDS_BYTES = 148480;

struct Params {
    const float *x, *norm_w, *w_in, *w_out, *mu, *w0, *w2, *a0, *a2, *k_k, *k_a, *r_k, *ln_w, *ln_b, *a_up, *a_b, *gnw, *fnw;
    float* out;
    u16 *WtIn, *WtOut, *W2t, *A2t, *H, *P;
    float *yraw, *ybonus, *kmean, *gst, *gdec;
    unsigned* bar;
    int phase_lo, phase_hi;
};

__device__ __forceinline__ int tid_() { int t = threadIdx.x; asm volatile("" : "+v"(t)); return t; }
__device__ __forceinline__ float bf2f(u16 v) { return __uint_as_float(((unsigned)v) << 16); }
__device__ __forceinline__ float bflo(unsigned w) { return __uint_as_float(w << 16); }
__device__ __forceinline__ float bfhi(unsigned w) { return __uint_as_float(w & 0xffff0000u); }
__device__ __forceinline__ u16 f2bf(float f) { return (u16)(cvt_pk_bf16(f, 0.f) & 0xffffu); }
template <int CTRL> __device__ __forceinline__ float dpp_f(float v) { return __int_as_float(__builtin_amdgcn_update_dpp(0, __float_as_int(v), CTRL, 0xF, 0xF, true)); }
__device__ __forceinline__ float red16_sum(float v) { v += dpp_f<0xB1>(v); v += dpp_f<0x4E>(v); v += dpp_f<0x141>(v); v += dpp_f<0x140>(v); return v; }
__device__ __forceinline__ float red8_sum(float v) { v += dpp_f<0xB1>(v); v += dpp_f<0x4E>(v); v += dpp_f<0x141>(v); return v; }
__device__ __forceinline__ float red16_max(float v) { v = fmaxf(v, dpp_f<0xB1>(v)); v = fmaxf(v, dpp_f<0x4E>(v)); v = fmaxf(v, dpp_f<0x141>(v)); v = fmaxf(v, dpp_f<0x140>(v)); return v; }
__device__ __forceinline__ float wave_sum(float v) {
#pragma unroll
    for (int o = 1; o < 64; o <<= 1) v += __shfl_xor(v, o);
    return v;
}
__device__ __forceinline__ float sigmoidf_(float x) { return 1.f / (1.f + __expf(-x)); }
__device__ __forceinline__ float siluf_(float x) { return x / (1.f + __expf(-x)); }
__device__ __forceinline__ float logsigmoidf_(float z) { return fminf(z, 0.f) - log1pf(__expf(-fabsf(z))); }
__device__ __forceinline__ f32x4 mfma16(bf16x8 a, bf16x8 b, f32x4 c) { return __builtin_amdgcn_mfma_f32_16x16x32_bf16(a, b, c, 0, 0, 0); }

struct EpiP {
    static constexpr bool PERM = true, AFTER_DRAIN = false;
    bf16_t* O; int ldc;
    __device__ __forceinline__ void operator()(const f32x4 (&acc)[2][2][4][2], const Unit& u, int wr, int wc, int fr, int fq) const {
        const int row0 = u.pm * BM + wr * 64 + fr, col0 = u.pn * BM + wc * 32 + 8 * fq;
#pragma unroll
        for (int ai = 0; ai < 2; ++ai)
#pragma unroll
            for (int m = 0; m < 4; ++m) { bf16_t* rowp = O + (size_t)(row0 + ai * HALF + m * 16) * ldc + col0;
#pragma unroll
                for (int bj = 0; bj < 2; ++bj) { const f32x4 v0 = acc[ai][bj][m][0], v1 = acc[ai][bj][m][1];
                    u32x4 w; w.x = cvt_pk_bf16(v0[0], v0[1]); w.y = cvt_pk_bf16(v0[2], v0[3]); w.z = cvt_pk_bf16(v1[0], v1[1]); w.w = cvt_pk_bf16(v1[2], v1[3]);
                    *(u32x4*)(rowp + bj * HALF) = w; } }
    }
};
struct EpiRes {
    static constexpr bool PERM = false, AFTER_DRAIN = false;
    const float* R; float* C; int ldc;
    __device__ __forceinline__ void operator()(const f32x4 (&acc)[2][2][4][2], const Unit& u, int wr, int wc, int fr, int fq) const {
        const int row0 = u.pm * BM + wr * 64 + fr, col0 = u.pn * BM + wc * 32 + 4 * fq;
#pragma unroll
        for (int ai = 0; ai < 2; ++ai)
#pragma unroll
            for (int m = 0; m < 4; ++m) { const size_t off = (size_t)(row0 + ai * HALF + m * 16) * ldc + col0;
#pragma unroll
                for (int bj = 0; bj < 2; ++bj)
#pragma unroll
                    for (int n = 0; n < 2; ++n) { const f32x4 r = *(const f32x4*)(R + off + bj * HALF + n * 16); *(f32x4*)(C + off + bj * HALF + n * 16) = acc[ai][bj][m][n] + r; }
                asm volatile("" ::: "memory"); }
    }
};

__device__ void transpose_cvt_range(LAS unsigned char* lds, const float* src, u16* dst, int K, int N, int Npad, int t_begin, int t_end, int t_step) {
    LAS float* tile = (LAS float*)lds;
    const int tilesN = Npad / 64, tid = tid_();
    for (int t = t_begin; t < t_end; t += t_step) {
        const int tn = t % tilesN, tk = t / tilesN, n0 = tn * 64, k0 = tk * 64;
#pragma unroll
        for (int i = 0; i < 2; ++i) { const int idx = tid + i * 512, kk = idx >> 4, n4 = (idx & 15) * 4;
            float4 v = make_float4(0.f, 0.f, 0.f, 0.f);
            if (n0 + n4 < N) v = *(const float4*)(src + (size_t)(k0 + kk) * N + n0 + n4);
            tile[(n4 + 0) * 65 + kk] = v.x; tile[(n4 + 1) * 65 + kk] = v.y; tile[(n4 + 2) * 65 + kk] = v.z; tile[(n4 + 3) * 65 + kk] = v.w; }
        __syncthreads();
        { const int n = tid >> 3, k8 = (tid & 7) * 8; const LAS float* r = tile + n * 65 + k8;
            u32x4 o; o.x = cvt_pk_bf16(r[0], r[1]); o.y = cvt_pk_bf16(r[2], r[3]); o.z = cvt_pk_bf16(r[4], r[5]); o.w = cvt_pk_bf16(r[6], r[7]);
            *(u32x4*)(dst + (size_t)(n0 + n) * K + k0 + k8) = o; }
        __syncthreads();
    }
}
__device__ __forceinline__ void transpose_cvt(LAS unsigned char* lds, const float* src, u16* dst, int K, int N, int Npad, int bid, int nb) {
    transpose_cvt_range(lds, src, dst, K, N, Npad, bid, (Npad / 64) * (K / 64), nb);
}

__device__ void rmsnorm_phase(const float* x, const float* w, u16* hb, float* of, int bid, int nb) {
    const int tid0 = tid_(), wid = tid0 >> 6, lane = tid0 & 63;
    for (int row = bid * 8 + wid; row < MTOK; row += nb * 8) {
        const float4* xr = (const float4*)(x + (size_t)row * DM);
        float4 v[8]; float s = 0.f;
#pragma unroll
        for (int i = 0; i < 8; ++i) { v[i] = xr[i * 64 + lane]; s += v[i].x * v[i].x + v[i].y * v[i].y + v[i].z * v[i].z + v[i].w * v[i].w; }
        s = wave_sum(s);
        const float rs = rsqrtf(s * (1.f / DM) + 1e-6f);
#pragma unroll
        for (int i = 0; i < 8; ++i) { const float4 wv = ((const float4*)w)[i * 64 + lane];
            const float a = v[i].x * rs * wv.x, b = v[i].y * rs * wv.y, c = v[i].z * rs * wv.z, d = v[i].w * rs * wv.w;
            if (hb) { uint2 o; o.x = cvt_pk_bf16(a, b); o.y = cvt_pk_bf16(c, d); *(uint2*)(hb + (size_t)row * DM + (i * 64 + lane) * 4) = o; }
            else { ((float4*)(of + (size_t)row * DM))[i * 64 + lane] = make_float4(a, b, c, d); } }
    }
}

__device__ void kmean_phase(const Params& p, LAS unsigned char* lds, int bid, int nb) {
    LAS float* part = (LAS float*)lds;
    const int tid = tid_();
    for (int task = bid; task < 256; task += nb) {
        const int b = task >> 5, h = (task >> 3) & 3, blk = task & 7;
        const int d8 = (tid & 15) * 8, kg = tid >> 4;
        float s[8];
#pragma unroll
        for (int e = 0; e < 8; ++e) s[e] = 0.f;
        for (int kk = 0; kk < 8; ++kk) {
            const int tok = b * SEQ + blk * 256 + kg * 8 + kk;
            const uint4 v = *(const uint4*)(p.P + (size_t)tok * NP + C_KB + h * 128 + d8);
            s[0] += bflo(v.x); s[1] += bfhi(v.x); s[2] += bflo(v.y); s[3] += bfhi(v.y); s[4] += bflo(v.z); s[5] += bfhi(v.z); s[6] += bflo(v.w); s[7] += bfhi(v.w);
        }
        __syncthreads();
#pragma unroll
        for (int e = 0; e < 8; ++e) part[kg * 128 + d8 + e] = s[e];
        __syncthreads();
        if (tid < 128) { float a = 0.f; for (int g = 0; g < 32; ++g) a += part[g * 128 + tid]; p.kmean[(size_t)task * 128 + tid] = a * (1.f / 256.f); }
    }
    __syncthreads();
}

constexpr int RW_T = 32;
constexpr int RW_XB = 49152;
constexpr int RW_RAW = 98304, RW_A1 = 119808, RW_A2 = 124416, RW_KS = 129024, RW_AS = 137216, RW_MU = 145408, RW_PAR = 146688, RW_FLG = 147968;
__device__ __forceinline__ void rw_issue(const Params& p, int pt, int b, int h, int t0, u32x4 (&rg)[6]) {
#pragma unroll
    for (int i = 0; i < 6; ++i) { const int piece = pt + 256 * i; rg[i] = (u32x4){0u, 0u, 0u, 0u};
        if (piece < 33 * 40) { const int row = piece / 40, pc = piece % 40; const int t = t0 - 1 + row;
            const int col = pc < 8 ? C_R + h * 64 + pc * 8 : pc < 16 ? C_K + h * 64 + (pc - 8) * 8 : pc < 24 ? C_V + h * 64 + (pc - 16) * 8 : C_WD + (pc - 24) * 8;
            if (t >= 0) rg[i] = *(const u32x4*)(p.P + (size_t)(b * SEQ + t) * NP + col); } }
}
__device__ __forceinline__ void prep_bar(volatile LAS unsigned* flg, int pw, int lane, unsigned& ep) {
    ++ep;
    asm volatile("s_waitcnt lgkmcnt(0)" ::: "memory");
    if (lane == 0) flg[pw] = ep;
    for (;;) { const u32x4 f = *(volatile LAS u32x4*)flg; if (f.x >= ep && f.y >= ep && f.z >= ep && f.w >= ep) break; __builtin_amdgcn_s_sleep(2); }
    asm volatile("s_waitcnt lgkmcnt(0)" ::: "memory");
}
__device__ __forceinline__ float red4_sum(float v) { v += dpp_f<0xB1>(v); v += dpp_f<0x4E>(v); return v; }
__device__ __forceinline__ float rs8_sum(const float (&y)[8], bool b2, bool b1, bool b0) {
    float n[4], n2[2];
#pragma unroll
    for (int j = 0; j < 4; ++j) { const float k = b2 ? y[4 + j] : y[j], sd = b2 ? y[j] : y[4 + j]; n[j] = k + dpp_f<0x141>(sd); }
#pragma unroll
    for (int j = 0; j < 2; ++j) { const float k = b1 ? n[2 + j] : n[j], sd = b1 ? n[j] : n[2 + j]; n2[j] = k + dpp_f<0x1B>(sd); }
    const float k = b0 ? n2[1] : n2[0], sd = b0 ? n2[0] : n2[1];
    return k + dpp_f<0xB1>(sd);
}
__device__ void rwkv_scan_task(const Params& p, int l, LAS unsigned char* lds, int task) {
    const int tid = tid_(), wid = tid >> 6, lane = tid & 63;
    LAS u16* raw = (LAS u16*)(lds + RW_RAW); LAS u16* A1 = (LAS u16*)(lds + RW_A1); LAS u16* A2 = (LAS u16*)(lds + RW_A2);
    LAS float* kS = (LAS float*)(lds + RW_KS); LAS float* aS = (LAS float*)(lds + RW_AS);
    LAS float* muS = (LAS float*)(lds + RW_MU); LAS float* parS = (LAS float*)(lds + RW_PAR);
    volatile LAS unsigned* flg = (volatile LAS unsigned*)(lds + RW_FLG);
    {
        const int b = task >> 4, h = task & 15;
        __syncthreads();
        if (tid >= 256 && tid < 260) flg[tid - 256] = 0u;
        __syncthreads();
        if (wid < 4) {
            const int rp = wid * 8 + (lane >> 3), ssub = lane & 7; const bool sb2 = (ssub & 4) != 0, sb1 = (ssub & 2) != 0, sb0 = (ssub & 1) != 0;
            f32x2 SA[4], SB[4];
#pragma unroll
            for (int q = 0; q < 4; ++q) { SA[q] = (f32x2){0.f, 0.f}; SB[q] = (f32x2){0.f, 0.f}; }
            float* yout = p.yraw + (size_t)(b * SEQ + ssub) * 1024 + h * 64 + 2 * rp;
            for (int c = 0; c < SEQ / RW_T; ++c) {
                __syncthreads();
                const LAS float* ob = (const LAS float*)(lds + (c & 1) * RW_XB) + ssub * 8;
                const LAS float* ov = (const LAS float*)(lds + (c & 1) * RW_XB + 40960) + 2 * rp;
                f32x4 nw0 = *(const LAS f32x4*)(ob), nw1 = *(const LAS f32x4*)(ob + 4), na0 = *(const LAS f32x4*)(ob + 2048), na1 = *(const LAS f32x4*)(ob + 2052);
                f32x4 nb0 = *(const LAS f32x4*)(ob + 4096), nb1 = *(const LAS f32x4*)(ob + 4100), nk0 = *(const LAS f32x4*)(ob + 6144), nk1 = *(const LAS f32x4*)(ob + 6148);
                f32x4 nr0 = *(const LAS f32x4*)(ob + 8192), nr1 = *(const LAS f32x4*)(ob + 8196);
                f32x2 nv = *(const LAS f32x2*)(ov);
                float ypA[8], ypB[8];
#pragma unroll
                for (int t = 0; t < RW_T; ++t) {
                    const f32x4 w0 = nw0, w1 = nw1, a0 = na0, a1 = na1, b0 = nb0, b1 = nb1, k0 = nk0, k1 = nk1, r0 = nr0, r1 = nr1; const f32x2 vv = nv;
                    if (t + 1 < RW_T) { const LAS float* o2 = ob + (t + 1) * 64;
                        nw0 = *(const LAS f32x4*)(o2); nw1 = *(const LAS f32x4*)(o2 + 4); na0 = *(const LAS f32x4*)(o2 + 2048); na1 = *(const LAS f32x4*)(o2 + 2052);
                        nb0 = *(const LAS f32x4*)(o2 + 4096); nb1 = *(const LAS f32x4*)(o2 + 4100); nk0 = *(const LAS f32x4*)(o2 + 6144); nk1 = *(const LAS f32x4*)(o2 + 6148);
                        nr0 = *(const LAS f32x4*)(o2 + 8192); nr1 = *(const LAS f32x4*)(o2 + 8196);
                        nv = *(const LAS f32x2*)(ov + (t + 1) * 64); }
                    const f32x2 sA2 = (SA[0] * a0.lo + SA[1] * a0.hi) + (SA[2] * a1.lo + SA[3] * a1.hi);
                    const f32x2 sB2 = (SB[0] * a0.lo + SB[1] * a0.hi) + (SB[2] * a1.lo + SB[3] * a1.hi);
                    const float saA = red8_sum(sA2.x + sA2.y), saB = red8_sum(sB2.x + sB2.y);
                    const f32x2 svA = {saA, saA}, svB = {saB, saB}, vA = {vv.x, vv.x}, vB = {vv.y, vv.y};
                    SA[0] = SA[0] * w0.lo + svA * b0.lo + vA * k0.lo; SA[1] = SA[1] * w0.hi + svA * b0.hi + vA * k0.hi;
                    SA[2] = SA[2] * w1.lo + svA * b1.lo + vA * k1.lo; SA[3] = SA[3] * w1.hi + svA * b1.hi + vA * k1.hi;
                    SB[0] = SB[0] * w0.lo + svB * b0.lo + vB * k0.lo; SB[1] = SB[1] * w0.hi + svB * b0.hi + vB * k0.hi;
                    SB[2] = SB[2] * w1.lo + svB * b1.lo + vB * k1.lo; SB[3] = SB[3] * w1.hi + svB * b1.hi + vB * k1.hi;
                    const f32x2 yA2 = (SA[0] * r0.lo + SA[1] * r0.hi) + (SA[2] * r1.lo + SA[3] * r1.hi);
                    const f32x2 yB2 = (SB[0] * r0.lo + SB[1] * r0.hi) + (SB[2] * r1.lo + SB[3] * r1.hi);
                    ypA[t & 7] = yA2.x + yA2.y; ypB[t & 7] = yB2.x + yB2.y;
                    if ((t & 7) == 7) { f32x2 o = {rs8_sum(ypA, sb2, sb1, sb0), rs8_sum(ypB, sb2, sb1, sb0)}; *(f32x2*)(yout + (size_t)(c * RW_T + (t & ~7)) * 1024) = o; }
                }
            }
        } else {
            const int pt = tid - 256, pw = wid - 4;
            unsigned ep = 0u;
            for (int c2 = pt; c2 < 320; c2 += 256) { const int mi = c2 < 64 ? h * 64 + c2 : c2 < 128 ? 1024 + h * 64 + (c2 - 64) : c2 < 192 ? 2048 + h * 64 + (c2 - 128) : 3072 + (c2 - 192);
                muS[c2] = p.mu[(size_t)l * 3200 + mi]; }
            if (pt < 64) { const size_t o = (size_t)l * 1024 + h * 64 + pt;
                parS[pt] = p.w0[o]; parS[64 + pt] = p.a0[o]; parS[128 + pt] = p.k_k[o]; parS[192 + pt] = p.k_a[o]; parS[256 + pt] = p.r_k[o]; }
            const int mat = pw >> 1, ct0 = (pw & 1) * 2;
            bf16x8 bfr[2][2];
#pragma unroll
            for (int ci = 0; ci < 2; ++ci) { const u16* Bt = (mat ? p.A2t : p.W2t) + (size_t)l * 1024 * 64 + (size_t)(h * 64 + (ct0 + ci) * 16 + (lane & 15)) * 64 + (lane >> 4) * 8;
                bfr[ci][0] = *(const bf16x8*)(Bt); bfr[ci][1] = *(const bf16x8*)(Bt + 32); }
            u32x4 rg[6];
            int goff[6], loff[6];
#pragma unroll
            for (int i = 0; i < 6; ++i) { const int piece = pt + 256 * i, row = piece / 40, pc = piece % 40;
                const int col = pc < 8 ? C_R + h * 64 + pc * 8 : pc < 16 ? C_K + h * 64 + (pc - 8) * 8 : pc < 24 ? C_V + h * 64 + (pc - 16) * 8 : C_WD + (pc - 24) * 8;
                goff[i] = piece < 33 * 40 ? row * NP + col : -1; loff[i] = row * 320 + pc * 8; }
            const u16* pbase = p.P + (size_t)b * SEQ * NP;
#define RW_ISSUE(t0_) do { _Pragma("unroll") for (int i = 0; i < 6; ++i) { rg[i] = (u32x4){0u, 0u, 0u, 0u}; \
                if (goff[i] >= 0 && ((t0_) > 0 || goff[i] >= NP)) rg[i] = *(const u32x4*)(pbase + (ptrdiff_t)((t0_) - 1) * NP + goff[i]); } } while (0)
            RW_ISSUE(0);
            for (int c = 0; c < SEQ / RW_T; ++c) {
                const int t0 = c * RW_T;
                LAS float* opW = (LAS float*)(lds + (c & 1) * RW_XB); LAS float* opA = opW + 2048; LAS float* opB = opW + 4096; LAS float* opK = opW + 6144; LAS float* opR = opW + 8192; LAS float* opV = opW + 10240;
#pragma unroll
                for (int i = 0; i < 6; ++i) { if (goff[i] >= 0) *(LAS u32x4*)(raw + loff[i]) = rg[i]; }
                prep_bar(flg, pw, lane, ep);
                if (c + 1 < SEQ / RW_T) RW_ISSUE(t0 + RW_T);
#pragma unroll
                for (int reg = 0; reg < 5; ++reg)
#pragma unroll
                    for (int i = 0; i < 2; ++i) { const int e = pt + 256 * i, t = e >> 4, qd = e & 15, cc = reg * 64 + 4 * qd;
                        const u32x2 cu = *(const LAS u32x2*)(raw + (t + 1) * 320 + cc), pu = *(const LAS u32x2*)(raw + t * 320 + cc);
                        const f32x4 mu4 = *(const LAS f32x4*)(muS + cc);
                        const f32x4 cur = {bflo(cu.x), bfhi(cu.x), bflo(cu.y), bfhi(cu.y)}, prv = {bflo(pu.x), bfhi(pu.x), bflo(pu.y), bfhi(pu.y)};
                        const f32x4 xs = cur + mu4 * (prv - cur);
                        if (reg == 0) *(LAS f32x4*)(opR + t * 64 + 4 * qd) = xs;
                        else if (reg == 1) *(LAS f32x4*)(kS + t * 64 + 4 * qd) = xs;
                        else if (reg == 2) *(LAS f32x4*)(opV + t * 64 + 4 * qd) = xs;
                        else if (reg == 3) { float th[4];
#pragma unroll
                            for (int q = 0; q < 4; ++q) th[q] = 1.f - 2.f * __builtin_amdgcn_rcpf(__expf(2.f * xs[q]) + 1.f);
                            u32x2 o; o.x = cvt_pk_bf16(th[0], th[1]); o.y = cvt_pk_bf16(th[2], th[3]); *(LAS u32x2*)(A1 + t * 72 + 4 * qd) = o; }
                        else { u32x2 o; o.x = cvt_pk_bf16(xs.x, xs.y); o.y = cvt_pk_bf16(xs.z, xs.w); *(LAS u32x2*)(A2 + t * 72 + 4 * qd) = o; } }
                prep_bar(flg, pw, lane, ep);
                { LAS u16* Ab = mat ? A2 : A1;
#pragma unroll
                    for (int ci = 0; ci < 2; ++ci)
#pragma unroll
                        for (int rt = 0; rt < 2; ++rt) { f32x4 acc = {0.f, 0.f, 0.f, 0.f};
#pragma unroll
                            for (int ks = 0; ks < 2; ++ks) { const bf16x8 af = *(const LAS bf16x8*)(Ab + (rt * 16 + (lane & 15)) * 72 + ks * 32 + (lane >> 4) * 8); acc = mfma16(af, bfr[ci][ks], acc); }
                            const int cc = (ct0 + ci) * 16 + (lane & 15);
#pragma unroll
                            for (int i = 0; i < 4; ++i) { const int t = rt * 16 + (lane >> 4) * 4 + i;
                                if (mat == 0) { float wv = parS[cc] + acc[i]; wv = fminf(wv, 0.f) - __logf(1.f + __expf(-fabsf(wv))) - 0.5f; opW[t * 64 + cc] = __expf(-__expf(wv)); }
                                else aS[t * 64 + cc] = __builtin_amdgcn_rcpf(1.f + __expf(-(parS[64 + cc] + acc[i]))); } } }
                prep_bar(flg, pw, lane, ep);
#pragma unroll
                for (int j = 0; j < 2; ++j) { const int item = pt + 256 * j, t = item >> 4, sub = item & 15, c4 = sub * 4;
                    const f32x4 kr = *(const LAS f32x4*)(kS + t * 64 + c4), av = *(const LAS f32x4*)(aS + t * 64 + c4), rr = *(const LAS f32x4*)(opR + t * 64 + c4);
                    const f32x4 kkp = *(const LAS f32x4*)(parS + 128 + c4), kap = *(const LAS f32x4*)(parS + 192 + c4), rkp = *(const LAS f32x4*)(parS + 256 + c4);
                    f32x4 kk = kr * kkp;
                    float ss = kk.x * kk.x + kk.y * kk.y + kk.z * kk.z + kk.w * kk.w; ss = red16_sum(ss);
                    const float inv = rsqrtf(fmaxf(ss, 1e-24f));
                    kk.x *= inv; kk.y *= inv; kk.z *= inv; kk.w *= inv;
                    const f32x4 km = kr * (1.f + (av - 1.f) * kap);
                    *(LAS f32x4*)(opA + t * 64 + c4) = -kk;
                    *(LAS f32x4*)(opB + t * 64 + c4) = kk * av;
                    *(LAS f32x4*)(opK + t * 64 + c4) = km;
                    float bo = rr.x * km.x * rkp.x + rr.y * km.y * rkp.y + rr.z * km.z * rkp.z + rr.w * km.w * rkp.w; bo = red16_sum(bo);
                    if (sub == 0) p.ybonus[(size_t)(b * SEQ + t0 + t) * 16 + h] = bo; }
                __syncthreads();
            }
        }
    }
    __syncthreads();
}

__device__ void rwkv_post_item(const Params& p, int l, int item) {
    const int tid = tid_(), pair = item * 32 + (tid >> 4), tok = pair >> 4, h = pair & 15, c4 = (tid & 15) * 4;
    const float4 y = *(const float4*)(p.yraw + (size_t)tok * 1024 + h * 64 + c4);
    const float mean = red16_sum(y.x + y.y + y.z + y.w) * (1.f / 64.f);
    const float d0 = y.x - mean, d1 = y.y - mean, d2 = y.z - mean, d3 = y.w - mean;
    const float var = red16_sum(d0 * d0 + d1 * d1 + d2 * d2 + d3 * d3) * (1.f / 64.f);
    const float rs = rsqrtf(var + 64e-5f);
    const size_t po = (size_t)l * 1024 + h * 64 + c4;
    const float4 lw = *(const float4*)(p.ln_w + po), lb = *(const float4*)(p.ln_b + po), muv = *(const float4*)(p.mu + (size_t)l * 3200 + 2048 + h * 64 + c4);
    const uint2 vc = *(const uint2*)(p.P + (size_t)tok * NP + C_V + h * 64 + c4);
    uint2 vp = make_uint2(0u, 0u);
    if ((tok & (SEQ - 1)) != 0) vp = *(const uint2*)(p.P + (size_t)(tok - 1) * NP + C_V + h * 64 + c4);
    const uint2 gg = *(const uint2*)(p.P + (size_t)tok * NP + C_GA + h * 64 + c4);
    const float bo = p.ybonus[(size_t)tok * 16 + h];
    float v0 = bflo(vc.x), v1 = bfhi(vc.x), v2 = bflo(vc.y), v3 = bfhi(vc.y);
    v0 += muv.x * (bflo(vp.x) - v0); v1 += muv.y * (bfhi(vp.x) - v1); v2 += muv.z * (bflo(vp.y) - v2); v3 += muv.w * (bfhi(vp.y) - v3);
    const float o0 = (d0 * rs * lw.x + lb.x + bo * v0) * siluf_(bflo(gg.x)), o1 = (d1 * rs * lw.y + lb.y + bo * v1) * siluf_(bfhi(gg.x));
    const float o2 = (d2 * rs * lw.z + lb.z + bo * v2) * siluf_(bflo(gg.y)), o3 = (d3 * rs * lw.w + lb.w + bo * v3) * siluf_(bfhi(gg.y));
    uint2 o; o.x = cvt_pk_bf16(o0, o1); o.y = cvt_pk_bf16(o2, o3);
    *(uint2*)(p.H + (size_t)tok * DM + h * 64 + c4) = o;
}

__device__ void rwkv_post_task(const Params& p, int l, int task) {
    const int tid = tid_(), h = (tid >> 4) & 15, c4 = (tid & 15) * 4;
    const size_t po = (size_t)l * 1024 + h * 64 + c4;
    const f32x4 lw = *(const f32x4*)(p.ln_w + po), lb = *(const f32x4*)(p.ln_b + po), muv = *(const f32x4*)(p.mu + (size_t)l * 3200 + 2048 + h * 64 + c4);
#pragma unroll 1
    for (int bt = 0; bt < 4; ++bt) {
        f32x4 y[4]; u32x2 vc[4], vp[4], gg[4]; float bo[4];
#pragma unroll
        for (int q = 0; q < 4; ++q) { const int tok = (task * 16 + bt * 4 + q) * 2 + (tid >> 8);
            y[q] = *(const f32x4*)(p.yraw + (size_t)tok * 1024 + h * 64 + c4);
            vc[q] = *(const u32x2*)(p.P + (size_t)tok * NP + C_V + h * 64 + c4);
            vp[q] = (u32x2){0u, 0u};
            if ((tok & (SEQ - 1)) != 0) vp[q] = *(const u32x2*)(p.P + (size_t)(tok - 1) * NP + C_V + h * 64 + c4);
            gg[q] = *(const u32x2*)(p.P + (size_t)tok * NP + C_GA + h * 64 + c4);
            bo[q] = p.ybonus[(size_t)tok * 16 + h]; }
#pragma unroll
        for (int q = 0; q < 4; ++q) { const int tok = (task * 16 + bt * 4 + q) * 2 + (tid >> 8);
            const float mean = red16_sum(y[q].x + y[q].y + y[q].z + y[q].w) * (1.f / 64.f);
            const f32x4 d = y[q] - mean;
            const float var = red16_sum(d.x * d.x + d.y * d.y + d.z * d.z + d.w * d.w) * (1.f / 64.f);
            const float rs = rsqrtf(var + 64e-5f);
            f32x4 v = {bflo(vc[q].x), bfhi(vc[q].x), bflo(vc[q].y), bfhi(vc[q].y)};
            const f32x4 pv = {bflo(vp[q].x), bfhi(vp[q].x), bflo(vp[q].y), bfhi(vp[q].y)};
            v += muv * (pv - v);
            const f32x4 r = d * rs * lw + lb + bo[q] * v;
            u32x2 o; o.x = cvt_pk_bf16(r.x * siluf_(bflo(gg[q].x)), r.y * siluf_(bfhi(gg[q].x))); o.y = cvt_pk_bf16(r.z * siluf_(bflo(gg[q].y)), r.w * siluf_(bfhi(gg[q].y)));
            *(u32x2*)(p.H + (size_t)tok * DM + h * 64 + c4) = o; }
    }
}

constexpr int MB_K = 0, MB_VT = 17408, MB_PW = 35840, MB_KM = 54272, MB_SEL = 57856, MB_TM = 58368;
__device__ void moba_task(const Params& p, LAS unsigned char* lds, int task) {
    const int tid = tid_(), wid = tid >> 6, lane = tid & 63, l15 = lane & 15, lq = lane >> 4;
    const int qt = 15 - (task >> 5), bh = task & 31, b = bh >> 2, h = bh & 3, qblk = qt >> 1, q0 = qt * 128;
    LAS u16* Kt = (LAS u16*)(lds + MB_K); LAS u16* VT = (LAS u16*)(lds + MB_VT); LAS u16* Pw = (LAS u16*)(lds + MB_PW) + wid * 16 * 72;
    LAS float* kmS = (LAS float*)(lds + MB_KM); LAS int* selS = (LAS int*)(lds + MB_SEL); LAS int* tmS = (LAS int*)(lds + MB_TM);
    __syncthreads();
    for (int i = tid; i < qblk * 128; i += 512) kmS[i] = p.kmean[(size_t)(bh * 8) * 128 + i];
    if (tid == 0) *tmS = 0;
    __syncthreads();
    if (tid < 128) {
        const u16* qp = p.P + (size_t)(b * SEQ + q0 + tid) * NP + C_QB + h * 128;
        float g[7];
#pragma unroll
        for (int j = 0; j < 7; ++j) g[j] = 0.f;
        for (int d8 = 0; d8 < 128; d8 += 8) {
            const uint4 v = *(const uint4*)(qp + d8);
            const float q[8] = {bflo(v.x), bfhi(v.x), bflo(v.y), bfhi(v.y), bflo(v.z), bfhi(v.z), bflo(v.w), bfhi(v.w)};
#pragma unroll
            for (int j = 0; j < 7; ++j) if (j < qblk) {
#pragma unroll
                for (int e = 0; e < 8; ++e) g[j] += q[e] * kmS[j * 128 + d8 + e]; }
        }
        int mask = 0;
#pragma unroll
        for (int r = 0; r < 3; ++r) { float best = -INFINITY; int bi = -1;
#pragma unroll
            for (int j = 0; j < 7; ++j) if (j < qblk && !((mask >> j) & 1) && g[j] > best) { best = g[j]; bi = j; }
            if (bi >= 0) mask |= 1 << bi; }
        mask |= 1 << qblk;
        selS[tid] = mask; atomicOr((int*)tmS, mask);
    }
    __syncthreads();
    const int tmask = *tmS;
    bf16x8 qf[4];
    { const u16* qp = p.P + (size_t)(b * SEQ + q0 + wid * 16 + l15) * NP + C_QB + h * 128 + lq * 8;
#pragma unroll
        for (int ks = 0; ks < 4; ++ks) qf[ks] = *(const bf16x8*)(qp + ks * 32); }
    int rm[4]; int wmask = 0;
#pragma unroll
    for (int i = 0; i < 4; ++i) rm[i] = selS[wid * 16 + lq * 4 + i];
    for (int i = 0; i < 16; ++i) wmask |= selS[wid * 16 + i];
    float m[4], ls[4]; f32x4 O[8];
#pragma unroll
    for (int i = 0; i < 4; ++i) { m[i] = -1e30f; ls[i] = 0.f; }
#pragma unroll
    for (int dt = 0; dt < 8; ++dt) O[dt] = (f32x4){0.f, 0.f, 0.f, 0.f};
    const float sc2 = 0.08838834764831845f * 1.4426950408889634f;
    const int last = (q0 + 127) >> 6;
    const int kp = lane & 31, vd8 = (wid * 2 + (lane >> 5)) * 8;
    struct Stage { u32x4 k0, k1, v0, v1; };
    auto issue = [&](Stage& R, int tt) {
        const size_t kb_ = (size_t)(b * SEQ + tt * 64);
        R.k0 = *(const u32x4*)(p.P + (kb_ + (tid >> 4)) * NP + C_KB + h * 128 + (tid & 15) * 8); R.k1 = *(const u32x4*)(p.P + (kb_ + 32 + (tid >> 4)) * NP + C_KB + h * 128 + (tid & 15) * 8);
        R.v0 = *(const u32x4*)(p.P + (kb_ + 2 * kp) * NP + C_VB + h * 128 + vd8); R.v1 = *(const u32x4*)(p.P + (kb_ + 2 * kp + 1) * NP + C_VB + h * 128 + vd8); };
    auto nextv = [&](int t) { ++t; while (t <= last && !((tmask >> (t >> 2)) & 1)) ++t; return t; };
    auto stage = [&](const Stage& R) {
        { const int ka = tid >> 4, kb2 = 32 + (tid >> 4);
          *(LAS u32x4*)(Kt + ((ka & 3) * 16 + (ka >> 2)) * 136 + (tid & 15) * 8) = R.k0; *(LAS u32x4*)(Kt + ((kb2 & 3) * 16 + (kb2 >> 2)) * 136 + (tid & 15) * 8) = R.k1; }
        LAS unsigned* vt = (LAS unsigned*)(VT + vd8 * 72 + 2 * kp);
        vt[0] = (R.v0.x & 0xffffu) | (R.v1.x << 16); vt[36] = (R.v0.x >> 16) | (R.v1.x & 0xffff0000u);
        vt[72] = (R.v0.y & 0xffffu) | (R.v1.y << 16); vt[108] = (R.v0.y >> 16) | (R.v1.y & 0xffff0000u);
        vt[144] = (R.v0.z & 0xffffu) | (R.v1.z << 16); vt[180] = (R.v0.z >> 16) | (R.v1.z & 0xffff0000u);
        vt[216] = (R.v0.w & 0xffffu) | (R.v1.w << 16); vt[252] = (R.v0.w >> 16) | (R.v1.w & 0xffff0000u); };
    auto compute = [&](int ti) {
        const int j = ti >> 2, key0 = ti * 64, qw0 = q0 + wid * 16;
        const bool own = (j == qblk);
        if (((wmask >> j) & 1) && !(own && key0 > qw0 + 15)) {
            f32x4 s[4];
#pragma unroll
            for (int nt = 0; nt < 4; ++nt) { s[nt] = (f32x4){0.f, 0.f, 0.f, 0.f};
#pragma unroll
                for (int ks = 0; ks < 4; ++ks) { const bf16x8 kf = *(const LAS bf16x8*)(Kt + (nt * 16 + l15) * 136 + ks * 32 + lq * 8); s[nt] = mfma16(qf[ks], kf, s[nt]); } }
            const bool diag = own && (key0 + 63 > qw0);
#pragma unroll
            for (int i = 0; i < 4; ++i) {
                const int qpos = qw0 + lq * 4 + i;
                const float bias = (own || ((rm[i] >> j) & 1)) ? 0.f : -3e30f;
                float sv[4];
#pragma unroll
                for (int nt = 0; nt < 4; ++nt) sv[nt] = s[nt][i] * sc2 + bias;
                if (diag) {
#pragma unroll
                    for (int nt = 0; nt < 4; ++nt) sv[nt] = (key0 + l15 * 4 + nt <= qpos) ? sv[nt] : -3e30f; }
                float mx = fmaxf(fmaxf(sv[0], sv[1]), fmaxf(sv[2], sv[3]));
                mx = red16_max(mx);
                const float mnew = fmaxf(m[i], mx), alpha = __builtin_amdgcn_exp2f(m[i] - mnew);
                const float p0 = __builtin_amdgcn_exp2f(sv[0] - mnew), p1 = __builtin_amdgcn_exp2f(sv[1] - mnew), p2 = __builtin_amdgcn_exp2f(sv[2] - mnew), p3 = __builtin_amdgcn_exp2f(sv[3] - mnew);
                u32x2 pw; pw.x = cvt_pk_bf16(p0, p1); pw.y = cvt_pk_bf16(p2, p3);
                *(LAS u32x2*)(Pw + (lq * 4 + i) * 72 + l15 * 4) = pw;
                const float rs = red16_sum((p0 + p1) + (p2 + p3));
                ls[i] = ls[i] * alpha + rs; m[i] = mnew;
#pragma unroll
                for (int dt = 0; dt < 8; ++dt) O[dt][i] *= alpha;
            }
            __builtin_amdgcn_wave_barrier();
            bf16x8 pf[2];
#pragma unroll
            for (int ks = 0; ks < 2; ++ks) pf[ks] = *(const LAS bf16x8*)(Pw + l15 * 72 + ks * 32 + lq * 8);
#pragma unroll
            for (int dt = 0; dt < 8; ++dt)
#pragma unroll
                for (int ks = 0; ks < 2; ++ks) { const bf16x8 vf = *(const LAS bf16x8*)(VT + (dt * 16 + l15) * 72 + ks * 32 + lq * 8); O[dt] = mfma16(pf[ks], vf, O[dt]); }
            __builtin_amdgcn_wave_barrier();
        } };
    Stage R0, R1;
    int ta = 0;
    while (ta <= last && !((tmask >> (ta >> 2)) & 1)) ++ta;
    int tb = nextv(ta);
    if (ta <= last) issue(R0, ta);
    if (tb <= last) issue(R1, tb);
    while (ta <= last) {
        int tc = nextv(tb);
        __syncthreads(); stage(R0); __syncthreads();
        if (tc <= last) issue(R0, tc);
        compute(ta);
        if (tb > last) break;
        int td = nextv(tc);
        __syncthreads(); stage(R1); __syncthreads();
        if (td <= last) issue(R1, td);
        compute(tb);
        ta = tc; tb = td;
    }
#pragma unroll
    for (int i = 0; i < 4; ++i) { const float inv = 1.f / ls[i]; const size_t tok = (size_t)(b * SEQ + q0 + wid * 16 + lq * 4 + i);
#pragma unroll
        for (int dt = 0; dt < 8; ++dt) { const int d = dt * 16 + l15;
            const float g = bf2f(p.P[tok * NP + C_GB + h * 128 + d]);
            p.H[tok * DM + 1024 + h * 128 + d] = f2bf(O[dt][i] * inv * siluf_(g)); } }
}

constexpr int GL_QE = 0, GL_KE = 9216, GL_KDT = 18432, GL_VT = 27648, GL_ATT = 46080, GL_ST = 55296, GL_LA = 73728, GL_TOT = 90112,
              GL_AUP = 92160, GL_LOW = 96256, GL_DEC = 100352, GL_ABS = 100608, GL_GNW = 100864, GL_OB = 0;
__device__ void gla_chunk(const Params& p, int l, LAS unsigned char* lds, int bh, int n, int pass) {
    const int tid = tid_(), wid = tid >> 6, lane = tid & 63, l15 = lane & 15, lq = lane >> 4;
    const int b = bh >> 2, h = bh & 3;
    LAS u16* QE = (LAS u16*)(lds + GL_QE); LAS u16* KE = (LAS u16*)(lds + GL_KE); LAS u16* KDT = (LAS u16*)(lds + GL_KDT); LAS u16* VT = (LAS u16*)(lds + GL_VT);
    LAS u16* ATT = (LAS u16*)(lds + GL_ATT); LAS u16* ST = (LAS u16*)(lds + GL_ST); LAS float* LA = (LAS float*)(lds + GL_LA); LAS float* TOT = (LAS float*)(lds + GL_TOT);
    LAS float* AUP = (LAS float*)(lds + GL_AUP); LAS float* LOW = (LAS float*)(lds + GL_LOW); LAS float* DEC = (LAS float*)(lds + GL_DEC); LAS float* OB = (LAS float*)(lds + GL_OB); LAS float* ABS = (LAS float*)(lds + GL_ABS); LAS float* GNW = (LAS float*)(lds + GL_GNW);
    __syncthreads();
    for (int i = tid; i < 1024; i += 512) AUP[i] = p.a_up[(size_t)l * 16 * 256 + (i >> 6) * 256 + h * 64 + (i & 63)];
    if (tid < 64) ABS[tid] = p.a_b[(size_t)l * 256 + h * 64 + tid];
    if (tid >= 64 && tid < 192) GNW[tid - 64] = p.gnw[(size_t)l * 128 + tid - 64];
    const int rt = wid >> 1, dv0t = (wid & 1) * 4;
    const int tp = lane & 31, dg = wid * 2 + (lane >> 5);
    {
        const size_t tokb = (size_t)(b * SEQ + n * 64);
        const u16* rowp = p.P + (tokb + (tid >> 3)) * NP;
        const u16* rp0 = p.P + (tokb + 2 * tp) * NP; const u16* rp1 = rp0 + NP;
        const unsigned c_low = *(const unsigned*)(rowp + C_LOW + (tid & 7) * 2);
        const u32x2 c_q0 = *(const u32x2*)(rp0 + C_QC + h * 64 + dg * 4), c_q1 = *(const u32x2*)(rp1 + C_QC + h * 64 + dg * 4);
        const u32x2 c_k0 = *(const u32x2*)(rp0 + C_KC + h * 64 + dg * 4), c_k1 = *(const u32x2*)(rp1 + C_KC + h * 64 + dg * 4);
        const u32x4 c_v0 = *(const u32x4*)(rp0 + C_VC + h * 128 + dg * 8), c_v1 = *(const u32x4*)(rp1 + C_VC + h * 128 + dg * 8);
        const u32x4 c_g0 = *(const u32x4*)(rowp + C_GC + h * 128 + (tid & 7) * 16), c_g1 = *(const u32x4*)(rowp + C_GC + h * 128 + (tid & 7) * 16 + 8);
        { const int e2 = tid * 2, t = e2 >> 4, r = e2 & 15; LOW[t * 16 + r] = bflo(c_low); LOW[t * 16 + r + 1] = bfhi(c_low); }
        __syncthreads();
        { const int t = tid >> 3, d0 = (tid & 7) * 8;
            f32x4 lo[4];
#pragma unroll
            for (int i = 0; i < 4; ++i) lo[i] = *(const LAS f32x4*)(LOW + t * 16 + 4 * i);
            f32x4 z0 = *(const LAS f32x4*)(ABS + d0), z1 = *(const LAS f32x4*)(ABS + d0 + 4);
#pragma unroll
            for (int r = 0; r < 16; ++r) { const f32x4 u0 = *(const LAS f32x4*)(AUP + r * 64 + d0), u1 = *(const LAS f32x4*)(AUP + r * 64 + d0 + 4);
                const float lv = lo[r >> 2][r & 3]; z0 += lv * u0; z1 += lv * u1; }
#pragma unroll
            for (int e = 0; e < 4; ++e) { z0[e] = (fminf(z0[e], 0.f) - __logf(1.f + __expf(-fabsf(z0[e])))) * (1.f / 16.f); z1[e] = (fminf(z1[e], 0.f) - __logf(1.f + __expf(-fabsf(z1[e])))) * (1.f / 16.f); }
            *(LAS f32x4*)(LA + t * 64 + d0) = z0; *(LAS f32x4*)(LA + t * 64 + d0 + 4) = z1; }
        __syncthreads();
        { float a = 0.f;
#pragma unroll
            for (int tt = 0; tt < 8; ++tt) { a += LA[(wid * 8 + tt) * 64 + lane]; LA[(wid * 8 + tt) * 64 + lane] = a; }
            TOT[wid * 64 + lane] = a; }
        __syncthreads();
        { const int t0 = 2 * tp, wt = tp >> 2, d0 = dg * 4;
            f32x4 off = {0.f, 0.f, 0.f, 0.f}, tot = {0.f, 0.f, 0.f, 0.f};
#pragma unroll
            for (int w2 = 0; w2 < 8; ++w2) { const f32x4 tv = *(const LAS f32x4*)(TOT + w2 * 64 + d0); tot += tv; off += (w2 < wt) ? tv : (f32x4){0.f, 0.f, 0.f, 0.f}; }
            const f32x4 b0 = *(const LAS f32x4*)(LA + t0 * 64 + d0) + off, b1 = *(const LAS f32x4*)(LA + (t0 + 1) * 64 + d0) + off;
            const float q0[4] = {bflo(c_q0.x), bfhi(c_q0.x), bflo(c_q0.y), bfhi(c_q0.y)}, q1[4] = {bflo(c_q1.x), bfhi(c_q1.x), bflo(c_q1.y), bfhi(c_q1.y)};
            const float k0[4] = {bflo(c_k0.x), bfhi(c_k0.x), bflo(c_k0.y), bfhi(c_k0.y)}, k1[4] = {bflo(c_k1.x), bfhi(c_k1.x), bflo(c_k1.y), bfhi(c_k1.y)};
            float qe0[4], qe1[4], ke0[4], ke1[4];
#pragma unroll
            for (int e = 0; e < 4; ++e) {
                qe0[e] = q0[e] * 0.125f * __expf(b0[e]); qe1[e] = q1[e] * 0.125f * __expf(b1[e]);
                ke0[e] = k0[e] * __expf(-b0[e]); ke1[e] = k1[e] * __expf(-b1[e]);
                *(LAS unsigned*)(KDT + (d0 + e) * 72 + t0) = cvt_pk_bf16(k0[e] * __expf(tot[e] - b0[e]), k1[e] * __expf(tot[e] - b1[e]));
                if (tp == 0) DEC[d0 + e] = __expf(tot[e]); }
            u32x2 o; o.x = cvt_pk_bf16(qe0[0], qe0[1]); o.y = cvt_pk_bf16(qe0[2], qe0[3]); *(LAS u32x2*)(QE + t0 * 72 + d0) = o;
            o.x = cvt_pk_bf16(qe1[0], qe1[1]); o.y = cvt_pk_bf16(qe1[2], qe1[3]); *(LAS u32x2*)(QE + (t0 + 1) * 72 + d0) = o;
            o.x = cvt_pk_bf16(ke0[0], ke0[1]); o.y = cvt_pk_bf16(ke0[2], ke0[3]); *(LAS u32x2*)(KE + t0 * 72 + d0) = o;
            o.x = cvt_pk_bf16(ke1[0], ke1[1]); o.y = cvt_pk_bf16(ke1[2], ke1[3]); *(LAS u32x2*)(KE + (t0 + 1) * 72 + d0) = o;
            { LAS unsigned* vt = (LAS unsigned*)(VT + dg * 8 * 72 + t0);
                vt[0] = (c_v0.x & 0xffffu) | (c_v1.x << 16); vt[36] = (c_v0.x >> 16) | (c_v1.x & 0xffff0000u);
                vt[72] = (c_v0.y & 0xffffu) | (c_v1.y << 16); vt[108] = (c_v0.y >> 16) | (c_v1.y & 0xffff0000u);
                vt[144] = (c_v0.z & 0xffffu) | (c_v1.z << 16); vt[180] = (c_v0.z >> 16) | (c_v1.z & 0xffff0000u);
                vt[216] = (c_v0.w & 0xffffu) | (c_v1.w << 16); vt[252] = (c_v0.w >> 16) | (c_v1.w & 0xffff0000u); } }
        __syncthreads();
        if (pass == 1) {
            bf16x8 kd[2];
#pragma unroll
            for (int ks = 0; ks < 2; ++ks) kd[ks] = *(const LAS bf16x8*)(KDT + (rt * 16 + l15) * 72 + ks * 32 + lq * 8);
            f32x4* gout = (f32x4*)(p.gst + ((size_t)(bh * 32 + n) * 512 + tid) * 16);
#pragma unroll
            for (int c = 0; c < 4; ++c) { const int dvt = dv0t + c; f32x4 acc = {0.f, 0.f, 0.f, 0.f};
#pragma unroll
                for (int ks = 0; ks < 2; ++ks) { const bf16x8 vf = *(const LAS bf16x8*)(VT + (dvt * 16 + l15) * 72 + ks * 32 + lq * 8); acc = mfma16(kd[ks], vf, acc); }
                gout[c] = acc; }
            if (tid < 64) p.gdec[(size_t)(bh * 32 + n) * 64 + tid] = DEC[tid];
            return;
        }
        { bf16x8 af[2];
#pragma unroll
            for (int ks = 0; ks < 2; ++ks) af[ks] = *(const LAS bf16x8*)(QE + (rt * 16 + l15) * 72 + ks * 32 + lq * 8);
#pragma unroll
            for (int c2 = 0; c2 < 2; ++c2) { const int ctile = (wid & 1) * 2 + c2; f32x4 acc = {0.f, 0.f, 0.f, 0.f};
#pragma unroll
                for (int ks = 0; ks < 2; ++ks) { const bf16x8 bf = *(const LAS bf16x8*)(KE + (ctile * 16 + l15) * 72 + ks * 32 + lq * 8); acc = mfma16(af[ks], bf, acc); }
#pragma unroll
                for (int i = 0; i < 4; ++i) { const int t = rt * 16 + lq * 4 + i, jj = ctile * 16 + l15; ATT[t * 72 + jj] = f2bf(jj <= t ? acc[i] : 0.f); } } }
        { f32x4 S[4];
#pragma unroll
            for (int c = 0; c < 4; ++c) S[c] = (f32x4){0.f, 0.f, 0.f, 0.f};
#pragma unroll 2
            for (int m = 0; m < n; ++m) { const f32x4* gin = (const f32x4*)(p.gst + ((size_t)(bh * 32 + m) * 512 + tid) * 16);
                const f32x4 dm = *(const f32x4*)(p.gdec + (size_t)(bh * 32 + m) * 64 + rt * 16 + lq * 4);
#pragma unroll
                for (int c = 0; c < 4; ++c) S[c] = S[c] * dm + gin[c]; }
#pragma unroll
            for (int c = 0; c < 4; ++c) { const int dv = (dv0t + c) * 16 + l15;
                u32x2 sv; sv.x = cvt_pk_bf16(S[c][0], S[c][1]); sv.y = cvt_pk_bf16(S[c][2], S[c][3]);
                *(LAS u32x2*)(ST + dv * 72 + rt * 16 + lq * 4) = sv; } }
        __syncthreads();
        f32x4 oacc[4];
        { bf16x8 at[2], qf[2];
#pragma unroll
            for (int ks = 0; ks < 2; ++ks) { at[ks] = *(const LAS bf16x8*)(ATT + (rt * 16 + l15) * 72 + ks * 32 + lq * 8); qf[ks] = *(const LAS bf16x8*)(QE + (rt * 16 + l15) * 72 + ks * 32 + lq * 8); }
#pragma unroll
            for (int c = 0; c < 4; ++c) { const int dvt = dv0t + c; f32x4 acc = {0.f, 0.f, 0.f, 0.f};
#pragma unroll
                for (int ks = 0; ks < 2; ++ks) { const bf16x8 vf = *(const LAS bf16x8*)(VT + (dvt * 16 + l15) * 72 + ks * 32 + lq * 8), sf = *(const LAS bf16x8*)(ST + (dvt * 16 + l15) * 72 + ks * 32 + lq * 8);
                    acc = mfma16(at[ks], vf, acc); acc = mfma16(qf[ks], sf, acc); }
                oacc[c] = acc; } }
        __syncthreads();
#pragma unroll
        for (int c = 0; c < 4; ++c) { const int dv = (dv0t + c) * 16 + l15;
#pragma unroll
            for (int i = 0; i < 4; ++i) OB[(rt * 16 + lq * 4 + i) * 132 + dv] = oacc[c][i]; }
        __syncthreads();
        { const int t = tid >> 3, dvb = (tid & 7) * 16;
            f32x4 o4[4]; float ss = 0.f;
#pragma unroll
            for (int i = 0; i < 4; ++i) { o4[i] = *(const LAS f32x4*)(OB + t * 132 + dvb + 4 * i); ss += o4[i].x * o4[i].x + o4[i].y * o4[i].y + o4[i].z * o4[i].z + o4[i].w * o4[i].w; }
            ss = red8_sum(ss);
            const float rs = rsqrtf(ss * (1.f / 128.f) + 1e-6f);
            const float g[16] = {bflo(c_g0.x), bfhi(c_g0.x), bflo(c_g0.y), bfhi(c_g0.y), bflo(c_g0.z), bfhi(c_g0.z), bflo(c_g0.w), bfhi(c_g0.w),
                                 bflo(c_g1.x), bfhi(c_g1.x), bflo(c_g1.y), bfhi(c_g1.y), bflo(c_g1.z), bfhi(c_g1.z), bflo(c_g1.w), bfhi(c_g1.w)};
            float r[16];
#pragma unroll
            for (int e = 0; e < 16; ++e) r[e] = o4[e >> 2][e & 3] * rs * GNW[dvb + e] * siluf_(g[e]);
            u32x4 w0, w1; w0.x = cvt_pk_bf16(r[0], r[1]); w0.y = cvt_pk_bf16(r[2], r[3]); w0.z = cvt_pk_bf16(r[4], r[5]); w0.w = cvt_pk_bf16(r[6], r[7]);
            w1.x = cvt_pk_bf16(r[8], r[9]); w1.y = cvt_pk_bf16(r[10], r[11]); w1.z = cvt_pk_bf16(r[12], r[13]); w1.w = cvt_pk_bf16(r[14], r[15]);
            u16* op = p.H + (tokb + t) * DM + 1536 + h * 128 + dvb;
            *(u32x4*)op = w0; *(u32x4*)(op + 8) = w1; }
    }
}

__device__ void gla_task(const Params& p, int l, LAS unsigned char* lds, int bh, int hs, int nlen) {
    const int tid = tid_(), wid = tid >> 6, lane = tid & 63, l15 = lane & 15, lq = lane >> 4;
    const int b = bh >> 2, h = bh & 3;
    LAS u16* QE = (LAS u16*)(lds + GL_QE); LAS u16* KE = (LAS u16*)(lds + GL_KE); LAS u16* KDT = (LAS u16*)(lds + GL_KDT); LAS u16* VT = (LAS u16*)(lds + GL_VT);
    LAS u16* ATT = (LAS u16*)(lds + GL_ATT); LAS u16* ST = (LAS u16*)(lds + GL_ST); LAS float* LA = (LAS float*)(lds + GL_LA); LAS float* TOT = (LAS float*)(lds + GL_TOT);
    LAS float* AUP = (LAS float*)(lds + GL_AUP); LAS float* LOW = (LAS float*)(lds + GL_LOW); LAS float* DEC = (LAS float*)(lds + GL_DEC); LAS float* OB = (LAS float*)(lds + GL_OB); LAS float* ABS = (LAS float*)(lds + GL_ABS); LAS float* GNW = (LAS float*)(lds + GL_GNW);
    __syncthreads();
    for (int i = tid; i < 1024; i += 512) AUP[i] = p.a_up[(size_t)l * 16 * 256 + (i >> 6) * 256 + h * 64 + (i & 63)];
    for (int i = tid; i < 128 * 72 / 2; i += 512) ((LAS unsigned*)ST)[i] = 0u;
    if (tid < 64) ABS[tid] = p.a_b[(size_t)l * 256 + h * 64 + tid];
    if (tid >= 64 && tid < 192) GNW[tid - 64] = p.gnw[(size_t)l * 128 + tid - 64];
    f32x4 Sacc[4];
#pragma unroll
    for (int c = 0; c < 4; ++c) Sacc[c] = (f32x4){0.f, 0.f, 0.f, 0.f};
    const int rt = wid >> 1, dv0t = (wid & 1) * 4;
    const int tp = lane & 31, dg = wid * 2 + (lane >> 5);
    if (hs) {
#pragma unroll 2
        for (int m = 0; m < 16; ++m) { const f32x4* gin = (const f32x4*)(p.gst + ((size_t)(bh * 32 + m) * 512 + tid) * 16);
            const f32x4 dm = *(const f32x4*)(p.gdec + (size_t)(bh * 32 + m) * 64 + rt * 16 + lq * 4);
#pragma unroll
            for (int c = 0; c < 4; ++c) Sacc[c] = Sacc[c] * dm + gin[c]; }
        __syncthreads();
#pragma unroll
        for (int c = 0; c < 4; ++c) { const int dv = (dv0t + c) * 16 + l15;
            u32x2 sv; sv.x = cvt_pk_bf16(Sacc[c][0], Sacc[c][1]); sv.y = cvt_pk_bf16(Sacc[c][2], Sacc[c][3]);
            *(LAS u32x2*)(ST + dv * 72 + rt * 16 + lq * 4) = sv; }
    }
    for (int n = hs * 16; n < hs * 16 + nlen; ++n) {
        const size_t tokb = (size_t)(b * SEQ + n * 64);
        const u16* rowp = p.P + (tokb + (tid >> 3)) * NP;
        const u16* rp0 = p.P + (tokb + 2 * tp) * NP; const u16* rp1 = rp0 + NP;
        const unsigned c_low = *(const unsigned*)(rowp + C_LOW + (tid & 7) * 2);
        const u32x2 c_q0 = *(const u32x2*)(rp0 + C_QC + h * 64 + dg * 4), c_q1 = *(const u32x2*)(rp1 + C_QC + h * 64 + dg * 4);
        const u32x2 c_k0 = *(const u32x2*)(rp0 + C_KC + h * 64 + dg * 4), c_k1 = *(const u32x2*)(rp1 + C_KC + h * 64 + dg * 4);
        const u32x4 c_v0 = *(const u32x4*)(rp0 + C_VC + h * 128 + dg * 8), c_v1 = *(const u32x4*)(rp1 + C_VC + h * 128 + dg * 8);
        const u32x4 c_g0 = *(const u32x4*)(rowp + C_GC + h * 128 + (tid & 7) * 16), c_g1 = *(const u32x4*)(rowp + C_GC + h * 128 + (tid & 7) * 16 + 8);
        { const int e2 = tid * 2, t = e2 >> 4, r = e2 & 15; LOW[t * 16 + r] = bflo(c_low); LOW[t * 16 + r + 1] = bfhi(c_low); }
        __syncthreads();
        { const int t = tid >> 3, d0 = (tid & 7) * 8;
            f32x4 lo[4];
#pragma unroll
            for (int i = 0; i < 4; ++i) lo[i] = *(const LAS f32x4*)(LOW + t * 16 + 4 * i);
            f32x4 z0 = *(const LAS f32x4*)(ABS + d0), z1 = *(const LAS f32x4*)(ABS + d0 + 4);
#pragma unroll
            for (int r = 0; r < 16; ++r) { const f32x4 u0 = *(const LAS f32x4*)(AUP + r * 64 + d0), u1 = *(const LAS f32x4*)(AUP + r * 64 + d0 + 4);
                const float lv = lo[r >> 2][r & 3]; z0 += lv * u0; z1 += lv * u1; }
#pragma unroll
            for (int e = 0; e < 4; ++e) { z0[e] = (fminf(z0[e], 0.f) - __logf(1.f + __expf(-fabsf(z0[e])))) * (1.f / 16.f); z1[e] = (fminf(z1[e], 0.f) - __logf(1.f + __expf(-fabsf(z1[e])))) * (1.f / 16.f); }
            *(LAS f32x4*)(LA + t * 64 + d0) = z0; *(LAS f32x4*)(LA + t * 64 + d0 + 4) = z1; }
        __syncthreads();
        { float a = 0.f;
#pragma unroll
            for (int tt = 0; tt < 8; ++tt) { a += LA[(wid * 8 + tt) * 64 + lane]; LA[(wid * 8 + tt) * 64 + lane] = a; }
            TOT[wid * 64 + lane] = a; }
        __syncthreads();
        { const int t0 = 2 * tp, wt = tp >> 2, d0 = dg * 4;
            f32x4 off = {0.f, 0.f, 0.f, 0.f}, tot = {0.f, 0.f, 0.f, 0.f};
#pragma unroll
            for (int w2 = 0; w2 < 8; ++w2) { const f32x4 tv = *(const LAS f32x4*)(TOT + w2 * 64 + d0); tot += tv; off += (w2 < wt) ? tv : (f32x4){0.f, 0.f, 0.f, 0.f}; }
            const f32x4 b0 = *(const LAS f32x4*)(LA + t0 * 64 + d0) + off, b1 = *(const LAS f32x4*)(LA + (t0 + 1) * 64 + d0) + off;
            const float q0[4] = {bflo(c_q0.x), bfhi(c_q0.x), bflo(c_q0.y), bfhi(c_q0.y)}, q1[4] = {bflo(c_q1.x), bfhi(c_q1.x), bflo(c_q1.y), bfhi(c_q1.y)};
            const float k0[4] = {bflo(c_k0.x), bfhi(c_k0.x), bflo(c_k0.y), bfhi(c_k0.y)}, k1[4] = {bflo(c_k1.x), bfhi(c_k1.x), bflo(c_k1.y), bfhi(c_k1.y)};
            float qe0[4], qe1[4], ke0[4], ke1[4];
#pragma unroll
            for (int e = 0; e < 4; ++e) {
                qe0[e] = q0[e] * 0.125f * __expf(b0[e]); qe1[e] = q1[e] * 0.125f * __expf(b1[e]);
                ke0[e] = k0[e] * __expf(-b0[e]); ke1[e] = k1[e] * __expf(-b1[e]);
                *(LAS unsigned*)(KDT + (d0 + e) * 72 + t0) = cvt_pk_bf16(k0[e] * __expf(tot[e] - b0[e]), k1[e] * __expf(tot[e] - b1[e]));
                if (tp == 0) DEC[d0 + e] = __expf(tot[e]); }
            u32x2 o; o.x = cvt_pk_bf16(qe0[0], qe0[1]); o.y = cvt_pk_bf16(qe0[2], qe0[3]); *(LAS u32x2*)(QE + t0 * 72 + d0) = o;
            o.x = cvt_pk_bf16(qe1[0], qe1[1]); o.y = cvt_pk_bf16(qe1[2], qe1[3]); *(LAS u32x2*)(QE + (t0 + 1) * 72 + d0) = o;
            o.x = cvt_pk_bf16(ke0[0], ke0[1]); o.y = cvt_pk_bf16(ke0[2], ke0[3]); *(LAS u32x2*)(KE + t0 * 72 + d0) = o;
            o.x = cvt_pk_bf16(ke1[0], ke1[1]); o.y = cvt_pk_bf16(ke1[2], ke1[3]); *(LAS u32x2*)(KE + (t0 + 1) * 72 + d0) = o;
            { LAS unsigned* vt = (LAS unsigned*)(VT + dg * 8 * 72 + t0);
                vt[0] = (c_v0.x & 0xffffu) | (c_v1.x << 16); vt[36] = (c_v0.x >> 16) | (c_v1.x & 0xffff0000u);
                vt[72] = (c_v0.y & 0xffffu) | (c_v1.y << 16); vt[108] = (c_v0.y >> 16) | (c_v1.y & 0xffff0000u);
                vt[144] = (c_v0.z & 0xffffu) | (c_v1.z << 16); vt[180] = (c_v0.z >> 16) | (c_v1.z & 0xffff0000u);
                vt[216] = (c_v0.w & 0xffffu) | (c_v1.w << 16); vt[252] = (c_v0.w >> 16) | (c_v1.w & 0xffff0000u); } }
        __syncthreads();
        { bf16x8 af[2];
#pragma unroll
            for (int ks = 0; ks < 2; ++ks) af[ks] = *(const LAS bf16x8*)(QE + (rt * 16 + l15) * 72 + ks * 32 + lq * 8);
#pragma unroll
            for (int c2 = 0; c2 < 2; ++c2) { const int ctile = (wid & 1) * 2 + c2; f32x4 acc = {0.f, 0.f, 0.f, 0.f};
#pragma unroll
                for (int ks = 0; ks < 2; ++ks) { const bf16x8 bf = *(const LAS bf16x8*)(KE + (ctile * 16 + l15) * 72 + ks * 32 + lq * 8); acc = mfma16(af[ks], bf, acc); }
#pragma unroll
                for (int i = 0; i < 4; ++i) { const int t = rt * 16 + lq * 4 + i, jj = ctile * 16 + l15; ATT[t * 72 + jj] = f2bf(jj <= t ? acc[i] : 0.f); } } }
        __syncthreads();
        f32x4 oacc[4];
        { bf16x8 at[2], qf[2], kd[2];
#pragma unroll
            for (int ks = 0; ks < 2; ++ks) { at[ks] = *(const LAS bf16x8*)(ATT + (rt * 16 + l15) * 72 + ks * 32 + lq * 8); qf[ks] = *(const LAS bf16x8*)(QE + (rt * 16 + l15) * 72 + ks * 32 + lq * 8);
                kd[ks] = *(const LAS bf16x8*)(KDT + (rt * 16 + l15) * 72 + ks * 32 + lq * 8); }
            const f32x4 dec = *(const LAS f32x4*)(DEC + rt * 16 + lq * 4);
#pragma unroll
            for (int c = 0; c < 4; ++c) { const int dvt = dv0t + c; f32x4 acc = {0.f, 0.f, 0.f, 0.f};
                Sacc[c] *= dec;
#pragma unroll
                for (int ks = 0; ks < 2; ++ks) { const bf16x8 vf = *(const LAS bf16x8*)(VT + (dvt * 16 + l15) * 72 + ks * 32 + lq * 8), sf = *(const LAS bf16x8*)(ST + (dvt * 16 + l15) * 72 + ks * 32 + lq * 8);
                    acc = mfma16(at[ks], vf, acc); acc = mfma16(qf[ks], sf, acc); Sacc[c] = mfma16(kd[ks], vf, Sacc[c]); }
                oacc[c] = acc; } }
        __syncthreads();
#pragma unroll
        for (int c = 0; c < 4; ++c) { const int dv = (dv0t + c) * 16 + l15;
#pragma unroll
            for (int i = 0; i < 4; ++i) OB[(rt * 16 + lq * 4 + i) * 132 + dv] = oacc[c][i];
            u32x2 sv; sv.x = cvt_pk_bf16(Sacc[c][0], Sacc[c][1]); sv.y = cvt_pk_bf16(Sacc[c][2], Sacc[c][3]);
            *(LAS u32x2*)(ST + dv * 72 + rt * 16 + lq * 4) = sv; }
        __syncthreads();
        { const int t = tid >> 3, dvb = (tid & 7) * 16;
            f32x4 o4[4]; float ss = 0.f;
#pragma unroll
            for (int i = 0; i < 4; ++i) { o4[i] = *(const LAS f32x4*)(OB + t * 132 + dvb + 4 * i); ss += o4[i].x * o4[i].x + o4[i].y * o4[i].y + o4[i].z * o4[i].z + o4[i].w * o4[i].w; }
            ss = red8_sum(ss);
            const float rs = rsqrtf(ss * (1.f / 128.f) + 1e-6f);
            const float g[16] = {bflo(c_g0.x), bfhi(c_g0.x), bflo(c_g0.y), bfhi(c_g0.y), bflo(c_g0.z), bfhi(c_g0.z), bflo(c_g0.w), bfhi(c_g0.w),
                                 bflo(c_g1.x), bfhi(c_g1.x), bflo(c_g1.y), bfhi(c_g1.y), bflo(c_g1.z), bfhi(c_g1.z), bflo(c_g1.w), bfhi(c_g1.w)};
            float r[16];
#pragma unroll
            for (int e = 0; e < 16; ++e) r[e] = o4[e >> 2][e & 3] * rs * GNW[dvb + e] * siluf_(g[e]);
            u32x4 w0, w1; w0.x = cvt_pk_bf16(r[0], r[1]); w0.y = cvt_pk_bf16(r[2], r[3]); w0.z = cvt_pk_bf16(r[4], r[5]); w0.w = cvt_pk_bf16(r[6], r[7]);
            w1.x = cvt_pk_bf16(r[8], r[9]); w1.y = cvt_pk_bf16(r[10], r[11]); w1.z = cvt_pk_bf16(r[12], r[13]); w1.w = cvt_pk_bf16(r[14], r[15]);
            u16* op = p.H + (tokb + t) * DM + 1536 + h * 128 + dvb;
            *(u32x4*)op = w0; *(u32x4*)(op + 8) = w1; }
        __syncthreads();
    }
}

#define XB_TMO      128
#define XB_XCNT(j)  (256  + 64 * (j))
#define XB_XSUB(j)  (1280 + 64 * (j))
#define XB_XGEN(j)  (2304 + 64 * (j))
#define XB_TOP      3328
#define XB_TOPGEN   3392
#define XCD_BAR_WORDS 3456
#define XB_SPIN_CAP (1u << 18)

__device__ __forceinline__ unsigned xb_ld(unsigned* p)              { return __hip_atomic_load(p, __ATOMIC_RELAXED, __HIP_MEMORY_SCOPE_AGENT); }
__device__ __forceinline__ unsigned xb_add(unsigned* p, unsigned v) { return __hip_atomic_fetch_add(p, v, __ATOMIC_RELAXED, __HIP_MEMORY_SCOPE_AGENT); }
__device__ __forceinline__ unsigned xb_xcc_id() { return (unsigned)__builtin_amdgcn_s_getreg((3 << 11) | 20) & 0xFu; }
#define XB_SPIN(cond, bar) do { unsigned _sp = 0; while (cond) { __builtin_amdgcn_s_sleep(1); \
    if ((++_sp & 255u) == 0u) { if (xb_ld(&(bar)[XB_TMO])) break; if (_sp > XB_SPIN_CAP) { atomicAdd(&(bar)[XB_TMO], 1u); break; } } } } while (0)

struct XcdBarrier {
    unsigned* bar; unsigned x;
    volatile LAS unsigned* st;
};

__device__ __forceinline__ XcdBarrier xcd_barrier_post(unsigned* bar, volatile LAS unsigned* st) {
    XcdBarrier b; b.bar = bar; b.x = xb_xcc_id(); b.st = st;
    if (threadIdx.x == 0) (void)xb_add(&bar[XB_XCNT(b.x)], 1u);
    return b;
}
__device__ __forceinline__ void xcd_barrier_complete(unsigned* bar, unsigned x, unsigned& nloc, unsigned& nx) {
    const unsigned G = gridDim.x * gridDim.y * gridDim.z;
    unsigned sum, cnt, mine, sp = 0u;
    for (;;) {
        sum = 0u; cnt = 0u; mine = 0u;
#pragma unroll
        for (unsigned j = 0; j < 16; ++j) { const unsigned c = xb_ld(&bar[XB_XCNT(j)]); sum += c; cnt += (c > 0u) ? 1u : 0u; mine = (j == x) ? c : mine; }
        if (sum == G) break;
        __builtin_amdgcn_s_sleep(1);
        if ((++sp & 255u) == 0u) { if (xb_ld(&bar[XB_TMO])) break; if (sp > XB_SPIN_CAP) { atomicAdd(&bar[XB_TMO], 1u); break; } }
    }
    nloc = mine > 0u ? mine : 1u; nx = cnt > 0u ? cnt : 1u;
}

__device__ __forceinline__ void xcd_barrier(const XcdBarrier& b) {
    asm volatile("s_waitcnt vmcnt(0)" ::: "memory");
    __syncthreads();
    if (threadIdx.x == 0) {
        unsigned* bar = b.bar;
        __builtin_amdgcn_s_waitcnt(0);
        unsigned nloc = b.st[0], nx = b.st[1];
        if (nloc == 0u) { xcd_barrier_complete(bar, b.x, nloc, nx); b.st[0] = nloc; b.st[1] = nx; }
        const unsigned old = xb_add(&bar[XB_XSUB(b.x)], 1u);
        const unsigned gen = old / nloc;
        if (old + 1u == (gen + 1u) * nloc) {
            __builtin_amdgcn_fence(__ATOMIC_RELEASE, "agent");
            asm volatile("s_waitcnt vmcnt(0)" ::: "memory");
            const unsigned og = xb_add(&bar[XB_TOP], 1u);
            const unsigned tg = og / nx;
            if (og + 1u == (tg + 1u) * nx) xb_add(&bar[XB_TOPGEN], 1u);
            else XB_SPIN(xb_ld(&bar[XB_TOPGEN]) == tg, bar);
            __builtin_amdgcn_fence(__ATOMIC_ACQUIRE, "agent");
            xb_add(&bar[XB_XGEN(b.x)], 1u);
            asm volatile("s_waitcnt vmcnt(0)" ::: "memory");
        } else {
            XB_SPIN(xb_ld(&bar[XB_XGEN(b.x)]) == gen, bar);
            __builtin_amdgcn_fence(__ATOMIC_ACQUIRE, "agent");
            asm volatile("s_waitcnt vmcnt(0)" ::: "memory");
        }
    }
    __syncthreads();
}

constexpr int N_PHASES = 13;
__device__ __forceinline__ void run_phase(const Params& p, int ph, LAS unsigned char* lds, LAS unsigned* qslot, int bid, int nb) {
    if (ph == 0) {
        transpose_cvt(lds, p.w_in, p.WtIn, DM, DIN, NP, bid, nb);
        transpose_cvt(lds, p.w_out, p.WtOut, DM, DM, DM, bid, nb);
        for (int l = 0; l < 2; ++l) {
            transpose_cvt(lds, p.w2 + (size_t)l * 64 * 1024, p.W2t + (size_t)l * 1024 * 64, 64, 1024, 1024, bid, nb);
            transpose_cvt(lds, p.a2 + (size_t)l * 64 * 1024, p.A2t + (size_t)l * 1024 * 64, 64, 1024, 1024, bid, nb);
        }
        rmsnorm_phase(p.x, p.norm_w, p.H, nullptr, bid, nb);
        return;
    }
    const int l = (ph - 1) / 6, s = (ph - 1) % 6;
    if (s == 0) {
        Gemm g; g.A = p.H; g.Bt = p.WtIn + (size_t)l * NP * DM; g.M = MTOK; g.N = NP; g.K = DM;
        StaticOrder S; S.init(MTOK, NP, nb, bid);
        EpiP E; E.O = p.P; E.ldc = NP;
        gemm_phase<EpiP, StaticOrder, false>(lds, g, S, E, nullptr);
    } else if (s == 1) {
        kmean_phase(p, lds, bid, nb);
    } else if (s == 2) {
        const int nscan = nb >> 1;
        if (bid < nscan) {
            for (int task = bid; task < 128; task += nscan) rwkv_scan_task(p, l, lds, task);
        } else {
            LAS int* slot = (LAS int*)qslot;
            for (;;) {
                __syncthreads();
                if (tid_() == 0) *slot = (int)atomicAdd(p.bar + 64 * l, 1u);
                __syncthreads();
                const int tk = *slot;
#ifdef PROBE_MOBA2
                if (tk >= 32 + 768) break;
                if (tk < 32) gla_task(p, l, lds, tk, 0, 32);
                else moba_task(p, lds, (tk - 32) % 512);
#else
                if (tk >= 32 + 512 + (l == 0 ? 312 : 0)) break;
                if (tk < 32) gla_task(p, l, lds, tk, 0, 32);
                else if (tk < 544) moba_task(p, lds, tk - 32);
                else { const int ct = tk - 544;
                    __syncthreads();
                    if (ct < 248) transpose_cvt_range(lds, p.w_in + (size_t)DM * DIN, p.WtIn + (size_t)NP * DM, DM, DIN, NP, ct * 16, ct * 16 + 16, 1);
                    else transpose_cvt_range(lds, p.w_out + (size_t)DM * DM, p.WtOut + (size_t)DM * DM, DM, DM, DM, (ct - 248) * 16, (ct - 248) * 16 + 16, 1); }
#endif
            }
        }
    } else if (s == 3) {
        for (int tk = bid; tk < 512; tk += nb) rwkv_post_task(p, l, tk);
    } else if (s == 4) {
        Gemm g; g.A = p.H; g.Bt = p.WtOut + (size_t)l * DM * DM; g.M = MTOK; g.N = DM; g.K = DM;
        StaticOrder S; S.init(MTOK, DM, nb, bid);
        EpiRes E; E.R = (l == 0) ? p.x : p.out; E.C = p.out; E.ldc = DM;
        gemm_phase<EpiRes, StaticOrder, false>(lds, g, S, E, nullptr);
    } else {
        if (l == 0) rmsnorm_phase(p.out, p.norm_w + DM, p.H, nullptr, bid, nb);
        else rmsnorm_phase(p.out, p.fnw, nullptr, p.out, bid, nb);
    }
}

__global__ void __launch_bounds__(512, 2) hybrid_fwd(Params p) {
    extern __shared__ __attribute__((aligned(16))) unsigned char shm[];
    LAS unsigned char* lds = (LAS unsigned char*)shm;
    const int bid = blockIdx.x, nb = gridDim.x;
#if defined(TEST_GEMM)
    { Gemm g; g.A = p.H; g.Bt = p.WtIn; g.M = MTOK; g.N = NP; g.K = DM;
      StaticOrder S; S.init(MTOK, NP, nb, bid);
      EpiP E; E.O = p.P; E.ldc = NP;
      gemm_phase<EpiP, StaticOrder, false>(lds, g, S, E, nullptr);
#if TEST_GEMM >= 2
      if (p.phase_lo) {
      Gemm g2; g2.A = p.H; g2.Bt = p.WtOut; g2.M = MTOK; g2.N = DM; g2.K = DM;
      StaticOrder S2; S2.init(MTOK, DM, nb, bid);
      EpiRes E2; E2.R = p.x; E2.C = p.out; E2.ldc = DM;
      gemm_phase<EpiRes, StaticOrder, false>(lds, g2, S2, E2, nullptr); }
#endif
    }
#elif ONE_LAUNCH
    cg::grid_group grid = cg::this_grid();
    __shared__ uint4 xb_words;
    if (threadIdx.x == 0) xb_words = make_uint4(0u, 0u, 0u, 0u);
    __syncthreads();
    const XcdBarrier xb = xcd_barrier_post(p.bar, (volatile LAS unsigned*)&xb_words);
    for (int ph = p.phase_lo; ph < p.phase_hi; ++ph) {
        run_phase(p, ph, lds, (LAS unsigned*)&xb_words.z, bid, nb);
#ifdef REPEAT_PH
        if (ph == REPEAT_PH) { xcd_barrier(xb); run_phase(p, ph, lds, (LAS unsigned*)&xb_words.z, bid, nb); }
#endif
        if (ph + 1 < p.phase_hi) { if (p.phase_lo < 0) grid.sync(); else xcd_barrier(xb); }
    }
#else
    run_phase(p, p.phase_lo, lds, nullptr, bid, nb);
#endif
}

extern "C" void kernel_launch(void* const* d_in, const int* in_sizes, int n_in, void* d_out, int out_size, void* d_ws, size_t ws_size, hipStream_t stream) {
    static int grid = 0;
    if (grid == 0) {
        int dev = 0, cus = 0, per_cu = 0;
        hipGetDevice(&dev);
        hipDeviceGetAttribute(&cus, hipDeviceAttributeMultiprocessorCount, dev);
        hipFuncSetAttribute((const void*)hybrid_fwd, hipFuncAttributeMaxDynamicSharedMemorySize, LDS_BYTES);
        hipOccupancyMaxActiveBlocksPerMultiprocessor(&per_cu, (const void*)hybrid_fwd, 512, LDS_BYTES);
        if (per_cu < 1) { fprintf(stderr, "kernel_launch: occupancy query says %d blocks per CU\n", per_cu); per_cu = 1; }
        (void)hipGetLastError();
        grid = cus;
    }
    Params p{};
    const float* const* in = (const float* const*)d_in;
    p.x = in[0]; p.norm_w = in[1]; p.w_in = in[2]; p.w_out = in[3]; p.mu = in[4]; p.w0 = in[5]; p.w2 = in[6]; p.a0 = in[7]; p.a2 = in[8];
    p.k_k = in[9]; p.k_a = in[10]; p.r_k = in[11]; p.ln_w = in[12]; p.ln_b = in[13]; p.a_up = in[14]; p.a_b = in[15]; p.gnw = in[16]; p.fnw = in[17];
    p.out = (float*)d_out;
    unsigned char* ws = (unsigned char*)d_ws; size_t off = 0;
    auto take = [&](size_t bytes) { unsigned char* r = ws + off; off += (bytes + 255) & ~(size_t)255; return r; };
    p.WtIn = (u16*)take((size_t)2 * NP * DM * 2); p.WtOut = (u16*)take((size_t)2 * DM * DM * 2);
    p.W2t = (u16*)take((size_t)2 * 1024 * 64 * 2); p.A2t = (u16*)take((size_t)2 * 1024 * 64 * 2);
    p.H = (u16*)take((size_t)MTOK * DM * 2); p.P = (u16*)take((size_t)MTOK * NP * 2);
    p.yraw = (float*)take((size_t)MTOK * 1024 * 4); p.ybonus = (float*)take((size_t)MTOK * 16 * 4); p.kmean = (float*)take((size_t)256 * 128 * 4);
    p.bar = (unsigned*)take((size_t)XCD_BAR_WORDS * 4);
    p.gst = (float*)take((size_t)1024 * 8192 * 4); p.gdec = (float*)take((size_t)1024 * 64 * 4);
    if (off > ws_size) { fprintf(stderr, "kernel_launch: workspace too small (%zu > %zu)\n", off, ws_size); return; }
#if ONE_LAUNCH
    hipMemsetAsync(p.bar, 0, (size_t)XCD_BAR_WORDS * 4, stream);
    p.phase_lo = 0; p.phase_hi = N_PHASES;
    void* args[] = {&p};
    hipError_t e = hipLaunchCooperativeKernel((const void*)hybrid_fwd, dim3(grid), dim3(512), args, LDS_BYTES, stream);
    if (e != hipSuccess) fprintf(stderr, "cooperative launch failed: %s (grid %d)\n", hipGetErrorString(e), grid);
#else
    for (int ph = 0; ph < N_PHASES; ++ph) { p.phase_lo = ph; p.phase_hi = ph + 1; hipLaunchKernelGGL(hybrid_fwd, dim3(grid), dim3(512), LDS_BYTES, stream, p); }
#endif
}
```

```cpp
#include <hip/hip_runtime.h>
#include <hip/hip_cooperative_groups.h>
#include <cstdio>
namespace cg = cooperative_groups;

#ifndef ONE_LAUNCH
#define ONE_LAUNCH 1
#endif

namespace pg8 {
#define PG8_LAS __attribute__((address_space(3)))
typedef unsigned short bf16_t;
typedef short bf16x8 __attribute__((ext_vector_type(8)));
typedef float f32x4 __attribute__((ext_vector_type(4)));
typedef unsigned u32x4 __attribute__((ext_vector_type(4)));
constexpr int BM = 256, BK = 64, HALF = 128, HTB = HALF * BK * 2  , STAGE_BYTES = 8 * HTB, NXCD = 8, WGM = 8;

__host__ __device__ __forceinline__ int lds_byte(int r, int c) { const int st = (r >> 4) * 2 + (c >> 5), rr = r & 15, cc = c & 31, ob = rr * 64 + cc * 2; return st * 1024 + (ob ^ (((ob >> 9) & 1) << 5)); }
__host__ __device__ __forceinline__ void stage_rc(int b, int& R, int& C) { const int st = b / 1024, sb = b % 1024, swz = sb ^ (((sb >> 9) & 1) << 5); R = (st >> 1) * 16 + swz / 64; C = (st & 1) * 32 + (swz % 64) / 2; }
__host__ __device__ __forceinline__ int perm32(int rho) { const int n = rho >> 4, i = rho & 15; return 8 * (i >> 2) + 4 * n + (i & 3); }

struct Unit { int pm, pn; };
struct Gemm { const bf16_t* A; const bf16_t* Bt; int M, N, K; };

struct StaticOrder {
    int nM, nN, nwg, G, c;
    __host__ __device__ void init(int M, int N, int G_, int c_) { nM = M / BM; nN = N / BM; nwg = nM * nN; G = G_; c = c_; }
    __host__ __device__ bool next(int i, Unit& u) const {
        const long L = (long)i * G + c; if (L >= nwg) return false;
        int wgid = (int)L; { const int q = nwg / NXCD, r = nwg % NXCD, xcd = wgid % NXCD, off = wgid / NXCD; wgid = (xcd < r ? xcd * (q + 1) : r * (q + 1) + (xcd - r) * q) + off; }
        const int nig = WGM * nN, gid = wgid / nig, fm = gid * WGM, gsz = (nM - fm) < WGM ? (nM - fm) : WGM;
        u.pm = fm + ((wgid % nig) % gsz); u.pn = (wgid % nig) / gsz; return true;
    }
    __device__ __forceinline__ void a_ready(const Unit&) const {}
    __device__ __forceinline__ void done(const Unit&) const {}
};
__device__ __forceinline__ unsigned cvt_pk_bf16(float lo, float hi) { unsigned r; asm volatile("v_cvt_pk_bf16_f32 %0, %1, %2" : "=v"(r) : "v"(lo), "v"(hi)); return r; }
template <class Epi, class Sched, bool STAMP = false>
__device__ __forceinline__ void gemm_phase(PG8_LAS unsigned char* lds, const Gemm g, const Sched& S, const Epi& E, unsigned long long* stamps) {
    int tid = threadIdx.x; asm volatile("" : "+v"(tid)); const int wid = __builtin_amdgcn_readfirstlane(tid >> 6), lane = tid & 63, wr = wid >> 2, wc = wid & 3, fr = lane & 15, fq = lane >> 4;
    const int K = g.K, nt = K / BK;
    int ts_lo = 0, ts_hi = 0, nts = 0; const unsigned long long rt_entry = STAMP ? (unsigned long long)wall_clock64() : 0ull;
#define PG8_STAMP() do { if (STAMP && wid == 0 && nts < 64) { const unsigned long long _c = (unsigned long long)clock64(); \
        ts_lo = (lane == nts) ? (int)(unsigned)_c : ts_lo; ts_hi = (lane == nts) ? (int)(unsigned)(_c >> 32) : ts_hi; ++nts; } } while (0)
    PG8_STAMP();
    unsigned voffA[2], voffB[2];
#pragma unroll
    for (int i = 0; i < 2; ++i) { int R, C; stage_rc(tid * 16 + i * 8192, R, C); const int Rb = Epi::PERM ? ((R & ~31) + perm32(R & 31)) : R;
        voffA[i] = (unsigned)(R * K + C) * 2u; voffB[i] = (unsigned)(Rb * K + C) * 2u; }
    const size_t kstep = (size_t)(BK * 2);
    const size_t hstep = (size_t)HALF * K * 2;
    const size_t tstep = 2 * hstep;
    const unsigned ldsw = (unsigned)wid * 1024u;
    const int aoff = lds_byte(wr * 64 + fr, fq * 8), boff = lds_byte(wc * 32 + fr, fq * 8);
#define PG8_SA(b, h) (((b) * 2 + (h)) * HTB)
#define PG8_SB(b, h) ((4 + (b) * 2 + (h)) * HTB)
#define PG8_STAGE(bufoff, gbase, voff) do { _Pragma("unroll") for (int _i = 0; _i < 2; ++_i) \
        __builtin_amdgcn_global_load_lds((const unsigned*)((const char*)(gbase) + (voff)[_i]), (PG8_LAS unsigned*)(lds + (bufoff) + ldsw + _i * 8192), 16, 0, 0); } while (0)
#define PG8_LDA(dst, b, h) do { _Pragma("unroll") for (int m = 0; m < 4; ++m) _Pragma("unroll") for (int k = 0; k < 2; ++k) dst[m][k] = *(const PG8_LAS bf16x8*)(lds + PG8_SA(b, h) + aoff + m * 2048 + k * 1024); } while (0)
#define PG8_LDB(dst, b, h) do { _Pragma("unroll") for (int n = 0; n < 2; ++n) _Pragma("unroll") for (int k = 0; k < 2; ++k) dst[n][k] = *(const PG8_LAS bf16x8*)(lds + PG8_SB(b, h) + boff + n * 2048 + k * 1024); } while (0)
#define PG8_MMA(ai, bj, At, Bt) do { __builtin_amdgcn_s_setprio(1); _Pragma("unroll") for (int m = 0; m < 4; ++m) _Pragma("unroll") for (int n = 0; n < 2; ++n) _Pragma("unroll") for (int k = 0; k < 2; ++k) \
        acc[ai][bj][m][n] = __builtin_amdgcn_mfma_f32_16x16x32_bf16(Bt[n][k], At[m][k], acc[ai][bj][m][n], 0, 0, 0); __builtin_amdgcn_s_setprio(0); } while (0)
#define PG8_WAIT_V(n) asm volatile("s_waitcnt vmcnt(" #n ")" ::: "memory")
#define PG8_WAIT_L(n) asm volatile("s_waitcnt lgkmcnt(" #n ")" ::: "memory")
#define PG8_BAR __builtin_amdgcn_s_barrier()
#define PG8_SCHED __builtin_amdgcn_sched_barrier(0)
    Unit cur, nxt; int ui = 0;
    if (!S.next(0, cur)) return;
    f32x4 acc[2][2][4][2];
#pragma unroll
    for (int a = 0; a < 2; ++a)
#pragma unroll
        for (int b = 0; b < 2; ++b)
#pragma unroll
            for (int m = 0; m < 4; ++m)
#pragma unroll
                for (int n = 0; n < 2; ++n) acc[a][b][m][n] = (f32x4){0.f, 0.f, 0.f, 0.f};
    bf16x8 At[4][2], B0[2][2], B1[2][2];
    const char* cA = (const char*)g.A + (size_t)cur.pm * tstep; const char* cB = (const char*)g.Bt + (size_t)cur.pn * tstep;
    S.a_ready(cur);
    PG8_STAGE(PG8_SB(0, 0), cB, voffB); PG8_STAGE(PG8_SA(0, 0), cA, voffA); PG8_STAGE(PG8_SB(0, 1), cB + hstep, voffB); PG8_STAGE(PG8_SA(0, 1), cA + hstep, voffA);
    if (wr == 1) PG8_BAR;
    PG8_WAIT_V(4); PG8_BAR;
    PG8_STAGE(PG8_SB(1, 0), cB + kstep, voffB); PG8_STAGE(PG8_SA(1, 0), cA + kstep, voffA); PG8_STAGE(PG8_SB(1, 1), cB + hstep + kstep, voffB);
    PG8_WAIT_V(6); PG8_BAR;
    PG8_STAMP();
    for (;;) {
        const bool has_next = S.next(ui + 1, nxt);
        const char* nA = has_next ? (const char*)g.A + (size_t)nxt.pm * tstep : cA; const char* nB = has_next ? (const char*)g.Bt + (size_t)nxt.pn * tstep : cB;
        for (int t = 0; t < nt; t += 2) {
            const bool last = (t == nt - 2);
            const char* a1 = cA + (size_t)(t + 1) * kstep;
            const char* a2 = last ? nA : cA + (size_t)(t + 2) * kstep; const char* b2 = last ? nB : cB + (size_t)(t + 2) * kstep;
            const char* a3 = a2 + kstep; const char* b3 = b2 + kstep;
            if (last && has_next) S.a_ready(nxt);
            PG8_LDB(B0, 0, 0); PG8_SCHED; PG8_LDA(At, 0, 0); PG8_STAGE(PG8_SA(1, 1), a1 + hstep, voffA);
            PG8_WAIT_L(8); PG8_BAR; PG8_WAIT_L(0); PG8_MMA(0, 0, At, B0); PG8_BAR; PG8_SCHED;
            PG8_LDB(B1, 0, 1); PG8_STAGE(PG8_SB(0, 0), b2, voffB);
            PG8_BAR; PG8_WAIT_L(0); PG8_MMA(0, 1, At, B1); PG8_BAR;
            PG8_LDA(At, 0, 1); PG8_STAGE(PG8_SA(0, 0), a2, voffA);
            PG8_BAR; PG8_WAIT_L(0); PG8_MMA(1, 0, At, B0); PG8_BAR; PG8_SCHED;
            PG8_STAGE(PG8_SB(0, 1), b2 + hstep, voffB);
            PG8_WAIT_V(6); PG8_BAR; PG8_MMA(1, 1, At, B1); PG8_BAR;
            PG8_LDB(B0, 1, 0); PG8_SCHED; PG8_LDA(At, 1, 0); PG8_STAGE(PG8_SA(0, 1), a2 + hstep, voffA);
            PG8_WAIT_L(8); PG8_BAR; PG8_WAIT_L(0); PG8_MMA(0, 0, At, B0); PG8_BAR; PG8_SCHED;
            PG8_LDB(B1, 1, 1); PG8_STAGE(PG8_SB(1, 0), b3, voffB);
            PG8_BAR; PG8_WAIT_L(0); PG8_MMA(0, 1, At, B1); PG8_BAR;
            PG8_LDA(At, 1, 1); PG8_STAGE(PG8_SA(1, 0), a3, voffA);
            PG8_BAR; PG8_WAIT_L(0); PG8_MMA(1, 0, At, B0); PG8_BAR; PG8_SCHED;
            PG8_STAGE(PG8_SB(1, 1), b3 + hstep, voffB);
            PG8_WAIT_V(6); PG8_BAR; PG8_MMA(1, 1, At, B1); PG8_BAR;
        }
        PG8_STAMP();
        if constexpr (!Epi::AFTER_DRAIN) { E(acc, cur, wr, wc, fr, fq); S.done(cur); }
        PG8_STAMP();
        if (!has_next) break;
#pragma unroll
        for (int a = 0; a < 2; ++a)
#pragma unroll
            for (int b = 0; b < 2; ++b)
#pragma unroll
                for (int m = 0; m < 4; ++m)
#pragma unroll
                    for (int n = 0; n < 2; ++n) acc[a][b][m][n] = (f32x4){0.f, 0.f, 0.f, 0.f};
        cur = nxt; cA = nA; cB = nB; ++ui;
    }
    PG8_WAIT_V(0);
    if (wr == 0) PG8_BAR;
    PG8_BAR;
    if constexpr (Epi::AFTER_DRAIN) { E.fused(acc, cur, wr, wc, fr, fq, lds, wid, lane); S.done(cur); }
    PG8_STAMP();
    if (STAMP && wid == 0) { stamps[lane] = lane < nts ? (((unsigned long long)(unsigned)ts_hi << 32) | (unsigned)ts_lo) : 0ull;
        if (lane == 62) stamps[62] = rt_entry; if (lane == 63) stamps[63] = (unsigned long long)wall_clock64(); }
#undef PG8_STAMP
#undef PG8_SA
#undef PG8_SB
#undef PG8_STAGE
#undef PG8_LDA
#undef PG8_LDB
#undef PG8_MMA
#undef PG8_WAIT_V
#undef PG8_WAIT_L
#undef PG8_BAR
#undef PG8_SCHED
}
}
using namespace pg8;
#define LAS PG8_LAS
typedef unsigned short u16;
typedef unsigned u32x2 __attribute__((ext_vector_type(2)));
typedef float f32x2 __attribute__((ext_vector_type(2)));

constexpr int NBATCH = 8, SEQ = 2048, DM = 2048, MTOK = NBATCH * SEQ, DIN = 7824, NP = 7936;
constexpr int C_R = 0, C_K = 1024, C_V = 2048, C_WD = 3072, C_GA = 3200, C_QB = 4224, C_KB = 4736, C_VB = 5248, C_GB = 5760,
              C_QC = 6272, C_KC = 6528, C_VC = 6784, C_GC = 7296, C_LOW = 7808;
constexpr int LDS_BYTES = 148480;

struct Params {
    const float *x, *norm_w, *w_in, *w_out, *mu, *w0, *w2, *a0, *a2, *k_k, *k_a, *r_k, *ln_w, *ln_b, *a_up, *a_b, *gnw, *fnw;
    float* out;
    u16 *WtIn, *WtOut, *W2t, *A2t, *H, *P;
    float *yraw, *ybonus, *kmean, *gst, *gdec;
    unsigned* bar;
    unsigned* sync;
    int phase_lo, phase_hi;
};

__device__ __forceinline__ int tid_() { int t = threadIdx.x; asm volatile("" : "+v"(t)); return t; }
__device__ __forceinline__ float bf2f(u16 v) { return __uint_as_float(((unsigned)v) << 16); }
__device__ __forceinline__ float bflo(unsigned w) { return __uint_as_float(w << 16); }
__device__ __forceinline__ float bfhi(unsigned w) { return __uint_as_float(w & 0xffff0000u); }
__device__ __forceinline__ u16 f2bf(float f) { return (u16)(cvt_pk_bf16(f, 0.f) & 0xffffu); }
template <int CTRL> __device__ __forceinline__ float dpp_f(float v) { return __int_as_float(__builtin_amdgcn_update_dpp(0, __float_as_int(v), CTRL, 0xF, 0xF, true)); }
__device__ __forceinline__ float red16_sum(float v) { v += dpp_f<0xB1>(v); v += dpp_f<0x4E>(v); v += dpp_f<0x141>(v); v += dpp_f<0x140>(v); return v; }
__device__ __forceinline__ float red8_sum(float v) { v += dpp_f<0xB1>(v); v += dpp_f<0x4E>(v); v += dpp_f<0x141>(v); return v; }
__device__ __forceinline__ float red16_max(float v) { v = fmaxf(v, dpp_f<0xB1>(v)); v = fmaxf(v, dpp_f<0x4E>(v)); v = fmaxf(v, dpp_f<0x141>(v)); v = fmaxf(v, dpp_f<0x140>(v)); return v; }
__device__ __forceinline__ float wave_sum(float v) {
#pragma unroll
    for (int o = 1; o < 64; o <<= 1) v += __shfl_xor(v, o);
    return v;
}
__device__ __forceinline__ float sigmoidf_(float x) { return 1.f / (1.f + __expf(-x)); }
__device__ __forceinline__ float siluf_(float x) { return x / (1.f + __expf(-x)); }
__device__ __forceinline__ float logsigmoidf_(float z) { return fminf(z, 0.f) - log1pf(__expf(-fabsf(z))); }
__device__ __forceinline__ f32x4 mfma16(bf16x8 a, bf16x8 b, f32x4 c) { return __builtin_amdgcn_mfma_f32_16x16x32_bf16(a, b, c, 0, 0, 0); }

struct EpiP {
    static constexpr bool PERM = true, AFTER_DRAIN = false;
    bf16_t* O; int ldc;
    __device__ __forceinline__ void operator()(const f32x4 (&acc)[2][2][4][2], const Unit& u, int wr, int wc, int fr, int fq) const {
        const int row0 = u.pm * BM + wr * 64 + fr, col0 = u.pn * BM + wc * 32 + 8 * fq;
#pragma unroll
        for (int ai = 0; ai < 2; ++ai)
#pragma unroll
            for (int m = 0; m < 4; ++m) { bf16_t* rowp = O + (size_t)(row0 + ai * HALF + m * 16) * ldc + col0;
#pragma unroll
                for (int bj = 0; bj < 2; ++bj) { const f32x4 v0 = acc[ai][bj][m][0], v1 = acc[ai][bj][m][1];
                    u32x4 w; w.x = cvt_pk_bf16(v0[0], v0[1]); w.y = cvt_pk_bf16(v0[2], v0[3]); w.z = cvt_pk_bf16(v1[0], v1[1]); w.w = cvt_pk_bf16(v1[2], v1[3]);
                    *(u32x4*)(rowp + bj * HALF) = w; } }
    }
};
struct EpiRes {
    static constexpr bool PERM = false, AFTER_DRAIN = false;
    const float* R; float* C; int ldc;
    __device__ __forceinline__ void operator()(const f32x4 (&acc)[2][2][4][2], const Unit& u, int wr, int wc, int fr, int fq) const {
        const int row0 = u.pm * BM + wr * 64 + fr, col0 = u.pn * BM + wc * 32 + 4 * fq;
#pragma unroll
        for (int ai = 0; ai < 2; ++ai)
#pragma unroll
            for (int m = 0; m < 4; ++m) { const size_t off = (size_t)(row0 + ai * HALF + m * 16) * ldc + col0;
#pragma unroll
                for (int bj = 0; bj < 2; ++bj)
#pragma unroll
                    for (int n = 0; n < 2; ++n) { const f32x4 r = *(const f32x4*)(R + off + bj * HALF + n * 16); *(f32x4*)(C + off + bj * HALF + n * 16) = acc[ai][bj][m][n] + r; }
                asm volatile("" ::: "memory"); }
    }
};

__device__ void transpose_cvt_range(LAS unsigned char* lds, const float* src, u16* dst, int K, int N, int Npad, int t_begin, int t_end, int t_step) {
    LAS float* tile = (LAS float*)lds;
    const int tilesN = Npad / 64, tid = tid_();
    for (int t = t_begin; t < t_end; t += t_step) {
        const int tn = t % tilesN, tk = t / tilesN, n0 = tn * 64, k0 = tk * 64;
#pragma unroll
        for (int i = 0; i < 2; ++i) { const int idx = tid + i * 512, kk = idx >> 4, n4 = (idx & 15) * 4;
            float4 v = make_float4(0.f, 0.f, 0.f, 0.f);
            if (n0 + n4 < N) v = *(const float4*)(src + (size_t)(k0 + kk) * N + n0 + n4);
            tile[(n4 + 0) * 65 + kk] = v.x; tile[(n4 + 1) * 65 + kk] = v.y; tile[(n4 + 2) * 65 + kk] = v.z; tile[(n4 + 3) * 65 + kk] = v.w; }
        __syncthreads();
        { const int n = tid >> 3, k8 = (tid & 7) * 8; const LAS float* r = tile + n * 65 + k8;
            u32x4 o; o.x = cvt_pk_bf16(r[0], r[1]); o.y = cvt_pk_bf16(r[2], r[3]); o.z = cvt_pk_bf16(r[4], r[5]); o.w = cvt_pk_bf16(r[6], r[7]);
            *(u32x4*)(dst + (size_t)(n0 + n) * K + k0 + k8) = o; }
        __syncthreads();
    }
}
__device__ __forceinline__ void transpose_cvt(LAS unsigned char* lds, const float* src, u16* dst, int K, int N, int Npad, int bid, int nb) {
    transpose_cvt_range(lds, src, dst, K, N, Npad, bid, (Npad / 64) * (K / 64), nb);
}

__device__ void rmsnorm_phase(const float* x, const float* w, u16* hb, float* of, int bid, int nb) {
    const int tid0 = tid_(), wid = tid0 >> 6, lane = tid0 & 63;
    for (int row = bid * 8 + wid; row < MTOK; row += nb * 8) {
        const float4* xr = (const float4*)(x + (size_t)row * DM);
        float4 v[8]; float s = 0.f;
#pragma unroll
        for (int i = 0; i < 8; ++i) { v[i] = xr[i * 64 + lane]; s += v[i].x * v[i].x + v[i].y * v[i].y + v[i].z * v[i].z + v[i].w * v[i].w; }
        s = wave_sum(s);
        const float rs = rsqrtf(s * (1.f / DM) + 1e-6f);
#pragma unroll
        for (int i = 0; i < 8; ++i) { const float4 wv = ((const float4*)w)[i * 64 + lane];
            const float a = v[i].x * rs * wv.x, b = v[i].y * rs * wv.y, c = v[i].z * rs * wv.z, d = v[i].w * rs * wv.w;
            if (hb) { uint2 o; o.x = cvt_pk_bf16(a, b); o.y = cvt_pk_bf16(c, d); *(uint2*)(hb + (size_t)row * DM + (i * 64 + lane) * 4) = o; }
            else { ((float4*)(of + (size_t)row * DM))[i * 64 + lane] = make_float4(a, b, c, d); } }
    }
}

__device__ void kmean_phase(const Params& p, LAS unsigned char* lds, int t_begin, int t_end, int t_step) {
    LAS float* part = (LAS float*)lds;
    const int tid = tid_();
    for (int task = t_begin; task < t_end; task += t_step) {
        const int b = task >> 5, h = (task >> 3) & 3, blk = task & 7;
        const int d8 = (tid & 15) * 8, kg = tid >> 4;
        float s[8];
#pragma unroll
        for (int e = 0; e < 8; ++e) s[e] = 0.f;
        for (int kk = 0; kk < 8; ++kk) {
            const int tok = b * SEQ + blk * 256 + kg * 8 + kk;
            const uint4 v = *(const uint4*)(p.P + (size_t)tok * NP + C_KB + h * 128 + d8);
            s[0] += bflo(v.x); s[1] += bfhi(v.x); s[2] += bflo(v.y); s[3] += bfhi(v.y); s[4] += bflo(v.z); s[5] += bfhi(v.z); s[6] += bflo(v.w); s[7] += bfhi(v.w);
        }
        __syncthreads();
#pragma unroll
        for (int e = 0; e < 8; ++e) part[kg * 128 + d8 + e] = s[e];
        __syncthreads();
        if (tid < 128) { float a = 0.f; for (int g = 0; g < 32; ++g) a += part[g * 128 + tid]; p.kmean[(size_t)task * 128 + tid] = a * (1.f / 256.f); }
    }
    __syncthreads();
}

constexpr int RW_T = 32;
constexpr int RW_XB = 49152;
constexpr int RW_RAW = 98304, RW_A1 = 119808, RW_A2 = 124416, RW_KS = 129024, RW_AS = 137216, RW_MU = 145408, RW_PAR = 146688, RW_FLG = 147968;
__device__ __forceinline__ void rw_issue(const Params& p, int pt, int b, int h, int t0, u32x4 (&rg)[6]) {
#pragma unroll
    for (int i = 0; i < 6; ++i) { const int piece = pt + 256 * i; rg[i] = (u32x4){0u, 0u, 0u, 0u};
        if (piece < 33 * 40) { const int row = piece / 40, pc = piece % 40; const int t = t0 - 1 + row;
            const int col = pc < 8 ? C_R + h * 64 + pc * 8 : pc < 16 ? C_K + h * 64 + (pc - 8) * 8 : pc < 24 ? C_V + h * 64 + (pc - 16) * 8 : C_WD + (pc - 24) * 8;
            if (t >= 0) rg[i] = *(const u32x4*)(p.P + (size_t)(b * SEQ + t) * NP + col); } }
}
__device__ __forceinline__ void prep_bar(volatile LAS unsigned* flg, int pw, int lane, unsigned& ep) {
    ++ep;
    asm volatile("s_waitcnt lgkmcnt(0)" ::: "memory");
    if (lane == 0) flg[pw] = ep;
    for (;;) { const u32x4 f = *(volatile LAS u32x4*)flg; if (f.x >= ep && f.y >= ep && f.z >= ep && f.w >= ep) break; __builtin_amdgcn_s_sleep(2); }
    asm volatile("s_waitcnt lgkmcnt(0)" ::: "memory");
}
__device__ __forceinline__ float red4_sum(float v) { v += dpp_f<0xB1>(v); v += dpp_f<0x4E>(v); return v; }
__device__ __forceinline__ float rs8_sum(const float (&y)[8], bool b2, bool b1, bool b0) {
    float n[4], n2[2];
#pragma unroll
    for (int j = 0; j < 4; ++j) { const float k = b2 ? y[4 + j] : y[j], sd = b2 ? y[j] : y[4 + j]; n[j] = k + dpp_f<0x141>(sd); }
#pragma unroll
    for (int j = 0; j < 2; ++j) { const float k = b1 ? n[2 + j] : n[j], sd = b1 ? n[j] : n[2 + j]; n2[j] = k + dpp_f<0x1B>(sd); }
    const float k = b0 ? n2[1] : n2[0], sd = b0 ? n2[0] : n2[1];
    return k + dpp_f<0xB1>(sd);
}
__device__ void rwkv_scan_task(const Params& p, int l, LAS unsigned char* lds, int task) {
    const int tid = tid_(), wid = tid >> 6, lane = tid & 63;
    LAS u16* raw = (LAS u16*)(lds + RW_RAW); LAS u16* A1 = (LAS u16*)(lds + RW_A1); LAS u16* A2 = (LAS u16*)(lds + RW_A2);
    LAS float* kS = (LAS float*)(lds + RW_KS); LAS float* aS = (LAS float*)(lds + RW_AS);
    LAS float* muS = (LAS float*)(lds + RW_MU); LAS float* parS = (LAS float*)(lds + RW_PAR);
    volatile LAS unsigned* flg = (volatile LAS unsigned*)(lds + RW_FLG);
    {
        const int b = task >> 4, h = task & 15;
        __syncthreads();
        if (tid >= 256 && tid < 260) flg[tid - 256] = 0u;
        __syncthreads();
        if (wid < 4) {
            const int rp = wid * 8 + (lane >> 3), ssub = lane & 7; const bool sb2 = (ssub & 4) != 0, sb1 = (ssub & 2) != 0, sb0 = (ssub & 1) != 0;
            f32x2 SA[4], SB[4];
#pragma unroll
            for (int q = 0; q < 4; ++q) { SA[q] = (f32x2){0.f, 0.f}; SB[q] = (f32x2){0.f, 0.f}; }
            float* yout = p.yraw + (size_t)(b * SEQ + ssub) * 1024 + h * 64 + 2 * rp;
            for (int c = 0; c < SEQ / RW_T; ++c) {
                __syncthreads();
                const LAS float* ob = (const LAS float*)(lds + (c & 1) * RW_XB) + ssub * 8;
                const LAS float* ov = (const LAS float*)(lds + (c & 1) * RW_XB + 40960) + 2 * rp;
                f32x4 nw0 = *(const LAS f32x4*)(ob), nw1 = *(const LAS f32x4*)(ob + 4), na0 = *(const LAS f32x4*)(ob + 2048), na1 = *(const LAS f32x4*)(ob + 2052);
                f32x4 nb0 = *(const LAS f32x4*)(ob + 4096), nb1 = *(const LAS f32x4*)(ob + 4100), nk0 = *(const LAS f32x4*)(ob + 6144), nk1 = *(const LAS f32x4*)(ob + 6148);
                f32x4 nr0 = *(const LAS f32x4*)(ob + 8192), nr1 = *(const LAS f32x4*)(ob + 8196);
                f32x2 nv = *(const LAS f32x2*)(ov);
                float ypA[8], ypB[8];
#pragma unroll
                for (int t = 0; t < RW_T; ++t) {
                    const f32x4 w0 = nw0, w1 = nw1, a0 = na0, a1 = na1, b0 = nb0, b1 = nb1, k0 = nk0, k1 = nk1, r0 = nr0, r1 = nr1; const f32x2 vv = nv;
                    if (t + 1 < RW_T) { const LAS float* o2 = ob + (t + 1) * 64;
                        nw0 = *(const LAS f32x4*)(o2); nw1 = *(const LAS f32x4*)(o2 + 4); na0 = *(const LAS f32x4*)(o2 + 2048); na1 = *(const LAS f32x4*)(o2 + 2052);
                        nb0 = *(const LAS f32x4*)(o2 + 4096); nb1 = *(const LAS f32x4*)(o2 + 4100); nk0 = *(const LAS f32x4*)(o2 + 6144); nk1 = *(const LAS f32x4*)(o2 + 6148);
                        nr0 = *(const LAS f32x4*)(o2 + 8192); nr1 = *(const LAS f32x4*)(o2 + 8196);
                        nv = *(const LAS f32x2*)(ov + (t + 1) * 64); }
                    const f32x2 sA2 = (SA[0] * a0.lo + SA[1] * a0.hi) + (SA[2] * a1.lo + SA[3] * a1.hi);
                    const f32x2 sB2 = (SB[0] * a0.lo + SB[1] * a0.hi) + (SB[2] * a1.lo + SB[3] * a1.hi);
                    const float saA = red8_sum(sA2.x + sA2.y), saB = red8_sum(sB2.x + sB2.y);
                    const f32x2 svA = {saA, saA}, svB = {saB, saB}, vA = {vv.x, vv.x}, vB = {vv.y, vv.y};
                    SA[0] = SA[0] * w0.lo + svA * b0.lo + vA * k0.lo; SA[1] = SA[1] * w0.hi + svA * b0.hi + vA * k0.hi;
                    SA[2] = SA[2] * w1.lo + svA * b1.lo + vA * k1.lo; SA[3] = SA[3] * w1.hi + svA * b1.hi + vA * k1.hi;
                    SB[0] = SB[0] * w0.lo + svB * b0.lo + vB * k0.lo; SB[1] = SB[1] * w0.hi + svB * b0.hi + vB * k0.hi;
                    SB[2] = SB[2] * w1.lo + svB * b1.lo + vB * k1.lo; SB[3] = SB[3] * w1.hi + svB * b1.hi + vB * k1.hi;
                    const f32x2 yA2 = (SA[0] * r0.lo + SA[1] * r0.hi) + (SA[2] * r1.lo + SA[3] * r1.hi);
                    const f32x2 yB2 = (SB[0] * r0.lo + SB[1] * r0.hi) + (SB[2] * r1.lo + SB[3] * r1.hi);
                    ypA[t & 7] = yA2.x + yA2.y; ypB[t & 7] = yB2.x + yB2.y;
                    if ((t & 7) == 7) { f32x2 o = {rs8_sum(ypA, sb2, sb1, sb0), rs8_sum(ypB, sb2, sb1, sb0)}; *(f32x2*)(yout + (size_t)(c * RW_T + (t & ~7)) * 1024) = o; }
                }
            }
        } else {
            const int pt = tid - 256, pw = wid - 4;
            unsigned ep = 0u;
            for (int c2 = pt; c2 < 320; c2 += 256) { const int mi = c2 < 64 ? h * 64 + c2 : c2 < 128 ? 1024 + h * 64 + (c2 - 64) : c2 < 192 ? 2048 + h * 64 + (c2 - 128) : 3072 + (c2 - 192);
                muS[c2] = p.mu[(size_t)l * 3200 + mi]; }
            if (pt < 64) { const size_t o = (size_t)l * 1024 + h * 64 + pt;
                parS[pt] = p.w0[o]; parS[64 + pt] = p.a0[o]; parS[128 + pt] = p.k_k[o]; parS[192 + pt] = p.k_a[o]; parS[256 + pt] = p.r_k[o]; }
            const int mat = pw >> 1, ct0 = (pw & 1) * 2;
            bf16x8 bfr[2][2];
#pragma unroll
            for (int ci = 0; ci < 2; ++ci) { const u16* Bt = (mat ? p.A2t : p.W2t) + (size_t)l * 1024 * 64 + (size_t)(h * 64 + (ct0 + ci) * 16 + (lane & 15)) * 64 + (lane >> 4) * 8;
                bfr[ci][0] = *(const bf16x8*)(Bt); bfr[ci][1] = *(const bf16x8*)(Bt + 32); }
            u32x4 rg[6];
            int goff[6], loff[6];
#pragma unroll
            for (int i = 0; i < 6; ++i) { const int piece = pt + 256 * i, row = piece / 40, pc = piece % 40;
                const int col = pc < 8 ? C_R + h * 64 + pc * 8 : pc < 16 ? C_K + h * 64 + (pc - 8) * 8 : pc < 24 ? C_V + h * 64 + (pc - 16) * 8 : C_WD + (pc - 24) * 8;
                goff[i] = piece < 33 * 40 ? row * NP + col : -1; loff[i] = row * 320 + pc * 8; }
            const u16* pbase = p.P + (size_t)b * SEQ * NP;
#define RW_ISSUE(t0_) do { _Pragma("unroll") for (int i = 0; i < 6; ++i) { rg[i] = (u32x4){0u, 0u, 0u, 0u}; \
                if (goff[i] >= 0 && ((t0_) > 0 || goff[i] >= NP)) rg[i] = *(const u32x4*)(pbase + (ptrdiff_t)((t0_) - 1) * NP + goff[i]); } } while (0)
            RW_ISSUE(0);
            for (int c = 0; c < SEQ / RW_T; ++c) {
                const int t0 = c * RW_T;
                LAS float* opW = (LAS float*)(lds + (c & 1) * RW_XB); LAS float* opA = opW + 2048; LAS float* opB = opW + 4096; LAS float* opK = opW + 6144; LAS float* opR = opW + 8192; LAS float* opV = opW + 10240;
#pragma unroll
                for (int i = 0; i < 6; ++i) { if (goff[i] >= 0) *(LAS u32x4*)(raw + loff[i]) = rg[i]; }
                prep_bar(flg, pw, lane, ep);
                if (c + 1 < SEQ / RW_T) RW_ISSUE(t0 + RW_T);
#pragma unroll
                for (int reg = 0; reg < 5; ++reg)
#pragma unroll
                    for (int i = 0; i < 2; ++i) { const int e = pt + 256 * i, t = e >> 4, qd = e & 15, cc = reg * 64 + 4 * qd;
                        const u32x2 cu = *(const LAS u32x2*)(raw + (t + 1) * 320 + cc), pu = *(const LAS u32x2*)(raw + t * 320 + cc);
                        const f32x4 mu4 = *(const LAS f32x4*)(muS + cc);
                        const f32x4 cur = {bflo(cu.x), bfhi(cu.x), bflo(cu.y), bfhi(cu.y)}, prv = {bflo(pu.x), bfhi(pu.x), bflo(pu.y), bfhi(pu.y)};
                        const f32x4 xs = cur + mu4 * (prv - cur);
                        if (reg == 0) *(LAS f32x4*)(opR + t * 64 + 4 * qd) = xs;
                        else if (reg == 1) *(LAS f32x4*)(kS + t * 64 + 4 * qd) = xs;
                        else if (reg == 2) *(LAS f32x4*)(opV + t * 64 + 4 * qd) = xs;
                        else if (reg == 3) { float th[4];
#pragma unroll
                            for (int q = 0; q < 4; ++q) th[q] = 1.f - 2.f * __builtin_amdgcn_rcpf(__expf(2.f * xs[q]) + 1.f);
                            u32x2 o; o.x = cvt_pk_bf16(th[0], th[1]); o.y = cvt_pk_bf16(th[2], th[3]); *(LAS u32x2*)(A1 + t * 72 + 4 * qd) = o; }
                        else { u32x2 o; o.x = cvt_pk_bf16(xs.x, xs.y); o.y = cvt_pk_bf16(xs.z, xs.w); *(LAS u32x2*)(A2 + t * 72 + 4 * qd) = o; } }
                prep_bar(flg, pw, lane, ep);
                { LAS u16* Ab = mat ? A2 : A1;
#pragma unroll
                    for (int ci = 0; ci < 2; ++ci)
#pragma unroll
                        for (int rt = 0; rt < 2; ++rt) { f32x4 acc = {0.f, 0.f, 0.f, 0.f};
#pragma unroll
                            for (int ks = 0; ks < 2; ++ks) { const bf16x8 af = *(const LAS bf16x8*)(Ab + (rt * 16 + (lane & 15)) * 72 + ks * 32 + (lane >> 4) * 8); acc = mfma16(af, bfr[ci][ks], acc); }
                            const int cc = (ct0 + ci) * 16 + (lane & 15);
#pragma unroll
                            for (int i = 0; i < 4; ++i) { const int t = rt * 16 + (lane >> 4) * 4 + i;
                                if (mat == 0) { float wv = parS[cc] + acc[i]; wv = fminf(wv, 0.f) - __logf(1.f + __expf(-fabsf(wv))) - 0.5f; opW[t * 64 + cc] = __expf(-__expf(wv)); }
                                else aS[t * 64 + cc] = __builtin_amdgcn_rcpf(1.f + __expf(-(parS[64 + cc] + acc[i]))); } } }
                prep_bar(flg, pw, lane, ep);
#pragma unroll
                for (int j = 0; j < 2; ++j) { const int item = pt + 256 * j, t = item >> 4, sub = item & 15, c4 = sub * 4;
                    const f32x4 kr = *(const LAS f32x4*)(kS + t * 64 + c4), av = *(const LAS f32x4*)(aS + t * 64 + c4), rr = *(const LAS f32x4*)(opR + t * 64 + c4);
                    const f32x4 kkp = *(const LAS f32x4*)(parS + 128 + c4), kap = *(const LAS f32x4*)(parS + 192 + c4), rkp = *(const LAS f32x4*)(parS + 256 + c4);
                    f32x4 kk = kr * kkp;
                    float ss = kk.x * kk.x + kk.y * kk.y + kk.z * kk.z + kk.w * kk.w; ss = red16_sum(ss);
                    const float inv = rsqrtf(fmaxf(ss, 1e-24f));
                    kk.x *= inv; kk.y *= inv; kk.z *= inv; kk.w *= inv;
                    const f32x4 km = kr * (1.f + (av - 1.f) * kap);
                    *(LAS f32x4*)(opA + t * 64 + c4) = -kk;
                    *(LAS f32x4*)(opB + t * 64 + c4) = kk * av;
                    *(LAS f32x4*)(opK + t * 64 + c4) = km;
                    float bo = rr.x * km.x * rkp.x + rr.y * km.y * rkp.y + rr.z * km.z * rkp.z + rr.w * km.w * rkp.w; bo = red16_sum(bo);
                    if (sub == 0) p.ybonus[(size_t)(b * SEQ + t0 + t) * 16 + h] = bo; }
                __syncthreads();
            }
        }
    }
    __syncthreads();
}

__device__ void rwkv_post_item(const Params& p, int l, int item) {
    const int tid = tid_(), pair = item * 32 + (tid >> 4), tok = pair >> 4, h = pair & 15, c4 = (tid & 15) * 4;
    const float4 y = *(const float4*)(p.yraw + (size_t)tok * 1024 + h * 64 + c4);
    const float mean = red16_sum(y.x + y.y + y.z + y.w) * (1.f / 64.f);
    const float d0 = y.x - mean, d1 = y.y - mean, d2 = y.z - mean, d3 = y.w - mean;
    const float var = red16_sum(d0 * d0 + d1 * d1 + d2 * d2 + d3 * d3) * (1.f / 64.f);
    const float rs = rsqrtf(var + 64e-5f);
    const size_t po = (size_t)l * 1024 + h * 64 + c4;
    const float4 lw = *(const float4*)(p.ln_w + po), lb = *(const float4*)(p.ln_b + po), muv = *(const float4*)(p.mu + (size_t)l * 3200 + 2048 + h * 64 + c4);
    const uint2 vc = *(const uint2*)(p.P + (size_t)tok * NP + C_V + h * 64 + c4);
    uint2 vp = make_uint2(0u, 0u);
    if ((tok & (SEQ - 1)) != 0) vp = *(const uint2*)(p.P + (size_t)(tok - 1) * NP + C_V + h * 64 + c4);
    const uint2 gg = *(const uint2*)(p.P + (size_t)tok * NP + C_GA + h * 64 + c4);
    const float bo = p.ybonus[(size_t)tok * 16 + h];
    float v0 = bflo(vc.x), v1 = bfhi(vc.x), v2 = bflo(vc.y), v3 = bfhi(vc.y);
    v0 += muv.x * (bflo(vp.x) - v0); v1 += muv.y * (bfhi(vp.x) - v1); v2 += muv.z * (bflo(vp.y) - v2); v3 += muv.w * (bfhi(vp.y) - v3);
    const float o0 = (d0 * rs * lw.x + lb.x + bo * v0) * siluf_(bflo(gg.x)), o1 = (d1 * rs * lw.y + lb.y + bo * v1) * siluf_(bfhi(gg.x));
    const float o2 = (d2 * rs * lw.z + lb.z + bo * v2) * siluf_(bflo(gg.y)), o3 = (d3 * rs * lw.w + lb.w + bo * v3) * siluf_(bfhi(gg.y));
    uint2 o; o.x = cvt_pk_bf16(o0, o1); o.y = cvt_pk_bf16(o2, o3);
    *(uint2*)(p.H + (size_t)tok * DM + h * 64 + c4) = o;
}

__device__ void rwkv_post_task(const Params& p, int l, int task) {
    const int tid = tid_(), h = (tid >> 4) & 15, c4 = (tid & 15) * 4;
    const size_t po = (size_t)l * 1024 + h * 64 + c4;
    const f32x4 lw = *(const f32x4*)(p.ln_w + po), lb = *(const f32x4*)(p.ln_b + po), muv = *(const f32x4*)(p.mu + (size_t)l * 3200 + 2048 + h * 64 + c4);
#pragma unroll 1
    for (int bt = 0; bt < 4; ++bt) {
        f32x4 y[4]; u32x2 vc[4], vp[4], gg[4]; float bo[4];
#pragma unroll
        for (int q = 0; q < 4; ++q) { const int tok = (task * 16 + bt * 4 + q) * 2 + (tid >> 8);
            y[q] = *(const f32x4*)(p.yraw + (size_t)tok * 1024 + h * 64 + c4);
            vc[q] = *(const u32x2*)(p.P + (size_t)tok * NP + C_V + h * 64 + c4);
            vp[q] = (u32x2){0u, 0u};
            if ((tok & (SEQ - 1)) != 0) vp[q] = *(const u32x2*)(p.P + (size_t)(tok - 1) * NP + C_V + h * 64 + c4);
            gg[q] = *(const u32x2*)(p.P + (size_t)tok * NP + C_GA + h * 64 + c4);
            bo[q] = p.ybonus[(size_t)tok * 16 + h]; }
#pragma unroll
        for (int q = 0; q < 4; ++q) { const int tok = (task * 16 + bt * 4 + q) * 2 + (tid >> 8);
            const float mean = red16_sum(y[q].x + y[q].y + y[q].z + y[q].w) * (1.f / 64.f);
            const f32x4 d = y[q] - mean;
            const float var = red16_sum(d.x * d.x + d.y * d.y + d.z * d.z + d.w * d.w) * (1.f / 64.f);
            const float rs = rsqrtf(var + 64e-5f);
            f32x4 v = {bflo(vc[q].x), bfhi(vc[q].x), bflo(vc[q].y), bfhi(vc[q].y)};
            const f32x4 pv = {bflo(vp[q].x), bfhi(vp[q].x), bflo(vp[q].y), bfhi(vp[q].y)};
            v += muv * (pv - v);
            const f32x4 r = d * rs * lw + lb + bo[q] * v;
            u32x2 o; o.x = cvt_pk_bf16(r.x * siluf_(bflo(gg[q].x)), r.y * siluf_(bfhi(gg[q].x))); o.y = cvt_pk_bf16(r.z * siluf_(bflo(gg[q].y)), r.w * siluf_(bfhi(gg[q].y)));
            *(u32x2*)(p.H + (size_t)tok * DM + h * 64 + c4) = o; }
    }
}

__device__ void rwkv_post_block(const Params& p, int l, int bh, int half) {
    const int tid = tid_(), b = bh >> 4, h = bh & 15, c4 = (tid & 15) * 4;
    const size_t po = (size_t)l * 1024 + h * 64 + c4;
    const f32x4 lw = *(const f32x4*)(p.ln_w + po), lb = *(const f32x4*)(p.ln_b + po), muv = *(const f32x4*)(p.mu + (size_t)l * 3200 + 2048 + h * 64 + c4);
    const int tokb = b * SEQ + half * 1024 + (tid >> 4);
#pragma unroll 1
    for (int bt = 0; bt < 8; ++bt) {
        f32x4 y[4]; u32x2 vc[4], vp[4], gg[4]; float bo[4];
#pragma unroll
        for (int q = 0; q < 4; ++q) { const int tok = tokb + (bt * 4 + q) * 32;
            y[q] = *(const f32x4*)(p.yraw + (size_t)tok * 1024 + h * 64 + c4);
            vc[q] = *(const u32x2*)(p.P + (size_t)tok * NP + C_V + h * 64 + c4);
            vp[q] = (u32x2){0u, 0u};
            if ((tok & (SEQ - 1)) != 0) vp[q] = *(const u32x2*)(p.P + (size_t)(tok - 1) * NP + C_V + h * 64 + c4);
            gg[q] = *(const u32x2*)(p.P + (size_t)tok * NP + C_GA + h * 64 + c4);
            bo[q] = p.ybonus[(size_t)tok * 16 + h]; }
#pragma unroll
        for (int q = 0; q < 4; ++q) { const int tok = tokb + (bt * 4 + q) * 32;
            const float mean = red16_sum(y[q].x + y[q].y + y[q].z + y[q].w) * (1.f / 64.f);
            const f32x4 d = y[q] - mean;
            const float var = red16_sum(d.x * d.x + d.y * d.y + d.z * d.z + d.w * d.w) * (1.f / 64.f);
            const float rs = rsqrtf(var + 64e-5f);
            f32x4 v = {bflo(vc[q].x), bfhi(vc[q].x), bflo(vc[q].y), bfhi(vc[q].y)};
            const f32x4 pv = {bflo(vp[q].x), bfhi(vp[q].x), bflo(vp[q].y), bfhi(vp[q].y)};
            v += muv * (pv - v);
            const f32x4 r = d * rs * lw + lb + bo[q] * v;
            u32x2 o; o.x = cvt_pk_bf16(r.x * siluf_(bflo(gg[q].x)), r.y * siluf_(bfhi(gg[q].x))); o.y = cvt_pk_bf16(r.z * siluf_(bflo(gg[q].y)), r.w * siluf_(bfhi(gg[q].y)));
            *(u32x2*)(p.H + (size_t)tok * DM + h * 64 + c4) = o; }
    }
}
__device__ __forceinline__ void wg_publish(unsigned* word, unsigned add) {
    asm volatile("s_waitcnt vmcnt(0)" ::: "memory");
    __syncthreads();
    if (threadIdx.x == 0) { __builtin_amdgcn_fence(__ATOMIC_RELEASE, "agent"); asm volatile("s_waitcnt vmcnt(0)" ::: "memory");
        __hip_atomic_fetch_add(word, add, __ATOMIC_RELAXED, __HIP_MEMORY_SCOPE_AGENT); }
}
__device__ __forceinline__ void wg_wait_ge(unsigned* word, unsigned need) {
    if (threadIdx.x == 0) { unsigned sp = 0u;
        while (__hip_atomic_load(word, __ATOMIC_RELAXED, __HIP_MEMORY_SCOPE_AGENT) < need) { __builtin_amdgcn_s_sleep(2); if (++sp > (1u << 24)) break; }
        __builtin_amdgcn_fence(__ATOMIC_ACQUIRE, "agent"); asm volatile("s_waitcnt vmcnt(0)" ::: "memory"); }
    __syncthreads();
}

constexpr int MB_K = 0, MB_VT = 17408, MB_PW = 35840, MB_KM = 54272, MB_SEL = 57856, MB_TM = 58368;
__device__ void moba_task(const Params& p, LAS unsigned char* lds, int task) {
    const int tid = tid_(), wid = tid >> 6, lane = tid & 63, l15 = lane & 15, lq = lane >> 4;
    const int qt = 15 - (task >> 5), bh = task & 31, b = bh >> 2, h = bh & 3, qblk = qt >> 1, q0 = qt * 128;
    LAS u16* Kt = (LAS u16*)(lds + MB_K); LAS u16* VT = (LAS u16*)(lds + MB_VT); LAS u16* Pw = (LAS u16*)(lds + MB_PW) + wid * 16 * 72;
    LAS float* kmS = (LAS float*)(lds + MB_KM); LAS int* selS = (LAS int*)(lds + MB_SEL); LAS int* tmS = (LAS int*)(lds + MB_TM);
    __syncthreads();
    for (int i = tid; i < qblk * 128; i += 512) kmS[i] = p.kmean[(size_t)(bh * 8) * 128 + i];
    if (tid == 0) *tmS = 0;
    __syncthreads();
    if (tid < 128) {
        const u16* qp = p.P + (size_t)(b * SEQ + q0 + tid) * NP + C_QB + h * 128;
        float g[7];
#pragma unroll
        for (int j = 0; j < 7; ++j) g[j] = 0.f;
        for (int d8 = 0; d8 < 128; d8 += 8) {
            const uint4 v = *(const uint4*)(qp + d8);
            const float q[8] = {bflo(v.x), bfhi(v.x), bflo(v.y), bfhi(v.y), bflo(v.z), bfhi(v.z), bflo(v.w), bfhi(v.w)};
#pragma unroll
            for (int j = 0; j < 7; ++j) if (j < qblk) {
#pragma unroll
                for (int e = 0; e < 8; ++e) g[j] += q[e] * kmS[j * 128 + d8 + e]; }
        }
        int mask = 0;
#pragma unroll
        for (int r = 0; r < 3; ++r) { float best = -INFINITY; int bi = -1;
#pragma unroll
            for (int j = 0; j < 7; ++j) if (j < qblk && !((mask >> j) & 1) && g[j] > best) { best = g[j]; bi = j; }
            if (bi >= 0) mask |= 1 << bi; }
        mask |= 1 << qblk;
        selS[tid] = mask; atomicOr((int*)tmS, mask);
    }
    __syncthreads();
    const int tmask = *tmS;
    bf16x8 qf[4];
    { const u16* qp = p.P + (size_t)(b * SEQ + q0 + wid * 16 + l15) * NP + C_QB + h * 128 + lq * 8;
#pragma unroll
        for (int ks = 0; ks < 4; ++ks) qf[ks] = *(const bf16x8*)(qp + ks * 32); }
    int rm[4]; int wmask = 0;
#pragma unroll
    for (int i = 0; i < 4; ++i) rm[i] = selS[wid * 16 + lq * 4 + i];
    for (int i = 0; i < 16; ++i) wmask |= selS[wid * 16 + i];
    float m[4], ls[4]; f32x4 O[8];
#pragma unroll
    for (int i = 0; i < 4; ++i) { m[i] = -1e30f; ls[i] = 0.f; }
#pragma unroll
    for (int dt = 0; dt < 8; ++dt) O[dt] = (f32x4){0.f, 0.f, 0.f, 0.f};
    const float sc2 = 0.08838834764831845f * 1.4426950408889634f;
    const int last = (q0 + 127) >> 6;
    const int kp = lane & 31, vd8 = (wid * 2 + (lane >> 5)) * 8;
    struct Stage { u32x4 k0, k1, v0, v1; };
    auto issue = [&](Stage& R, int tt) {
        const size_t kb_ = (size_t)(b * SEQ + tt * 64);
        R.k0 = *(const u32x4*)(p.P + (kb_ + (tid >> 4)) * NP + C_KB + h * 128 + (tid & 15) * 8); R.k1 = *(const u32x4*)(p.P + (kb_ + 32 + (tid >> 4)) * NP + C_KB + h * 128 + (tid & 15) * 8);
        R.v0 = *(const u32x4*)(p.P + (kb_ + 2 * kp) * NP + C_VB + h * 128 + vd8); R.v1 = *(const u32x4*)(p.P + (kb_ + 2 * kp + 1) * NP + C_VB + h * 128 + vd8); };
    auto nextv = [&](int t) { ++t; while (t <= last && !((tmask >> (t >> 2)) & 1)) ++t; return t; };
    auto stage = [&](const Stage& R) {
        { const int ka = tid >> 4, kb2 = 32 + (tid >> 4);
          *(LAS u32x4*)(Kt + ((ka & 3) * 16 + (ka >> 2)) * 136 + (tid & 15) * 8) = R.k0; *(LAS u32x4*)(Kt + ((kb2 & 3) * 16 + (kb2 >> 2)) * 136 + (tid & 15) * 8) = R.k1; }
        LAS unsigned* vt = (LAS unsigned*)(VT + vd8 * 72 + 2 * kp);
        vt[0] = (R.v0.x & 0xffffu) | (R.v1.x << 16); vt[36] = (R.v0.x >> 16) | (R.v1.x & 0xffff0000u);
        vt[72] = (R.v0.y & 0xffffu) | (R.v1.y << 16); vt[108] = (R.v0.y >> 16) | (R.v1.y & 0xffff0000u);
        vt[144] = (R.v0.z & 0xffffu) | (R.v1.z << 16); vt[180] = (R.v0.z >> 16) | (R.v1.z & 0xffff0000u);
        vt[216] = (R.v0.w & 0xffffu) | (R.v1.w << 16); vt[252] = (R.v0.w >> 16) | (R.v1.w & 0xffff0000u); };
    auto compute = [&](int ti) {
        const int j = ti >> 2, key0 = ti * 64, qw0 = q0 + wid * 16;
        const bool own = (j == qblk);
        if (((wmask >> j) & 1) && !(own && key0 > qw0 + 15)) {
            f32x4 s[4];
#pragma unroll
            for (int nt = 0; nt < 4; ++nt) { s[nt] = (f32x4){0.f, 0.f, 0.f, 0.f};
#pragma unroll
                for (int ks = 0; ks < 4; ++ks) { const bf16x8 kf = *(const LAS bf16x8*)(Kt + (nt * 16 + l15) * 136 + ks * 32 + lq * 8); s[nt] = mfma16(qf[ks], kf, s[nt]); } }
            const bool diag = own && (key0 + 63 > qw0);
#pragma unroll
            for (int i = 0; i < 4; ++i) {
                const int qpos = qw0 + lq * 4 + i;
                const float bias = (own || ((rm[i] >> j) & 1)) ? 0.f : -3e30f;
                float sv[4];
#pragma unroll
                for (int nt = 0; nt < 4; ++nt) sv[nt] = s[nt][i] * sc2 + bias;
                if (diag) {
#pragma unroll
                    for (int nt = 0; nt < 4; ++nt) sv[nt] = (key0 + l15 * 4 + nt <= qpos) ? sv[nt] : -3e30f; }
                float mx = fmaxf(fmaxf(sv[0], sv[1]), fmaxf(sv[2], sv[3]));
                mx = red16_max(mx);
                const float mnew = fmaxf(m[i], mx), alpha = __builtin_amdgcn_exp2f(m[i] - mnew);
                const float p0 = __builtin_amdgcn_exp2f(sv[0] - mnew), p1 = __builtin_amdgcn_exp2f(sv[1] - mnew), p2 = __builtin_amdgcn_exp2f(sv[2] - mnew), p3 = __builtin_amdgcn_exp2f(sv[3] - mnew);
                u32x2 pw; pw.x = cvt_pk_bf16(p0, p1); pw.y = cvt_pk_bf16(p2, p3);
                *(LAS u32x2*)(Pw + (lq * 4 + i) * 72 + l15 * 4) = pw;
                const float rs = red16_sum((p0 + p1) + (p2 + p3));
                ls[i] = ls[i] * alpha + rs; m[i] = mnew;
#pragma unroll
                for (int dt = 0; dt < 8; ++dt) O[dt][i] *= alpha;
            }
            __builtin_amdgcn_wave_barrier();
            bf16x8 pf[2];
#pragma unroll
            for (int ks = 0; ks < 2; ++ks) pf[ks] = *(const LAS bf16x8*)(Pw + l15 * 72 + ks * 32 + lq * 8);
#pragma unroll
            for (int dt = 0; dt < 8; ++dt)
#pragma unroll
                for (int ks = 0; ks < 2; ++ks) { const bf16x8 vf = *(const LAS bf16x8*)(VT + (dt * 16 + l15) * 72 + ks * 32 + lq * 8); O[dt] = mfma16(pf[ks], vf, O[dt]); }
            __builtin_amdgcn_wave_barrier();
        } };
    Stage R0, R1;
    int ta = 0;
    while (ta <= last && !((tmask >> (ta >> 2)) & 1)) ++ta;
    int tb = nextv(ta);
    if (ta <= last) issue(R0, ta);
    if (tb <= last) issue(R1, tb);
    while (ta <= last) {
        int tc = nextv(tb);
        __syncthreads(); stage(R0); __syncthreads();
        if (tc <= last) issue(R0, tc);
        compute(ta);
        if (tb > last) break;
        int td = nextv(tc);
        __syncthreads(); stage(R1); __syncthreads();
        if (td <= last) issue(R1, td);
        compute(tb);
        ta = tc; tb = td;
    }
#pragma unroll
    for (int i = 0; i < 4; ++i) { const float inv = 1.f / ls[i]; const size_t tok = (size_t)(b * SEQ + q0 + wid * 16 + lq * 4 + i);
#pragma unroll
        for (int dt = 0; dt < 8; ++dt) { const int d = dt * 16 + l15;
            const float g = bf2f(p.P[tok * NP + C_GB + h * 128 + d]);
            p.H[tok * DM + 1024 + h * 128 + d] = f2bf(O[dt][i] * inv * siluf_(g)); } }
}

constexpr int GL_QE = 0, GL_KE = 9216, GL_KDT = 18432, GL_VT = 27648, GL_ATT = 46080, GL_ST = 55296, GL_LA = 73728, GL_TOT = 90112,
              GL_AUP = 92160, GL_LOW = 96256, GL_DEC = 100352, GL_ABS = 100608, GL_GNW = 100864, GL_OB = 0;
__device__ void gla_chunk(const Params& p, int l, LAS unsigned char* lds, int bh, int n, int pass) {
    const int tid = tid_(), wid = tid >> 6, lane = tid & 63, l15 = lane & 15, lq = lane >> 4;
    const int b = bh >> 2, h = bh & 3;
    LAS u16* QE = (LAS u16*)(lds + GL_QE); LAS u16* KE = (LAS u16*)(lds + GL_KE); LAS u16* KDT = (LAS u16*)(lds + GL_KDT); LAS u16* VT = (LAS u16*)(lds + GL_VT);
    LAS u16* ATT = (LAS u16*)(lds + GL_ATT); LAS u16* ST = (LAS u16*)(lds + GL_ST); LAS float* LA = (LAS float*)(lds + GL_LA); LAS float* TOT = (LAS float*)(lds + GL_TOT);
    LAS float* AUP = (LAS float*)(lds + GL_AUP); LAS float* LOW = (LAS float*)(lds + GL_LOW); LAS float* DEC = (LAS float*)(lds + GL_DEC); LAS float* OB = (LAS float*)(lds + GL_OB); LAS float* ABS = (LAS float*)(lds + GL_ABS); LAS float* GNW = (LAS float*)(lds + GL_GNW);
    __syncthreads();
    for (int i = tid; i < 1024; i += 512) AUP[i] = p.a_up[(size_t)l * 16 * 256 + (i >> 6) * 256 + h * 64 + (i & 63)];
    if (tid < 64) ABS[tid] = p.a_b[(size_t)l * 256 + h * 64 + tid];
    if (tid >= 64 && tid < 192) GNW[tid - 64] = p.gnw[(size_t)l * 128 + tid - 64];
    const int rt = wid >> 1, dv0t = (wid & 1) * 4;
    const int tp = lane & 31, dg = wid * 2 + (lane >> 5);
    {
        const size_t tokb = (size_t)(b * SEQ + n * 64);
        const u16* rowp = p.P + (tokb + (tid >> 3)) * NP;
        const u16* rp0 = p.P + (tokb + 2 * tp) * NP; const u16* rp1 = rp0 + NP;
        const unsigned c_low = *(const unsigned*)(rowp + C_LOW + (tid & 7) * 2);
        const u32x2 c_q0 = *(const u32x2*)(rp0 + C_QC + h * 64 + dg * 4), c_q1 = *(const u32x2*)(rp1 + C_QC + h * 64 + dg * 4);
        const u32x2 c_k0 = *(const u32x2*)(rp0 + C_KC + h * 64 + dg * 4), c_k1 = *(const u32x2*)(rp1 + C_KC + h * 64 + dg * 4);
        const u32x4 c_v0 = *(const u32x4*)(rp0 + C_VC + h * 128 + dg * 8), c_v1 = *(const u32x4*)(rp1 + C_VC + h * 128 + dg * 8);
        const u32x4 c_g0 = *(const u32x4*)(rowp + C_GC + h * 128 + (tid & 7) * 16), c_g1 = *(const u32x4*)(rowp + C_GC + h * 128 + (tid & 7) * 16 + 8);
        { const int e2 = tid * 2, t = e2 >> 4, r = e2 & 15; LOW[t * 16 + r] = bflo(c_low); LOW[t * 16 + r + 1] = bfhi(c_low); }
        __syncthreads();
        { const int t = tid >> 3, d0 = (tid & 7) * 8;
            f32x4 lo[4];
#pragma unroll
            for (int i = 0; i < 4; ++i) lo[i] = *(const LAS f32x4*)(LOW + t * 16 + 4 * i);
            f32x4 z0 = *(const LAS f32x4*)(ABS + d0), z1 = *(const LAS f32x4*)(ABS + d0 + 4);
#pragma unroll
            for (int r = 0; r < 16; ++r) { const f32x4 u0 = *(const LAS f32x4*)(AUP + r * 64 + d0), u1 = *(const LAS f32x4*)(AUP + r * 64 + d0 + 4);
                const float lv = lo[r >> 2][r & 3]; z0 += lv * u0; z1 += lv * u1; }
#pragma unroll
            for (int e = 0; e < 4; ++e) { z0[e] = (fminf(z0[e], 0.f) - __logf(1.f + __expf(-fabsf(z0[e])))) * (1.f / 16.f); z1[e] = (fminf(z1[e], 0.f) - __logf(1.f + __expf(-fabsf(z1[e])))) * (1.f / 16.f); }
            *(LAS f32x4*)(LA + t * 64 + d0) = z0; *(LAS f32x4*)(LA + t * 64 + d0 + 4) = z1; }
        __syncthreads();
        { float a = 0.f;
#pragma unroll
            for (int tt = 0; tt < 8; ++tt) { a += LA[(wid * 8 + tt) * 64 + lane]; LA[(wid * 8 + tt) * 64 + lane] = a; }
            TOT[wid * 64 + lane] = a; }
        __syncthreads();
        { const int t0 = 2 * tp, wt = tp >> 2, d0 = dg * 4;
            f32x4 off = {0.f, 0.f, 0.f, 0.f}, tot = {0.f, 0.f, 0.f, 0.f};
#pragma unroll
            for (int w2 = 0; w2 < 8; ++w2) { const f32x4 tv = *(const LAS f32x4*)(TOT + w2 * 64 + d0); tot += tv; off += (w2 < wt) ? tv : (f32x4){0.f, 0.f, 0.f, 0.f}; }
            const f32x4 b0 = *(const LAS f32x4*)(LA + t0 * 64 + d0) + off, b1 = *(const LAS f32x4*)(LA + (t0 + 1) * 64 + d0) + off;
            const float q0[4] = {bflo(c_q0.x), bfhi(c_q0.x), bflo(c_q0.y), bfhi(c_q0.y)}, q1[4] = {bflo(c_q1.x), bfhi(c_q1.x), bflo(c_q1.y), bfhi(c_q1.y)};
            const float k0[4] = {bflo(c_k0.x), bfhi(c_k0.x), bflo(c_k0.y), bfhi(c_k0.y)}, k1[4] = {bflo(c_k1.x), bfhi(c_k1.x), bflo(c_k1.y), bfhi(c_k1.y)};
            float qe0[4], qe1[4], ke0[4], ke1[4];
#pragma unroll
            for (int e = 0; e < 4; ++e) {
                qe0[e] = q0[e] * 0.125f * __expf(b0[e]); qe1[e] = q1[e] * 0.125f * __expf(b1[e]);
                ke0[e] = k0[e] * __expf(-b0[e]); ke1[e] = k1[e] * __expf(-b1[e]);
                *(LAS unsigned*)(KDT + (d0 + e) * 72 + t0) = cvt_pk_bf16(k0[e] * __expf(tot[e] - b0[e]), k1[e] * __expf(tot[e] - b1[e]));
                if (tp == 0) DEC[d0 + e] = __expf(tot[e]); }
            u32x2 o; o.x = cvt_pk_bf16(qe0[0], qe0[1]); o.y = cvt_pk_bf16(qe0[2], qe0[3]); *(LAS u32x2*)(QE + t0 * 72 + d0) = o;
            o.x = cvt_pk_bf16(qe1[0], qe1[1]); o.y = cvt_pk_bf16(qe1[2], qe1[3]); *(LAS u32x2*)(QE + (t0 + 1) * 72 + d0) = o;
            o.x = cvt_pk_bf16(ke0[0], ke0[1]); o.y = cvt_pk_bf16(ke0[2], ke0[3]); *(LAS u32x2*)(KE + t0 * 72 + d0) = o;
            o.x = cvt_pk_bf16(ke1[0], ke1[1]); o.y = cvt_pk_bf16(ke1[2], ke1[3]); *(LAS u32x2*)(KE + (t0 + 1) * 72 + d0) = o;
            { LAS unsigned* vt = (LAS unsigned*)(VT + dg * 8 * 72 + t0);
                vt[0] = (c_v0.x & 0xffffu) | (c_v1.x << 16); vt[36] = (c_v0.x >> 16) | (c_v1.x & 0xffff0000u);
                vt[72] = (c_v0.y & 0xffffu) | (c_v1.y << 16); vt[108] = (c_v0.y >> 16) | (c_v1.y & 0xffff0000u);
                vt[144] = (c_v0.z & 0xffffu) | (c_v1.z << 16); vt[180] = (c_v0.z >> 16) | (c_v1.z & 0xffff0000u);
                vt[216] = (c_v0.w & 0xffffu) | (c_v1.w << 16); vt[252] = (c_v0.w >> 16) | (c_v1.w & 0xffff0000u); } }
        __syncthreads();
        if (pass == 1) {
            bf16x8 kd[2];
#pragma unroll
            for (int ks = 0; ks < 2; ++ks) kd[ks] = *(const LAS bf16x8*)(KDT + (rt * 16 + l15) * 72 + ks * 32 + lq * 8);
            f32x4* gout = (f32x4*)(p.gst + ((size_t)(bh * 32 + n) * 512 + tid) * 16);
#pragma unroll
            for (int c = 0; c < 4; ++c) { const int dvt = dv0t + c; f32x4 acc = {0.f, 0.f, 0.f, 0.f};
#pragma unroll
                for (int ks = 0; ks < 2; ++ks) { const bf16x8 vf = *(const LAS bf16x8*)(VT + (dvt * 16 + l15) * 72 + ks * 32 + lq * 8); acc = mfma16(kd[ks], vf, acc); }
                gout[c] = acc; }
            if (tid < 64) p.gdec[(size_t)(bh * 32 + n) * 64 + tid] = DEC[tid];
            return;
        }
        { bf16x8 af[2];
#pragma unroll
            for (int ks = 0; ks < 2; ++ks) af[ks] = *(const LAS bf16x8*)(QE + (rt * 16 + l15) * 72 + ks * 32 + lq * 8);
#pragma unroll
            for (int c2 = 0; c2 < 2; ++c2) { const int ctile = (wid & 1) * 2 + c2; f32x4 acc = {0.f, 0.f, 0.f, 0.f};
#pragma unroll
                for (int ks = 0; ks < 2; ++ks) { const bf16x8 bf = *(const LAS bf16x8*)(KE + (ctile * 16 + l15) * 72 + ks * 32 + lq * 8); acc = mfma16(af[ks], bf, acc); }
#pragma unroll
                for (int i = 0; i < 4; ++i) { const int t = rt * 16 + lq * 4 + i, jj = ctile * 16 + l15; ATT[t * 72 + jj] = f2bf(jj <= t ? acc[i] : 0.f); } } }
        { f32x4 S[4];
#pragma unroll
            for (int c = 0; c < 4; ++c) S[c] = (f32x4){0.f, 0.f, 0.f, 0.f};
#pragma unroll 2
            for (int m = 0; m < n; ++m) { const f32x4* gin = (const f32x4*)(p.gst + ((size_t)(bh * 32 + m) * 512 + tid) * 16);
                const f32x4 dm = *(const f32x4*)(p.gdec + (size_t)(bh * 32 + m) * 64 + rt * 16 + lq * 4);
#pragma unroll
                for (int c = 0; c < 4; ++c) S[c] = S[c] * dm + gin[c]; }
#pragma unroll
            for (int c = 0; c < 4; ++c) { const int dv = (dv0t + c) * 16 + l15;
                u32x2 sv; sv.x = cvt_pk_bf16(S[c][0], S[c][1]); sv.y = cvt_pk_bf16(S[c][2], S[c][3]);
                *(LAS u32x2*)(ST + dv * 72 + rt * 16 + lq * 4) = sv; } }
        __syncthreads();
        f32x4 oacc[4];
        { bf16x8 at[2], qf[2];
#pragma unroll
            for (int ks = 0; ks < 2; ++ks) { at[ks] = *(const LAS bf16x8*)(ATT + (rt * 16 + l15) * 72 + ks * 32 + lq * 8); qf[ks] = *(const LAS bf16x8*)(QE + (rt * 16 + l15) * 72 + ks * 32 + lq * 8); }
#pragma unroll
            for (int c = 0; c < 4; ++c) { const int dvt = dv0t + c; f32x4 acc = {0.f, 0.f, 0.f, 0.f};
#pragma unroll
                for (int ks = 0; ks < 2; ++ks) { const bf16x8 vf = *(const LAS bf16x8*)(VT + (dvt * 16 + l15) * 72 + ks * 32 + lq * 8), sf = *(const LAS bf16x8*)(ST + (dvt * 16 + l15) * 72 + ks * 32 + lq * 8);
                    acc = mfma16(at[ks], vf, acc); acc = mfma16(qf[ks], sf, acc); }
                oacc[c] = acc; } }
        __syncthreads();
#pragma unroll
        for (int c = 0; c < 4; ++c) { const int dv = (dv0t + c) * 16 + l15;
#pragma unroll
            for (int i = 0; i < 4; ++i) OB[(rt * 16 + lq * 4 + i) * 132 + dv] = oacc[c][i]; }
        __syncthreads();
        { const int t = tid >> 3, dvb = (tid & 7) * 16;
            f32x4 o4[4]; float ss = 0.f;
#pragma unroll
            for (int i = 0; i < 4; ++i) { o4[i] = *(const LAS f32x4*)(OB + t * 132 + dvb + 4 * i); ss += o4[i].x * o4[i].x + o4[i].y * o4[i].y + o4[i].z * o4[i].z + o4[i].w * o4[i].w; }
            ss = red8_sum(ss);
            const float rs = rsqrtf(ss * (1.f / 128.f) + 1e-6f);
            const float g[16] = {bflo(c_g0.x), bfhi(c_g0.x), bflo(c_g0.y), bfhi(c_g0.y), bflo(c_g0.z), bfhi(c_g0.z), bflo(c_g0.w), bfhi(c_g0.w),
                                 bflo(c_g1.x), bfhi(c_g1.x), bflo(c_g1.y), bfhi(c_g1.y), bflo(c_g1.z), bfhi(c_g1.z), bflo(c_g1.w), bfhi(c_g1.w)};
            float r[16];
#pragma unroll
            for (int e = 0; e < 16; ++e) r[e] = o4[e >> 2][e & 3] * rs * GNW[dvb + e] * siluf_(g[e]);
            u32x4 w0, w1; w0.x = cvt_pk_bf16(r[0], r[1]); w0.y = cvt_pk_bf16(r[2], r[3]); w0.z = cvt_pk_bf16(r[4], r[5]); w0.w = cvt_pk_bf16(r[6], r[7]);
            w1.x = cvt_pk_bf16(r[8], r[9]); w1.y = cvt_pk_bf16(r[10], r[11]); w1.z = cvt_pk_bf16(r[12], r[13]); w1.w = cvt_pk_bf16(r[14], r[15]);
            u16* op = p.H + (tokb + t) * DM + 1536 + h * 128 + dvb;
            *(u32x4*)op = w0; *(u32x4*)(op + 8) = w1; }
    }
}

__device__ void gla_task(const Params& p, int l, LAS unsigned char* lds, int bh, int hs, int nlen) {
    const int tid = tid_(), wid = tid >> 6, lane = tid & 63, l15 = lane & 15, lq = lane >> 4;
    const int b = bh >> 2, h = bh & 3;
    LAS u16* QE = (LAS u16*)(lds + GL_QE); LAS u16* KE = (LAS u16*)(lds + GL_KE); LAS u16* KDT = (LAS u16*)(lds + GL_KDT); LAS u16* VT = (LAS u16*)(lds + GL_VT);
    LAS u16* ATT = (LAS u16*)(lds + GL_ATT); LAS u16* ST = (LAS u16*)(lds + GL_ST); LAS float* LA = (LAS float*)(lds + GL_LA); LAS float* TOT = (LAS float*)(lds + GL_TOT);
    LAS float* AUP = (LAS float*)(lds + GL_AUP); LAS float* LOW = (LAS float*)(lds + GL_LOW); LAS float* DEC = (LAS float*)(lds + GL_DEC); LAS float* OB = (LAS float*)(lds + GL_OB); LAS float* ABS = (LAS float*)(lds + GL_ABS); LAS float* GNW = (LAS float*)(lds + GL_GNW);
    __syncthreads();
    for (int i = tid; i < 1024; i += 512) AUP[i] = p.a_up[(size_t)l * 16 * 256 + (i >> 6) * 256 + h * 64 + (i & 63)];
    for (int i = tid; i < 128 * 72 / 2; i += 512) ((LAS unsigned*)ST)[i] = 0u;
    if (tid < 64) ABS[tid] = p.a_b[(size_t)l * 256 + h * 64 + tid];
    if (tid >= 64 && tid < 192) GNW[tid - 64] = p.gnw[(size_t)l * 128 + tid - 64];
    f32x4 Sacc[4];
#pragma unroll
    for (int c = 0; c < 4; ++c) Sacc[c] = (f32x4){0.f, 0.f, 0.f, 0.f};
    const int rt = wid >> 1, dv0t = (wid & 1) * 4;
    const int tp = lane & 31, dg = wid * 2 + (lane >> 5);
    if (hs) {
#pragma unroll 2
        for (int m = 0; m < 16; ++m) { const f32x4* gin = (const f32x4*)(p.gst + ((size_t)(bh * 32 + m) * 512 + tid) * 16);
            const f32x4 dm = *(const f32x4*)(p.gdec + (size_t)(bh * 32 + m) * 64 + rt * 16 + lq * 4);
#pragma unroll
            for (int c = 0; c < 4; ++c) Sacc[c] = Sacc[c] * dm + gin[c]; }
        __syncthreads();
#pragma unroll
        for (int c = 0; c < 4; ++c) { const int dv = (dv0t + c) * 16 + l15;
            u32x2 sv; sv.x = cvt_pk_bf16(Sacc[c][0], Sacc[c][1]); sv.y = cvt_pk_bf16(Sacc[c][2], Sacc[c][3]);
            *(LAS u32x2*)(ST + dv * 72 + rt * 16 + lq * 4) = sv; }
    }
    for (int n = hs * 16; n < hs * 16 + nlen; ++n) {
        const size_t tokb = (size_t)(b * SEQ + n * 64);
        const u16* rowp = p.P + (tokb + (tid >> 3)) * NP;
        const u16* rp0 = p.P + (tokb + 2 * tp) * NP; const u16* rp1 = rp0 + NP;
        const unsigned c_low = *(const unsigned*)(rowp + C_LOW + (tid & 7) * 2);
        const u32x2 c_q0 = *(const u32x2*)(rp0 + C_QC + h * 64 + dg * 4), c_q1 = *(const u32x2*)(rp1 + C_QC + h * 64 + dg * 4);
        const u32x2 c_k0 = *(const u32x2*)(rp0 + C_KC + h * 64 + dg * 4), c_k1 = *(const u32x2*)(rp1 + C_KC + h * 64 + dg * 4);
        const u32x4 c_v0 = *(const u32x4*)(rp0 + C_VC + h * 128 + dg * 8), c_v1 = *(const u32x4*)(rp1 + C_VC + h * 128 + dg * 8);
        const u32x4 c_g0 = *(const u32x4*)(rowp + C_GC + h * 128 + (tid & 7) * 16), c_g1 = *(const u32x4*)(rowp + C_GC + h * 128 + (tid & 7) * 16 + 8);
        { const int e2 = tid * 2, t = e2 >> 4, r = e2 & 15; LOW[t * 16 + r] = bflo(c_low); LOW[t * 16 + r + 1] = bfhi(c_low); }
        __syncthreads();
        { const int t = tid >> 3, d0 = (tid & 7) * 8;
            f32x4 lo[4];
#pragma unroll
            for (int i = 0; i < 4; ++i) lo[i] = *(const LAS f32x4*)(LOW + t * 16 + 4 * i);
            f32x4 z0 = *(const LAS f32x4*)(ABS + d0), z1 = *(const LAS f32x4*)(ABS + d0 + 4);
#pragma unroll
            for (int r = 0; r < 16; ++r) { const f32x4 u0 = *(const LAS f32x4*)(AUP + r * 64 + d0), u1 = *(const LAS f32x4*)(AUP + r * 64 + d0 + 4);
                const float lv = lo[r >> 2][r & 3]; z0 += lv * u0; z1 += lv * u1; }
#pragma unroll
            for (int e = 0; e < 4; ++e) { z0[e] = (fminf(z0[e], 0.f) - __logf(1.f + __expf(-fabsf(z0[e])))) * (1.f / 16.f); z1[e] = (fminf(z1[e], 0.f) - __logf(1.f + __expf(-fabsf(z1[e])))) * (1.f / 16.f); }
            *(LAS f32x4*)(LA + t * 64 + d0) = z0; *(LAS f32x4*)(LA + t * 64 + d0 + 4) = z1; }
        __syncthreads();
        { float a = 0.f;
#pragma unroll
            for (int tt = 0; tt < 8; ++tt) { a += LA[(wid * 8 + tt) * 64 + lane]; LA[(wid * 8 + tt) * 64 + lane] = a; }
            TOT[wid * 64 + lane] = a; }
        __syncthreads();
        { const int t0 = 2 * tp, wt = tp >> 2, d0 = dg * 4;
            f32x4 off = {0.f, 0.f, 0.f, 0.f}, tot = {0.f, 0.f, 0.f, 0.f};
#pragma unroll
            for (int w2 = 0; w2 < 8; ++w2) { const f32x4 tv = *(const LAS f32x4*)(TOT + w2 * 64 + d0); tot += tv; off += (w2 < wt) ? tv : (f32x4){0.f, 0.f, 0.f, 0.f}; }
            const f32x4 b0 = *(const LAS f32x4*)(LA + t0 * 64 + d0) + off, b1 = *(const LAS f32x4*)(LA + (t0 + 1) * 64 + d0) + off;
            const float q0[4] = {bflo(c_q0.x), bfhi(c_q0.x), bflo(c_q0.y), bfhi(c_q0.y)}, q1[4] = {bflo(c_q1.x), bfhi(c_q1.x), bflo(c_q1.y), bfhi(c_q1.y)};
            const float k0[4] = {bflo(c_k0.x), bfhi(c_k0.x), bflo(c_k0.y), bfhi(c_k0.y)}, k1[4] = {bflo(c_k1.x), bfhi(c_k1.x), bflo(c_k1.y), bfhi(c_k1.y)};
            float qe0[4], qe1[4], ke0[4], ke1[4];
#pragma unroll
            for (int e = 0; e < 4; ++e) {
                qe0[e] = q0[e] * 0.125f * __expf(b0[e]); qe1[e] = q1[e] * 0.125f * __expf(b1[e]);
                ke0[e] = k0[e] * __expf(-b0[e]); ke1[e] = k1[e] * __expf(-b1[e]);
                *(LAS unsigned*)(KDT + (d0 + e) * 72 + t0) = cvt_pk_bf16(k0[e] * __expf(tot[e] - b0[e]), k1[e] * __expf(tot[e] - b1[e]));
                if (tp == 0) DEC[d0 + e] = __expf(tot[e]); }
            u32x2 o; o.x = cvt_pk_bf16(qe0[0], qe0[1]); o.y = cvt_pk_bf16(qe0[2], qe0[3]); *(LAS u32x2*)(QE + t0 * 72 + d0) = o;
            o.x = cvt_pk_bf16(qe1[0], qe1[1]); o.y = cvt_pk_bf16(qe1[2], qe1[3]); *(LAS u32x2*)(QE + (t0 + 1) * 72 + d0) = o;
            o.x = cvt_pk_bf16(ke0[0], ke0[1]); o.y = cvt_pk_bf16(ke0[2], ke0[3]); *(LAS u32x2*)(KE + t0 * 72 + d0) = o;
            o.x = cvt_pk_bf16(ke1[0], ke1[1]); o.y = cvt_pk_bf16(ke1[2], ke1[3]); *(LAS u32x2*)(KE + (t0 + 1) * 72 + d0) = o;
            { LAS unsigned* vt = (LAS unsigned*)(VT + dg * 8 * 72 + t0);
                vt[0] = (c_v0.x & 0xffffu) | (c_v1.x << 16); vt[36] = (c_v0.x >> 16) | (c_v1.x & 0xffff0000u);
                vt[72] = (c_v0.y & 0xffffu) | (c_v1.y << 16); vt[108] = (c_v0.y >> 16) | (c_v1.y & 0xffff0000u);
                vt[144] = (c_v0.z & 0xffffu) | (c_v1.z << 16); vt[180] = (c_v0.z >> 16) | (c_v1.z & 0xffff0000u);
                vt[216] = (c_v0.w & 0xffffu) | (c_v1.w << 16); vt[252] = (c_v0.w >> 16) | (c_v1.w & 0xffff0000u); } }
        __syncthreads();
        { bf16x8 af[2];
#pragma unroll
            for (int ks = 0; ks < 2; ++ks) af[ks] = *(const LAS bf16x8*)(QE + (rt * 16 + l15) * 72 + ks * 32 + lq * 8);
#pragma unroll
            for (int c2 = 0; c2 < 2; ++c2) { const int ctile = (wid & 1) * 2 + c2; f32x4 acc = {0.f, 0.f, 0.f, 0.f};
#pragma unroll
                for (int ks = 0; ks < 2; ++ks) { const bf16x8 bf = *(const LAS bf16x8*)(KE + (ctile * 16 + l15) * 72 + ks * 32 + lq * 8); acc = mfma16(af[ks], bf, acc); }
#pragma unroll
                for (int i = 0; i < 4; ++i) { const int t = rt * 16 + lq * 4 + i, jj = ctile * 16 + l15; ATT[t * 72 + jj] = f2bf(jj <= t ? acc[i] : 0.f); } } }
        __syncthreads();
        f32x4 oacc[4];
        { bf16x8 at[2], qf[2], kd[2];
#pragma unroll
            for (int ks = 0; ks < 2; ++ks) { at[ks] = *(const LAS bf16x8*)(ATT + (rt * 16 + l15) * 72 + ks * 32 + lq * 8); qf[ks] = *(const LAS bf16x8*)(QE + (rt * 16 + l15) * 72 + ks * 32 + lq * 8);
                kd[ks] = *(const LAS bf16x8*)(KDT + (rt * 16 + l15) * 72 + ks * 32 + lq * 8); }
            const f32x4 dec = *(const LAS f32x4*)(DEC + rt * 16 + lq * 4);
#pragma unroll
            for (int c = 0; c < 4; ++c) { const int dvt = dv0t + c; f32x4 acc = {0.f, 0.f, 0.f, 0.f};
                Sacc[c] *= dec;
#pragma unroll
                for (int ks = 0; ks < 2; ++ks) { const bf16x8 vf = *(const LAS bf16x8*)(VT + (dvt * 16 + l15) * 72 + ks * 32 + lq * 8), sf = *(const LAS bf16x8*)(ST + (dvt * 16 + l15) * 72 + ks * 32 + lq * 8);
                    acc = mfma16(at[ks], vf, acc); acc = mfma16(qf[ks], sf, acc); Sacc[c] = mfma16(kd[ks], vf, Sacc[c]); }
                oacc[c] = acc; } }
        __syncthreads();
#pragma unroll
        for (int c = 0; c < 4; ++c) { const int dv = (dv0t + c) * 16 + l15;
#pragma unroll
            for (int i = 0; i < 4; ++i) OB[(rt * 16 + lq * 4 + i) * 132 + dv] = oacc[c][i];
            u32x2 sv; sv.x = cvt_pk_bf16(Sacc[c][0], Sacc[c][1]); sv.y = cvt_pk_bf16(Sacc[c][2], Sacc[c][3]);
            *(LAS u32x2*)(ST + dv * 72 + rt * 16 + lq * 4) = sv; }
        __syncthreads();
        { const int t = tid >> 3, dvb = (tid & 7) * 16;
            f32x4 o4[4]; float ss = 0.f;
#pragma unroll
            for (int i = 0; i < 4; ++i) { o4[i] = *(const LAS f32x4*)(OB + t * 132 + dvb + 4 * i); ss += o4[i].x * o4[i].x + o4[i].y * o4[i].y + o4[i].z * o4[i].z + o4[i].w * o4[i].w; }
            ss = red8_sum(ss);
            const float rs = rsqrtf(ss * (1.f / 128.f) + 1e-6f);
            const float g[16] = {bflo(c_g0.x), bfhi(c_g0.x), bflo(c_g0.y), bfhi(c_g0.y), bflo(c_g0.z), bfhi(c_g0.z), bflo(c_g0.w), bfhi(c_g0.w),
                                 bflo(c_g1.x), bfhi(c_g1.x), bflo(c_g1.y), bfhi(c_g1.y), bflo(c_g1.z), bfhi(c_g1.z), bflo(c_g1.w), bfhi(c_g1.w)};
            float r[16];
#pragma unroll
            for (int e = 0; e < 16; ++e) r[e] = o4[e >> 2][e & 3] * rs * GNW[dvb + e] * siluf_(g[e]);
            u32x4 w0, w1; w0.x = cvt_pk_bf16(r[0], r[1]); w0.y = cvt_pk_bf16(r[2], r[3]); w0.z = cvt_pk_bf16(r[4], r[5]); w0.w = cvt_pk_bf16(r[6], r[7]);
            w1.x = cvt_pk_bf16(r[8], r[9]); w1.y = cvt_pk_bf16(r[10], r[11]); w1.z = cvt_pk_bf16(r[12], r[13]); w1.w = cvt_pk_bf16(r[14], r[15]);
            u16* op = p.H + (tokb + t) * DM + 1536 + h * 128 + dvb;
            *(u32x4*)op = w0; *(u32x4*)(op + 8) = w1; }
        __syncthreads();
    }
}

#define XB_TMO      128
#define XB_XCNT(j)  (256  + 64 * (j))
#define XB_XSUB(j)  (1280 + 64 * (j))
#define XB_XGEN(j)  (2304 + 64 * (j))
#define XB_TOP      3328
#define XB_TOPGEN   3392
#define XCD_BAR_WORDS 3456
#define XB_SPIN_CAP (1u << 18)

__device__ __forceinline__ unsigned xb_ld(unsigned* p)              { return __hip_atomic_load(p, __ATOMIC_RELAXED, __HIP_MEMORY_SCOPE_AGENT); }
__device__ __forceinline__ unsigned xb_add(unsigned* p, unsigned v) { return __hip_atomic_fetch_add(p, v, __ATOMIC_RELAXED, __HIP_MEMORY_SCOPE_AGENT); }
__device__ __forceinline__ unsigned xb_xcc_id() { return (unsigned)__builtin_amdgcn_s_getreg((3 << 11) | 20) & 0xFu; }
#define XB_SPIN(cond, bar) do { unsigned _sp = 0; while (cond) { __builtin_amdgcn_s_sleep(1); \
    if ((++_sp & 255u) == 0u) { if (xb_ld(&(bar)[XB_TMO])) break; if (_sp > XB_SPIN_CAP) { atomicAdd(&(bar)[XB_TMO], 1u); break; } } } } while (0)

struct XcdBarrier {
    unsigned* bar; unsigned x;
    volatile LAS unsigned* st;
};

__device__ __forceinline__ XcdBarrier xcd_barrier_post(unsigned* bar, volatile LAS unsigned* st) {
    XcdBarrier b; b.bar = bar; b.x = xb_xcc_id(); b.st = st;
    if (threadIdx.x == 0) (void)xb_add(&bar[XB_XCNT(b.x)], 1u);
    return b;
}
__device__ __forceinline__ void xcd_barrier_complete(unsigned* bar, unsigned x, unsigned& nloc, unsigned& nx) {
    const unsigned G = gridDim.x * gridDim.y * gridDim.z;
    unsigned sum, cnt, mine, sp = 0u;
    for (;;) {
        sum = 0u; cnt = 0u; mine = 0u;
#pragma unroll
        for (unsigned j = 0; j < 16; ++j) { const unsigned c = xb_ld(&bar[XB_XCNT(j)]); sum += c; cnt += (c > 0u) ? 1u : 0u; mine = (j == x) ? c : mine; }
        if (sum == G) break;
        __builtin_amdgcn_s_sleep(1);
        if ((++sp & 255u) == 0u) { if (xb_ld(&bar[XB_TMO])) break; if (sp > XB_SPIN_CAP) { atomicAdd(&bar[XB_TMO], 1u); break; } }
    }
    nloc = mine > 0u ? mine : 1u; nx = cnt > 0u ? cnt : 1u;
}

__device__ __forceinline__ void xcd_barrier(const XcdBarrier& b) {
    asm volatile("s_waitcnt vmcnt(0)" ::: "memory");
    __syncthreads();
    if (threadIdx.x == 0) {
        unsigned* bar = b.bar;
        __builtin_amdgcn_s_waitcnt(0);
        unsigned nloc = b.st[0], nx = b.st[1];
        if (nloc == 0u) { xcd_barrier_complete(bar, b.x, nloc, nx); b.st[0] = nloc; b.st[1] = nx; }
        const unsigned old = xb_add(&bar[XB_XSUB(b.x)], 1u);
        const unsigned gen = old / nloc;
        if (old + 1u == (gen + 1u) * nloc) {
            __builtin_amdgcn_fence(__ATOMIC_RELEASE, "agent");
            asm volatile("s_waitcnt vmcnt(0)" ::: "memory");
            const unsigned og = xb_add(&bar[XB_TOP], 1u);
            const unsigned tg = og / nx;
            if (og + 1u == (tg + 1u) * nx) xb_add(&bar[XB_TOPGEN], 1u);
            else XB_SPIN(xb_ld(&bar[XB_TOPGEN]) == tg, bar);
            __builtin_amdgcn_fence(__ATOMIC_ACQUIRE, "agent");
            xb_add(&bar[XB_XGEN(b.x)], 1u);
            asm volatile("s_waitcnt vmcnt(0)" ::: "memory");
        } else {
            XB_SPIN(xb_ld(&bar[XB_XGEN(b.x)]) == gen, bar);
            __builtin_amdgcn_fence(__ATOMIC_ACQUIRE, "agent");
            asm volatile("s_waitcnt vmcnt(0)" ::: "memory");
        }
    }
    __syncthreads();
}

constexpr int N_PHASES = 9;
__device__ __forceinline__ void run_phase(const Params& p, int ph, LAS unsigned char* lds, LAS unsigned* qslot, int bid, int nb) {
    if (ph == 0) {
        transpose_cvt(lds, p.w_in, p.WtIn, DM, DIN, NP, bid, nb);
        for (int l = 0; l < 2; ++l) {
            transpose_cvt(lds, p.w2 + (size_t)l * 64 * 1024, p.W2t + (size_t)l * 1024 * 64, 64, 1024, 1024, bid, nb);
            transpose_cvt(lds, p.a2 + (size_t)l * 64 * 1024, p.A2t + (size_t)l * 1024 * 64, 64, 1024, 1024, bid, nb);
        }
        rmsnorm_phase(p.x, p.norm_w, p.H, nullptr, bid, nb);
        return;
    }
    const int l = (ph - 1) / 4, s = (ph - 1) % 4;
    if (s == 0) {
        Gemm g; g.A = p.H; g.Bt = p.WtIn + (size_t)l * NP * DM; g.M = MTOK; g.N = NP; g.K = DM;
        StaticOrder S; S.init(MTOK, NP, nb, bid);
        EpiP E; E.O = p.P; E.ldc = NP;
        gemm_phase<EpiP, StaticOrder, false>(lds, g, S, E, nullptr);
    } else if (s == 1) {
        unsigned* sy = p.sync + 512 * l;
        LAS int* slot = (LAS int*)qslot;
        const int nscan = nb >> 1;
        if (bid < nscan) {
            for (int task = bid; task < 128; task += nscan) { rwkv_scan_task(p, l, lds, task); wg_publish(sy + 64 + task, 1u); }
        } else {
            bool km_ready = false;
            for (;;) {
                __syncthreads();
                if (tid_() == 0) *slot = (int)atomicAdd(sy, 1u);
                __syncthreads();
                const int tk = *slot;
                if (tk >= 256 + 32 + 512 + (l == 0 ? 376 : 0)) break;
                if (tk < 256) { __syncthreads(); kmean_phase(p, lds, tk, tk + 1, 1); wg_publish(sy + 16, 1u); }
                else if (tk < 288) gla_task(p, l, lds, tk - 256, 0, 32);
                else if (tk < 800) { if (!km_ready) { wg_wait_ge(sy + 16, 256u); km_ready = true; } moba_task(p, lds, tk - 288); }
                else { const int ct = tk - 800;
                    __syncthreads();
                    if (ct < 64) transpose_cvt_range(lds, p.w_out, p.WtOut, DM, DM, DM, ct * 16, ct * 16 + 16, 1);
                    else if (ct < 312) transpose_cvt_range(lds, p.w_in + (size_t)DM * DIN, p.WtIn + (size_t)NP * DM, DM, DIN, NP, (ct - 64) * 16, (ct - 64) * 16 + 16, 1);
                    else transpose_cvt_range(lds, p.w_out + (size_t)DM * DM, p.WtOut + (size_t)DM * DM, DM, DM, DM, (ct - 312) * 16, (ct - 312) * 16 + 16, 1); }
            }
        }
        for (;;) {
            __syncthreads();
            if (tid_() == 0) *slot = (int)atomicAdd(sy + 32, 1u);
            __syncthreads();
            const int tk = *slot;
            if (tk >= 256) break;
            wg_wait_ge(sy + 64 + (tk >> 1), 1u);
            rwkv_post_block(p, l, tk >> 1, tk & 1);
        }
    } else if (s == 2) {
        Gemm g; g.A = p.H; g.Bt = p.WtOut + (size_t)l * DM * DM; g.M = MTOK; g.N = DM; g.K = DM;
        StaticOrder S; S.init(MTOK, DM, nb, bid);
        EpiRes E; E.R = (l == 0) ? p.x : p.out; E.C = p.out; E.ldc = DM;
        gemm_phase<EpiRes, StaticOrder, false>(lds, g, S, E, nullptr);
    } else {
        if (l == 0) rmsnorm_phase(p.out, p.norm_w + DM, p.H, nullptr, bid, nb);
        else rmsnorm_phase(p.out, p.fnw, nullptr, p.out, bid, nb);
    }
}

__global__ void __launch_bounds__(512, 2) hybrid_fwd(Params p) {
    extern __shared__ __attribute__((aligned(16))) unsigned char shm[];
    LAS unsigned char* lds = (LAS unsigned char*)shm;
    const int bid = blockIdx.x, nb = gridDim.x;
#if defined(TEST_GEMM)
    { Gemm g; g.A = p.H; g.Bt = p.WtIn; g.M = MTOK; g.N = NP; g.K = DM;
      StaticOrder S; S.init(MTOK, NP, nb, bid);
      EpiP E; E.O = p.P; E.ldc = NP;
      gemm_phase<EpiP, StaticOrder, false>(lds, g, S, E, nullptr);
#if TEST_GEMM >= 2
      if (p.phase_lo) {
      Gemm g2; g2.A = p.H; g2.Bt = p.WtOut; g2.M = MTOK; g2.N = DM; g2.K = DM;
      StaticOrder S2; S2.init(MTOK, DM, nb, bid);
      EpiRes E2; E2.R = p.x; E2.C = p.out; E2.ldc = DM;
      gemm_phase<EpiRes, StaticOrder, false>(lds, g2, S2, E2, nullptr); }
#endif
    }
#elif ONE_LAUNCH
    cg::grid_group grid = cg::this_grid();
    __shared__ uint4 xb_words;
    if (threadIdx.x == 0) xb_words = make_uint4(0u, 0u, 0u, 0u);
    __syncthreads();
    const XcdBarrier xb = xcd_barrier_post(p.bar, (volatile LAS unsigned*)&xb_words);
    for (int ph = p.phase_lo; ph < p.phase_hi; ++ph) {
        run_phase(p, ph, lds, (LAS unsigned*)&xb_words.z, bid, nb);
#ifdef REPEAT_PH
        if (ph == REPEAT_PH) { xcd_barrier(xb); run_phase(p, ph, lds, (LAS unsigned*)&xb_words.z, bid, nb); }
#endif
        if (ph + 1 < p.phase_hi) { if (p.phase_lo < 0) grid.sync(); else xcd_barrier(xb); }
    }
#else
    run_phase(p, p.phase_lo, lds, nullptr, bid, nb);
#endif
}

extern "C" void kernel_launch(void* const* d_in, const int* in_sizes, int n_in, void* d_out, int out_size, void* d_ws, size_t ws_size, hipStream_t stream) {
    static int grid = 0;
    if (grid == 0) {
        int dev = 0, cus = 0, per_cu = 0;
        hipGetDevice(&dev);
        hipDeviceGetAttribute(&cus, hipDeviceAttributeMultiprocessorCount, dev);
        hipFuncSetAttribute((const void*)hybrid_fwd, hipFuncAttributeMaxDynamicSharedMemorySize, LDS_BYTES);
        hipOccupancyMaxActiveBlocksPerMultiprocessor(&per_cu, (const void*)hybrid_fwd, 512, LDS_BYTES);
        if (per_cu < 1) { fprintf(stderr, "kernel_launch: occupancy query says %d blocks per CU\n", per_cu); per_cu = 1; }
        (void)hipGetLastError();
        grid = cus;
    }
    Params p{};
    const float* const* in = (const float* const*)d_in;
    p.x = in[0]; p.norm_w = in[1]; p.w_in = in[2]; p.w_out = in[3]; p.mu = in[4]; p.w0 = in[5]; p.w2 = in[6]; p.a0 = in[7]; p.a2 = in[8];
    p.k_k = in[9]; p.k_a = in[10]; p.r_k = in[11]; p.ln_w = in[12]; p.ln_b = in[13]; p.a_up = in[14]; p.a_b = in[15]; p.gnw = in[16]; p.fnw = in[17];
    p.out = (float*)d_out;
    unsigned char* ws = (unsigned char*)d_ws; size_t off = 0;
    auto take = [&](size_t bytes) { unsigned char* r = ws + off; off += (bytes + 255) & ~(size_t)255; return r; };
    p.WtIn = (u16*)take((size_t)2 * NP * DM * 2); p.WtOut = (u16*)take((size_t)2 * DM * DM * 2);
    p.W2t = (u16*)take((size_t)2 * 1024 * 64 * 2); p.A2t = (u16*)take((size_t)2 * 1024 * 64 * 2);
    p.H = (u16*)take((size_t)MTOK * DM * 2); p.P = (u16*)take((size_t)MTOK * NP * 2);
    p.yraw = (float*)take((size_t)MTOK * 1024 * 4); p.ybonus = (float*)take((size_t)MTOK * 16 * 4); p.kmean = (float*)take((size_t)256 * 128 * 4);
    p.bar = (unsigned*)take((size_t)XCD_BAR_WORDS * 4);
    p.sync = (unsigned*)take((size_t)1024 * 4);
    if (off > ws_size) { fprintf(stderr, "kernel_launch: workspace too small (%zu > %zu)\n", off, ws_size); return; }
#if ONE_LAUNCH
    hipMemsetAsync(p.bar, 0, (size_t)XCD_BAR_WORDS * 4, stream);
    hipMemsetAsync(p.sync, 0, (size_t)1024 * 4, stream);
    p.phase_lo = 0; p.phase_hi = N_PHASES;
    void* args[] = {&p};
    hipError_t e = hipLaunchCooperativeKernel((const void*)hybrid_fwd, dim3(grid), dim3(512), args, LDS_BYTES, stream);
    if (e != hipSuccess) fprintf(stderr, "cooperative launch failed: %s (grid %d)\n", hipGetErrorString(e), grid);
#else
    for (int ph = 0; ph < N_PHASES; ++ph) { p.phase_lo = ph; p.phase_hi = ph + 1; hipLaunchKernelGGL(hybrid_fwd, dim3(grid), dim3(512), LDS_BYTES, stream, p); }
#endif
}
```

```cpp
#include <hip/hip_runtime.h>
#include <hip/hip_cooperative_groups.h>
#include <cstdio>
namespace cg = cooperative_groups;

#ifndef ONE_LAUNCH
#define ONE_LAUNCH 1
#endif

namespace pg8 {
#define PG8_LAS __attribute__((address_space(3)))
typedef unsigned short bf16_t;
typedef short bf16x8 __attribute__((ext_vector_type(8)));
typedef float f32x4 __attribute__((ext_vector_type(4)));
typedef unsigned u32x4 __attribute__((ext_vector_type(4)));
constexpr int BM = 256, BK = 64, HALF = 128, HTB = HALF * BK * 2  , STAGE_BYTES = 8 * HTB, NXCD = 8, WGM = 8;

__host__ __device__ __forceinline__ int lds_byte(int r, int c) { const int st = (r >> 4) * 2 + (c >> 5), rr = r & 15, cc = c & 31, ob = rr * 64 + cc * 2; return st * 1024 + (ob ^ (((ob >> 9) & 1) << 5)); }
__host__ __device__ __forceinline__ void stage_rc(int b, int& R, int& C) { const int st = b / 1024, sb = b % 1024, swz = sb ^ (((sb >> 9) & 1) << 5); R = (st >> 1) * 16 + swz / 64; C = (st & 1) * 32 + (swz % 64) / 2; }
__host__ __device__ __forceinline__ int perm32(int rho) { const int n = rho >> 4, i = rho & 15; return 8 * (i >> 2) + 4 * n + (i & 3); }

struct Unit { int pm, pn; };
struct Gemm { const bf16_t* A; const bf16_t* Bt; int M, N, K; };

struct StaticOrder {
    int nM, nN, nwg, G, c;
    __host__ __device__ void init(int M, int N, int G_, int c_) { nM = M / BM; nN = N / BM; nwg = nM * nN; G = G_; c = c_; }
    __host__ __device__ bool next(int i, Unit& u) const {
        const long L = (long)i * G + c; if (L >= nwg) return false;
        int wgid = (int)L; { const int q = nwg / NXCD, r = nwg % NXCD, xcd = wgid % NXCD, off = wgid / NXCD; wgid = (xcd < r ? xcd * (q + 1) : r * (q + 1) + (xcd - r) * q) + off; }
        const int nig = WGM * nN, gid = wgid / nig, fm = gid * WGM, gsz = (nM - fm) < WGM ? (nM - fm) : WGM;
        u.pm = fm + ((wgid % nig) % gsz); u.pn = (wgid % nig) / gsz; return true;
    }
    __device__ __forceinline__ void a_ready(const Unit&) const {}
    __device__ __forceinline__ void done(const Unit&) const {}
};
__device__ __forceinline__ unsigned cvt_pk_bf16(float lo, float hi) { unsigned r; asm volatile("v_cvt_pk_bf16_f32 %0, %1, %2" : "=v"(r) : "v"(lo), "v"(hi)); return r; }
template <class Epi, class Sched, bool STAMP = false>
__device__ __forceinline__ void gemm_phase(PG8_LAS unsigned char* lds, const Gemm g, const Sched& S, const Epi& E, unsigned long long* stamps) {
    int tid = threadIdx.x; asm volatile("" : "+v"(tid)); const int wid = __builtin_amdgcn_readfirstlane(tid >> 6), lane = tid & 63, wr = wid >> 2, wc = wid & 3, fr = lane & 15, fq = lane >> 4;
    const int K = g.K, nt = K / BK;
    int ts_lo = 0, ts_hi = 0, nts = 0; const unsigned long long rt_entry = STAMP ? (unsigned long long)wall_clock64() : 0ull;
#define PG8_STAMP() do { if (STAMP && wid == 0 && nts < 64) { const unsigned long long _c = (unsigned long long)clock64(); \
        ts_lo = (lane == nts) ? (int)(unsigned)_c : ts_lo; ts_hi = (lane == nts) ? (int)(unsigned)(_c >> 32) : ts_hi; ++nts; } } while (0)
    PG8_STAMP();
    unsigned voffA[2], voffB[2];
#pragma unroll
    for (int i = 0; i < 2; ++i) { int R, C; stage_rc(tid * 16 + i * 8192, R, C); const int Rb = Epi::PERM ? ((R & ~31) + perm32(R & 31)) : R;
        voffA[i] = (unsigned)(R * K + C) * 2u; voffB[i] = (unsigned)(Rb * K + C) * 2u; }
    const size_t kstep = (size_t)(BK * 2);
    const size_t hstep = (size_t)HALF * K * 2;
    const size_t tstep = 2 * hstep;
    const unsigned ldsw = (unsigned)wid * 1024u;
    const int aoff = lds_byte(wr * 64 + fr, fq * 8), boff = lds_byte(wc * 32 + fr, fq * 8);
#define PG8_SA(b, h) (((b) * 2 + (h)) * HTB)
#define PG8_SB(b, h) ((4 + (b) * 2 + (h)) * HTB)
#define PG8_STAGE(bufoff, gbase, voff) do { _Pragma("unroll") for (int _i = 0; _i < 2; ++_i) \
        __builtin_amdgcn_global_load_lds((const unsigned*)((const char*)(gbase) + (voff)[_i]), (PG8_LAS unsigned*)(lds + (bufoff) + ldsw + _i * 8192), 16, 0, 0); } while (0)
#define PG8_LDA(dst, b, h) do { _Pragma("unroll") for (int m = 0; m < 4; ++m) _Pragma("unroll") for (int k = 0; k < 2; ++k) dst[m][k] = *(const PG8_LAS bf16x8*)(lds + PG8_SA(b, h) + aoff + m * 2048 + k * 1024); } while (0)
#define PG8_LDB(dst, b, h) do { _Pragma("unroll") for (int n = 0; n < 2; ++n) _Pragma("unroll") for (int k = 0; k < 2; ++k) dst[n][k] = *(const PG8_LAS bf16x8*)(lds + PG8_SB(b, h) + boff + n * 2048 + k * 1024); } while (0)
#define PG8_MMA(ai, bj, At, Bt) do { __builtin_amdgcn_s_setprio(1); _Pragma("unroll") for (int m = 0; m < 4; ++m) _Pragma("unroll") for (int n = 0; n < 2; ++n) _Pragma("unroll") for (int k = 0; k < 2; ++k) \
        acc[ai][bj][m][n] = __builtin_amdgcn_mfma_f32_16x16x32_bf16(Bt[n][k], At[m][k], acc[ai][bj][m][n], 0, 0, 0); __builtin_amdgcn_s_setprio(0); } while (0)
#define PG8_WAIT_V(n) asm volatile("s_waitcnt vmcnt(" #n ")" ::: "memory")
#define PG8_WAIT_L(n) asm volatile("s_waitcnt lgkmcnt(" #n ")" ::: "memory")
#define PG8_BAR __builtin_amdgcn_s_barrier()
#define PG8_SCHED __builtin_amdgcn_sched_barrier(0)
    Unit cur, nxt; int ui = 0;
    if (!S.next(0, cur)) return;
    f32x4 acc[2][2][4][2];
#pragma unroll
    for (int a = 0; a < 2; ++a)
#pragma unroll
        for (int b = 0; b < 2; ++b)
#pragma unroll
            for (int m = 0; m < 4; ++m)
#pragma unroll
                for (int n = 0; n < 2; ++n) acc[a][b][m][n] = (f32x4){0.f, 0.f, 0.f, 0.f};
    bf16x8 At[4][2], B0[2][2], B1[2][2];
    const char* cA = (const char*)g.A + (size_t)cur.pm * tstep; const char* cB = (const char*)g.Bt + (size_t)cur.pn * tstep;
    S.a_ready(cur);
    PG8_STAGE(PG8_SB(0, 0), cB, voffB); PG8_STAGE(PG8_SA(0, 0), cA, voffA); PG8_STAGE(PG8_SB(0, 1), cB + hstep, voffB); PG8_STAGE(PG8_SA(0, 1), cA + hstep, voffA);
    if (wr == 1) PG8_BAR;
    PG8_WAIT_V(4); PG8_BAR;
    PG8_STAGE(PG8_SB(1, 0), cB + kstep, voffB); PG8_STAGE(PG8_SA(1, 0), cA + kstep, voffA); PG8_STAGE(PG8_SB(1, 1), cB + hstep + kstep, voffB);
    PG8_WAIT_V(6); PG8_BAR;
    PG8_STAMP();
    for (;;) {
        const bool has_next = S.next(ui + 1, nxt);
        const char* nA = has_next ? (const char*)g.A + (size_t)nxt.pm * tstep : cA; const char* nB = has_next ? (const char*)g.Bt + (size_t)nxt.pn * tstep : cB;
        for (int t = 0; t < nt; t += 2) {
            const bool last = (t == nt - 2);
            const char* a1 = cA + (size_t)(t + 1) * kstep;
            const char* a2 = last ? nA : cA + (size_t)(t + 2) * kstep; const char* b2 = last ? nB : cB + (size_t)(t + 2) * kstep;
            const char* a3 = a2 + kstep; const char* b3 = b2 + kstep;
            if (last && has_next) S.a_ready(nxt);
            PG8_LDB(B0, 0, 0); PG8_SCHED; PG8_LDA(At, 0, 0); PG8_STAGE(PG8_SA(1, 1), a1 + hstep, voffA);
            PG8_WAIT_L(8); PG8_BAR; PG8_WAIT_L(0); PG8_MMA(0, 0, At, B0); PG8_BAR; PG8_SCHED;
            PG8_LDB(B1, 0, 1); PG8_STAGE(PG8_SB(0, 0), b2, voffB);
            PG8_BAR; PG8_WAIT_L(0); PG8_MMA(0, 1, At, B1); PG8_BAR;
            PG8_LDA(At, 0, 1); PG8_STAGE(PG8_SA(0, 0), a2, voffA);
            PG8_BAR; PG8_WAIT_L(0); PG8_MMA(1, 0, At, B0); PG8_BAR; PG8_SCHED;
            PG8_STAGE(PG8_SB(0, 1), b2 + hstep, voffB);
            PG8_WAIT_V(6); PG8_BAR; PG8_MMA(1, 1, At, B1); PG8_BAR;
            PG8_LDB(B0, 1, 0); PG8_SCHED; PG8_LDA(At, 1, 0); PG8_STAGE(PG8_SA(0, 1), a2 + hstep, voffA);
            PG8_WAIT_L(8); PG8_BAR; PG8_WAIT_L(0); PG8_MMA(0, 0, At, B0); PG8_BAR; PG8_SCHED;
            PG8_LDB(B1, 1, 1); PG8_STAGE(PG8_SB(1, 0), b3, voffB);
            PG8_BAR; PG8_WAIT_L(0); PG8_MMA(0, 1, At, B1); PG8_BAR;
            PG8_LDA(At, 1, 1); PG8_STAGE(PG8_SA(1, 0), a3, voffA);
            PG8_BAR; PG8_WAIT_L(0); PG8_MMA(1, 0, At, B0); PG8_BAR; PG8_SCHED;
            PG8_STAGE(PG8_SB(1, 1), b3 + hstep, voffB);
            PG8_WAIT_V(6); PG8_BAR; PG8_MMA(1, 1, At, B1); PG8_BAR;
        }
        PG8_STAMP();
        if constexpr (!Epi::AFTER_DRAIN) { E(acc, cur, wr, wc, fr, fq); S.done(cur); }
        PG8_STAMP();
        if (!has_next) break;
#pragma unroll
        for (int a = 0; a < 2; ++a)
#pragma unroll
            for (int b = 0; b < 2; ++b)
#pragma unroll
                for (int m = 0; m < 4; ++m)
#pragma unroll
                    for (int n = 0; n < 2; ++n) acc[a][b][m][n] = (f32x4){0.f, 0.f, 0.f, 0.f};
        cur = nxt; cA = nA; cB = nB; ++ui;
    }
    PG8_WAIT_V(0);
    if (wr == 0) PG8_BAR;
    PG8_BAR;
    if constexpr (Epi::AFTER_DRAIN) { E.fused(acc, cur, wr, wc, fr, fq, lds, wid, lane); S.done(cur); }
    PG8_STAMP();
    if (STAMP && wid == 0) { stamps[lane] = lane < nts ? (((unsigned long long)(unsigned)ts_hi << 32) | (unsigned)ts_lo) : 0ull;
        if (lane == 62) stamps[62] = rt_entry; if (lane == 63) stamps[63] = (unsigned long long)wall_clock64(); }
#undef PG8_STAMP
#undef PG8_SA
#undef PG8_SB
#undef PG8_STAGE
#undef PG8_LDA
#undef PG8_LDB
#undef PG8_MMA
#undef PG8_WAIT_V
#undef PG8_WAIT_L
#undef PG8_BAR
#undef PG8_SCHED
}
}
using namespace pg8;
#define LAS PG8_LAS
typedef unsigned short u16;
typedef unsigned u32x2 __attribute__((ext_vector_type(2)));
typedef float f32x2 __attribute__((ext_vector_type(2)));

constexpr int NBATCH = 8, SEQ = 2048, DM = 2048, MTOK = NBATCH * SEQ, DIN = 7824, NP = 7936;
constexpr int C_R = 0, C_K = 1024, C_V = 2048, C_WD = 3072, C_QB = 3200, C_KB = 3712, C_VB = 4224, C_GB = 4736,
              C_QC = 5248, C_KC = 5504, C_VC = 5760, C_GC = 6272, C_LOW = 6784, C_GA = 6912;
__host__ __device__ constexpr int win_src_col(int n) { return n < 3200 ? n : (n < 6912 ? n + 1024 : n - 3712); }
constexpr int LDS_BYTES = 148480;

struct Params {
    const float *x, *norm_w, *w_in, *w_out, *mu, *w0, *w2, *a0, *a2, *k_k, *k_a, *r_k, *ln_w, *ln_b, *a_up, *a_b, *gnw, *fnw;
    float* out;
    u16 *WtIn, *WtOut, *W2t, *A2t, *H, *P, *MIX, *yraw;
    float *ybonus, *kmean;
    unsigned* bar;
    unsigned* sync;
    int phase_lo, phase_hi;
};

__device__ __forceinline__ int tid_() { int t = threadIdx.x; asm volatile("" : "+v"(t)); return t; }
__device__ __forceinline__ float bf2f(u16 v) { return __uint_as_float(((unsigned)v) << 16); }
__device__ __forceinline__ float bflo(unsigned w) { return __uint_as_float(w << 16); }
__device__ __forceinline__ float bfhi(unsigned w) { return __uint_as_float(w & 0xffff0000u); }
__device__ __forceinline__ u16 f2bf(float f) { return (u16)(cvt_pk_bf16(f, 0.f) & 0xffffu); }
template <int CTRL> __device__ __forceinline__ float dpp_f(float v) { return __int_as_float(__builtin_amdgcn_update_dpp(0, __float_as_int(v), CTRL, 0xF, 0xF, true)); }
__device__ __forceinline__ float red16_sum(float v) { v += dpp_f<0xB1>(v); v += dpp_f<0x4E>(v); v += dpp_f<0x141>(v); v += dpp_f<0x140>(v); return v; }
__device__ __forceinline__ float red8_sum(float v) { v += dpp_f<0xB1>(v); v += dpp_f<0x4E>(v); v += dpp_f<0x141>(v); return v; }
__device__ __forceinline__ float red16_max(float v) { v = fmaxf(v, dpp_f<0xB1>(v)); v = fmaxf(v, dpp_f<0x4E>(v)); v = fmaxf(v, dpp_f<0x141>(v)); v = fmaxf(v, dpp_f<0x140>(v)); return v; }
__device__ __forceinline__ float wave_sum(float v) {
#pragma unroll
    for (int o = 1; o < 64; o <<= 1) v += __shfl_xor(v, o);
    return v;
}
__device__ __forceinline__ float sigmoidf_(float x) { return 1.f / (1.f + __expf(-x)); }
__device__ __forceinline__ float siluf_(float x) { return x / (1.f + __expf(-x)); }
__device__ __forceinline__ float logsigmoidf_(float z) { return fminf(z, 0.f) - log1pf(__expf(-fabsf(z))); }
__device__ __forceinline__ f32x4 mfma16(bf16x8 a, bf16x8 b, f32x4 c) { return __builtin_amdgcn_mfma_f32_16x16x32_bf16(a, b, c, 0, 0, 0); }

struct EpiP {
    static constexpr bool PERM = true, AFTER_DRAIN = false;
    bf16_t* O; int ldc;
    __device__ __forceinline__ void operator()(const f32x4 (&acc)[2][2][4][2], const Unit& u, int wr, int wc, int fr, int fq) const {
        const int row0 = u.pm * BM + wr * 64 + fr, col0 = u.pn * BM + wc * 32 + 8 * fq;
#pragma unroll
        for (int ai = 0; ai < 2; ++ai)
#pragma unroll
            for (int m = 0; m < 4; ++m) { bf16_t* rowp = O + (size_t)(row0 + ai * HALF + m * 16) * ldc + col0;
#pragma unroll
                for (int bj = 0; bj < 2; ++bj) { const f32x4 v0 = acc[ai][bj][m][0], v1 = acc[ai][bj][m][1];
                    u32x4 w; w.x = cvt_pk_bf16(v0[0], v0[1]); w.y = cvt_pk_bf16(v0[2], v0[3]); w.z = cvt_pk_bf16(v1[0], v1[1]); w.w = cvt_pk_bf16(v1[2], v1[3]);
                    *(u32x4*)(rowp + bj * HALF) = w; } }
    }
};
struct EpiRes {
    static constexpr bool PERM = false, AFTER_DRAIN = false;
    const float* R; float* C; int ldc;
    __device__ __forceinline__ void operator()(const f32x4 (&acc)[2][2][4][2], const Unit& u, int wr, int wc, int fr, int fq) const {
        const int row0 = u.pm * BM + wr * 64 + fr, col0 = u.pn * BM + wc * 32 + 4 * fq;
#pragma unroll
        for (int ai = 0; ai < 2; ++ai)
#pragma unroll
            for (int m = 0; m < 4; ++m) { const size_t off = (size_t)(row0 + ai * HALF + m * 16) * ldc + col0;
#pragma unroll
                for (int bj = 0; bj < 2; ++bj)
#pragma unroll
                    for (int n = 0; n < 2; ++n) { const f32x4 r = *(const f32x4*)(R + off + bj * HALF + n * 16); *(f32x4*)(C + off + bj * HALF + n * 16) = acc[ai][bj][m][n] + r; }
                asm volatile("" ::: "memory"); }
    }
};

struct GaOrder {
    int base;
    __device__ bool next(int i, Unit& u) const { if (i >= 2) return false; const int unit = base * 2 + i; u.pm = unit >> 2; u.pn = 27 + (unit & 3); return true; }
    __device__ __forceinline__ void a_ready(const Unit&) const {}
    __device__ __forceinline__ void done(const Unit&) const {}
};

template <bool REMAP = false>
__device__ void transpose_cvt_range(LAS unsigned char* lds, const float* src, u16* dst, int K, int N, int Npad, int t_begin, int t_end, int t_step) {
    LAS float* tile = (LAS float*)lds;
    const int tilesN = Npad / 64, tid = tid_();
    for (int t = t_begin; t < t_end; t += 4 * t_step) {
        float4 v[4][2];
#pragma unroll
        for (int q = 0; q < 4; ++q) { const int tq = t + q * t_step; const int tn = tq % tilesN, tk = tq / tilesN, n0 = tn * 64, k0 = tk * 64;
#pragma unroll
            for (int i = 0; i < 2; ++i) { const int idx = tid + i * 512, kk = idx >> 4, n4 = (idx & 15) * 4;
                v[q][i] = make_float4(0.f, 0.f, 0.f, 0.f);
                const int sn = (REMAP ? win_src_col(n0) : n0) + n4;
                if (tq < t_end && sn < N) v[q][i] = *(const float4*)(src + (size_t)(k0 + kk) * N + sn); } }
#pragma unroll
        for (int q = 0; q < 4; ++q)
#pragma unroll
            for (int i = 0; i < 2; ++i) { const int idx = tid + i * 512, kk = idx >> 4, n4 = (idx & 15) * 4; LAS float* tl = tile + q * (64 * 65);
                tl[(n4 + 0) * 65 + kk] = v[q][i].x; tl[(n4 + 1) * 65 + kk] = v[q][i].y; tl[(n4 + 2) * 65 + kk] = v[q][i].z; tl[(n4 + 3) * 65 + kk] = v[q][i].w; }
        __syncthreads();
#pragma unroll
        for (int q = 0; q < 4; ++q) { const int tq = t + q * t_step; const int tn = tq % tilesN, tk = tq / tilesN, n0 = tn * 64, k0 = tk * 64;
            const int n = tid >> 3, k8 = (tid & 7) * 8; const LAS float* r = tile + q * (64 * 65) + n * 65 + k8;
            u32x4 o; o.x = cvt_pk_bf16(r[0], r[1]); o.y = cvt_pk_bf16(r[2], r[3]); o.z = cvt_pk_bf16(r[4], r[5]); o.w = cvt_pk_bf16(r[6], r[7]);
            if (tq < t_end) *(u32x4*)(dst + (size_t)(n0 + n) * K + k0 + k8) = o; }
        __syncthreads();
    }
}
template <bool REMAP = false>
__device__ __forceinline__ void transpose_cvt(LAS unsigned char* lds, const float* src, u16* dst, int K, int N, int Npad, int bid, int nb) {
    transpose_cvt_range<REMAP>(lds, src, dst, K, N, Npad, bid, (Npad / 64) * (K / 64), nb);
}

__device__ void rmsnorm_phase(const float* x, const float* w, u16* hb, float* of, int bid, int nb) {
    const int tid0 = tid_(), wid = tid0 >> 6, lane = tid0 & 63;
    for (int row = bid * 8 + wid; row < MTOK; row += nb * 8) {
        const float4* xr = (const float4*)(x + (size_t)row * DM);
        float4 v[8]; float s = 0.f;
#pragma unroll
        for (int i = 0; i < 8; ++i) { v[i] = xr[i * 64 + lane]; s += v[i].x * v[i].x + v[i].y * v[i].y + v[i].z * v[i].z + v[i].w * v[i].w; }
        s = wave_sum(s);
        const float rs = rsqrtf(s * (1.f / DM) + 1e-6f);
#pragma unroll
        for (int i = 0; i < 8; ++i) { const float4 wv = ((const float4*)w)[i * 64 + lane];
            const float a = v[i].x * rs * wv.x, b = v[i].y * rs * wv.y, c = v[i].z * rs * wv.z, d = v[i].w * rs * wv.w;
            if (hb) { uint2 o; o.x = cvt_pk_bf16(a, b); o.y = cvt_pk_bf16(c, d); *(uint2*)(hb + (size_t)row * DM + (i * 64 + lane) * 4) = o; }
            else { ((float4*)(of + (size_t)row * DM))[i * 64 + lane] = make_float4(a, b, c, d); } }
    }
}

__device__ void kmean_phase(const Params& p, LAS unsigned char* lds, int t_begin, int t_end, int t_step) {
    LAS float* part = (LAS float*)lds;
    const int tid = tid_();
    for (int task = t_begin; task < t_end; task += t_step) {
        const int b = task >> 5, h = (task >> 3) & 3, blk = task & 7;
        const int d8 = (tid & 15) * 8, kg = tid >> 4;
        float s[8];
#pragma unroll
        for (int e = 0; e < 8; ++e) s[e] = 0.f;
        for (int kk = 0; kk < 8; ++kk) {
            const int tok = b * SEQ + blk * 256 + kg * 8 + kk;
            const uint4 v = *(const uint4*)(p.P + (size_t)tok * NP + C_KB + h * 128 + d8);
            s[0] += bflo(v.x); s[1] += bfhi(v.x); s[2] += bflo(v.y); s[3] += bfhi(v.y); s[4] += bflo(v.z); s[5] += bfhi(v.z); s[6] += bflo(v.w); s[7] += bfhi(v.w);
        }
        __syncthreads();
#pragma unroll
        for (int e = 0; e < 8; ++e) part[kg * 128 + d8 + e] = s[e];
        __syncthreads();
        if (tid < 128) { float a = 0.f; for (int g = 0; g < 32; ++g) a += part[g * 128 + tid]; p.kmean[(size_t)task * 128 + tid] = a * (1.f / 256.f); }
    }
    __syncthreads();
}

constexpr int RW_T = 32;
constexpr int RW_XB = 49152;
constexpr int RW_RAW = 98304, RW_A1 = 119808, RW_A2 = 124416, RW_KS = 129024, RW_AS = 137216, RW_MU = 145408, RW_PAR = 146688, RW_FLG = 147968;
__device__ __forceinline__ void rw_issue(const Params& p, int pt, int b, int h, int t0, u32x4 (&rg)[6]) {
#pragma unroll
    for (int i = 0; i < 6; ++i) { const int piece = pt + 256 * i; rg[i] = (u32x4){0u, 0u, 0u, 0u};
        if (piece < 33 * 40) { const int row = piece / 40, pc = piece % 40; const int t = t0 - 1 + row;
            const int col = pc < 8 ? C_R + h * 64 + pc * 8 : pc < 16 ? C_K + h * 64 + (pc - 8) * 8 : pc < 24 ? C_V + h * 64 + (pc - 16) * 8 : C_WD + (pc - 24) * 8;
            if (t >= 0) rg[i] = *(const u32x4*)(p.P + (size_t)(b * SEQ + t) * NP + col); } }
}
__device__ __forceinline__ void prep_bar(volatile LAS unsigned* flg, int pw, int lane, unsigned& ep) {
    ++ep;
    asm volatile("s_waitcnt lgkmcnt(0)" ::: "memory");
    if (lane == 0) flg[pw] = ep;
    for (;;) { const u32x4 f = *(volatile LAS u32x4*)flg; if (f.x >= ep && f.y >= ep && f.z >= ep && f.w >= ep) break; __builtin_amdgcn_s_sleep(2); }
    asm volatile("s_waitcnt lgkmcnt(0)" ::: "memory");
}
__device__ __forceinline__ float red4_sum(float v) { v += dpp_f<0xB1>(v); v += dpp_f<0x4E>(v); return v; }
__device__ __forceinline__ float rs8_sum(const float (&y)[8], bool b2, bool b1, bool b0) {
    float n[4], n2[2];
#pragma unroll
    for (int j = 0; j < 4; ++j) { const float k = b2 ? y[4 + j] : y[j], sd = b2 ? y[j] : y[4 + j]; n[j] = k + dpp_f<0x141>(sd); }
#pragma unroll
    for (int j = 0; j < 2; ++j) { const float k = b1 ? n[2 + j] : n[j], sd = b1 ? n[j] : n[2 + j]; n2[j] = k + dpp_f<0x1B>(sd); }
    const float k = b0 ? n2[1] : n2[0], sd = b0 ? n2[0] : n2[1];
    return k + dpp_f<0xB1>(sd);
}
__device__ void rwkv_scan_task(const Params& p, int l, LAS unsigned char* lds, int task) {
    const int tid = tid_(), wid = tid >> 6, lane = tid & 63;
    LAS u16* raw = (LAS u16*)(lds + RW_RAW); LAS u16* A1 = (LAS u16*)(lds + RW_A1); LAS u16* A2 = (LAS u16*)(lds + RW_A2);
    LAS float* kS = (LAS float*)(lds + RW_KS); LAS float* aS = (LAS float*)(lds + RW_AS);
    LAS float* muS = (LAS float*)(lds + RW_MU); LAS float* parS = (LAS float*)(lds + RW_PAR);
    volatile LAS unsigned* flg = (volatile LAS unsigned*)(lds + RW_FLG);
    {
        const int b = task >> 4, h = task & 15;
        __syncthreads();
        if (tid >= 256 && tid < 260) flg[tid - 256] = 0u;
        __syncthreads();
        if (wid < 4) {
            const int rp = wid * 8 + (lane >> 3), ssub = lane & 7; const bool sb2 = (ssub & 4) != 0, sb1 = (ssub & 2) != 0, sb0 = (ssub & 1) != 0;
            f32x2 SA[4], SB[4];
#pragma unroll
            for (int q = 0; q < 4; ++q) { SA[q] = (f32x2){0.f, 0.f}; SB[q] = (f32x2){0.f, 0.f}; }
            u16* yout = p.yraw + (size_t)(b * SEQ + ssub) * 1024 + h * 64 + 2 * rp;
            for (int c = 0; c < SEQ / RW_T; ++c) {
                __syncthreads();
                const LAS float* ob = (const LAS float*)(lds + (c & 1) * RW_XB) + ssub * 8;
                const LAS float* ov = (const LAS float*)(lds + (c & 1) * RW_XB + 40960) + 2 * rp;
                f32x4 nw0 = *(const LAS f32x4*)(ob), nw1 = *(const LAS f32x4*)(ob + 4), na0 = *(const LAS f32x4*)(ob + 2048), na1 = *(const LAS f32x4*)(ob + 2052);
                f32x4 nb0 = *(const LAS f32x4*)(ob + 4096), nb1 = *(const LAS f32x4*)(ob + 4100), nk0 = *(const LAS f32x4*)(ob + 6144), nk1 = *(const LAS f32x4*)(ob + 6148);
                f32x4 nr0 = *(const LAS f32x4*)(ob + 8192), nr1 = *(const LAS f32x4*)(ob + 8196);
                f32x2 nv = *(const LAS f32x2*)(ov);
                float ypA[8], ypB[8];
#pragma unroll
                for (int t = 0; t < RW_T; ++t) {
                    const f32x4 w0 = nw0, w1 = nw1, a0 = na0, a1 = na1, b0 = nb0, b1 = nb1, k0 = nk0, k1 = nk1, r0 = nr0, r1 = nr1; const f32x2 vv = nv;
                    if (t + 1 < RW_T) { const LAS float* o2 = ob + (t + 1) * 64;
                        nw0 = *(const LAS f32x4*)(o2); nw1 = *(const LAS f32x4*)(o2 + 4); na0 = *(const LAS f32x4*)(o2 + 2048); na1 = *(const LAS f32x4*)(o2 + 2052);
                        nb0 = *(const LAS f32x4*)(o2 + 4096); nb1 = *(const LAS f32x4*)(o2 + 4100); nk0 = *(const LAS f32x4*)(o2 + 6144); nk1 = *(const LAS f32x4*)(o2 + 6148);
                        nr0 = *(const LAS f32x4*)(o2 + 8192); nr1 = *(const LAS f32x4*)(o2 + 8196);
                        nv = *(const LAS f32x2*)(ov + (t + 1) * 64); }
                    const f32x2 sA2 = (SA[0] * a0.lo + SA[1] * a0.hi) + (SA[2] * a1.lo + SA[3] * a1.hi);
                    const f32x2 sB2 = (SB[0] * a0.lo + SB[1] * a0.hi) + (SB[2] * a1.lo + SB[3] * a1.hi);
                    const float saA = red8_sum(sA2.x + sA2.y), saB = red8_sum(sB2.x + sB2.y);
                    const f32x2 svA = {saA, saA}, svB = {saB, saB}, vA = {vv.x, vv.x}, vB = {vv.y, vv.y};
                    SA[0] = SA[0] * w0.lo + svA * b0.lo + vA * k0.lo; SA[1] = SA[1] * w0.hi + svA * b0.hi + vA * k0.hi;
                    SA[2] = SA[2] * w1.lo + svA * b1.lo + vA * k1.lo; SA[3] = SA[3] * w1.hi + svA * b1.hi + vA * k1.hi;
                    SB[0] = SB[0] * w0.lo + svB * b0.lo + vB * k0.lo; SB[1] = SB[1] * w0.hi + svB * b0.hi + vB * k0.hi;
                    SB[2] = SB[2] * w1.lo + svB * b1.lo + vB * k1.lo; SB[3] = SB[3] * w1.hi + svB * b1.hi + vB * k1.hi;
                    const f32x2 yA2 = (SA[0] * r0.lo + SA[1] * r0.hi) + (SA[2] * r1.lo + SA[3] * r1.hi);
                    const f32x2 yB2 = (SB[0] * r0.lo + SB[1] * r0.hi) + (SB[2] * r1.lo + SB[3] * r1.hi);
                    ypA[t & 7] = yA2.x + yA2.y; ypB[t & 7] = yB2.x + yB2.y;
                    if ((t & 7) == 7) *(unsigned*)(yout + (size_t)(c * RW_T + (t & ~7)) * 1024) = cvt_pk_bf16(rs8_sum(ypA, sb2, sb1, sb0), rs8_sum(ypB, sb2, sb1, sb0));
                }
            }
        } else {
            const int pt = tid - 256, pw = wid - 4;
            unsigned ep = 0u;
            for (int c2 = pt; c2 < 320; c2 += 256) { const int mi = c2 < 64 ? h * 64 + c2 : c2 < 128 ? 1024 + h * 64 + (c2 - 64) : c2 < 192 ? 2048 + h * 64 + (c2 - 128) : 3072 + (c2 - 192);
                muS[c2] = p.mu[(size_t)l * 3200 + mi]; }
            if (pt < 64) { const size_t o = (size_t)l * 1024 + h * 64 + pt;
                parS[pt] = p.w0[o]; parS[64 + pt] = p.a0[o]; parS[128 + pt] = p.k_k[o]; parS[192 + pt] = p.k_a[o]; parS[256 + pt] = p.r_k[o]; }
            const int mat = pw >> 1, ct0 = (pw & 1) * 2;
            bf16x8 bfr[2][2];
#pragma unroll
            for (int ci = 0; ci < 2; ++ci) { const u16* Bt = (mat ? p.A2t : p.W2t) + (size_t)l * 1024 * 64 + (size_t)(h * 64 + (ct0 + ci) * 16 + (lane & 15)) * 64 + (lane >> 4) * 8;
                bfr[ci][0] = *(const bf16x8*)(Bt); bfr[ci][1] = *(const bf16x8*)(Bt + 32); }
            u32x4 rg[6];
            int goff[6], loff[6];
#pragma unroll
            for (int i = 0; i < 6; ++i) { const int piece = pt + 256 * i, row = piece / 40, pc = piece % 40;
                const int col = pc < 8 ? C_R + h * 64 + pc * 8 : pc < 16 ? C_K + h * 64 + (pc - 8) * 8 : pc < 24 ? C_V + h * 64 + (pc - 16) * 8 : C_WD + (pc - 24) * 8;
                goff[i] = piece < 33 * 40 ? row * NP + col : -1; loff[i] = row * 320 + pc * 8; }
            const u16* pbase = p.P + (size_t)b * SEQ * NP;
#define RW_ISSUE(t0_) do { _Pragma("unroll") for (int i = 0; i < 6; ++i) { rg[i] = (u32x4){0u, 0u, 0u, 0u}; \
                if (goff[i] >= 0 && ((t0_) > 0 || goff[i] >= NP)) rg[i] = *(const u32x4*)(pbase + (ptrdiff_t)((t0_) - 1) * NP + goff[i]); } } while (0)
            RW_ISSUE(0);
            for (int c = 0; c < SEQ / RW_T; ++c) {
                const int t0 = c * RW_T;
                LAS float* opW = (LAS float*)(lds + (c & 1) * RW_XB); LAS float* opA = opW + 2048; LAS float* opB = opW + 4096; LAS float* opK = opW + 6144; LAS float* opR = opW + 8192; LAS float* opV = opW + 10240;
#pragma unroll
                for (int i = 0; i < 6; ++i) { if (goff[i] >= 0) *(LAS u32x4*)(raw + loff[i]) = rg[i]; }
                prep_bar(flg, pw, lane, ep);
                if (c + 1 < SEQ / RW_T) RW_ISSUE(t0 + RW_T);
#pragma unroll
                for (int reg = 0; reg < 5; ++reg)
#pragma unroll
                    for (int i = 0; i < 2; ++i) { const int e = pt + 256 * i, t = e >> 4, qd = e & 15, cc = reg * 64 + 4 * qd;
                        const u32x2 cu = *(const LAS u32x2*)(raw + (t + 1) * 320 + cc), pu = *(const LAS u32x2*)(raw + t * 320 + cc);
                        const f32x4 mu4 = *(const LAS f32x4*)(muS + cc);
                        const f32x4 cur = {bflo(cu.x), bfhi(cu.x), bflo(cu.y), bfhi(cu.y)}, prv = {bflo(pu.x), bfhi(pu.x), bflo(pu.y), bfhi(pu.y)};
                        const f32x4 xs = cur + mu4 * (prv - cur);
                        if (reg == 0) *(LAS f32x4*)(opR + t * 64 + 4 * qd) = xs;
                        else if (reg == 1) *(LAS f32x4*)(kS + t * 64 + 4 * qd) = xs;
                        else if (reg == 2) *(LAS f32x4*)(opV + t * 64 + 4 * qd) = xs;
                        else if (reg == 3) { float th[4];
#pragma unroll
                            for (int q = 0; q < 4; ++q) th[q] = 1.f - 2.f * __builtin_amdgcn_rcpf(__expf(2.f * xs[q]) + 1.f);
                            u32x2 o; o.x = cvt_pk_bf16(th[0], th[1]); o.y = cvt_pk_bf16(th[2], th[3]); *(LAS u32x2*)(A1 + t * 72 + 4 * qd) = o; }
                        else { u32x2 o; o.x = cvt_pk_bf16(xs.x, xs.y); o.y = cvt_pk_bf16(xs.z, xs.w); *(LAS u32x2*)(A2 + t * 72 + 4 * qd) = o; } }
                prep_bar(flg, pw, lane, ep);
                { LAS u16* Ab = mat ? A2 : A1;
#pragma unroll
                    for (int ci = 0; ci < 2; ++ci)
#pragma unroll
                        for (int rt = 0; rt < 2; ++rt) { f32x4 acc = {0.f, 0.f, 0.f, 0.f};
#pragma unroll
                            for (int ks = 0; ks < 2; ++ks) { const bf16x8 af = *(const LAS bf16x8*)(Ab + (rt * 16 + (lane & 15)) * 72 + ks * 32 + (lane >> 4) * 8); acc = mfma16(af, bfr[ci][ks], acc); }
                            const int cc = (ct0 + ci) * 16 + (lane & 15);
#pragma unroll
                            for (int i = 0; i < 4; ++i) { const int t = rt * 16 + (lane >> 4) * 4 + i;
                                if (mat == 0) { float wv = parS[cc] + acc[i]; wv = fminf(wv, 0.f) - __logf(1.f + __expf(-fabsf(wv))) - 0.5f; opW[t * 64 + cc] = __expf(-__expf(wv)); }
                                else aS[t * 64 + cc] = __builtin_amdgcn_rcpf(1.f + __expf(-(parS[64 + cc] + acc[i]))); } } }
                prep_bar(flg, pw, lane, ep);
#pragma unroll
                for (int j = 0; j < 2; ++j) { const int item = pt + 256 * j, t = item >> 4, sub = item & 15, c4 = sub * 4;
                    const f32x4 kr = *(const LAS f32x4*)(kS + t * 64 + c4), av = *(const LAS f32x4*)(aS + t * 64 + c4), rr = *(const LAS f32x4*)(opR + t * 64 + c4);
                    const f32x4 kkp = *(const LAS f32x4*)(parS + 128 + c4), kap = *(const LAS f32x4*)(parS + 192 + c4), rkp = *(const LAS f32x4*)(parS + 256 + c4);
                    f32x4 kk = kr * kkp;
                    float ss = kk.x * kk.x + kk.y * kk.y + kk.z * kk.z + kk.w * kk.w; ss = red16_sum(ss);
                    const float inv = rsqrtf(fmaxf(ss, 1e-24f));
                    kk.x *= inv; kk.y *= inv; kk.z *= inv; kk.w *= inv;
                    const f32x4 km = kr * (1.f + (av - 1.f) * kap);
                    *(LAS f32x4*)(opA + t * 64 + c4) = -kk;
                    *(LAS f32x4*)(opB + t * 64 + c4) = kk * av;
                    *(LAS f32x4*)(opK + t * 64 + c4) = km;
                    float bo = rr.x * km.x * rkp.x + rr.y * km.y * rkp.y + rr.z * km.z * rkp.z + rr.w * km.w * rkp.w; bo = red16_sum(bo);
                    if (sub == 0) p.ybonus[(size_t)(b * SEQ + t0 + t) * 16 + h] = bo; }
                __syncthreads();
            }
        }
    }
    __syncthreads();
}

__device__ void rwkv_post_block(const Params& p, int l, int bh, int half) {
    const int tid = tid_(), b = bh >> 4, h = bh & 15, c4 = (tid & 15) * 4;
    const size_t po = (size_t)l * 1024 + h * 64 + c4;
    const f32x4 lw = *(const f32x4*)(p.ln_w + po), lb = *(const f32x4*)(p.ln_b + po), muv = *(const f32x4*)(p.mu + (size_t)l * 3200 + 2048 + h * 64 + c4);
    const int tokb = b * SEQ + half * 1024 + (tid >> 4);
#pragma unroll 1
    for (int bt = 0; bt < 8; ++bt) {
        u32x2 yb[4], vc[4], vp[4], gg[4]; float bo[4];
#pragma unroll
        for (int q = 0; q < 4; ++q) { const int tok = tokb + (bt * 4 + q) * 32;
            yb[q] = *(const u32x2*)(p.yraw + (size_t)tok * 1024 + h * 64 + c4);
            vc[q] = *(const u32x2*)(p.P + (size_t)tok * NP + C_V + h * 64 + c4);
            vp[q] = (u32x2){0u, 0u};
            if ((tok & (SEQ - 1)) != 0) vp[q] = *(const u32x2*)(p.P + (size_t)(tok - 1) * NP + C_V + h * 64 + c4);
            gg[q] = *(const u32x2*)(p.P + (size_t)tok * NP + C_GA + h * 64 + c4);
            bo[q] = p.ybonus[(size_t)tok * 16 + h]; }
#pragma unroll
        for (int q = 0; q < 4; ++q) { const int tok = tokb + (bt * 4 + q) * 32;
            const f32x4 yv = {bflo(yb[q].x), bfhi(yb[q].x), bflo(yb[q].y), bfhi(yb[q].y)};
            const float mean = red16_sum(yv.x + yv.y + yv.z + yv.w) * (1.f / 64.f);
            const f32x4 d = yv - mean;
            const float var = red16_sum(d.x * d.x + d.y * d.y + d.z * d.z + d.w * d.w) * (1.f / 64.f);
            const float rs = rsqrtf(var + 64e-5f);
            f32x4 v = {bflo(vc[q].x), bfhi(vc[q].x), bflo(vc[q].y), bfhi(vc[q].y)};
            const f32x4 pv = {bflo(vp[q].x), bfhi(vp[q].x), bflo(vp[q].y), bfhi(vp[q].y)};
            v += muv * (pv - v);
            const f32x4 r = d * rs * lw + lb + bo[q] * v;
            u32x2 o; o.x = cvt_pk_bf16(r.x * siluf_(bflo(gg[q].x)), r.y * siluf_(bfhi(gg[q].x))); o.y = cvt_pk_bf16(r.z * siluf_(bflo(gg[q].y)), r.w * siluf_(bfhi(gg[q].y)));
            *(u32x2*)(p.MIX + (size_t)tok * DM + h * 64 + c4) = o; }
    }
}
__device__ __forceinline__ void wg_publish(unsigned* word, unsigned add) {
    asm volatile("s_waitcnt vmcnt(0)" ::: "memory");
    __syncthreads();
    if (threadIdx.x == 0) { __builtin_amdgcn_fence(__ATOMIC_RELEASE, "agent"); asm volatile("s_waitcnt vmcnt(0)" ::: "memory");
        __hip_atomic_fetch_add(word, add, __ATOMIC_RELAXED, __HIP_MEMORY_SCOPE_AGENT); }
}
__device__ __forceinline__ void wg_wait_ge(unsigned* word, unsigned need) {
    if (threadIdx.x == 0) { unsigned sp = 0u;
        while (__hip_atomic_load(word, __ATOMIC_RELAXED, __HIP_MEMORY_SCOPE_AGENT) < need) { __builtin_amdgcn_s_sleep(2); if (++sp > (1u << 24)) break; }
        __builtin_amdgcn_fence(__ATOMIC_ACQUIRE, "agent"); asm volatile("s_waitcnt vmcnt(0)" ::: "memory"); }
    __syncthreads();
}

constexpr int MB_K = 0, MB_VT = 17408, MB_PW = 35840, MB_KM = 54272, MB_SEL = 57856, MB_TM = 58368;
__device__ void moba_task(const Params& p, LAS unsigned char* lds, int task) {
    const int tid = tid_(), wid = tid >> 6, lane = tid & 63, l15 = lane & 15, lq = lane >> 4;
    const int qt = 15 - (task >> 5), bh = task & 31, b = bh >> 2, h = bh & 3, qblk = qt >> 1, q0 = qt * 128;
    LAS u16* Kt = (LAS u16*)(lds + MB_K); LAS u16* VT = (LAS u16*)(lds + MB_VT); LAS u16* Pw = (LAS u16*)(lds + MB_PW) + wid * 16 * 72;
    LAS float* kmS = (LAS float*)(lds + MB_KM); LAS int* selS = (LAS int*)(lds + MB_SEL); LAS int* tmS = (LAS int*)(lds + MB_TM);
    __syncthreads();
    for (int i = tid; i < qblk * 128; i += 512) kmS[i] = p.kmean[(size_t)(bh * 8) * 128 + i];
    if (tid == 0) *tmS = 0;
    __syncthreads();
    if (tid < 128) {
        const u16* qp = p.P + (size_t)(b * SEQ + q0 + tid) * NP + C_QB + h * 128;
        float g[7];
#pragma unroll
        for (int j = 0; j < 7; ++j) g[j] = 0.f;
        for (int d8 = 0; d8 < 128; d8 += 8) {
            const uint4 v = *(const uint4*)(qp + d8);
            const float q[8] = {bflo(v.x), bfhi(v.x), bflo(v.y), bfhi(v.y), bflo(v.z), bfhi(v.z), bflo(v.w), bfhi(v.w)};
#pragma unroll
            for (int j = 0; j < 7; ++j) if (j < qblk) {
#pragma unroll
                for (int e = 0; e < 8; ++e) g[j] += q[e] * kmS[j * 128 + d8 + e]; }
        }
        int mask = 0;
#pragma unroll
        for (int r = 0; r < 3; ++r) { float best = -INFINITY; int bi = -1;
#pragma unroll
            for (int j = 0; j < 7; ++j) if (j < qblk && !((mask >> j) & 1) && g[j] > best) { best = g[j]; bi = j; }
            if (bi >= 0) mask |= 1 << bi; }
        mask |= 1 << qblk;
        selS[tid] = mask; atomicOr((int*)tmS, mask);
    }
    __syncthreads();
    const int tmask = *tmS;
    bf16x8 qf[4];
    { const u16* qp = p.P + (size_t)(b * SEQ + q0 + wid * 16 + l15) * NP + C_QB + h * 128 + lq * 8;
#pragma unroll
        for (int ks = 0; ks < 4; ++ks) qf[ks] = *(const bf16x8*)(qp + ks * 32); }
    int rm[4]; int wmask = 0;
#pragma unroll
    for (int i = 0; i < 4; ++i) rm[i] = selS[wid * 16 + lq * 4 + i];
    for (int i = 0; i < 16; ++i) wmask |= selS[wid * 16 + i];
    float m[4], ls[4]; f32x4 O[8];
#pragma unroll
    for (int i = 0; i < 4; ++i) { m[i] = -1e30f; ls[i] = 0.f; }
#pragma unroll
    for (int dt = 0; dt < 8; ++dt) O[dt] = (f32x4){0.f, 0.f, 0.f, 0.f};
    const float sc2 = 0.08838834764831845f * 1.4426950408889634f;
    const int last = (q0 + 127) >> 6;
    const int kp = lane & 31, vd8 = (wid * 2 + (lane >> 5)) * 8;
    struct Stage { u32x4 k0, k1, v0, v1; };
    auto issue = [&](Stage& R, int tt) {
        const size_t kb_ = (size_t)(b * SEQ + tt * 64);
        R.k0 = *(const u32x4*)(p.P + (kb_ + (tid >> 4)) * NP + C_KB + h * 128 + (tid & 15) * 8); R.k1 = *(const u32x4*)(p.P + (kb_ + 32 + (tid >> 4)) * NP + C_KB + h * 128 + (tid & 15) * 8);
        R.v0 = *(const u32x4*)(p.P + (kb_ + 2 * kp) * NP + C_VB + h * 128 + vd8); R.v1 = *(const u32x4*)(p.P + (kb_ + 2 * kp + 1) * NP + C_VB + h * 128 + vd8); };
    auto nextv = [&](int t) { ++t; while (t <= last && !((tmask >> (t >> 2)) & 1)) ++t; return t; };
    auto stage = [&](const Stage& R) {
        { const int ka = tid >> 4, kb2 = 32 + (tid >> 4);
          *(LAS u32x4*)(Kt + ((ka & 3) * 16 + (ka >> 2)) * 136 + (tid & 15) * 8) = R.k0; *(LAS u32x4*)(Kt + ((kb2 & 3) * 16 + (kb2 >> 2)) * 136 + (tid & 15) * 8) = R.k1; }
        LAS unsigned* vt = (LAS unsigned*)(VT + vd8 * 72 + 2 * kp);
        vt[0] = (R.v0.x & 0xffffu) | (R.v1.x << 16); vt[36] = (R.v0.x >> 16) | (R.v1.x & 0xffff0000u);
        vt[72] = (R.v0.y & 0xffffu) | (R.v1.y << 16); vt[108] = (R.v0.y >> 16) | (R.v1.y & 0xffff0000u);
        vt[144] = (R.v0.z & 0xffffu) | (R.v1.z << 16); vt[180] = (R.v0.z >> 16) | (R.v1.z & 0xffff0000u);
        vt[216] = (R.v0.w & 0xffffu) | (R.v1.w << 16); vt[252] = (R.v0.w >> 16) | (R.v1.w & 0xffff0000u); };
    auto compute = [&](int ti) {
        const int j = ti >> 2, key0 = ti * 64, qw0 = q0 + wid * 16;
        const bool own = (j == qblk);
        if (((wmask >> j) & 1) && !(own && key0 > qw0 + 15)) {
            f32x4 s[4];
#pragma unroll
            for (int nt = 0; nt < 4; ++nt) { s[nt] = (f32x4){0.f, 0.f, 0.f, 0.f};
#pragma unroll
                for (int ks = 0; ks < 4; ++ks) { const bf16x8 kf = *(const LAS bf16x8*)(Kt + (nt * 16 + l15) * 136 + ks * 32 + lq * 8); s[nt] = mfma16(qf[ks], kf, s[nt]); } }
            const bool diag = own && (key0 + 63 > qw0);
#pragma unroll
            for (int i = 0; i < 4; ++i) {
                const int qpos = qw0 + lq * 4 + i;
                const float bias = (own || ((rm[i] >> j) & 1)) ? 0.f : -3e30f;
                float sv[4];
#pragma unroll
                for (int nt = 0; nt < 4; ++nt) sv[nt] = s[nt][i] * sc2 + bias;
                if (diag) {
#pragma unroll
                    for (int nt = 0; nt < 4; ++nt) sv[nt] = (key0 + l15 * 4 + nt <= qpos) ? sv[nt] : -3e30f; }
                float mx = fmaxf(fmaxf(sv[0], sv[1]), fmaxf(sv[2], sv[3]));
                mx = red16_max(mx);
                const float mnew = fmaxf(m[i], mx), alpha = __builtin_amdgcn_exp2f(m[i] - mnew);
                const float p0 = __builtin_amdgcn_exp2f(sv[0] - mnew), p1 = __builtin_amdgcn_exp2f(sv[1] - mnew), p2 = __builtin_amdgcn_exp2f(sv[2] - mnew), p3 = __builtin_amdgcn_exp2f(sv[3] - mnew);
                u32x2 pw; pw.x = cvt_pk_bf16(p0, p1); pw.y = cvt_pk_bf16(p2, p3);
                *(LAS u32x2*)(Pw + (lq * 4 + i) * 72 + l15 * 4) = pw;
                const float rs = red16_sum((p0 + p1) + (p2 + p3));
                ls[i] = ls[i] * alpha + rs; m[i] = mnew;
#pragma unroll
                for (int dt = 0; dt < 8; ++dt) O[dt][i] *= alpha;
            }
            __builtin_amdgcn_wave_barrier();
            bf16x8 pf[2];
#pragma unroll
            for (int ks = 0; ks < 2; ++ks) pf[ks] = *(const LAS bf16x8*)(Pw + l15 * 72 + ks * 32 + lq * 8);
#pragma unroll
            for (int dt = 0; dt < 8; ++dt)
#pragma unroll
                for (int ks = 0; ks < 2; ++ks) { const bf16x8 vf = *(const LAS bf16x8*)(VT + (dt * 16 + l15) * 72 + ks * 32 + lq * 8); O[dt] = mfma16(pf[ks], vf, O[dt]); }
            __builtin_amdgcn_wave_barrier();
        } };
    Stage R0, R1;
    int ta = 0;
    while (ta <= last && !((tmask >> (ta >> 2)) & 1)) ++ta;
    int tb = nextv(ta);
    if (ta <= last) issue(R0, ta);
    if (tb <= last) issue(R1, tb);
    while (ta <= last) {
        int tc = nextv(tb);
        __syncthreads(); stage(R0); __syncthreads();
        if (tc <= last) issue(R0, tc);
        compute(ta);
        if (tb > last) break;
        int td = nextv(tc);
        __syncthreads(); stage(R1); __syncthreads();
        if (td <= last) issue(R1, td);
        compute(tb);
        ta = tc; tb = td;
    }
#pragma unroll
    for (int i = 0; i < 4; ++i) { const float inv = 1.f / ls[i]; const size_t tok = (size_t)(b * SEQ + q0 + wid * 16 + lq * 4 + i);
#pragma unroll
        for (int dt = 0; dt < 8; ++dt) { const int d = dt * 16 + l15;
            const float g = bf2f(p.P[tok * NP + C_GB + h * 128 + d]);
            p.MIX[tok * DM + 1024 + h * 128 + d] = f2bf(O[dt][i] * inv * siluf_(g)); } }
}

constexpr int GL_QE = 0, GL_KE = 9216, GL_KDT = 18432, GL_VT = 27648, GL_ATT = 46080, GL_ST = 55296, GL_LA = 73728, GL_TOT = 90112,
              GL_AUP = 92160, GL_LOW = 96256, GL_DEC = 100352, GL_ABS = 100608, GL_GNW = 100864, GL_OB = 0;
__device__ void gla_task(const Params& p, int l, LAS unsigned char* lds, int bh, int hs, int nlen) {
    const int tid = tid_(), wid = tid >> 6, lane = tid & 63, l15 = lane & 15, lq = lane >> 4;
    const int b = bh >> 2, h = bh & 3;
    LAS u16* QE = (LAS u16*)(lds + GL_QE); LAS u16* KE = (LAS u16*)(lds + GL_KE); LAS u16* KDT = (LAS u16*)(lds + GL_KDT); LAS u16* VT = (LAS u16*)(lds + GL_VT);
    LAS u16* ATT = (LAS u16*)(lds + GL_ATT); LAS u16* ST = (LAS u16*)(lds + GL_ST); LAS float* LA = (LAS float*)(lds + GL_LA); LAS float* TOT = (LAS float*)(lds + GL_TOT);
    LAS float* AUP = (LAS float*)(lds + GL_AUP); LAS float* LOW = (LAS float*)(lds + GL_LOW); LAS float* DEC = (LAS float*)(lds + GL_DEC); LAS float* OB = (LAS float*)(lds + GL_OB); LAS float* ABS = (LAS float*)(lds + GL_ABS); LAS float* GNW = (LAS float*)(lds + GL_GNW);
    __syncthreads();
    for (int i = tid; i < 1024; i += 512) AUP[i] = p.a_up[(size_t)l * 16 * 256 + (i >> 6) * 256 + h * 64 + (i & 63)];
    for (int i = tid; i < 128 * 72 / 2; i += 512) ((LAS unsigned*)ST)[i] = 0u;
    if (tid < 64) ABS[tid] = p.a_b[(size_t)l * 256 + h * 64 + tid];
    if (tid >= 64 && tid < 192) GNW[tid - 64] = p.gnw[(size_t)l * 128 + tid - 64];
    f32x4 Sacc[4];
#pragma unroll
    for (int c = 0; c < 4; ++c) Sacc[c] = (f32x4){0.f, 0.f, 0.f, 0.f};
    const int rt = wid >> 1, dv0t = (wid & 1) * 4;
    const int tp = lane & 31, dg = wid * 2 + (lane >> 5);
    for (int n = hs * 16; n < hs * 16 + nlen; ++n) {
        const size_t tokb = (size_t)(b * SEQ + n * 64);
        const u16* rowp = p.P + (tokb + (tid >> 3)) * NP;
        const u16* rp0 = p.P + (tokb + 2 * tp) * NP; const u16* rp1 = rp0 + NP;
        const unsigned c_low = *(const unsigned*)(rowp + C_LOW + (tid & 7) * 2);
        const u32x2 c_q0 = *(const u32x2*)(rp0 + C_QC + h * 64 + dg * 4), c_q1 = *(const u32x2*)(rp1 + C_QC + h * 64 + dg * 4);
        const u32x2 c_k0 = *(const u32x2*)(rp0 + C_KC + h * 64 + dg * 4), c_k1 = *(const u32x2*)(rp1 + C_KC + h * 64 + dg * 4);
        const u32x4 c_v0 = *(const u32x4*)(rp0 + C_VC + h * 128 + dg * 8), c_v1 = *(const u32x4*)(rp1 + C_VC + h * 128 + dg * 8);
        const u32x4 c_g0 = *(const u32x4*)(rowp + C_GC + h * 128 + (tid & 7) * 16), c_g1 = *(const u32x4*)(rowp + C_GC + h * 128 + (tid & 7) * 16 + 8);
        { const int e2 = tid * 2, t = e2 >> 4, r = e2 & 15; LOW[t * 16 + r] = bflo(c_low); LOW[t * 16 + r + 1] = bfhi(c_low); }
        __syncthreads();
        { const int t = tid >> 3, d0 = (tid & 7) * 8;
            f32x4 lo[4];
#pragma unroll
            for (int i = 0; i < 4; ++i) lo[i] = *(const LAS f32x4*)(LOW + t * 16 + 4 * i);
            f32x4 z0 = *(const LAS f32x4*)(ABS + d0), z1 = *(const LAS f32x4*)(ABS + d0 + 4);
#pragma unroll
            for (int r = 0; r < 16; ++r) { const f32x4 u0 = *(const LAS f32x4*)(AUP + r * 64 + d0), u1 = *(const LAS f32x4*)(AUP + r * 64 + d0 + 4);
                const float lv = lo[r >> 2][r & 3]; z0 += lv * u0; z1 += lv * u1; }
#pragma unroll
            for (int e = 0; e < 4; ++e) { z0[e] = (fminf(z0[e], 0.f) - __logf(1.f + __expf(-fabsf(z0[e])))) * (1.f / 16.f); z1[e] = (fminf(z1[e], 0.f) - __logf(1.f + __expf(-fabsf(z1[e])))) * (1.f / 16.f); }
            *(LAS f32x4*)(LA + t * 64 + d0) = z0; *(LAS f32x4*)(LA + t * 64 + d0 + 4) = z1; }
        __syncthreads();
        { float a = 0.f;
#pragma unroll
            for (int tt = 0; tt < 8; ++tt) { a += LA[(wid * 8 + tt) * 64 + lane]; LA[(wid * 8 + tt) * 64 + lane] = a; }
            TOT[wid * 64 + lane] = a; }
        __syncthreads();
        { const int t0 = 2 * tp, wt = tp >> 2, d0 = dg * 4;
            f32x4 off = {0.f, 0.f, 0.f, 0.f}, tot = {0.f, 0.f, 0.f, 0.f};
#pragma unroll
            for (int w2 = 0; w2 < 8; ++w2) { const f32x4 tv = *(const LAS f32x4*)(TOT + w2 * 64 + d0); tot += tv; off += (w2 < wt) ? tv : (f32x4){0.f, 0.f, 0.f, 0.f}; }
            const f32x4 b0 = *(const LAS f32x4*)(LA + t0 * 64 + d0) + off, b1 = *(const LAS f32x4*)(LA + (t0 + 1) * 64 + d0) + off;
            const float q0[4] = {bflo(c_q0.x), bfhi(c_q0.x), bflo(c_q0.y), bfhi(c_q0.y)}, q1[4] = {bflo(c_q1.x), bfhi(c_q1.x), bflo(c_q1.y), bfhi(c_q1.y)};
            const float k0[4] = {bflo(c_k0.x), bfhi(c_k0.x), bflo(c_k0.y), bfhi(c_k0.y)}, k1[4] = {bflo(c_k1.x), bfhi(c_k1.x), bflo(c_k1.y), bfhi(c_k1.y)};
            float qe0[4], qe1[4], ke0[4], ke1[4];
#pragma unroll
            for (int e = 0; e < 4; ++e) {
                qe0[e] = q0[e] * 0.125f * __expf(b0[e]); qe1[e] = q1[e] * 0.125f * __expf(b1[e]);
                ke0[e] = k0[e] * __expf(-b0[e]); ke1[e] = k1[e] * __expf(-b1[e]);
                *(LAS unsigned*)(KDT + (d0 + e) * 72 + t0) = cvt_pk_bf16(k0[e] * __expf(tot[e] - b0[e]), k1[e] * __expf(tot[e] - b1[e]));
                if (tp == 0) DEC[d0 + e] = __expf(tot[e]); }
            u32x2 o; o.x = cvt_pk_bf16(qe0[0], qe0[1]); o.y = cvt_pk_bf16(qe0[2], qe0[3]); *(LAS u32x2*)(QE + t0 * 72 + d0) = o;
            o.x = cvt_pk_bf16(qe1[0], qe1[1]); o.y = cvt_pk_bf16(qe1[2], qe1[3]); *(LAS u32x2*)(QE + (t0 + 1) * 72 + d0) = o;
            o.x = cvt_pk_bf16(ke0[0], ke0[1]); o.y = cvt_pk_bf16(ke0[2], ke0[3]); *(LAS u32x2*)(KE + t0 * 72 + d0) = o;
            o.x = cvt_pk_bf16(ke1[0], ke1[1]); o.y = cvt_pk_bf16(ke1[2], ke1[3]); *(LAS u32x2*)(KE + (t0 + 1) * 72 + d0) = o;
            { LAS unsigned* vt = (LAS unsigned*)(VT + dg * 8 * 72 + t0);
                vt[0] = (c_v0.x & 0xffffu) | (c_v1.x << 16); vt[36] = (c_v0.x >> 16) | (c_v1.x & 0xffff0000u);
                vt[72] = (c_v0.y & 0xffffu) | (c_v1.y << 16); vt[108] = (c_v0.y >> 16) | (c_v1.y & 0xffff0000u);
                vt[144] = (c_v0.z & 0xffffu) | (c_v1.z << 16); vt[180] = (c_v0.z >> 16) | (c_v1.z & 0xffff0000u);
                vt[216] = (c_v0.w & 0xffffu) | (c_v1.w << 16); vt[252] = (c_v0.w >> 16) | (c_v1.w & 0xffff0000u); } }
        __syncthreads();
        { bf16x8 af[2];
#pragma unroll
            for (int ks = 0; ks < 2; ++ks) af[ks] = *(const LAS bf16x8*)(QE + (rt * 16 + l15) * 72 + ks * 32 + lq * 8);
#pragma unroll
            for (int c2 = 0; c2 < 2; ++c2) { const int ctile = (wid & 1) * 2 + c2; f32x4 acc = {0.f, 0.f, 0.f, 0.f};
#pragma unroll
                for (int ks = 0; ks < 2; ++ks) { const bf16x8 bf = *(const LAS bf16x8*)(KE + (ctile * 16 + l15) * 72 + ks * 32 + lq * 8); acc = mfma16(af[ks], bf, acc); }
#pragma unroll
                for (int i = 0; i < 4; ++i) { const int t = rt * 16 + lq * 4 + i, jj = ctile * 16 + l15; ATT[t * 72 + jj] = f2bf(jj <= t ? acc[i] : 0.f); } } }
        __syncthreads();
        f32x4 oacc[4];
        { bf16x8 at[2], qf[2], kd[2];
#pragma unroll
            for (int ks = 0; ks < 2; ++ks) { at[ks] = *(const LAS bf16x8*)(ATT + (rt * 16 + l15) * 72 + ks * 32 + lq * 8); qf[ks] = *(const LAS bf16x8*)(QE + (rt * 16 + l15) * 72 + ks * 32 + lq * 8);
                kd[ks] = *(const LAS bf16x8*)(KDT + (rt * 16 + l15) * 72 + ks * 32 + lq * 8); }
            const f32x4 dec = *(const LAS f32x4*)(DEC + rt * 16 + lq * 4);
#pragma unroll
            for (int c = 0; c < 4; ++c) { const int dvt = dv0t + c; f32x4 acc = {0.f, 0.f, 0.f, 0.f};
                Sacc[c] *= dec;
#pragma unroll
                for (int ks = 0; ks < 2; ++ks) { const bf16x8 vf = *(const LAS bf16x8*)(VT + (dvt * 16 + l15) * 72 + ks * 32 + lq * 8), sf = *(const LAS bf16x8*)(ST + (dvt * 16 + l15) * 72 + ks * 32 + lq * 8);
                    acc = mfma16(at[ks], vf, acc); acc = mfma16(qf[ks], sf, acc); Sacc[c] = mfma16(kd[ks], vf, Sacc[c]); }
                oacc[c] = acc; } }
        __syncthreads();
#pragma unroll
        for (int c = 0; c < 4; ++c) { const int dv = (dv0t + c) * 16 + l15;
#pragma unroll
            for (int i = 0; i < 4; ++i) OB[(rt * 16 + lq * 4 + i) * 132 + dv] = oacc[c][i];
            u32x2 sv; sv.x = cvt_pk_bf16(Sacc[c][0], Sacc[c][1]); sv.y = cvt_pk_bf16(Sacc[c][2], Sacc[c][3]);
            *(LAS u32x2*)(ST + dv * 72 + rt * 16 + lq * 4) = sv; }
        __syncthreads();
        { const int t = tid >> 3, dvb = (tid & 7) * 16;
            f32x4 o4[4]; float ss = 0.f;
#pragma unroll
            for (int i = 0; i < 4; ++i) { o4[i] = *(const LAS f32x4*)(OB + t * 132 + dvb + 4 * i); ss += o4[i].x * o4[i].x + o4[i].y * o4[i].y + o4[i].z * o4[i].z + o4[i].w * o4[i].w; }
            ss = red8_sum(ss);
            const float rs = rsqrtf(ss * (1.f / 128.f) + 1e-6f);
            const float g[16] = {bflo(c_g0.x), bfhi(c_g0.x), bflo(c_g0.y), bfhi(c_g0.y), bflo(c_g0.z), bfhi(c_g0.z), bflo(c_g0.w), bfhi(c_g0.w),
                                 bflo(c_g1.x), bfhi(c_g1.x), bflo(c_g1.y), bfhi(c_g1.y), bflo(c_g1.z), bfhi(c_g1.z), bflo(c_g1.w), bfhi(c_g1.w)};
            float r[16];
#pragma unroll
            for (int e = 0; e < 16; ++e) r[e] = o4[e >> 2][e & 3] * rs * GNW[dvb + e] * siluf_(g[e]);
            u32x4 w0, w1; w0.x = cvt_pk_bf16(r[0], r[1]); w0.y = cvt_pk_bf16(r[2], r[3]); w0.z = cvt_pk_bf16(r[4], r[5]); w0.w = cvt_pk_bf16(r[6], r[7]);
            w1.x = cvt_pk_bf16(r[8], r[9]); w1.y = cvt_pk_bf16(r[10], r[11]); w1.z = cvt_pk_bf16(r[12], r[13]); w1.w = cvt_pk_bf16(r[14], r[15]);
            u16* op = p.MIX + (tokb + t) * DM + 1536 + h * 128 + dvb;
            *(u32x4*)op = w0; *(u32x4*)(op + 8) = w1; }
        __syncthreads();
    }
}

#define XB_TMO      128
#define XB_XCNT(j)  (256  + 64 * (j))
#define XB_XSUB(j)  (1280 + 64 * (j))
#define XB_XGEN(j)  (2304 + 64 * (j))
#define XB_TOP      3328
#define XB_TOPGEN   3392
#define XCD_BAR_WORDS 3456
#define XB_SPIN_CAP (1u << 18)

__device__ __forceinline__ unsigned xb_ld(unsigned* p)              { return __hip_atomic_load(p, __ATOMIC_RELAXED, __HIP_MEMORY_SCOPE_AGENT); }
__device__ __forceinline__ unsigned xb_add(unsigned* p, unsigned v) { return __hip_atomic_fetch_add(p, v, __ATOMIC_RELAXED, __HIP_MEMORY_SCOPE_AGENT); }
__device__ __forceinline__ unsigned xb_xcc_id() { return (unsigned)__builtin_amdgcn_s_getreg((3 << 11) | 20) & 0xFu; }
#define XB_SPIN(cond, bar) do { unsigned _sp = 0; while (cond) { __builtin_amdgcn_s_sleep(1); \
    if ((++_sp & 255u) == 0u) { if (xb_ld(&(bar)[XB_TMO])) break; if (_sp > XB_SPIN_CAP) { atomicAdd(&(bar)[XB_TMO], 1u); break; } } } } while (0)

struct XcdBarrier {
    unsigned* bar; unsigned x;
    volatile LAS unsigned* st;
};

__device__ __forceinline__ XcdBarrier xcd_barrier_post(unsigned* bar, volatile LAS unsigned* st) {
    XcdBarrier b; b.bar = bar; b.x = xb_xcc_id(); b.st = st;
    if (threadIdx.x == 0) (void)xb_add(&bar[XB_XCNT(b.x)], 1u);
    return b;
}
__device__ __forceinline__ void xcd_barrier_complete(unsigned* bar, unsigned x, unsigned& nloc, unsigned& nx) {
    const unsigned G = gridDim.x * gridDim.y * gridDim.z;
    unsigned sum, cnt, mine, sp = 0u;
    for (;;) {
        sum = 0u; cnt = 0u; mine = 0u;
#pragma unroll
        for (unsigned j = 0; j < 16; ++j) { const unsigned c = xb_ld(&bar[XB_XCNT(j)]); sum += c; cnt += (c > 0u) ? 1u : 0u; mine = (j == x) ? c : mine; }
        if (sum == G) break;
        __builtin_amdgcn_s_sleep(1);
        if ((++sp & 255u) == 0u) { if (xb_ld(&bar[XB_TMO])) break; if (sp > XB_SPIN_CAP) { atomicAdd(&bar[XB_TMO], 1u); break; } }
    }
    nloc = mine > 0u ? mine : 1u; nx = cnt > 0u ? cnt : 1u;
}

__device__ __forceinline__ void xcd_barrier(const XcdBarrier& b) {
    asm volatile("s_waitcnt vmcnt(0)" ::: "memory");
    __syncthreads();
    if (threadIdx.x == 0) {
        unsigned* bar = b.bar;
        __builtin_amdgcn_s_waitcnt(0);
        unsigned nloc = b.st[0], nx = b.st[1];
        if (nloc == 0u) { xcd_barrier_complete(bar, b.x, nloc, nx); b.st[0] = nloc; b.st[1] = nx; }
        const unsigned old = xb_add(&bar[XB_XSUB(b.x)], 1u);
        const unsigned gen = old / nloc;
        if (old + 1u == (gen + 1u) * nloc) {
            __builtin_amdgcn_fence(__ATOMIC_RELEASE, "agent");
            asm volatile("s_waitcnt vmcnt(0)" ::: "memory");
            const unsigned og = xb_add(&bar[XB_TOP], 1u);
            const unsigned tg = og / nx;
            if (og + 1u == (tg + 1u) * nx) xb_add(&bar[XB_TOPGEN], 1u);
            else XB_SPIN(xb_ld(&bar[XB_TOPGEN]) == tg, bar);
            __builtin_amdgcn_fence(__ATOMIC_ACQUIRE, "agent");
            xb_add(&bar[XB_XGEN(b.x)], 1u);
            asm volatile("s_waitcnt vmcnt(0)" ::: "memory");
        } else {
            XB_SPIN(xb_ld(&bar[XB_XGEN(b.x)]) == gen, bar);
            __builtin_amdgcn_fence(__ATOMIC_ACQUIRE, "agent");
            asm volatile("s_waitcnt vmcnt(0)" ::: "memory");
        }
    }
    __syncthreads();
}

constexpr int N_PHASES = 9;
__device__ __forceinline__ void run_phase(const Params& p, int ph, LAS unsigned char* lds, LAS unsigned* qslot, int bid, int nb) {
    if (ph == 0) {
        transpose_cvt<true>(lds, p.w_in, p.WtIn, DM, DIN, NP, bid, nb);
        for (int l = 0; l < 2; ++l) {
            transpose_cvt(lds, p.w2 + (size_t)l * 64 * 1024, p.W2t + (size_t)l * 1024 * 64, 64, 1024, 1024, bid, nb);
            transpose_cvt(lds, p.a2 + (size_t)l * 64 * 1024, p.A2t + (size_t)l * 1024 * 64, 64, 1024, 1024, bid, nb);
        }
        rmsnorm_phase(p.x, p.norm_w, p.H, nullptr, bid, nb);
        return;
    }
    const int l = (ph - 1) / 4, s = (ph - 1) % 4;
    if (s == 0) {
        Gemm g; g.A = p.H; g.Bt = p.WtIn + (size_t)l * NP * DM; g.M = MTOK; g.N = C_GA; g.K = DM;
        StaticOrder S; S.init(MTOK, C_GA, nb, bid);
        EpiP E; E.O = p.P; E.ldc = NP;
        gemm_phase<EpiP, StaticOrder, false>(lds, g, S, E, nullptr);
    } else if (s == 1) {
        unsigned* sy = p.sync + 512 * l;
        LAS int* slot = (LAS int*)qslot;
        const int nscan = nb >> 1;
        if (bid < nscan) {
            for (int task = bid; task < 128; task += nscan) { rwkv_scan_task(p, l, lds, task); wg_publish(sy + 64 + task, 1u); }
        } else {
            bool km_ready = false;
            for (;;) {
                __syncthreads();
                if (tid_() == 0) *slot = (int)atomicAdd(sy, 1u);
                __syncthreads();
                const int tk = *slot;
                if (tk >= 256 + 32 + 128 + 512 + (l == 0 ? 376 : 0)) break;
                if (tk < 256) { __syncthreads(); kmean_phase(p, lds, tk, tk + 1, 1); wg_publish(sy + 16, 1u); }
                else if (tk < 288) gla_task(p, l, lds, tk - 256, 0, 32);
                else if (tk < 416) {
                    __syncthreads();
                    Gemm g; g.A = p.H; g.Bt = p.WtIn + (size_t)l * NP * DM; g.M = MTOK; g.N = NP; g.K = DM;
                    GaOrder S; S.base = tk - 288;
                    EpiP E; E.O = p.P; E.ldc = NP;
                    gemm_phase<EpiP, GaOrder, false>(lds, g, S, E, nullptr);
                    wg_publish(sy + 48, 1u); }
                else if (tk < 928) { if (!km_ready) { wg_wait_ge(sy + 16, 256u); km_ready = true; } moba_task(p, lds, tk - 416); }
                else { const int ct = tk - 928;
                    __syncthreads();
                    if (ct < 64) transpose_cvt_range(lds, p.w_out, p.WtOut, DM, DM, DM, ct * 16, ct * 16 + 16, 1);
                    else if (ct < 312) transpose_cvt_range<true>(lds, p.w_in + (size_t)DM * DIN, p.WtIn + (size_t)NP * DM, DM, DIN, NP, (ct - 64) * 16, (ct - 64) * 16 + 16, 1);
                    else transpose_cvt_range(lds, p.w_out + (size_t)DM * DM, p.WtOut + (size_t)DM * DM, DM, DM, DM, (ct - 312) * 16, (ct - 312) * 16 + 16, 1); }
            }
        }
        for (;;) {
            __syncthreads();
            if (tid_() == 0) *slot = (int)atomicAdd(sy + 32, 1u);
            __syncthreads();
            const int tk = *slot;
            if (tk >= 256) break;
            wg_wait_ge(sy + 64 + (tk >> 1), 1u);
            wg_wait_ge(sy + 48, 128u);
            rwkv_post_block(p, l, tk >> 1, tk & 1);
        }
    } else if (s == 2) {
        Gemm g; g.A = p.MIX; g.Bt = p.WtOut + (size_t)l * DM * DM; g.M = MTOK; g.N = DM; g.K = DM;
        StaticOrder S; S.init(MTOK, DM, nb, bid);
        EpiRes E; E.R = (l == 0) ? p.x : p.out; E.C = p.out; E.ldc = DM;
        gemm_phase<EpiRes, StaticOrder, false>(lds, g, S, E, nullptr);
    } else {
        if (l == 0) rmsnorm_phase(p.out, p.norm_w + DM, p.H, nullptr, bid, nb);
        else rmsnorm_phase(p.out, p.fnw, nullptr, p.out, bid, nb);
    }
}

__global__ void __launch_bounds__(512, 2) hybrid_fwd(Params p) {
    extern __shared__ __attribute__((aligned(16))) unsigned char shm[];
    LAS unsigned char* lds = (LAS unsigned char*)shm;
    const int bid = blockIdx.x, nb = gridDim.x;
#if defined(TEST_GEMM)
    { Gemm g; g.A = p.H; g.Bt = p.WtIn; g.M = MTOK; g.N = NP; g.K = DM;
      StaticOrder S; S.init(MTOK, NP, nb, bid);
      EpiP E; E.O = p.P; E.ldc = NP;
      gemm_phase<EpiP, StaticOrder, false>(lds, g, S, E, nullptr);
#if TEST_GEMM >= 2
      if (p.phase_lo) {
      Gemm g2; g2.A = p.H; g2.Bt = p.WtOut; g2.M = MTOK; g2.N = DM; g2.K = DM;
      StaticOrder S2; S2.init(MTOK, DM, nb, bid);
      EpiRes E2; E2.R = p.x; E2.C = p.out; E2.ldc = DM;
      gemm_phase<EpiRes, StaticOrder, false>(lds, g2, S2, E2, nullptr); }
#endif
    }
#elif ONE_LAUNCH
    cg::grid_group grid = cg::this_grid();
    __shared__ uint4 xb_words;
    if (threadIdx.x == 0) xb_words = make_uint4(0u, 0u, 0u, 0u);
    __syncthreads();
    const XcdBarrier xb = xcd_barrier_post(p.bar, (volatile LAS unsigned*)&xb_words);
    for (int ph = p.phase_lo; ph < p.phase_hi; ++ph) {
        run_phase(p, ph, lds, (LAS unsigned*)&xb_words.z, bid, nb);
#ifdef REPEAT_PH
        if (ph == REPEAT_PH) { xcd_barrier(xb); run_phase(p, ph, lds, (LAS unsigned*)&xb_words.z, bid, nb); }
#endif
        if (ph + 1 < p.phase_hi) { if (p.phase_lo < 0) grid.sync(); else xcd_barrier(xb); }
    }
#else
    run_phase(p, p.phase_lo, lds, nullptr, bid, nb);
#endif
}

extern "C" void kernel_launch(void* const* d_in, const int* in_sizes, int n_in, void* d_out, int out_size, void* d_ws, size_t ws_size, hipStream_t stream) {
    static int grid = 0;
    if (grid == 0) {
        int dev = 0, cus = 0, per_cu = 0;
        hipGetDevice(&dev);
        hipDeviceGetAttribute(&cus, hipDeviceAttributeMultiprocessorCount, dev);
        hipFuncSetAttribute((const void*)hybrid_fwd, hipFuncAttributeMaxDynamicSharedMemorySize, LDS_BYTES);
        hipOccupancyMaxActiveBlocksPerMultiprocessor(&per_cu, (const void*)hybrid_fwd, 512, LDS_BYTES);
        if (per_cu < 1) { fprintf(stderr, "kernel_launch: occupancy query says %d blocks per CU\n", per_cu); per_cu = 1; }
        (void)hipGetLastError();
        grid = cus;
    }
    Params p{};
    const float* const* in = (const float* const*)d_in;
    p.x = in[0]; p.norm_w = in[1]; p.w_in = in[2]; p.w_out = in[3]; p.mu = in[4]; p.w0 = in[5]; p.w2 = in[6]; p.a0 = in[7]; p.a2 = in[8];
    p.k_k = in[9]; p.k_a = in[10]; p.r_k = in[11]; p.ln_w = in[12]; p.ln_b = in[13]; p.a_up = in[14]; p.a_b = in[15]; p.gnw = in[16]; p.fnw = in[17];
    p.out = (float*)d_out;
    unsigned char* ws = (unsigned char*)d_ws; size_t off = 0;
    auto take = [&](size_t bytes) { unsigned char* r = ws + off; off += (bytes + 255) & ~(size_t)255; return r; };
    p.WtIn = (u16*)take((size_t)2 * NP * DM * 2); p.WtOut = (u16*)take((size_t)2 * DM * DM * 2);
    p.W2t = (u16*)take((size_t)2 * 1024 * 64 * 2); p.A2t = (u16*)take((size_t)2 * 1024 * 64 * 2);
    p.H = (u16*)take((size_t)MTOK * DM * 2); p.P = (u16*)take((size_t)MTOK * NP * 2);
    p.yraw = (u16*)take((size_t)MTOK * 1024 * 2); p.MIX = (u16*)take((size_t)MTOK * DM * 2); p.ybonus = (float*)take((size_t)MTOK * 16 * 4); p.kmean = (float*)take((size_t)256 * 128 * 4);
    p.bar = (unsigned*)take((size_t)XCD_BAR_WORDS * 4);
    p.sync = (unsigned*)take((size_t)1024 * 4);
    if (off > ws_size) { fprintf(stderr, "kernel_launch: workspace too small (%zu > %zu)\n", off, ws_size); return; }
#if ONE_LAUNCH
    hipMemsetAsync(p.bar, 0, (size_t)XCD_BAR_WORDS * 4, stream);
    hipMemsetAsync(p.sync, 0, (size_t)1024 * 4, stream);
    p.phase_lo = 0; p.phase_hi = N_PHASES;
    void* args[] = {&p};
    hipError_t e = hipLaunchCooperativeKernel((const void*)hybrid_fwd, dim3(grid), dim3(512), args, LDS_BYTES, stream);
    if (e != hipSuccess) fprintf(stderr, "cooperative launch failed: %s (grid %d)\n", hipGetErrorString(e), grid);
#else
    for (int ph = 0; ph < N_PHASES; ++ph) { p.phase_lo = ph; p.phase_hi = ph + 1; hipLaunchKernelGGL(hybrid_fwd, dim3(grid), dim3(512), LDS_BYTES, stream, p); }
#endif
}
```

```cpp
#include <hip/hip_runtime.h>
#include <hip/hip_cooperative_groups.h>
#include <cstdio>
namespace cg = cooperative_groups;

#ifndef ONE_LAUNCH
#define ONE_LAUNCH 1
#endif

namespace pg8 {
#define PG8_LAS __attribute__((address_space(3)))
typedef unsigned short bf16_t;
typedef short bf16x8 __attribute__((ext_vector_type(8)));
typedef float f32x4 __attribute__((ext_vector_type(4)));
typedef unsigned u32x4 __attribute__((ext_vector_type(4)));
constexpr int BM = 256, BK = 64, HALF = 128, HTB = HALF * BK * 2  , STAGE_BYTES = 8 * HTB, NXCD = 8, WGM = 8;

__host__ __device__ __forceinline__ int lds_byte(int r, int c) { const int st = (r >> 4) * 2 + (c >> 5), rr = r & 15, cc = c & 31, ob = rr * 64 + cc * 2; return st * 1024 + (ob ^ (((ob >> 9) & 1) << 5)); }
__host__ __device__ __forceinline__ void stage_rc(int b, int& R, int& C) { const int st = b / 1024, sb = b % 1024, swz = sb ^ (((sb >> 9) & 1) << 5); R = (st >> 1) * 16 + swz / 64; C = (st & 1) * 32 + (swz % 64) / 2; }
__host__ __device__ __forceinline__ int perm32(int rho) { const int n = rho >> 4, i = rho & 15; return 8 * (i >> 2) + 4 * n + (i & 3); }

struct Unit { int pm, pn; };
struct Gemm { const bf16_t* A; const bf16_t* Bt; int M, N, K; };

struct StaticOrder {
    int nM, nN, nwg, G, c;
    __host__ __device__ void init(int M, int N, int G_, int c_) { nM = M / BM; nN = N / BM; nwg = nM * nN; G = G_; c = c_; }
    __host__ __device__ bool next(int i, Unit& u) const {
        const long L = (long)i * G + c; if (L >= nwg) return false;
        int wgid = (int)L; { const int q = nwg / NXCD, r = nwg % NXCD, xcd = wgid % NXCD, off = wgid / NXCD; wgid = (xcd < r ? xcd * (q + 1) : r * (q + 1) + (xcd - r) * q) + off; }
        const int nig = WGM * nN, gid = wgid / nig, fm = gid * WGM, gsz = (nM - fm) < WGM ? (nM - fm) : WGM;
        u.pm = fm + ((wgid % nig) % gsz); u.pn = (wgid % nig) / gsz; return true;
    }
    __device__ __forceinline__ void a_ready(const Unit&) const {}
    __device__ __forceinline__ void done(const Unit&) const {}
};
__device__ __forceinline__ unsigned cvt_pk_bf16(float lo, float hi) { unsigned r; asm volatile("v_cvt_pk_bf16_f32 %0, %1, %2" : "=v"(r) : "v"(lo), "v"(hi)); return r; }
template <class Epi, class Sched, bool STAMP = false>
__device__ __forceinline__ void gemm_phase(PG8_LAS unsigned char* lds, const Gemm g, const Sched& S, const Epi& E, unsigned long long* stamps) {
    int tid = threadIdx.x; asm volatile("" : "+v"(tid)); const int wid = __builtin_amdgcn_readfirstlane(tid >> 6), lane = tid & 63, wr = wid >> 2, wc = wid & 3, fr = lane & 15, fq = lane >> 4;
    const int K = g.K, nt = K / BK;
    int ts_lo = 0, ts_hi = 0, nts = 0; const unsigned long long rt_entry = STAMP ? (unsigned long long)wall_clock64() : 0ull;
#define PG8_STAMP() do { if (STAMP && wid == 0 && nts < 64) { const unsigned long long _c = (unsigned long long)clock64(); \
        ts_lo = (lane == nts) ? (int)(unsigned)_c : ts_lo; ts_hi = (lane == nts) ? (int)(unsigned)(_c >> 32) : ts_hi; ++nts; } } while (0)
    PG8_STAMP();
    unsigned voffA[2], voffB[2];
#pragma unroll
    for (int i = 0; i < 2; ++i) { int R, C; stage_rc(tid * 16 + i * 8192, R, C); const int Rb = Epi::PERM ? ((R & ~31) + perm32(R & 31)) : R;
        voffA[i] = (unsigned)(R * K + C) * 2u; voffB[i] = (unsigned)(Rb * K + C) * 2u; }
    const size_t kstep = (size_t)(BK * 2);
    const size_t hstep = (size_t)HALF * K * 2;
    const size_t tstep = 2 * hstep;
    const unsigned ldsw = (unsigned)wid * 1024u;
    const int aoff = lds_byte(wr * 64 + fr, fq * 8), boff = lds_byte(wc * 32 + fr, fq * 8);
#define PG8_SA(b, h) (((b) * 2 + (h)) * HTB)
#define PG8_SB(b, h) ((4 + (b) * 2 + (h)) * HTB)
#define PG8_STAGE(bufoff, gbase, voff) do { _Pragma("unroll") for (int _i = 0; _i < 2; ++_i) \
        __builtin_amdgcn_global_load_lds((const unsigned*)((const char*)(gbase) + (voff)[_i]), (PG8_LAS unsigned*)(lds + (bufoff) + ldsw + _i * 8192), 16, 0, 0); } while (0)
#define PG8_LDA(dst, b, h) do { _Pragma("unroll") for (int m = 0; m < 4; ++m) _Pragma("unroll") for (int k = 0; k < 2; ++k) dst[m][k] = *(const PG8_LAS bf16x8*)(lds + PG8_SA(b, h) + aoff + m * 2048 + k * 1024); } while (0)
#define PG8_LDB(dst, b, h) do { _Pragma("unroll") for (int n = 0; n < 2; ++n) _Pragma("unroll") for (int k = 0; k < 2; ++k) dst[n][k] = *(const PG8_LAS bf16x8*)(lds + PG8_SB(b, h) + boff + n * 2048 + k * 1024); } while (0)
#define PG8_MMA(ai, bj, At, Bt) do { __builtin_amdgcn_s_setprio(1); _Pragma("unroll") for (int m = 0; m < 4; ++m) _Pragma("unroll") for (int n = 0; n < 2; ++n) _Pragma("unroll") for (int k = 0; k < 2; ++k) \
        acc[ai][bj][m][n] = __builtin_amdgcn_mfma_f32_16x16x32_bf16(Bt[n][k], At[m][k], acc[ai][bj][m][n], 0, 0, 0); __builtin_amdgcn_s_setprio(0); } while (0)
#define PG8_WAIT_V(n) asm volatile("s_waitcnt vmcnt(" #n ")" ::: "memory")
#define PG8_WAIT_L(n) asm volatile("s_waitcnt lgkmcnt(" #n ")" ::: "memory")
#define PG8_BAR __builtin_amdgcn_s_barrier()
#define PG8_SCHED __builtin_amdgcn_sched_barrier(0)
    Unit cur, nxt; int ui = 0;
    if (!S.next(0, cur)) return;
    f32x4 acc[2][2][4][2];
#pragma unroll
    for (int a = 0; a < 2; ++a)
#pragma unroll
        for (int b = 0; b < 2; ++b)
#pragma unroll
            for (int m = 0; m < 4; ++m)
#pragma unroll
                for (int n = 0; n < 2; ++n) acc[a][b][m][n] = (f32x4){0.f, 0.f, 0.f, 0.f};
    bf16x8 At[4][2], B0[2][2], B1[2][2];
    const char* cA = (const char*)g.A + (size_t)cur.pm * tstep; const char* cB = (const char*)g.Bt + (size_t)cur.pn * tstep;
    S.a_ready(cur);
    PG8_STAGE(PG8_SB(0, 0), cB, voffB); PG8_STAGE(PG8_SA(0, 0), cA, voffA); PG8_STAGE(PG8_SB(0, 1), cB + hstep, voffB); PG8_STAGE(PG8_SA(0, 1), cA + hstep, voffA);
    if (wr == 1) PG8_BAR;
    PG8_WAIT_V(4); PG8_BAR;
    PG8_STAGE(PG8_SB(1, 0), cB + kstep, voffB); PG8_STAGE(PG8_SA(1, 0), cA + kstep, voffA); PG8_STAGE(PG8_SB(1, 1), cB + hstep + kstep, voffB);
    PG8_WAIT_V(6); PG8_BAR;
    PG8_STAMP();
    for (;;) {
        const bool has_next = S.next(ui + 1, nxt);
        const char* nA = has_next ? (const char*)g.A + (size_t)nxt.pm * tstep : cA; const char* nB = has_next ? (const char*)g.Bt + (size_t)nxt.pn * tstep : cB;
        for (int t = 0; t < nt; t += 2) {
            const bool last = (t == nt - 2);
            const char* a1 = cA + (size_t)(t + 1) * kstep;
            const char* a2 = last ? nA : cA + (size_t)(t + 2) * kstep; const char* b2 = last ? nB : cB + (size_t)(t + 2) * kstep;
            const char* a3 = a2 + kstep; const char* b3 = b2 + kstep;
            if (last && has_next) S.a_ready(nxt);
            PG8_LDB(B0, 0, 0); PG8_SCHED; PG8_LDA(At, 0, 0); PG8_STAGE(PG8_SA(1, 1), a1 + hstep, voffA);
            PG8_WAIT_L(8); PG8_BAR; PG8_WAIT_L(0); PG8_MMA(0, 0, At, B0); PG8_BAR; PG8_SCHED;
            PG8_LDB(B1, 0, 1); PG8_STAGE(PG8_SB(0, 0), b2, voffB);
            PG8_BAR; PG8_WAIT_L(0); PG8_MMA(0, 1, At, B1); PG8_BAR;
            PG8_LDA(At, 0, 1); PG8_STAGE(PG8_SA(0, 0), a2, voffA);
            PG8_BAR; PG8_WAIT_L(0); PG8_MMA(1, 0, At, B0); PG8_BAR; PG8_SCHED;
            PG8_STAGE(PG8_SB(0, 1), b2 + hstep, voffB);
            PG8_WAIT_V(6); PG8_BAR; PG8_MMA(1, 1, At, B1); PG8_BAR;
            PG8_LDB(B0, 1, 0); PG8_SCHED; PG8_LDA(At, 1, 0); PG8_STAGE(PG8_SA(0, 1), a2 + hstep, voffA);
            PG8_WAIT_L(8); PG8_BAR; PG8_WAIT_L(0); PG8_MMA(0, 0, At, B0); PG8_BAR; PG8_SCHED;
            PG8_LDB(B1, 1, 1); PG8_STAGE(PG8_SB(1, 0), b3, voffB);
            PG8_BAR; PG8_WAIT_L(0); PG8_MMA(0, 1, At, B1); PG8_BAR;
            PG8_LDA(At, 1, 1); PG8_STAGE(PG8_SA(1, 0), a3, voffA);
            PG8_BAR; PG8_WAIT_L(0); PG8_MMA(1, 0, At, B0); PG8_BAR; PG8_SCHED;
            PG8_STAGE(PG8_SB(1, 1), b3 + hstep, voffB);
            PG8_WAIT_V(6); PG8_BAR; PG8_MMA(1, 1, At, B1); PG8_BAR;
        }
        PG8_STAMP();
        if constexpr (!Epi::AFTER_DRAIN) { E(acc, cur, wr, wc, fr, fq); S.done(cur); }
        PG8_STAMP();
        if (!has_next) break;
#pragma unroll
        for (int a = 0; a < 2; ++a)
#pragma unroll
            for (int b = 0; b < 2; ++b)
#pragma unroll
                for (int m = 0; m < 4; ++m)
#pragma unroll
                    for (int n = 0; n < 2; ++n) acc[a][b][m][n] = (f32x4){0.f, 0.f, 0.f, 0.f};
        cur = nxt; cA = nA; cB = nB; ++ui;
    }
    PG8_WAIT_V(0);
    if (wr == 0) PG8_BAR;
    PG8_BAR;
    if constexpr (Epi::AFTER_DRAIN) { E.fused(acc, cur, wr, wc, fr, fq, lds, wid, lane); S.done(cur); }
    PG8_STAMP();
    if (STAMP && wid == 0) { stamps[lane] = lane < nts ? (((unsigned long long)(unsigned)ts_hi << 32) | (unsigned)ts_lo) : 0ull;
        if (lane == 62) stamps[62] = rt_entry; if (lane == 63) stamps[63] = (unsigned long long)wall_clock64(); }
#undef PG8_STAMP
#undef PG8_SA
#undef PG8_SB
#undef PG8_STAGE
#undef PG8_LDA
#undef PG8_LDB
#undef PG8_MMA
#undef PG8_WAIT_V
#undef PG8_WAIT_L
#undef PG8_BAR
#undef PG8_SCHED
}
}
using namespace pg8;
#define LAS PG8_LAS
typedef unsigned short u16;
typedef unsigned u32x2 __attribute__((ext_vector_type(2)));
typedef float f32x2 __attribute__((ext_vector_type(2)));

constexpr int NBATCH = 8, SEQ = 2048, DM = 2048, MTOK = NBATCH * SEQ, DIN = 7824, NP = 7936;
constexpr int C_R = 0, C_K = 1024, C_V = 2048, C_WD = 3072, C_QB = 3200, C_KB = 3712, C_VB = 4224, C_GB = 4736,
              C_QC = 5248, C_KC = 5504, C_VC = 5760, C_GC = 6272, C_LOW = 6784, C_GA = 6912;
__host__ __device__ constexpr int win_src_col(int n) { return n < 3200 ? n : (n < 6912 ? n + 1024 : n - 3712); }
constexpr int LDS_BYTES = 148480;

struct Params {
    const float *x, *norm_w, *w_in, *w_out, *mu, *w0, *w2, *a0, *a2, *k_k, *k_a, *r_k, *ln_w, *ln_b, *a_up, *a_b, *gnw, *fnw;
    float* out;
    u16 *WtIn, *WtOut, *W2t, *A2t, *H, *P, *MIX, *yraw;
    float *ybonus, *kmean;
    unsigned* bar;
    unsigned* sync;
    int phase_lo, phase_hi;
};

__device__ __forceinline__ int tid_() { int t = threadIdx.x; asm volatile("" : "+v"(t)); return t; }
__device__ __forceinline__ float bf2f(u16 v) { return __uint_as_float(((unsigned)v) << 16); }
__device__ __forceinline__ float bflo(unsigned w) { return __uint_as_float(w << 16); }
__device__ __forceinline__ float bfhi(unsigned w) { return __uint_as_float(w & 0xffff0000u); }
__device__ __forceinline__ u16 f2bf(float f) { return (u16)(cvt_pk_bf16(f, 0.f) & 0xffffu); }
template <int CTRL> __device__ __forceinline__ float dpp_f(float v) { return __int_as_float(__builtin_amdgcn_update_dpp(0, __float_as_int(v), CTRL, 0xF, 0xF, true)); }
__device__ __forceinline__ float red16_sum(float v) { v += dpp_f<0xB1>(v); v += dpp_f<0x4E>(v); v += dpp_f<0x141>(v); v += dpp_f<0x140>(v); return v; }
__device__ __forceinline__ float red8_sum(float v) { v += dpp_f<0xB1>(v); v += dpp_f<0x4E>(v); v += dpp_f<0x141>(v); return v; }
__device__ __forceinline__ float red16_max(float v) { v = fmaxf(v, dpp_f<0xB1>(v)); v = fmaxf(v, dpp_f<0x4E>(v)); v = fmaxf(v, dpp_f<0x141>(v)); v = fmaxf(v, dpp_f<0x140>(v)); return v; }
__device__ __forceinline__ float wave_sum(float v) {
#pragma unroll
    for (int o = 1; o < 64; o <<= 1) v += __shfl_xor(v, o);
    return v;
}
__device__ __forceinline__ float sigmoidf_(float x) { return 1.f / (1.f + __expf(-x)); }
__device__ __forceinline__ float siluf_(float x) { return x / (1.f + __expf(-x)); }
__device__ __forceinline__ float logsigmoidf_(float z) { return fminf(z, 0.f) - log1pf(__expf(-fabsf(z))); }
__device__ __forceinline__ f32x4 mfma16(bf16x8 a, bf16x8 b, f32x4 c) { return __builtin_amdgcn_mfma_f32_16x16x32_bf16(a, b, c, 0, 0, 0); }

struct EpiP {
    static constexpr bool PERM = true, AFTER_DRAIN = false;
    bf16_t* O; int ldc;
    __device__ __forceinline__ void operator()(const f32x4 (&acc)[2][2][4][2], const Unit& u, int wr, int wc, int fr, int fq) const {
        const int row0 = u.pm * BM + wr * 64 + fr, col0 = u.pn * BM + wc * 32 + 8 * fq;
#pragma unroll
        for (int ai = 0; ai < 2; ++ai)
#pragma unroll
            for (int m = 0; m < 4; ++m) { bf16_t* rowp = O + (size_t)(row0 + ai * HALF + m * 16) * ldc + col0;
#pragma unroll
                for (int bj = 0; bj < 2; ++bj) { const f32x4 v0 = acc[ai][bj][m][0], v1 = acc[ai][bj][m][1];
                    u32x4 w; w.x = cvt_pk_bf16(v0[0], v0[1]); w.y = cvt_pk_bf16(v0[2], v0[3]); w.z = cvt_pk_bf16(v1[0], v1[1]); w.w = cvt_pk_bf16(v1[2], v1[3]);
                    *(u32x4*)(rowp + bj * HALF) = w; } }
    }
};
struct EpiRes {
    static constexpr bool PERM = false, AFTER_DRAIN = false;
    const float* R; float* C; int ldc;
    __device__ __forceinline__ void operator()(const f32x4 (&acc)[2][2][4][2], const Unit& u, int wr, int wc, int fr, int fq) const {
        const int row0 = u.pm * BM + wr * 64 + fr, col0 = u.pn * BM + wc * 32 + 4 * fq;
#pragma unroll
        for (int ai = 0; ai < 2; ++ai) {
            f32x4 r[4][2][2];
#pragma unroll
            for (int m = 0; m < 4; ++m) { const size_t off = (size_t)(row0 + ai * HALF + m * 16) * ldc + col0;
#pragma unroll
                for (int bj = 0; bj < 2; ++bj)
#pragma unroll
                    for (int n = 0; n < 2; ++n) r[m][bj][n] = *(const f32x4*)(R + off + bj * HALF + n * 16); }
#pragma unroll
            for (int m = 0; m < 4; ++m) { const size_t off = (size_t)(row0 + ai * HALF + m * 16) * ldc + col0;
#pragma unroll
                for (int bj = 0; bj < 2; ++bj)
#pragma unroll
                    for (int n = 0; n < 2; ++n) *(f32x4*)(C + off + bj * HALF + n * 16) = acc[ai][bj][m][n] + r[m][bj][n]; }
            asm volatile("" ::: "memory");
        }
    }
};

struct GaOrder {
    int base;
    __device__ bool next(int i, Unit& u) const { if (i >= 2) return false; const int unit = base * 2 + i; u.pm = unit >> 2; u.pn = 27 + (unit & 3); return true; }
    __device__ __forceinline__ void a_ready(const Unit&) const {}
    __device__ __forceinline__ void done(const Unit&) const {}
};

template <bool REMAP = false>
__device__ void transpose_cvt_range(LAS unsigned char* lds, const float* src, u16* dst, int K, int N, int Npad, int t_begin, int t_end, int t_step) {
    LAS float* tile = (LAS float*)lds;
    const int tilesN = Npad / 64, tid = tid_();
    for (int t = t_begin; t < t_end; t += 4 * t_step) {
        float4 v[4][2];
#pragma unroll
        for (int q = 0; q < 4; ++q) { const int tq = t + q * t_step; const int tn = tq % tilesN, tk = tq / tilesN, n0 = tn * 64, k0 = tk * 64;
#pragma unroll
            for (int i = 0; i < 2; ++i) { const int idx = tid + i * 512, kk = idx >> 4, n4 = (idx & 15) * 4;
                v[q][i] = make_float4(0.f, 0.f, 0.f, 0.f);
                const int sn = (REMAP ? win_src_col(n0) : n0) + n4;
                if (tq < t_end && sn < N) v[q][i] = *(const float4*)(src + (size_t)(k0 + kk) * N + sn); } }
#pragma unroll
        for (int q = 0; q < 4; ++q)
#pragma unroll
            for (int i = 0; i < 2; ++i) { const int idx = tid + i * 512, kk = idx >> 4, n4 = (idx & 15) * 4; LAS float* tl = tile + q * (64 * 65);
                tl[(n4 + 0) * 65 + kk] = v[q][i].x; tl[(n4 + 1) * 65 + kk] = v[q][i].y; tl[(n4 + 2) * 65 + kk] = v[q][i].z; tl[(n4 + 3) * 65 + kk] = v[q][i].w; }
        __syncthreads();
#pragma unroll
        for (int q = 0; q < 4; ++q) { const int tq = t + q * t_step; const int tn = tq % tilesN, tk = tq / tilesN, n0 = tn * 64, k0 = tk * 64;
            const int n = tid >> 3, k8 = (tid & 7) * 8; const LAS float* r = tile + q * (64 * 65) + n * 65 + k8;
            u32x4 o; o.x = cvt_pk_bf16(r[0], r[1]); o.y = cvt_pk_bf16(r[2], r[3]); o.z = cvt_pk_bf16(r[4], r[5]); o.w = cvt_pk_bf16(r[6], r[7]);
            if (tq < t_end) *(u32x4*)(dst + (size_t)(n0 + n) * K + k0 + k8) = o; }
        __syncthreads();
    }
}
template <bool REMAP = false>
__device__ __forceinline__ void transpose_cvt(LAS unsigned char* lds, const float* src, u16* dst, int K, int N, int Npad, int bid, int nb) {
    transpose_cvt_range<REMAP>(lds, src, dst, K, N, Npad, bid, (Npad / 64) * (K / 64), nb);
}

__device__ void rmsnorm_phase(const float* x, const float* w, u16* hb, float* of, int bid, int nb) {
    const int tid0 = tid_(), wid = tid0 >> 6, lane = tid0 & 63;
    for (int row = bid * 8 + wid; row < MTOK; row += nb * 8) {
        const float4* xr = (const float4*)(x + (size_t)row * DM);
        float4 v[8]; float s = 0.f;
#pragma unroll
        for (int i = 0; i < 8; ++i) { v[i] = xr[i * 64 + lane]; s += v[i].x * v[i].x + v[i].y * v[i].y + v[i].z * v[i].z + v[i].w * v[i].w; }
        s = wave_sum(s);
        const float rs = rsqrtf(s * (1.f / DM) + 1e-6f);
#pragma unroll
        for (int i = 0; i < 8; ++i) { const float4 wv = ((const float4*)w)[i * 64 + lane];
            const float a = v[i].x * rs * wv.x, b = v[i].y * rs * wv.y, c = v[i].z * rs * wv.z, d = v[i].w * rs * wv.w;
            if (hb) { uint2 o; o.x = cvt_pk_bf16(a, b); o.y = cvt_pk_bf16(c, d); *(uint2*)(hb + (size_t)row * DM + (i * 64 + lane) * 4) = o; }
            else { ((float4*)(of + (size_t)row * DM))[i * 64 + lane] = make_float4(a, b, c, d); } }
    }
}

__device__ void kmean_phase(const Params& p, LAS unsigned char* lds, int t_begin, int t_end, int t_step) {
    LAS float* part = (LAS float*)lds;
    const int tid = tid_();
    for (int task = t_begin; task < t_end; task += t_step) {
        const int b = task >> 5, h = (task >> 3) & 3, blk = task & 7;
        const int d8 = (tid & 15) * 8, kg = tid >> 4;
        float s[8];
#pragma unroll
        for (int e = 0; e < 8; ++e) s[e] = 0.f;
        for (int kk = 0; kk < 8; ++kk) {
            const int tok = b * SEQ + blk * 256 + kg * 8 + kk;
            const uint4 v = *(const uint4*)(p.P + (size_t)tok * NP + C_KB + h * 128 + d8);
            s[0] += bflo(v.x); s[1] += bfhi(v.x); s[2] += bflo(v.y); s[3] += bfhi(v.y); s[4] += bflo(v.z); s[5] += bfhi(v.z); s[6] += bflo(v.w); s[7] += bfhi(v.w);
        }
        __syncthreads();
#pragma unroll
        for (int e = 0; e < 8; ++e) part[kg * 128 + d8 + e] = s[e];
        __syncthreads();
        if (tid < 128) { float a = 0.f; for (int g = 0; g < 32; ++g) a += part[g * 128 + tid]; p.kmean[(size_t)task * 128 + tid] = a * (1.f / 256.f); }
    }
    __syncthreads();
}

constexpr int RW_T = 32;
constexpr int RW_XB = 49152;
constexpr int RW_RAW = 98304, RW_A1 = 119808, RW_A2 = 124416, RW_KS = 129024, RW_AS = 137216, RW_MU = 145408, RW_PAR = 146688, RW_FLG = 147968;
__device__ __forceinline__ void rw_issue(const Params& p, int pt, int b, int h, int t0, u32x4 (&rg)[6]) {
#pragma unroll
    for (int i = 0; i < 6; ++i) { const int piece = pt + 256 * i; rg[i] = (u32x4){0u, 0u, 0u, 0u};
        if (piece < 33 * 40) { const int row = piece / 40, pc = piece % 40; const int t = t0 - 1 + row;
            const int col = pc < 8 ? C_R + h * 64 + pc * 8 : pc < 16 ? C_K + h * 64 + (pc - 8) * 8 : pc < 24 ? C_V + h * 64 + (pc - 16) * 8 : C_WD + (pc - 24) * 8;
            if (t >= 0) rg[i] = *(const u32x4*)(p.P + (size_t)(b * SEQ + t) * NP + col); } }
}
__device__ __forceinline__ void prep_bar(volatile LAS unsigned* flg, int pw, int lane, unsigned& ep) {
    ++ep;
    asm volatile("s_waitcnt lgkmcnt(0)" ::: "memory");
    if (lane == 0) flg[pw] = ep;
    for (;;) { const u32x4 f = *(volatile LAS u32x4*)flg; if (f.x >= ep && f.y >= ep && f.z >= ep && f.w >= ep) break; __builtin_amdgcn_s_sleep(2); }
    asm volatile("s_waitcnt lgkmcnt(0)" ::: "memory");
}
__device__ __forceinline__ float red4_sum(float v) { v += dpp_f<0xB1>(v); v += dpp_f<0x4E>(v); return v; }
__device__ __forceinline__ float rs8_sum(const float (&y)[8], bool b2, bool b1, bool b0) {
    float n[4], n2[2];
#pragma unroll
    for (int j = 0; j < 4; ++j) { const float k = b2 ? y[4 + j] : y[j], sd = b2 ? y[j] : y[4 + j]; n[j] = k + dpp_f<0x141>(sd); }
#pragma unroll
    for (int j = 0; j < 2; ++j) { const float k = b1 ? n[2 + j] : n[j], sd = b1 ? n[j] : n[2 + j]; n2[j] = k + dpp_f<0x1B>(sd); }
    const float k = b0 ? n2[1] : n2[0], sd = b0 ? n2[0] : n2[1];
    return k + dpp_f<0xB1>(sd);
}
__device__ void rwkv_scan_task(const Params& p, int l, LAS unsigned char* lds, int task) {
    const int tid = tid_(), wid = tid >> 6, lane = tid & 63;
    LAS u16* raw = (LAS u16*)(lds + RW_RAW); LAS u16* A1 = (LAS u16*)(lds + RW_A1); LAS u16* A2 = (LAS u16*)(lds + RW_A2);
    LAS float* kS = (LAS float*)(lds + RW_KS); LAS float* aS = (LAS float*)(lds + RW_AS);
    LAS float* muS = (LAS float*)(lds + RW_MU); LAS float* parS = (LAS float*)(lds + RW_PAR);
    volatile LAS unsigned* flg = (volatile LAS unsigned*)(lds + RW_FLG);
    {
        const int b = task >> 4, h = task & 15;
        __syncthreads();
        if (tid >= 256 && tid < 260) flg[tid - 256] = 0u;
        __syncthreads();
        if (wid < 4) {
            const int rp = wid * 8 + (lane >> 3), ssub = lane & 7; const bool sb2 = (ssub & 4) != 0, sb1 = (ssub & 2) != 0, sb0 = (ssub & 1) != 0;
            f32x2 SA[4], SB[4];
#pragma unroll
            for (int q = 0; q < 4; ++q) { SA[q] = (f32x2){0.f, 0.f}; SB[q] = (f32x2){0.f, 0.f}; }
            u16* yout = p.yraw + (size_t)(b * SEQ + ssub) * 1024 + h * 64 + 2 * rp;
            for (int c = 0; c < SEQ / RW_T; ++c) {
                __syncthreads();
                const LAS float* ob = (const LAS float*)(lds + (c & 1) * RW_XB) + ssub * 8;
                const LAS float* ov = (const LAS float*)(lds + (c & 1) * RW_XB + 40960) + 2 * rp;
                f32x4 nw0 = *(const LAS f32x4*)(ob), nw1 = *(const LAS f32x4*)(ob + 4), na0 = *(const LAS f32x4*)(ob + 2048), na1 = *(const LAS f32x4*)(ob + 2052);
                f32x4 nb0 = *(const LAS f32x4*)(ob + 4096), nb1 = *(const LAS f32x4*)(ob + 4100), nk0 = *(const LAS f32x4*)(ob + 6144), nk1 = *(const LAS f32x4*)(ob + 6148);
                f32x4 nr0 = *(const LAS f32x4*)(ob + 8192), nr1 = *(const LAS f32x4*)(ob + 8196);
                f32x2 nv = *(const LAS f32x2*)(ov);
                float ypA[8], ypB[8];
#pragma unroll
                for (int t = 0; t < RW_T; ++t) {
                    const f32x4 w0 = nw0, w1 = nw1, a0 = na0, a1 = na1, b0 = nb0, b1 = nb1, k0 = nk0, k1 = nk1, r0 = nr0, r1 = nr1; const f32x2 vv = nv;
                    if (t + 1 < RW_T) { const LAS float* o2 = ob + (t + 1) * 64;
                        nw0 = *(const LAS f32x4*)(o2); nw1 = *(const LAS f32x4*)(o2 + 4); na0 = *(const LAS f32x4*)(o2 + 2048); na1 = *(const LAS f32x4*)(o2 + 2052);
                        nb0 = *(const LAS f32x4*)(o2 + 4096); nb1 = *(const LAS f32x4*)(o2 + 4100); nk0 = *(const LAS f32x4*)(o2 + 6144); nk1 = *(const LAS f32x4*)(o2 + 6148);
                        nr0 = *(const LAS f32x4*)(o2 + 8192); nr1 = *(const LAS f32x4*)(o2 + 8196);
                        nv = *(const LAS f32x2*)(ov + (t + 1) * 64); }
                    const f32x2 sA2 = (SA[0] * a0.lo + SA[1] * a0.hi) + (SA[2] * a1.lo + SA[3] * a1.hi);
                    const f32x2 sB2 = (SB[0] * a0.lo + SB[1] * a0.hi) + (SB[2] * a1.lo + SB[3] * a1.hi);
                    const float saA = red8_sum(sA2.x + sA2.y), saB = red8_sum(sB2.x + sB2.y);
                    const f32x2 svA = {saA, saA}, svB = {saB, saB}, vA = {vv.x, vv.x}, vB = {vv.y, vv.y};
                    SA[0] = SA[0] * w0.lo + svA * b0.lo + vA * k0.lo; SA[1] = SA[1] * w0.hi + svA * b0.hi + vA * k0.hi;
                    SA[2] = SA[2] * w1.lo + svA * b1.lo + vA * k1.lo; SA[3] = SA[3] * w1.hi + svA * b1.hi + vA * k1.hi;
                    SB[0] = SB[0] * w0.lo + svB * b0.lo + vB * k0.lo; SB[1] = SB[1] * w0.hi + svB * b0.hi + vB * k0.hi;
                    SB[2] = SB[2] * w1.lo + svB * b1.lo + vB * k1.lo; SB[3] = SB[3] * w1.hi + svB * b1.hi + vB * k1.hi;
                    const f32x2 yA2 = (SA[0] * r0.lo + SA[1] * r0.hi) + (SA[2] * r1.lo + SA[3] * r1.hi);
                    const f32x2 yB2 = (SB[0] * r0.lo + SB[1] * r0.hi) + (SB[2] * r1.lo + SB[3] * r1.hi);
                    ypA[t & 7] = yA2.x + yA2.y; ypB[t & 7] = yB2.x + yB2.y;
                    if ((t & 7) == 7) *(unsigned*)(yout + (size_t)(c * RW_T + (t & ~7)) * 1024) = cvt_pk_bf16(rs8_sum(ypA, sb2, sb1, sb0), rs8_sum(ypB, sb2, sb1, sb0));
                }
            }
        } else {
            const int pt = tid - 256, pw = wid - 4;
            unsigned ep = 0u;
            for (int c2 = pt; c2 < 320; c2 += 256) { const int mi = c2 < 64 ? h * 64 + c2 : c2 < 128 ? 1024 + h * 64 + (c2 - 64) : c2 < 192 ? 2048 + h * 64 + (c2 - 128) : 3072 + (c2 - 192);
                muS[c2] = p.mu[(size_t)l * 3200 + mi]; }
            if (pt < 64) { const size_t o = (size_t)l * 1024 + h * 64 + pt;
                parS[pt] = p.w0[o]; parS[64 + pt] = p.a0[o]; parS[128 + pt] = p.k_k[o]; parS[192 + pt] = p.k_a[o]; parS[256 + pt] = p.r_k[o]; }
            const int mat = pw >> 1, ct0 = (pw & 1) * 2;
            bf16x8 bfr[2][2];
#pragma unroll
            for (int ci = 0; ci < 2; ++ci) { const u16* Bt = (mat ? p.A2t : p.W2t) + (size_t)l * 1024 * 64 + (size_t)(h * 64 + (ct0 + ci) * 16 + (lane & 15)) * 64 + (lane >> 4) * 8;
                bfr[ci][0] = *(const bf16x8*)(Bt); bfr[ci][1] = *(const bf16x8*)(Bt + 32); }
            u32x4 rg[6];
            int goff[6], loff[6];
#pragma unroll
            for (int i = 0; i < 6; ++i) { const int piece = pt + 256 * i, row = piece / 40, pc = piece % 40;
                const int col = pc < 8 ? C_R + h * 64 + pc * 8 : pc < 16 ? C_K + h * 64 + (pc - 8) * 8 : pc < 24 ? C_V + h * 64 + (pc - 16) * 8 : C_WD + (pc - 24) * 8;
                goff[i] = piece < 33 * 40 ? row * NP + col : -1; loff[i] = row * 320 + pc * 8; }
            const u16* pbase = p.P + (size_t)b * SEQ * NP;
#define RW_ISSUE(t0_) do { _Pragma("unroll") for (int i = 0; i < 6; ++i) { rg[i] = (u32x4){0u, 0u, 0u, 0u}; \
                if (goff[i] >= 0 && ((t0_) > 0 || goff[i] >= NP)) rg[i] = *(const u32x4*)(pbase + (ptrdiff_t)((t0_) - 1) * NP + goff[i]); } } while (0)
            RW_ISSUE(0);
            for (int c = 0; c < SEQ / RW_T; ++c) {
                const int t0 = c * RW_T;
                LAS float* opW = (LAS float*)(lds + (c & 1) * RW_XB); LAS float* opA = opW + 2048; LAS float* opB = opW + 4096; LAS float* opK = opW + 6144; LAS float* opR = opW + 8192; LAS float* opV = opW + 10240;
#pragma unroll
                for (int i = 0; i < 6; ++i) { if (goff[i] >= 0) *(LAS u32x4*)(raw + loff[i]) = rg[i]; }
                prep_bar(flg, pw, lane, ep);
                if (c + 1 < SEQ / RW_T) RW_ISSUE(t0 + RW_T);
#pragma unroll
                for (int reg = 0; reg < 5; ++reg)
#pragma unroll
                    for (int i = 0; i < 2; ++i) { const int e = pt + 256 * i, t = e >> 4, qd = e & 15, cc = reg * 64 + 4 * qd;
                        const u32x2 cu = *(const LAS u32x2*)(raw + (t + 1) * 320 + cc), pu = *(const LAS u32x2*)(raw + t * 320 + cc);
                        const f32x4 mu4 = *(const LAS f32x4*)(muS + cc);
                        const f32x4 cur = {bflo(cu.x), bfhi(cu.x), bflo(cu.y), bfhi(cu.y)}, prv = {bflo(pu.x), bfhi(pu.x), bflo(pu.y), bfhi(pu.y)};
                        const f32x4 xs = cur + mu4 * (prv - cur);
                        if (reg == 0) *(LAS f32x4*)(opR + t * 64 + 4 * qd) = xs;
                        else if (reg == 1) *(LAS f32x4*)(kS + t * 64 + 4 * qd) = xs;
                        else if (reg == 2) *(LAS f32x4*)(opV + t * 64 + 4 * qd) = xs;
                        else if (reg == 3) { float th[4];
#pragma unroll
                            for (int q = 0; q < 4; ++q) th[q] = 1.f - 2.f * __builtin_amdgcn_rcpf(__expf(2.f * xs[q]) + 1.f);
                            u32x2 o; o.x = cvt_pk_bf16(th[0], th[1]); o.y = cvt_pk_bf16(th[2], th[3]); *(LAS u32x2*)(A1 + t * 72 + 4 * qd) = o; }
                        else { u32x2 o; o.x = cvt_pk_bf16(xs.x, xs.y); o.y = cvt_pk_bf16(xs.z, xs.w); *(LAS u32x2*)(A2 + t * 72 + 4 * qd) = o; } }
                prep_bar(flg, pw, lane, ep);
                { LAS u16* Ab = mat ? A2 : A1;
#pragma unroll
                    for (int ci = 0; ci < 2; ++ci)
#pragma unroll
                        for (int rt = 0; rt < 2; ++rt) { f32x4 acc = {0.f, 0.f, 0.f, 0.f};
#pragma unroll
                            for (int ks = 0; ks < 2; ++ks) { const bf16x8 af = *(const LAS bf16x8*)(Ab + (rt * 16 + (lane & 15)) * 72 + ks * 32 + (lane >> 4) * 8); acc = mfma16(af, bfr[ci][ks], acc); }
                            const int cc = (ct0 + ci) * 16 + (lane & 15);
#pragma unroll
                            for (int i = 0; i < 4; ++i) { const int t = rt * 16 + (lane >> 4) * 4 + i;
                                if (mat == 0) { float wv = parS[cc] + acc[i]; wv = fminf(wv, 0.f) - __logf(1.f + __expf(-fabsf(wv))) - 0.5f; opW[t * 64 + cc] = __expf(-__expf(wv)); }
                                else aS[t * 64 + cc] = __builtin_amdgcn_rcpf(1.f + __expf(-(parS[64 + cc] + acc[i]))); } } }
                prep_bar(flg, pw, lane, ep);
#pragma unroll
                for (int j = 0; j < 2; ++j) { const int item = pt + 256 * j, t = item >> 4, sub = item & 15, c4 = sub * 4;
                    const f32x4 kr = *(const LAS f32x4*)(kS + t * 64 + c4), av = *(const LAS f32x4*)(aS + t * 64 + c4), rr = *(const LAS f32x4*)(opR + t * 64 + c4);
                    const f32x4 kkp = *(const LAS f32x4*)(parS + 128 + c4), kap = *(const LAS f32x4*)(parS + 192 + c4), rkp = *(const LAS f32x4*)(parS + 256 + c4);
                    f32x4 kk = kr * kkp;
                    float ss = kk.x * kk.x + kk.y * kk.y + kk.z * kk.z + kk.w * kk.w; ss = red16_sum(ss);
                    const float inv = rsqrtf(fmaxf(ss, 1e-24f));
                    kk.x *= inv; kk.y *= inv; kk.z *= inv; kk.w *= inv;
                    const f32x4 km = kr * (1.f + (av - 1.f) * kap);
                    *(LAS f32x4*)(opA + t * 64 + c4) = -kk;
                    *(LAS f32x4*)(opB + t * 64 + c4) = kk * av;
                    *(LAS f32x4*)(opK + t * 64 + c4) = km;
                    float bo = rr.x * km.x * rkp.x + rr.y * km.y * rkp.y + rr.z * km.z * rkp.z + rr.w * km.w * rkp.w; bo = red16_sum(bo);
                    if (sub == 0) p.ybonus[(size_t)(b * SEQ + t0 + t) * 16 + h] = bo; }
                __syncthreads();
            }
        }
    }
    __syncthreads();
}

__device__ void rwkv_post_block(const Params& p, int l, int bh, int half) {
    const int tid = tid_(), b = bh >> 4, h = bh & 15, c4 = (tid & 15) * 4;
    const size_t po = (size_t)l * 1024 + h * 64 + c4;
    const f32x4 lw = *(const f32x4*)(p.ln_w + po), lb = *(const f32x4*)(p.ln_b + po), muv = *(const f32x4*)(p.mu + (size_t)l * 3200 + 2048 + h * 64 + c4);
    const int tokb = b * SEQ + half * 1024 + (tid >> 4);
#pragma unroll 1
    for (int bt = 0; bt < 8; ++bt) {
        u32x2 yb[4], vc[4], vp[4], gg[4]; float bo[4];
#pragma unroll
        for (int q = 0; q < 4; ++q) { const int tok = tokb + (bt * 4 + q) * 32;
            yb[q] = *(const u32x2*)(p.yraw + (size_t)tok * 1024 + h * 64 + c4);
            vc[q] = *(const u32x2*)(p.P + (size_t)tok * NP + C_V + h * 64 + c4);
            vp[q] = (u32x2){0u, 0u};
            if ((tok & (SEQ - 1)) != 0) vp[q] = *(const u32x2*)(p.P + (size_t)(tok - 1) * NP + C_V + h * 64 + c4);
            gg[q] = *(const u32x2*)(p.P + (size_t)tok * NP + C_GA + h * 64 + c4);
            bo[q] = p.ybonus[(size_t)tok * 16 + h]; }
#pragma unroll
        for (int q = 0; q < 4; ++q) { const int tok = tokb + (bt * 4 + q) * 32;
            const f32x4 yv = {bflo(yb[q].x), bfhi(yb[q].x), bflo(yb[q].y), bfhi(yb[q].y)};
            const float mean = red16_sum(yv.x + yv.y + yv.z + yv.w) * (1.f / 64.f);
            const f32x4 d = yv - mean;
            const float var = red16_sum(d.x * d.x + d.y * d.y + d.z * d.z + d.w * d.w) * (1.f / 64.f);
            const float rs = rsqrtf(var + 64e-5f);
            f32x4 v = {bflo(vc[q].x), bfhi(vc[q].x), bflo(vc[q].y), bfhi(vc[q].y)};
            const f32x4 pv = {bflo(vp[q].x), bfhi(vp[q].x), bflo(vp[q].y), bfhi(vp[q].y)};
            v += muv * (pv - v);
            const f32x4 r = d * rs * lw + lb + bo[q] * v;
            u32x2 o; o.x = cvt_pk_bf16(r.x * siluf_(bflo(gg[q].x)), r.y * siluf_(bfhi(gg[q].x))); o.y = cvt_pk_bf16(r.z * siluf_(bflo(gg[q].y)), r.w * siluf_(bfhi(gg[q].y)));
            *(u32x2*)(p.MIX + (size_t)tok * DM + h * 64 + c4) = o; }
    }
}
__device__ __forceinline__ void wg_publish(unsigned* word, unsigned add) {
    asm volatile("s_waitcnt vmcnt(0)" ::: "memory");
    __syncthreads();
    if (threadIdx.x == 0) { __builtin_amdgcn_fence(__ATOMIC_RELEASE, "agent"); asm volatile("s_waitcnt vmcnt(0)" ::: "memory");
        __hip_atomic_fetch_add(word, add, __ATOMIC_RELAXED, __HIP_MEMORY_SCOPE_AGENT); }
}
__device__ __forceinline__ void wg_wait_ge(unsigned* word, unsigned need) {
    if (threadIdx.x == 0) { unsigned sp = 0u;
        while (__hip_atomic_load(word, __ATOMIC_RELAXED, __HIP_MEMORY_SCOPE_AGENT) < need) { __builtin_amdgcn_s_sleep(2); if (++sp > (1u << 24)) break; }
        __builtin_amdgcn_fence(__ATOMIC_ACQUIRE, "agent"); asm volatile("s_waitcnt vmcnt(0)" ::: "memory"); }
    __syncthreads();
}

constexpr int MB_K = 0, MB_VT = 17408, MB_PW = 35840, MB_KM = 54272, MB_SEL = 57856, MB_TM = 58368;
__device__ void moba_task(const Params& p, LAS unsigned char* lds, int task) {
    const int tid = tid_(), wid = tid >> 6, lane = tid & 63, l15 = lane & 15, lq = lane >> 4;
    const int qt = 15 - (task >> 5), bh = task & 31, b = bh >> 2, h = bh & 3, qblk = qt >> 1, q0 = qt * 128;
    LAS u16* Kt = (LAS u16*)(lds + MB_K); LAS u16* VT = (LAS u16*)(lds + MB_VT); LAS u16* Pw = (LAS u16*)(lds + MB_PW) + wid * 16 * 72;
    LAS float* kmS = (LAS float*)(lds + MB_KM); LAS int* selS = (LAS int*)(lds + MB_SEL); LAS int* tmS = (LAS int*)(lds + MB_TM);
    __syncthreads();
    for (int i = tid; i < qblk * 128; i += 512) kmS[i] = p.kmean[(size_t)(bh * 8) * 128 + i];
    if (tid == 0) *tmS = 0;
    __syncthreads();
    if (tid < 128) {
        const u16* qp = p.P + (size_t)(b * SEQ + q0 + tid) * NP + C_QB + h * 128;
        float g[7];
#pragma unroll
        for (int j = 0; j < 7; ++j) g[j] = 0.f;
        for (int d8 = 0; d8 < 128; d8 += 8) {
            const uint4 v = *(const uint4*)(qp + d8);
            const float q[8] = {bflo(v.x), bfhi(v.x), bflo(v.y), bfhi(v.y), bflo(v.z), bfhi(v.z), bflo(v.w), bfhi(v.w)};
#pragma unroll
            for (int j = 0; j < 7; ++j) if (j < qblk) {
#pragma unroll
                for (int e = 0; e < 8; ++e) g[j] += q[e] * kmS[j * 128 + d8 + e]; }
        }
        int mask = 0;
#pragma unroll
        for (int r = 0; r < 3; ++r) { float best = -INFINITY; int bi = -1;
#pragma unroll
            for (int j = 0; j < 7; ++j) if (j < qblk && !((mask >> j) & 1) && g[j] > best) { best = g[j]; bi = j; }
            if (bi >= 0) mask |= 1 << bi; }
        mask |= 1 << qblk;
        selS[tid] = mask; atomicOr((int*)tmS, mask);
    }
    __syncthreads();
    const int tmask = *tmS;
    bf16x8 qf[4];
    { const u16* qp = p.P + (size_t)(b * SEQ + q0 + wid * 16 + l15) * NP + C_QB + h * 128 + lq * 8;
#pragma unroll
        for (int ks = 0; ks < 4; ++ks) qf[ks] = *(const bf16x8*)(qp + ks * 32); }
    int rm[4]; int wmask = 0;
#pragma unroll
    for (int i = 0; i < 4; ++i) rm[i] = selS[wid * 16 + lq * 4 + i];
    for (int i = 0; i < 16; ++i) wmask |= selS[wid * 16 + i];
    float m[4], ls[4]; f32x4 O[8];
#pragma unroll
    for (int i = 0; i < 4; ++i) { m[i] = -1e30f; ls[i] = 0.f; }
#pragma unroll
    for (int dt = 0; dt < 8; ++dt) O[dt] = (f32x4){0.f, 0.f, 0.f, 0.f};
    const float sc2 = 0.08838834764831845f * 1.4426950408889634f;
    const int last = (q0 + 127) >> 6;
    const int kp = lane & 31, vd8 = (wid * 2 + (lane >> 5)) * 8;
    struct Stage { u32x4 k0, k1, v0, v1; };
    auto issue = [&](Stage& R, int tt) {
        const size_t kb_ = (size_t)(b * SEQ + tt * 64);
        R.k0 = *(const u32x4*)(p.P + (kb_ + (tid >> 4)) * NP + C_KB + h * 128 + (tid & 15) * 8); R.k1 = *(const u32x4*)(p.P + (kb_ + 32 + (tid >> 4)) * NP + C_KB + h * 128 + (tid & 15) * 8);
        R.v0 = *(const u32x4*)(p.P + (kb_ + 2 * kp) * NP + C_VB + h * 128 + vd8); R.v1 = *(const u32x4*)(p.P + (kb_ + 2 * kp + 1) * NP + C_VB + h * 128 + vd8); };
    auto nextv = [&](int t) { ++t; while (t <= last && !((tmask >> (t >> 2)) & 1)) ++t; return t; };
    auto stage = [&](const Stage& R) {
        { const int ka = tid >> 4, kb2 = 32 + (tid >> 4);
          *(LAS u32x4*)(Kt + ((ka & 3) * 16 + (ka >> 2)) * 136 + (tid & 15) * 8) = R.k0; *(LAS u32x4*)(Kt + ((kb2 & 3) * 16 + (kb2 >> 2)) * 136 + (tid & 15) * 8) = R.k1; }
        LAS unsigned* vt = (LAS unsigned*)(VT + vd8 * 72 + 2 * kp);
        vt[0] = (R.v0.x & 0xffffu) | (R.v1.x << 16); vt[36] = (R.v0.x >> 16) | (R.v1.x & 0xffff0000u);
        vt[72] = (R.v0.y & 0xffffu) | (R.v1.y << 16); vt[108] = (R.v0.y >> 16) | (R.v1.y & 0xffff0000u);
        vt[144] = (R.v0.z & 0xffffu) | (R.v1.z << 16); vt[180] = (R.v0.z >> 16) | (R.v1.z & 0xffff0000u);
        vt[216] = (R.v0.w & 0xffffu) | (R.v1.w << 16); vt[252] = (R.v0.w >> 16) | (R.v1.w & 0xffff0000u); };
    auto compute = [&](int ti) {
        const int j = ti >> 2, key0 = ti * 64, qw0 = q0 + wid * 16;
        const bool own = (j == qblk);
        if (((wmask >> j) & 1) && !(own && key0 > qw0 + 15)) {
            f32x4 s[4];
#pragma unroll
            for (int nt = 0; nt < 4; ++nt) { s[nt] = (f32x4){0.f, 0.f, 0.f, 0.f};
#pragma unroll
                for (int ks = 0; ks < 4; ++ks) { const bf16x8 kf = *(const LAS bf16x8*)(Kt + (nt * 16 + l15) * 136 + ks * 32 + lq * 8); s[nt] = mfma16(qf[ks], kf, s[nt]); } }
            const bool diag = own && (key0 + 63 > qw0);
#pragma unroll
            for (int i = 0; i < 4; ++i) {
                const int qpos = qw0 + lq * 4 + i;
                const float bias = (own || ((rm[i] >> j) & 1)) ? 0.f : -3e30f;
                float sv[4];
#pragma unroll
                for (int nt = 0; nt < 4; ++nt) sv[nt] = s[nt][i] * sc2 + bias;
                if (diag) {
#pragma unroll
                    for (int nt = 0; nt < 4; ++nt) sv[nt] = (key0 + l15 * 4 + nt <= qpos) ? sv[nt] : -3e30f; }
                float mx = fmaxf(fmaxf(sv[0], sv[1]), fmaxf(sv[2], sv[3]));
                mx = red16_max(mx);
                const float mnew = fmaxf(m[i], mx), alpha = __builtin_amdgcn_exp2f(m[i] - mnew);
                const float p0 = __builtin_amdgcn_exp2f(sv[0] - mnew), p1 = __builtin_amdgcn_exp2f(sv[1] - mnew), p2 = __builtin_amdgcn_exp2f(sv[2] - mnew), p3 = __builtin_amdgcn_exp2f(sv[3] - mnew);
                u32x2 pw; pw.x = cvt_pk_bf16(p0, p1); pw.y = cvt_pk_bf16(p2, p3);
                *(LAS u32x2*)(Pw + (lq * 4 + i) * 72 + l15 * 4) = pw;
                const float rs = red16_sum((p0 + p1) + (p2 + p3));
                ls[i] = ls[i] * alpha + rs; m[i] = mnew;
#pragma unroll
                for (int dt = 0; dt < 8; ++dt) O[dt][i] *= alpha;
            }
            __builtin_amdgcn_wave_barrier();
            bf16x8 pf[2];
#pragma unroll
            for (int ks = 0; ks < 2; ++ks) pf[ks] = *(const LAS bf16x8*)(Pw + l15 * 72 + ks * 32 + lq * 8);
#pragma unroll
            for (int dt = 0; dt < 8; ++dt)
#pragma unroll
                for (int ks = 0; ks < 2; ++ks) { const bf16x8 vf = *(const LAS bf16x8*)(VT + (dt * 16 + l15) * 72 + ks * 32 + lq * 8); O[dt] = mfma16(pf[ks], vf, O[dt]); }
            __builtin_amdgcn_wave_barrier();
        } };
    Stage R0, R1;
    int ta = 0;
    while (ta <= last && !((tmask >> (ta >> 2)) & 1)) ++ta;
    int tb = nextv(ta);
    if (ta <= last) issue(R0, ta);
    if (tb <= last) issue(R1, tb);
    while (ta <= last) {
        int tc = nextv(tb);
        __syncthreads(); stage(R0); __syncthreads();
        if (tc <= last) issue(R0, tc);
        compute(ta);
        if (tb > last) break;
        int td = nextv(tc);
        __syncthreads(); stage(R1); __syncthreads();
        if (td <= last) issue(R1, td);
        compute(tb);
        ta = tc; tb = td;
    }
#pragma unroll
    for (int i = 0; i < 4; ++i) { const float inv = 1.f / ls[i]; const size_t tok = (size_t)(b * SEQ + q0 + wid * 16 + lq * 4 + i);
#pragma unroll
        for (int dt = 0; dt < 8; ++dt) { const int d = dt * 16 + l15;
            const float g = bf2f(p.P[tok * NP + C_GB + h * 128 + d]);
            p.MIX[tok * DM + 1024 + h * 128 + d] = f2bf(O[dt][i] * inv * siluf_(g)); } }
}

constexpr int GL_QE = 0, GL_KE = 9216, GL_KDT = 18432, GL_VT = 27648, GL_ATT = 46080, GL_ST = 55296, GL_LA = 73728, GL_TOT = 90112,
              GL_AUP = 92160, GL_LOW = 96256, GL_DEC = 100352, GL_ABS = 100608, GL_GNW = 100864, GL_OB = 0;
__device__ void gla_task(const Params& p, int l, LAS unsigned char* lds, int bh, int hs, int nlen) {
    const int tid = tid_(), wid = tid >> 6, lane = tid & 63, l15 = lane & 15, lq = lane >> 4;
    const int b = bh >> 2, h = bh & 3;
    LAS u16* QE = (LAS u16*)(lds + GL_QE); LAS u16* KE = (LAS u16*)(lds + GL_KE); LAS u16* KDT = (LAS u16*)(lds + GL_KDT); LAS u16* VT = (LAS u16*)(lds + GL_VT);
    LAS u16* ATT = (LAS u16*)(lds + GL_ATT); LAS u16* ST = (LAS u16*)(lds + GL_ST); LAS float* LA = (LAS float*)(lds + GL_LA); LAS float* TOT = (LAS float*)(lds + GL_TOT);
    LAS float* AUP = (LAS float*)(lds + GL_AUP); LAS float* LOW = (LAS float*)(lds + GL_LOW); LAS float* DEC = (LAS float*)(lds + GL_DEC); LAS float* OB = (LAS float*)(lds + GL_OB); LAS float* ABS = (LAS float*)(lds + GL_ABS); LAS float* GNW = (LAS float*)(lds + GL_GNW);
    __syncthreads();
    for (int i = tid; i < 1024; i += 512) AUP[i] = p.a_up[(size_t)l * 16 * 256 + (i >> 6) * 256 + h * 64 + (i & 63)];
    for (int i = tid; i < 128 * 72 / 2; i += 512) ((LAS unsigned*)ST)[i] = 0u;
    if (tid < 64) ABS[tid] = p.a_b[(size_t)l * 256 + h * 64 + tid];
    if (tid >= 64 && tid < 192) GNW[tid - 64] = p.gnw[(size_t)l * 128 + tid - 64];
    f32x4 Sacc[4];
#pragma unroll
    for (int c = 0; c < 4; ++c) Sacc[c] = (f32x4){0.f, 0.f, 0.f, 0.f};
    const int rt = wid >> 1, dv0t = (wid & 1) * 4;
    const int tp = lane & 31, dg = wid * 2 + (lane >> 5);
    for (int n = hs * 16; n < hs * 16 + nlen; ++n) {
        const size_t tokb = (size_t)(b * SEQ + n * 64);
        const u16* rowp = p.P + (tokb + (tid >> 3)) * NP;
        const u16* rp0 = p.P + (tokb + 2 * tp) * NP; const u16* rp1 = rp0 + NP;
        const unsigned c_low = *(const unsigned*)(rowp + C_LOW + (tid & 7) * 2);
        const u32x2 c_q0 = *(const u32x2*)(rp0 + C_QC + h * 64 + dg * 4), c_q1 = *(const u32x2*)(rp1 + C_QC + h * 64 + dg * 4);
        const u32x2 c_k0 = *(const u32x2*)(rp0 + C_KC + h * 64 + dg * 4), c_k1 = *(const u32x2*)(rp1 + C_KC + h * 64 + dg * 4);
        const u32x4 c_v0 = *(const u32x4*)(rp0 + C_VC + h * 128 + dg * 8), c_v1 = *(const u32x4*)(rp1 + C_VC + h * 128 + dg * 8);
        const u32x4 c_g0 = *(const u32x4*)(rowp + C_GC + h * 128 + (tid & 7) * 16), c_g1 = *(const u32x4*)(rowp + C_GC + h * 128 + (tid & 7) * 16 + 8);
        { const int e2 = tid * 2, t = e2 >> 4, r = e2 & 15; LOW[t * 16 + r] = bflo(c_low); LOW[t * 16 + r + 1] = bfhi(c_low); }
        __syncthreads();
        { const int t = tid >> 3, d0 = (tid & 7) * 8;
            f32x4 lo[4];
#pragma unroll
            for (int i = 0; i < 4; ++i) lo[i] = *(const LAS f32x4*)(LOW + t * 16 + 4 * i);
            f32x4 z0 = *(const LAS f32x4*)(ABS + d0), z1 = *(const LAS f32x4*)(ABS + d0 + 4);
#pragma unroll
            for (int r = 0; r < 16; ++r) { const f32x4 u0 = *(const LAS f32x4*)(AUP + r * 64 + d0), u1 = *(const LAS f32x4*)(AUP + r * 64 + d0 + 4);
                const float lv = lo[r >> 2][r & 3]; z0 += lv * u0; z1 += lv * u1; }
#pragma unroll
            for (int e = 0; e < 4; ++e) { z0[e] = (fminf(z0[e], 0.f) - __logf(1.f + __expf(-fabsf(z0[e])))) * (1.f / 16.f); z1[e] = (fminf(z1[e], 0.f) - __logf(1.f + __expf(-fabsf(z1[e])))) * (1.f / 16.f); }
            *(LAS f32x4*)(LA + t * 64 + d0) = z0; *(LAS f32x4*)(LA + t * 64 + d0 + 4) = z1; }
        __syncthreads();
        { float a = 0.f;
#pragma unroll
            for (int tt = 0; tt < 8; ++tt) { a += LA[(wid * 8 + tt) * 64 + lane]; LA[(wid * 8 + tt) * 64 + lane] = a; }
            TOT[wid * 64 + lane] = a; }
        __syncthreads();
        { const int t0 = 2 * tp, wt = tp >> 2, d0 = dg * 4;
            f32x4 off = {0.f, 0.f, 0.f, 0.f}, tot = {0.f, 0.f, 0.f, 0.f};
#pragma unroll
            for (int w2 = 0; w2 < 8; ++w2) { const f32x4 tv = *(const LAS f32x4*)(TOT + w2 * 64 + d0); tot += tv; off += (w2 < wt) ? tv : (f32x4){0.f, 0.f, 0.f, 0.f}; }
            const f32x4 b0 = *(const LAS f32x4*)(LA + t0 * 64 + d0) + off, b1 = *(const LAS f32x4*)(LA + (t0 + 1) * 64 + d0) + off;
            const float q0[4] = {bflo(c_q0.x), bfhi(c_q0.x), bflo(c_q0.y), bfhi(c_q0.y)}, q1[4] = {bflo(c_q1.x), bfhi(c_q1.x), bflo(c_q1.y), bfhi(c_q1.y)};
            const float k0[4] = {bflo(c_k0.x), bfhi(c_k0.x), bflo(c_k0.y), bfhi(c_k0.y)}, k1[4] = {bflo(c_k1.x), bfhi(c_k1.x), bflo(c_k1.y), bfhi(c_k1.y)};
            float qe0[4], qe1[4], ke0[4], ke1[4];
#pragma unroll
            for (int e = 0; e < 4; ++e) {
                qe0[e] = q0[e] * 0.125f * __expf(b0[e]); qe1[e] = q1[e] * 0.125f * __expf(b1[e]);
                ke0[e] = k0[e] * __expf(-b0[e]); ke1[e] = k1[e] * __expf(-b1[e]);
                *(LAS unsigned*)(KDT + (d0 + e) * 72 + t0) = cvt_pk_bf16(k0[e] * __expf(tot[e] - b0[e]), k1[e] * __expf(tot[e] - b1[e]));
                if (tp == 0) DEC[d0 + e] = __expf(tot[e]); }
            u32x2 o; o.x = cvt_pk_bf16(qe0[0], qe0[1]); o.y = cvt_pk_bf16(qe0[2], qe0[3]); *(LAS u32x2*)(QE + t0 * 72 + d0) = o;
            o.x = cvt_pk_bf16(qe1[0], qe1[1]); o.y = cvt_pk_bf16(qe1[2], qe1[3]); *(LAS u32x2*)(QE + (t0 + 1) * 72 + d0) = o;
            o.x = cvt_pk_bf16(ke0[0], ke0[1]); o.y = cvt_pk_bf16(ke0[2], ke0[3]); *(LAS u32x2*)(KE + t0 * 72 + d0) = o;
            o.x = cvt_pk_bf16(ke1[0], ke1[1]); o.y = cvt_pk_bf16(ke1[2], ke1[3]); *(LAS u32x2*)(KE + (t0 + 1) * 72 + d0) = o;
            { LAS unsigned* vt = (LAS unsigned*)(VT + dg * 8 * 72 + t0);
                vt[0] = (c_v0.x & 0xffffu) | (c_v1.x << 16); vt[36] = (c_v0.x >> 16) | (c_v1.x & 0xffff0000u);
                vt[72] = (c_v0.y & 0xffffu) | (c_v1.y << 16); vt[108] = (c_v0.y >> 16) | (c_v1.y & 0xffff0000u);
                vt[144] = (c_v0.z & 0xffffu) | (c_v1.z << 16); vt[180] = (c_v0.z >> 16) | (c_v1.z & 0xffff0000u);
                vt[216] = (c_v0.w & 0xffffu) | (c_v1.w << 16); vt[252] = (c_v0.w >> 16) | (c_v1.w & 0xffff0000u); } }
        __syncthreads();
        { bf16x8 af[2];
#pragma unroll
            for (int ks = 0; ks < 2; ++ks) af[ks] = *(const LAS bf16x8*)(QE + (rt * 16 + l15) * 72 + ks * 32 + lq * 8);
#pragma unroll
            for (int c2 = 0; c2 < 2; ++c2) { const int ctile = (wid & 1) * 2 + c2; f32x4 acc = {0.f, 0.f, 0.f, 0.f};
#pragma unroll
                for (int ks = 0; ks < 2; ++ks) { const bf16x8 bf = *(const LAS bf16x8*)(KE + (ctile * 16 + l15) * 72 + ks * 32 + lq * 8); acc = mfma16(af[ks], bf, acc); }
#pragma unroll
                for (int i = 0; i < 4; ++i) { const int t = rt * 16 + lq * 4 + i, jj = ctile * 16 + l15; ATT[t * 72 + jj] = f2bf(jj <= t ? acc[i] : 0.f); } } }
        __syncthreads();
        f32x4 oacc[4];
        { bf16x8 at[2], qf[2], kd[2];
#pragma unroll
            for (int ks = 0; ks < 2; ++ks) { at[ks] = *(const LAS bf16x8*)(ATT + (rt * 16 + l15) * 72 + ks * 32 + lq * 8); qf[ks] = *(const LAS bf16x8*)(QE + (rt * 16 + l15) * 72 + ks * 32 + lq * 8);
                kd[ks] = *(const LAS bf16x8*)(KDT + (rt * 16 + l15) * 72 + ks * 32 + lq * 8); }
            const f32x4 dec = *(const LAS f32x4*)(DEC + rt * 16 + lq * 4);
#pragma unroll
            for (int c = 0; c < 4; ++c) { const int dvt = dv0t + c; f32x4 acc = {0.f, 0.f, 0.f, 0.f};
                Sacc[c] *= dec;
#pragma unroll
                for (int ks = 0; ks < 2; ++ks) { const bf16x8 vf = *(const LAS bf16x8*)(VT + (dvt * 16 + l15) * 72 + ks * 32 + lq * 8), sf = *(const LAS bf16x8*)(ST + (dvt * 16 + l15) * 72 + ks * 32 + lq * 8);
                    acc = mfma16(at[ks], vf, acc); acc = mfma16(qf[ks], sf, acc); Sacc[c] = mfma16(kd[ks], vf, Sacc[c]); }
                oacc[c] = acc; } }
        __syncthreads();
#pragma unroll
        for (int c = 0; c < 4; ++c) { const int dv = (dv0t + c) * 16 + l15;
#pragma unroll
            for (int i = 0; i < 4; ++i) OB[(rt * 16 + lq * 4 + i) * 132 + dv] = oacc[c][i];
            u32x2 sv; sv.x = cvt_pk_bf16(Sacc[c][0], Sacc[c][1]); sv.y = cvt_pk_bf16(Sacc[c][2], Sacc[c][3]);
            *(LAS u32x2*)(ST + dv * 72 + rt * 16 + lq * 4) = sv; }
        __syncthreads();
        { const int t = tid >> 3, dvb = (tid & 7) * 16;
            f32x4 o4[4]; float ss = 0.f;
#pragma unroll
            for (int i = 0; i < 4; ++i) { o4[i] = *(const LAS f32x4*)(OB + t * 132 + dvb + 4 * i); ss += o4[i].x * o4[i].x + o4[i].y * o4[i].y + o4[i].z * o4[i].z + o4[i].w * o4[i].w; }
            ss = red8_sum(ss);
            const float rs = rsqrtf(ss * (1.f / 128.f) + 1e-6f);
            const float g[16] = {bflo(c_g0.x), bfhi(c_g0.x), bflo(c_g0.y), bfhi(c_g0.y), bflo(c_g0.z), bfhi(c_g0.z), bflo(c_g0.w), bfhi(c_g0.w),
                                 bflo(c_g1.x), bfhi(c_g1.x), bflo(c_g1.y), bfhi(c_g1.y), bflo(c_g1.z), bfhi(c_g1.z), bflo(c_g1.w), bfhi(c_g1.w)};
            float r[16];
#pragma unroll
            for (int e = 0; e < 16; ++e) r[e] = o4[e >> 2][e & 3] * rs * GNW[dvb + e] * siluf_(g[e]);
            u32x4 w0, w1; w0.x = cvt_pk_bf16(r[0], r[1]); w0.y = cvt_pk_bf16(r[2], r[3]); w0.z = cvt_pk_bf16(r[4], r[5]); w0.w = cvt_pk_bf16(r[6], r[7]);
            w1.x = cvt_pk_bf16(r[8], r[9]); w1.y = cvt_pk_bf16(r[10], r[11]); w1.z = cvt_pk_bf16(r[12], r[13]); w1.w = cvt_pk_bf16(r[14], r[15]);
            u16* op = p.MIX + (tokb + t) * DM + 1536 + h * 128 + dvb;
            *(u32x4*)op = w0; *(u32x4*)(op + 8) = w1; }
        __syncthreads();
    }
}

#define XB_TMO      128
#define XB_XCNT(j)  (256  + 64 * (j))
#define XB_XSUB(j)  (1280 + 64 * (j))
#define XB_XGEN(j)  (2304 + 64 * (j))
#define XB_TOP      3328
#define XB_TOPGEN   3392
#define XCD_BAR_WORDS 3456
#define XB_SPIN_CAP (1u << 18)

__device__ __forceinline__ unsigned xb_ld(unsigned* p)              { return __hip_atomic_load(p, __ATOMIC_RELAXED, __HIP_MEMORY_SCOPE_AGENT); }
__device__ __forceinline__ unsigned xb_add(unsigned* p, unsigned v) { return __hip_atomic_fetch_add(p, v, __ATOMIC_RELAXED, __HIP_MEMORY_SCOPE_AGENT); }
__device__ __forceinline__ unsigned xb_xcc_id() { return (unsigned)__builtin_amdgcn_s_getreg((3 << 11) | 20) & 0xFu; }
#define XB_SPIN(cond, bar) do { unsigned _sp = 0; while (cond) { __builtin_amdgcn_s_sleep(1); \
    if ((++_sp & 255u) == 0u) { if (xb_ld(&(bar)[XB_TMO])) break; if (_sp > XB_SPIN_CAP) { atomicAdd(&(bar)[XB_TMO], 1u); break; } } } } while (0)

struct XcdBarrier {
    unsigned* bar; unsigned x;
    volatile LAS unsigned* st;
};

__device__ __forceinline__ XcdBarrier xcd_barrier_post(unsigned* bar, volatile LAS unsigned* st) {
    XcdBarrier b; b.bar = bar; b.x = xb_xcc_id(); b.st = st;
    if (threadIdx.x == 0) (void)xb_add(&bar[XB_XCNT(b.x)], 1u);
    return b;
}
__device__ __forceinline__ void xcd_barrier_complete(unsigned* bar, unsigned x, unsigned& nloc, unsigned& nx) {
    const unsigned G = gridDim.x * gridDim.y * gridDim.z;
    unsigned sum, cnt, mine, sp = 0u;
    for (;;) {
        sum = 0u; cnt = 0u; mine = 0u;
#pragma unroll
        for (unsigned j = 0; j < 16; ++j) { const unsigned c = xb_ld(&bar[XB_XCNT(j)]); sum += c; cnt += (c > 0u) ? 1u : 0u; mine = (j == x) ? c : mine; }
        if (sum == G) break;
        __builtin_amdgcn_s_sleep(1);
        if ((++sp & 255u) == 0u) { if (xb_ld(&bar[XB_TMO])) break; if (sp > XB_SPIN_CAP) { atomicAdd(&bar[XB_TMO], 1u); break; } }
    }
    nloc = mine > 0u ? mine : 1u; nx = cnt > 0u ? cnt : 1u;
}

__device__ __forceinline__ void xcd_barrier(const XcdBarrier& b) {
    asm volatile("s_waitcnt vmcnt(0)" ::: "memory");
    __syncthreads();
    if (threadIdx.x == 0) {
        unsigned* bar = b.bar;
        __builtin_amdgcn_s_waitcnt(0);
        unsigned nloc = b.st[0], nx = b.st[1];
        if (nloc == 0u) { xcd_barrier_complete(bar, b.x, nloc, nx); b.st[0] = nloc; b.st[1] = nx; }
        const unsigned old = xb_add(&bar[XB_XSUB(b.x)], 1u);
        const unsigned gen = old / nloc;
        if (old + 1u == (gen + 1u) * nloc) {
            __builtin_amdgcn_fence(__ATOMIC_RELEASE, "agent");
            asm volatile("s_waitcnt vmcnt(0)" ::: "memory");
            const unsigned og = xb_add(&bar[XB_TOP], 1u);
            const unsigned tg = og / nx;
            if (og + 1u == (tg + 1u) * nx) xb_add(&bar[XB_TOPGEN], 1u);
            else XB_SPIN(xb_ld(&bar[XB_TOPGEN]) == tg, bar);
            __builtin_amdgcn_fence(__ATOMIC_ACQUIRE, "agent");
            xb_add(&bar[XB_XGEN(b.x)], 1u);
            asm volatile("s_waitcnt vmcnt(0)" ::: "memory");
        } else {
            XB_SPIN(xb_ld(&bar[XB_XGEN(b.x)]) == gen, bar);
            __builtin_amdgcn_fence(__ATOMIC_ACQUIRE, "agent");
            asm volatile("s_waitcnt vmcnt(0)" ::: "memory");
        }
    }
    __syncthreads();
}

constexpr int N_CONV_TASKS = 376;
__device__ __forceinline__ void conv_task(const Params& p, LAS unsigned char* lds, int ct) {
    __syncthreads();
    if (ct < 64) transpose_cvt_range(lds, p.w_out, p.WtOut, DM, DM, DM, ct * 16, ct * 16 + 16, 1);
    else if (ct < 312) transpose_cvt_range<true>(lds, p.w_in + (size_t)DM * DIN, p.WtIn + (size_t)NP * DM, DM, DIN, NP, (ct - 64) * 16, (ct - 64) * 16 + 16, 1);
    else transpose_cvt_range(lds, p.w_out + (size_t)DM * DM, p.WtOut + (size_t)DM * DM, DM, DM, DM, (ct - 312) * 16, (ct - 312) * 16 + 16, 1);
}
constexpr int N_PHASES = 9;
__device__ __forceinline__ void run_phase(const Params& p, int ph, LAS unsigned char* lds, LAS unsigned* qslot, int bid, int nb) {
    if (ph == 0) {
        transpose_cvt<true>(lds, p.w_in, p.WtIn, DM, DIN, NP, bid, nb);
        for (int l = 0; l < 2; ++l) {
            transpose_cvt(lds, p.w2 + (size_t)l * 64 * 1024, p.W2t + (size_t)l * 1024 * 64, 64, 1024, 1024, bid, nb);
            transpose_cvt(lds, p.a2 + (size_t)l * 64 * 1024, p.A2t + (size_t)l * 1024 * 64, 64, 1024, 1024, bid, nb);
        }
        rmsnorm_phase(p.x, p.norm_w, p.H, nullptr, bid, nb);
        return;
    }
    const int l = (ph - 1) / 4, s = (ph - 1) % 4;
    if (s == 0) {
        Gemm g; g.A = p.H; g.Bt = p.WtIn + (size_t)l * NP * DM; g.M = MTOK; g.N = C_GA; g.K = DM;
        StaticOrder S; S.init(MTOK, C_GA, nb, bid);
        EpiP E; E.O = p.P; E.ldc = NP;
        gemm_phase<EpiP, StaticOrder, false>(lds, g, S, E, nullptr);
        if (l == 0) {
            const int nunits = (MTOK / 256) * (C_GA / 256), rounds = (nunits + nb - 1) / nb;
            if ((rounds - 1) * nb + bid >= nunits) {
                LAS int* slot = (LAS int*)qslot;
                for (int it = 0; it < 2; ++it) {
                    __syncthreads();
                    if (tid_() == 0) *slot = (int)atomicAdd(p.sync + 1000, 1u);
                    __syncthreads();
                    const int tk = *slot;
                    if (tk >= N_CONV_TASKS) break;
                    conv_task(p, lds, tk);
                }
            }
        }
    } else if (s == 1) {
        unsigned* sy = p.sync + 512 * l;
        LAS int* slot = (LAS int*)qslot;
        const int nscan = nb >> 1;
        if (bid < nscan) {
            for (int task = bid; task < 128; task += nscan) { rwkv_scan_task(p, l, lds, task); wg_publish(sy + 64 + task, 1u); }
        } else {
            bool km_ready = false;
            for (;;) {
                __syncthreads();
                if (tid_() == 0) *slot = (int)atomicAdd(sy, 1u);
                __syncthreads();
                const int tk = *slot;
                if (tk >= 256 + 32 + 128 + 512) break;
                if (tk < 256) { __syncthreads(); kmean_phase(p, lds, tk, tk + 1, 1); wg_publish(sy + 16, 1u); }
                else if (tk < 288) gla_task(p, l, lds, tk - 256, 0, 32);
                else if (tk < 416) {
                    __syncthreads();
                    Gemm g; g.A = p.H; g.Bt = p.WtIn + (size_t)l * NP * DM; g.M = MTOK; g.N = NP; g.K = DM;
                    GaOrder S; S.base = tk - 288;
                    EpiP E; E.O = p.P; E.ldc = NP;
                    gemm_phase<EpiP, GaOrder, false>(lds, g, S, E, nullptr);
                    wg_publish(sy + 48, 1u); }
                else { if (!km_ready) { wg_wait_ge(sy + 16, 256u); km_ready = true; } moba_task(p, lds, tk - 416); }
            }
            if (l == 0) for (;;) {
                __syncthreads();
                if (tid_() == 0) *slot = (int)atomicAdd(p.sync + 1000, 1u);
                __syncthreads();
                const int tk = *slot;
                if (tk >= N_CONV_TASKS) break;
                conv_task(p, lds, tk);
            }
        }
        for (;;) {
            __syncthreads();
            if (tid_() == 0) *slot = (int)atomicAdd(sy + 32, 1u);
            __syncthreads();
            const int tk = *slot;
            if (tk >= 256) break;
            wg_wait_ge(sy + 64 + (tk >> 1), 1u);
            wg_wait_ge(sy + 48, 128u);
            rwkv_post_block(p, l, tk >> 1, tk & 1);
        }
    } else if (s == 2) {
        Gemm g; g.A = p.MIX; g.Bt = p.WtOut + (size_t)l * DM * DM; g.M = MTOK; g.N = DM; g.K = DM;
        StaticOrder S; S.init(MTOK, DM, nb, bid);
        EpiRes E; E.R = (l == 0) ? p.x : p.out; E.C = p.out; E.ldc = DM;
        gemm_phase<EpiRes, StaticOrder, false>(lds, g, S, E, nullptr);
    } else {
        if (l == 0) rmsnorm_phase(p.out, p.norm_w + DM, p.H, nullptr, bid, nb);
        else rmsnorm_phase(p.out, p.fnw, nullptr, p.out, bid, nb);
    }
}

__global__ void __launch_bounds__(512, 2) hybrid_fwd(Params p) {
    extern __shared__ __attribute__((aligned(16))) unsigned char shm[];
    LAS unsigned char* lds = (LAS unsigned char*)shm;
    const int bid = blockIdx.x, nb = gridDim.x;
#if defined(TEST_GEMM)
    { Gemm g; g.A = p.H; g.Bt = p.WtIn; g.M = MTOK; g.N = NP; g.K = DM;
      StaticOrder S; S.init(MTOK, NP, nb, bid);
      EpiP E; E.O = p.P; E.ldc = NP;
      gemm_phase<EpiP, StaticOrder, false>(lds, g, S, E, nullptr);
#if TEST_GEMM >= 2
      if (p.phase_lo) {
      Gemm g2; g2.A = p.H; g2.Bt = p.WtOut; g2.M = MTOK; g2.N = DM; g2.K = DM;
      StaticOrder S2; S2.init(MTOK, DM, nb, bid);
      EpiRes E2; E2.R = p.x; E2.C = p.out; E2.ldc = DM;
      gemm_phase<EpiRes, StaticOrder, false>(lds, g2, S2, E2, nullptr); }
#endif
    }
#elif ONE_LAUNCH
    cg::grid_group grid = cg::this_grid();
    __shared__ uint4 xb_words;
    if (threadIdx.x == 0) xb_words = make_uint4(0u, 0u, 0u, 0u);
    __syncthreads();
    const XcdBarrier xb = xcd_barrier_post(p.bar, (volatile LAS unsigned*)&xb_words);
    for (int ph = p.phase_lo; ph < p.phase_hi; ++ph) {
        run_phase(p, ph, lds, (LAS unsigned*)&xb_words.z, bid, nb);
#ifdef REPEAT_PH
        if (ph == REPEAT_PH) { xcd_barrier(xb); run_phase(p, ph, lds, (LAS unsigned*)&xb_words.z, bid, nb); }
#endif
        if (ph + 1 < p.phase_hi) { if (p.phase_lo < 0) grid.sync(); else xcd_barrier(xb); }
    }
#else
    run_phase(p, p.phase_lo, lds, nullptr, bid, nb);
#endif
}

extern "C" void kernel_launch(void* const* d_in, const int* in_sizes, int n_in, void* d_out, int out_size, void* d_ws, size_t ws_size, hipStream_t stream) {
    static int grid = 0;
    if (grid == 0) {
        int dev = 0, cus = 0, per_cu = 0;
        hipGetDevice(&dev);
        hipDeviceGetAttribute(&cus, hipDeviceAttributeMultiprocessorCount, dev);
        hipFuncSetAttribute((const void*)hybrid_fwd, hipFuncAttributeMaxDynamicSharedMemorySize, LDS_BYTES);
        hipOccupancyMaxActiveBlocksPerMultiprocessor(&per_cu, (const void*)hybrid_fwd, 512, LDS_BYTES);
        if (per_cu < 1) { fprintf(stderr, "kernel_launch: occupancy query says %d blocks per CU\n", per_cu); per_cu = 1; }
        (void)hipGetLastError();
        grid = cus;
    }
    Params p{};
    const float* const* in = (const float* const*)d_in;
    p.x = in[0]; p.norm_w = in[1]; p.w_in = in[2]; p.w_out = in[3]; p.mu = in[4]; p.w0 = in[5]; p.w2 = in[6]; p.a0 = in[7]; p.a2 = in[8];
    p.k_k = in[9]; p.k_a = in[10]; p.r_k = in[11]; p.ln_w = in[12]; p.ln_b = in[13]; p.a_up = in[14]; p.a_b = in[15]; p.gnw = in[16]; p.fnw = in[17];
    p.out = (float*)d_out;
    unsigned char* ws = (unsigned char*)d_ws; size_t off = 0;
    auto take = [&](size_t bytes) { unsigned char* r = ws + off; off += (bytes + 255) & ~(size_t)255; return r; };
    p.WtIn = (u16*)take((size_t)2 * NP * DM * 2); p.WtOut = (u16*)take((size_t)2 * DM * DM * 2);
    p.W2t = (u16*)take((size_t)2 * 1024 * 64 * 2); p.A2t = (u16*)take((size_t)2 * 1024 * 64 * 2);
    p.H = (u16*)take((size_t)MTOK * DM * 2); p.P = (u16*)take((size_t)MTOK * NP * 2);
    p.yraw = (u16*)take((size_t)MTOK * 1024 * 2); p.MIX = (u16*)take((size_t)MTOK * DM * 2); p.ybonus = (float*)take((size_t)MTOK * 16 * 4); p.kmean = (float*)take((size_t)256 * 128 * 4);
    p.bar = (unsigned*)take((size_t)XCD_BAR_WORDS * 4);
    p.sync = (unsigned*)take((size_t)1024 * 4);
    if (off > ws_size) { fprintf(stderr, "kernel_launch: workspace too small (%zu > %zu)\n", off, ws_size); return; }
#if ONE_LAUNCH
    hipMemsetAsync(p.bar, 0, (size_t)XCD_BAR_WORDS * 4, stream);
    hipMemsetAsync(p.sync, 0, (size_t)1024 * 4, stream);
    p.phase_lo = 0; p.phase_hi = N_PHASES;
    void* args[] = {&p};
    hipError_t e = hipLaunchCooperativeKernel((const void*)hybrid_fwd, dim3(grid), dim3(512), args, LDS_BYTES, stream);
    if (e != hipSuccess) fprintf(stderr, "cooperative launch failed: %s (grid %d)\n", hipGetErrorString(e), grid);
#else
    for (int ph = 0; ph < N_PHASES; ++ph) { p.phase_lo = ph; p.phase_hi = ph + 1; hipLaunchKernelGGL(hybrid_fwd, dim3(grid), dim3(512), LDS_BYTES, stream, p); }
#endif
}
```

```cpp
#include <hip/hip_runtime.h>
#include <hip/hip_cooperative_groups.h>
#include <cstdio>
namespace cg = cooperative_groups;

#ifndef ONE_LAUNCH
#define ONE_LAUNCH 1
#endif

namespace pg8 {
#define PG8_LAS __attribute__((address_space(3)))
typedef unsigned short bf16_t;
typedef short bf16x8 __attribute__((ext_vector_type(8)));
typedef float f32x4 __attribute__((ext_vector_type(4)));
typedef unsigned u32x4 __attribute__((ext_vector_type(4)));
constexpr int BM = 256, BK = 64, HALF = 128, HTB = HALF * BK * 2  , STAGE_BYTES = 8 * HTB, NXCD = 8, WGM = 8;

__host__ __device__ __forceinline__ int lds_byte(int r, int c) { const int st = (r >> 4) * 2 + (c >> 5), rr = r & 15, cc = c & 31, ob = rr * 64 + cc * 2; return st * 1024 + (ob ^ (((ob >> 9) & 1) << 5)); }
__host__ __device__ __forceinline__ void stage_rc(int b, int& R, int& C) { const int st = b / 1024, sb = b % 1024, swz = sb ^ (((sb >> 9) & 1) << 5); R = (st >> 1) * 16 + swz / 64; C = (st & 1) * 32 + (swz % 64) / 2; }
__host__ __device__ __forceinline__ int perm32(int rho) { const int n = rho >> 4, i = rho & 15; return 8 * (i >> 2) + 4 * n + (i & 3); }

struct Unit { int pm, pn; };
struct Gemm { const bf16_t* A; const bf16_t* Bt; int M, N, K; };

struct StaticOrder {
    int nM, nN, nwg, G, c;
    __host__ __device__ void init(int M, int N, int G_, int c_) { nM = M / BM; nN = N / BM; nwg = nM * nN; G = G_; c = c_; }
    __host__ __device__ bool next(int i, Unit& u) const {
        const long L = (long)i * G + c; if (L >= nwg) return false;
        int wgid = (int)L; { const int q = nwg / NXCD, r = nwg % NXCD, xcd = wgid % NXCD, off = wgid / NXCD; wgid = (xcd < r ? xcd * (q + 1) : r * (q + 1) + (xcd - r) * q) + off; }
        const int nig = WGM * nN, gid = wgid / nig, fm = gid * WGM, gsz = (nM - fm) < WGM ? (nM - fm) : WGM;
        u.pm = fm + ((wgid % nig) % gsz); u.pn = (wgid % nig) / gsz; return true;
    }
    __device__ __forceinline__ void a_ready(const Unit&) const {}
    __device__ __forceinline__ void done(const Unit&) const {}
};
__device__ __forceinline__ unsigned cvt_pk_bf16(float lo, float hi) { unsigned r; asm volatile("v_cvt_pk_bf16_f32 %0, %1, %2" : "=v"(r) : "v"(lo), "v"(hi)); return r; }
template <class Epi, class Sched, bool STAMP = false>
__device__ __forceinline__ void gemm_phase(PG8_LAS unsigned char* lds, const Gemm g, const Sched& S, const Epi& E, unsigned long long* stamps) {
    int tid = threadIdx.x; asm volatile("" : "+v"(tid)); const int wid = __builtin_amdgcn_readfirstlane(tid >> 6), lane = tid & 63, wr = wid >> 2, wc = wid & 3, fr = lane & 15, fq = lane >> 4;
    const int K = g.K, nt = K / BK;
    int ts_lo = 0, ts_hi = 0, nts = 0; const unsigned long long rt_entry = STAMP ? (unsigned long long)wall_clock64() : 0ull;
#define PG8_STAMP() do { if (STAMP && wid == 0 && nts < 64) { const unsigned long long _c = (unsigned long long)clock64(); \
        ts_lo = (lane == nts) ? (int)(unsigned)_c : ts_lo; ts_hi = (lane == nts) ? (int)(unsigned)(_c >> 32) : ts_hi; ++nts; } } while (0)
    PG8_STAMP();
    unsigned voffA[2], voffB[2];
#pragma unroll
    for (int i = 0; i < 2; ++i) { int R, C; stage_rc(tid * 16 + i * 8192, R, C); const int Rb = Epi::PERM ? ((R & ~31) + perm32(R & 31)) : R;
        voffA[i] = (unsigned)(R * K + C) * 2u; voffB[i] = (unsigned)(Rb * K + C) * 2u; }
    const size_t kstep = (size_t)(BK * 2);
    const size_t hstep = (size_t)HALF * K * 2;
    const size_t tstep = 2 * hstep;
    const unsigned ldsw = (unsigned)wid * 1024u;
    const int aoff = lds_byte(wr * 64 + fr, fq * 8), boff = lds_byte(wc * 32 + fr, fq * 8);
#define PG8_SA(b, h) (((b) * 2 + (h)) * HTB)
#define PG8_SB(b, h) ((4 + (b) * 2 + (h)) * HTB)
#define PG8_STAGE(bufoff, gbase, voff) do { _Pragma("unroll") for (int _i = 0; _i < 2; ++_i) \
        __builtin_amdgcn_global_load_lds((const unsigned*)((const char*)(gbase) + (voff)[_i]), (PG8_LAS unsigned*)(lds + (bufoff) + ldsw + _i * 8192), 16, 0, 0); } while (0)
#define PG8_LDA(dst, b, h) do { _Pragma("unroll") for (int m = 0; m < 4; ++m) _Pragma("unroll") for (int k = 0; k < 2; ++k) dst[m][k] = *(const PG8_LAS bf16x8*)(lds + PG8_SA(b, h) + aoff + m * 2048 + k * 1024); } while (0)
#define PG8_LDB(dst, b, h) do { _Pragma("unroll") for (int n = 0; n < 2; ++n) _Pragma("unroll") for (int k = 0; k < 2; ++k) dst[n][k] = *(const PG8_LAS bf16x8*)(lds + PG8_SB(b, h) + boff + n * 2048 + k * 1024); } while (0)
#define PG8_MMA(ai, bj, At, Bt) do { __builtin_amdgcn_s_setprio(1); _Pragma("unroll") for (int m = 0; m < 4; ++m) _Pragma("unroll") for (int n = 0; n < 2; ++n) _Pragma("unroll") for (int k = 0; k < 2; ++k) \
        acc[ai][bj][m][n] = __builtin_amdgcn_mfma_f32_16x16x32_bf16(Bt[n][k], At[m][k], acc[ai][bj][m][n], 0, 0, 0); __builtin_amdgcn_s_setprio(0); } while (0)
#define PG8_WAIT_V(n) asm volatile("s_waitcnt vmcnt(" #n ")" ::: "memory")
#define PG8_WAIT_L(n) asm volatile("s_waitcnt lgkmcnt(" #n ")" ::: "memory")
#define PG8_BAR __builtin_amdgcn_s_barrier()
#define PG8_SCHED __builtin_amdgcn_sched_barrier(0)
    Unit cur, nxt; int ui = 0;
    if (!S.next(0, cur)) return;
    f32x4 acc[2][2][4][2];
#pragma unroll
    for (int a = 0; a < 2; ++a)
#pragma unroll
        for (int b = 0; b < 2; ++b)
#pragma unroll
            for (int m = 0; m < 4; ++m)
#pragma unroll
                for (int n = 0; n < 2; ++n) acc[a][b][m][n] = (f32x4){0.f, 0.f, 0.f, 0.f};
    bf16x8 At[4][2], B0[2][2], B1[2][2];
    const char* cA = (const char*)g.A + (size_t)cur.pm * tstep; const char* cB = (const char*)g.Bt + (size_t)cur.pn * tstep;
    S.a_ready(cur);
    PG8_STAGE(PG8_SB(0, 0), cB, voffB); PG8_STAGE(PG8_SA(0, 0), cA, voffA); PG8_STAGE(PG8_SB(0, 1), cB + hstep, voffB); PG8_STAGE(PG8_SA(0, 1), cA + hstep, voffA);
    if (wr == 1) PG8_BAR;
    PG8_WAIT_V(4); PG8_BAR;
    PG8_STAGE(PG8_SB(1, 0), cB + kstep, voffB); PG8_STAGE(PG8_SA(1, 0), cA + kstep, voffA); PG8_STAGE(PG8_SB(1, 1), cB + hstep + kstep, voffB);
    PG8_WAIT_V(6); PG8_BAR;
    PG8_STAMP();
    for (;;) {
        const bool has_next = S.next(ui + 1, nxt);
        const char* nA = has_next ? (const char*)g.A + (size_t)nxt.pm * tstep : cA; const char* nB = has_next ? (const char*)g.Bt + (size_t)nxt.pn * tstep : cB;
        for (int t = 0; t < nt; t += 2) {
            const bool last = (t == nt - 2);
            const char* a1 = cA + (size_t)(t + 1) * kstep;
            const char* a2 = last ? nA : cA + (size_t)(t + 2) * kstep; const char* b2 = last ? nB : cB + (size_t)(t + 2) * kstep;
            const char* a3 = a2 + kstep; const char* b3 = b2 + kstep;
            if (last && has_next) S.a_ready(nxt);
            PG8_LDB(B0, 0, 0); PG8_SCHED; PG8_LDA(At, 0, 0); PG8_STAGE(PG8_SA(1, 1), a1 + hstep, voffA);
            PG8_WAIT_L(8); PG8_BAR; PG8_WAIT_L(0); PG8_MMA(0, 0, At, B0); PG8_BAR; PG8_SCHED;
            PG8_LDB(B1, 0, 1); PG8_STAGE(PG8_SB(0, 0), b2, voffB);
            PG8_BAR; PG8_WAIT_L(0); PG8_MMA(0, 1, At, B1); PG8_BAR;
            PG8_LDA(At, 0, 1); PG8_STAGE(PG8_SA(0, 0), a2, voffA);
            PG8_BAR; PG8_WAIT_L(0); PG8_MMA(1, 0, At, B0); PG8_BAR; PG8_SCHED;
            PG8_STAGE(PG8_SB(0, 1), b2 + hstep, voffB);
            PG8_WAIT_V(6); PG8_BAR; PG8_MMA(1, 1, At, B1); PG8_BAR;
            PG8_LDB(B0, 1, 0); PG8_SCHED; PG8_LDA(At, 1, 0); PG8_STAGE(PG8_SA(0, 1), a2 + hstep, voffA);
            PG8_WAIT_L(8); PG8_BAR; PG8_WAIT_L(0); PG8_MMA(0, 0, At, B0); PG8_BAR; PG8_SCHED;
            PG8_LDB(B1, 1, 1); PG8_STAGE(PG8_SB(1, 0), b3, voffB);
            PG8_BAR; PG8_WAIT_L(0); PG8_MMA(0, 1, At, B1); PG8_BAR;
            PG8_LDA(At, 1, 1); PG8_STAGE(PG8_SA(1, 0), a3, voffA);
            PG8_BAR; PG8_WAIT_L(0); PG8_MMA(1, 0, At, B0); PG8_BAR; PG8_SCHED;
            PG8_STAGE(PG8_SB(1, 1), b3 + hstep, voffB);
            PG8_WAIT_V(6); PG8_BAR; PG8_MMA(1, 1, At, B1); PG8_BAR;
        }
        PG8_STAMP();
        if constexpr (!Epi::AFTER_DRAIN) { E(acc, cur, wr, wc, fr, fq); S.done(cur); }
        PG8_STAMP();
        if (!has_next) break;
#pragma unroll
        for (int a = 0; a < 2; ++a)
#pragma unroll
            for (int b = 0; b < 2; ++b)
#pragma unroll
                for (int m = 0; m < 4; ++m)
#pragma unroll
                    for (int n = 0; n < 2; ++n) acc[a][b][m][n] = (f32x4){0.f, 0.f, 0.f, 0.f};
        cur = nxt; cA = nA; cB = nB; ++ui;
    }
    PG8_WAIT_V(0);
    if (wr == 0) PG8_BAR;
    PG8_BAR;
    if constexpr (Epi::AFTER_DRAIN) { E.fused(acc, cur, wr, wc, fr, fq, lds, wid, lane); S.done(cur); }
    PG8_STAMP();
    if (STAMP && wid == 0) { stamps[lane] = lane < nts ? (((unsigned long long)(unsigned)ts_hi << 32) | (unsigned)ts_lo) : 0ull;
        if (lane == 62) stamps[62] = rt_entry; if (lane == 63) stamps[63] = (unsigned long long)wall_clock64(); }
#undef PG8_STAMP
#undef PG8_SA
#undef PG8_SB
#undef PG8_STAGE
#undef PG8_LDA
#undef PG8_LDB
#undef PG8_MMA
#undef PG8_WAIT_V
#undef PG8_WAIT_L
#undef PG8_BAR
#undef PG8_SCHED
}
}
using namespace pg8;
#define LAS PG8_LAS
typedef unsigned short u16;
typedef unsigned u32x2 __attribute__((ext_vector_type(2)));
typedef float f32x2 __attribute__((ext_vector_type(2)));

constexpr int NBATCH = 8, SEQ = 2048, DM = 2048, MTOK = NBATCH * SEQ, DIN = 7824, NP = 7936;
constexpr int C_R = 0, C_K = 1024, C_V = 2048, C_WD = 3072, C_QB = 3200, C_KB = 3712, C_VB = 4224, C_GB = 4736,
              C_QC = 5248, C_KC = 5504, C_VC = 5760, C_GC = 6272, C_LOW = 6784, C_GA = 6912;
__host__ __device__ constexpr int win_src_col(int n) { return n < 3200 ? n : (n < 6912 ? n + 1024 : n - 3712); }
constexpr int LDS_BYTES = 148480;

struct Params {
    const float *x, *norm_w, *w_in, *w_out, *mu, *w0, *w2, *a0, *a2, *k_k, *k_a, *r_k, *ln_w, *ln_b, *a_up, *a_b, *gnw, *fnw;
    float* out;
    u16 *WtIn, *WtOut, *W2t, *A2t, *H, *P, *MIX, *yraw;
    float *ybonus, *kmean;
    unsigned* bar;
    unsigned* sync;
    int phase_lo, phase_hi;
};

__device__ __forceinline__ int tid_() { int t = threadIdx.x; asm volatile("" : "+v"(t)); return t; }
__device__ __forceinline__ float bf2f(u16 v) { return __uint_as_float(((unsigned)v) << 16); }
__device__ __forceinline__ float bflo(unsigned w) { return __uint_as_float(w << 16); }
__device__ __forceinline__ float bfhi(unsigned w) { return __uint_as_float(w & 0xffff0000u); }
__device__ __forceinline__ u16 f2bf(float f) { return (u16)(cvt_pk_bf16(f, 0.f) & 0xffffu); }
template <int CTRL> __device__ __forceinline__ float dpp_f(float v) { return __int_as_float(__builtin_amdgcn_update_dpp(0, __float_as_int(v), CTRL, 0xF, 0xF, true)); }
__device__ __forceinline__ float red16_sum(float v) { v += dpp_f<0xB1>(v); v += dpp_f<0x4E>(v); v += dpp_f<0x141>(v); v += dpp_f<0x140>(v); return v; }
__device__ __forceinline__ float red8_sum(float v) { v += dpp_f<0xB1>(v); v += dpp_f<0x4E>(v); v += dpp_f<0x141>(v); return v; }
__device__ __forceinline__ float red16_max(float v) { v = fmaxf(v, dpp_f<0xB1>(v)); v = fmaxf(v, dpp_f<0x4E>(v)); v = fmaxf(v, dpp_f<0x141>(v)); v = fmaxf(v, dpp_f<0x140>(v)); return v; }
__device__ __forceinline__ float wave_sum(float v) {
#pragma unroll
    for (int o = 1; o < 64; o <<= 1) v += __shfl_xor(v, o);
    return v;
}
__device__ __forceinline__ float sigmoidf_(float x) { return 1.f / (1.f + __expf(-x)); }
__device__ __forceinline__ float siluf_(float x) { return x / (1.f + __expf(-x)); }
__device__ __forceinline__ float logsigmoidf_(float z) { return fminf(z, 0.f) - log1pf(__expf(-fabsf(z))); }
__device__ __forceinline__ f32x4 mfma16(bf16x8 a, bf16x8 b, f32x4 c) { return __builtin_amdgcn_mfma_f32_16x16x32_bf16(a, b, c, 0, 0, 0); }

struct EpiP {
    static constexpr bool PERM = true, AFTER_DRAIN = false;
    bf16_t* O; int ldc;
    __device__ __forceinline__ void operator()(const f32x4 (&acc)[2][2][4][2], const Unit& u, int wr, int wc, int fr, int fq) const {
        const int row0 = u.pm * BM + wr * 64 + fr, col0 = u.pn * BM + wc * 32 + 8 * fq;
#pragma unroll
        for (int ai = 0; ai < 2; ++ai)
#pragma unroll
            for (int m = 0; m < 4; ++m) { bf16_t* rowp = O + (size_t)(row0 + ai * HALF + m * 16) * ldc + col0;
#pragma unroll
                for (int bj = 0; bj < 2; ++bj) { const f32x4 v0 = acc[ai][bj][m][0], v1 = acc[ai][bj][m][1];
                    u32x4 w; w.x = cvt_pk_bf16(v0[0], v0[1]); w.y = cvt_pk_bf16(v0[2], v0[3]); w.z = cvt_pk_bf16(v1[0], v1[1]); w.w = cvt_pk_bf16(v1[2], v1[3]);
                    *(u32x4*)(rowp + bj * HALF) = w; } }
    }
};
struct EpiRes {
    static constexpr bool PERM = false, AFTER_DRAIN = false;
    const float* R; float* C; int ldc;
    __device__ __forceinline__ void operator()(const f32x4 (&acc)[2][2][4][2], const Unit& u, int wr, int wc, int fr, int fq) const {
        const int row0 = u.pm * BM + wr * 64 + fr, col0 = u.pn * BM + wc * 32 + 4 * fq;
#pragma unroll
        for (int ai = 0; ai < 2; ++ai) {
            f32x4 r[4][2][2];
#pragma unroll
            for (int m = 0; m < 4; ++m) { const size_t off = (size_t)(row0 + ai * HALF + m * 16) * ldc + col0;
#pragma unroll
                for (int bj = 0; bj < 2; ++bj)
#pragma unroll
                    for (int n = 0; n < 2; ++n) r[m][bj][n] = *(const f32x4*)(R + off + bj * HALF + n * 16); }
#pragma unroll
            for (int m = 0; m < 4; ++m) { const size_t off = (size_t)(row0 + ai * HALF + m * 16) * ldc + col0;
#pragma unroll
                for (int bj = 0; bj < 2; ++bj)
#pragma unroll
                    for (int n = 0; n < 2; ++n) *(f32x4*)(C + off + bj * HALF + n * 16) = acc[ai][bj][m][n] + r[m][bj][n]; }
            asm volatile("" ::: "memory");
        }
    }
};

struct GaOrder {
    int base;
    __device__ bool next(int i, Unit& u) const { if (i >= 2) return false; const int unit = base * 2 + i; u.pm = unit >> 2; u.pn = 27 + (unit & 3); return true; }
    __device__ __forceinline__ void a_ready(const Unit&) const {}
    __device__ __forceinline__ void done(const Unit&) const {}
};

template <bool REMAP = false>
__device__ void transpose_cvt_range(LAS unsigned char* lds, const float* src, u16* dst, int K, int N, int Npad, int t_begin, int t_end, int t_step) {
    LAS float* tile = (LAS float*)lds;
    const int tilesN = Npad / 64, tid = tid_();
    for (int t = t_begin; t < t_end; t += 4 * t_step) {
        float4 v[4][2];
#pragma unroll
        for (int q = 0; q < 4; ++q) { const int tq = t + q * t_step; const int tn = tq % tilesN, tk = tq / tilesN, n0 = tn * 64, k0 = tk * 64;
#pragma unroll
            for (int i = 0; i < 2; ++i) { const int idx = tid + i * 512, kk = idx >> 4, n4 = (idx & 15) * 4;
                v[q][i] = make_float4(0.f, 0.f, 0.f, 0.f);
                const int sn = (REMAP ? win_src_col(n0) : n0) + n4;
                if (tq < t_end && sn < N) v[q][i] = *(const float4*)(src + (size_t)(k0 + kk) * N + sn); } }
#pragma unroll
        for (int q = 0; q < 4; ++q)
#pragma unroll
            for (int i = 0; i < 2; ++i) { const int idx = tid + i * 512, kk = idx >> 4, n4 = (idx & 15) * 4; LAS float* tl = tile + q * (64 * 65);
                tl[(n4 + 0) * 65 + kk] = v[q][i].x; tl[(n4 + 1) * 65 + kk] = v[q][i].y; tl[(n4 + 2) * 65 + kk] = v[q][i].z; tl[(n4 + 3) * 65 + kk] = v[q][i].w; }
        __syncthreads();
#pragma unroll
        for (int q = 0; q < 4; ++q) { const int tq = t + q * t_step; const int tn = tq % tilesN, tk = tq / tilesN, n0 = tn * 64, k0 = tk * 64;
            const int n = tid >> 3, k8 = (tid & 7) * 8; const LAS float* r = tile + q * (64 * 65) + n * 65 + k8;
            u32x4 o; o.x = cvt_pk_bf16(r[0], r[1]); o.y = cvt_pk_bf16(r[2], r[3]); o.z = cvt_pk_bf16(r[4], r[5]); o.w = cvt_pk_bf16(r[6], r[7]);
            if (tq < t_end) *(u32x4*)(dst + (size_t)(n0 + n) * K + k0 + k8) = o; }
        __syncthreads();
    }
}
template <bool REMAP = false>
__device__ __forceinline__ void transpose_cvt(LAS unsigned char* lds, const float* src, u16* dst, int K, int N, int Npad, int bid, int nb) {
    transpose_cvt_range<REMAP>(lds, src, dst, K, N, Npad, bid, (Npad / 64) * (K / 64), nb);
}

__device__ void rmsnorm_phase(const float* x, const float* w, u16* hb, float* of, int bid, int nb) {
    const int tid0 = tid_(), wid = tid0 >> 6, lane = tid0 & 63;
    for (int row = bid * 8 + wid; row < MTOK; row += nb * 8) {
        const float4* xr = (const float4*)(x + (size_t)row * DM);
        float4 v[8]; float s = 0.f;
#pragma unroll
        for (int i = 0; i < 8; ++i) { v[i] = xr[i * 64 + lane]; s += v[i].x * v[i].x + v[i].y * v[i].y + v[i].z * v[i].z + v[i].w * v[i].w; }
        s = wave_sum(s);
        const float rs = rsqrtf(s * (1.f / DM) + 1e-6f);
#pragma unroll
        for (int i = 0; i < 8; ++i) { const float4 wv = ((const float4*)w)[i * 64 + lane];
            const float a = v[i].x * rs * wv.x, b = v[i].y * rs * wv.y, c = v[i].z * rs * wv.z, d = v[i].w * rs * wv.w;
            if (hb) { uint2 o; o.x = cvt_pk_bf16(a, b); o.y = cvt_pk_bf16(c, d); *(uint2*)(hb + (size_t)row * DM + (i * 64 + lane) * 4) = o; }
            else { ((float4*)(of + (size_t)row * DM))[i * 64 + lane] = make_float4(a, b, c, d); } }
    }
}

__device__ void kmean_phase(const Params& p, LAS unsigned char* lds, int t_begin, int t_end, int t_step) {
    LAS float* part = (LAS float*)lds;
    const int tid = tid_();
    for (int task = t_begin; task < t_end; task += t_step) {
        const int b = task >> 5, h = (task >> 3) & 3, blk = task & 7;
        const int d8 = (tid & 15) * 8, kg = tid >> 4;
        float s[8];
#pragma unroll
        for (int e = 0; e < 8; ++e) s[e] = 0.f;
        for (int kk = 0; kk < 8; ++kk) {
            const int tok = b * SEQ + blk * 256 + kg * 8 + kk;
            const uint4 v = *(const uint4*)(p.P + (size_t)tok * NP + C_KB + h * 128 + d8);
            s[0] += bflo(v.x); s[1] += bfhi(v.x); s[2] += bflo(v.y); s[3] += bfhi(v.y); s[4] += bflo(v.z); s[5] += bfhi(v.z); s[6] += bflo(v.w); s[7] += bfhi(v.w);
        }
        __syncthreads();
#pragma unroll
        for (int e = 0; e < 8; ++e) part[kg * 128 + d8 + e] = s[e];
        __syncthreads();
        if (tid < 128) { float a = 0.f; for (int g = 0; g < 32; ++g) a += part[g * 128 + tid]; p.kmean[(size_t)task * 128 + tid] = a * (1.f / 256.f); }
    }
    __syncthreads();
}

constexpr int RW_T = 32;
constexpr int RW_XB = 49152;
constexpr int RW_RAW = 98304, RW_A1 = 119808, RW_A2 = 124416, RW_KS = 129024, RW_AS = 137216, RW_MU = 145408, RW_PAR = 146688, RW_FLG = 147968;
__device__ __forceinline__ void rw_issue(const Params& p, int pt, int b, int h, int t0, u32x4 (&rg)[6]) {
#pragma unroll
    for (int i = 0; i < 6; ++i) { const int piece = pt + 256 * i; rg[i] = (u32x4){0u, 0u, 0u, 0u};
        if (piece < 33 * 40) { const int row = piece / 40, pc = piece % 40; const int t = t0 - 1 + row;
            const int col = pc < 8 ? C_R + h * 64 + pc * 8 : pc < 16 ? C_K + h * 64 + (pc - 8) * 8 : pc < 24 ? C_V + h * 64 + (pc - 16) * 8 : C_WD + (pc - 24) * 8;
            if (t >= 0) rg[i] = *(const u32x4*)(p.P + (size_t)(b * SEQ + t) * NP + col); } }
}
__device__ __forceinline__ void prep_bar(volatile LAS unsigned* flg, int pw, int lane, unsigned& ep) {
    ++ep;
    asm volatile("s_waitcnt lgkmcnt(0)" ::: "memory");
    if (lane == 0) flg[pw] = ep;
    for (;;) { const u32x4 f = *(volatile LAS u32x4*)flg; if (f.x >= ep && f.y >= ep && f.z >= ep && f.w >= ep) break; __builtin_amdgcn_s_sleep(2); }
    asm volatile("s_waitcnt lgkmcnt(0)" ::: "memory");
}
__device__ __forceinline__ float red4_sum(float v) { v += dpp_f<0xB1>(v); v += dpp_f<0x4E>(v); return v; }
__device__ __forceinline__ float rs8_sum(const float (&y)[8], bool b2, bool b1, bool b0) {
    float n[4], n2[2];
#pragma unroll
    for (int j = 0; j < 4; ++j) { const float k = b2 ? y[4 + j] : y[j], sd = b2 ? y[j] : y[4 + j]; n[j] = k + dpp_f<0x141>(sd); }
#pragma unroll
    for (int j = 0; j < 2; ++j) { const float k = b1 ? n[2 + j] : n[j], sd = b1 ? n[j] : n[2 + j]; n2[j] = k + dpp_f<0x1B>(sd); }
    const float k = b0 ? n2[1] : n2[0], sd = b0 ? n2[0] : n2[1];
    return k + dpp_f<0xB1>(sd);
}
__device__ void rwkv_scan_task(const Params& p, int l, LAS unsigned char* lds, int task) {
    const int tid = tid_(), wid = tid >> 6, lane = tid & 63;
    LAS u16* raw = (LAS u16*)(lds + RW_RAW); LAS u16* A1 = (LAS u16*)(lds + RW_A1); LAS u16* A2 = (LAS u16*)(lds + RW_A2);
    LAS float* kS = (LAS float*)(lds + RW_KS); LAS float* aS = (LAS float*)(lds + RW_AS);
    LAS float* muS = (LAS float*)(lds + RW_MU); LAS float* parS = (LAS float*)(lds + RW_PAR);
    volatile LAS unsigned* flg = (volatile LAS unsigned*)(lds + RW_FLG);
    {
        const int b = task >> 4, h = task & 15;
        __syncthreads();
        if (tid >= 256 && tid < 260) flg[tid - 256] = 0u;
        __syncthreads();
        if (wid < 4) {
            const int rp = wid * 8 + (lane >> 3), ssub = lane & 7; const bool sb2 = (ssub & 4) != 0, sb1 = (ssub & 2) != 0, sb0 = (ssub & 1) != 0;
            f32x2 SA[4], SB[4];
#pragma unroll
            for (int q = 0; q < 4; ++q) { SA[q] = (f32x2){0.f, 0.f}; SB[q] = (f32x2){0.f, 0.f}; }
            u16* yout = p.yraw + (size_t)(b * SEQ + ssub) * 1024 + h * 64 + 2 * rp;
            for (int c = 0; c < SEQ / RW_T; ++c) {
                __syncthreads();
                const LAS float* ob = (const LAS float*)(lds + (c & 1) * RW_XB) + ssub * 8;
                const LAS float* ov = (const LAS float*)(lds + (c & 1) * RW_XB + 40960) + 2 * rp;
                f32x4 nw0 = *(const LAS f32x4*)(ob), nw1 = *(const LAS f32x4*)(ob + 4), na0 = *(const LAS f32x4*)(ob + 2048), na1 = *(const LAS f32x4*)(ob + 2052);
                f32x4 nb0 = *(const LAS f32x4*)(ob + 4096), nb1 = *(const LAS f32x4*)(ob + 4100), nk0 = *(const LAS f32x4*)(ob + 6144), nk1 = *(const LAS f32x4*)(ob + 6148);
                f32x4 nr0 = *(const LAS f32x4*)(ob + 8192), nr1 = *(const LAS f32x4*)(ob + 8196);
                f32x2 nv = *(const LAS f32x2*)(ov);
                float ypA[8], ypB[8];
#pragma unroll
                for (int t = 0; t < RW_T; ++t) {
                    const f32x4 w0 = nw0, w1 = nw1, a0 = na0, a1 = na1, b0 = nb0, b1 = nb1, k0 = nk0, k1 = nk1, r0 = nr0, r1 = nr1; const f32x2 vv = nv;
                    if (t + 1 < RW_T) { const LAS float* o2 = ob + (t + 1) * 64;
                        nw0 = *(const LAS f32x4*)(o2); nw1 = *(const LAS f32x4*)(o2 + 4); na0 = *(const LAS f32x4*)(o2 + 2048); na1 = *(const LAS f32x4*)(o2 + 2052);
                        nb0 = *(const LAS f32x4*)(o2 + 4096); nb1 = *(const LAS f32x4*)(o2 + 4100); nk0 = *(const LAS f32x4*)(o2 + 6144); nk1 = *(const LAS f32x4*)(o2 + 6148);
                        nr0 = *(const LAS f32x4*)(o2 + 8192); nr1 = *(const LAS f32x4*)(o2 + 8196);
                        nv = *(const LAS f32x2*)(ov + (t + 1) * 64); }
                    const f32x2 sA2 = (SA[0] * a0.lo + SA[1] * a0.hi) + (SA[2] * a1.lo + SA[3] * a1.hi);
                    const f32x2 sB2 = (SB[0] * a0.lo + SB[1] * a0.hi) + (SB[2] * a1.lo + SB[3] * a1.hi);
                    const float saA = red8_sum(sA2.x + sA2.y), saB = red8_sum(sB2.x + sB2.y);
                    const f32x2 svA = {saA, saA}, svB = {saB, saB}, vA = {vv.x, vv.x}, vB = {vv.y, vv.y};
                    SA[0] = SA[0] * w0.lo + svA * b0.lo + vA * k0.lo; SA[1] = SA[1] * w0.hi + svA * b0.hi + vA * k0.hi;
                    SA[2] = SA[2] * w1.lo + svA * b1.lo + vA * k1.lo; SA[3] = SA[3] * w1.hi + svA * b1.hi + vA * k1.hi;
                    SB[0] = SB[0] * w0.lo + svB * b0.lo + vB * k0.lo; SB[1] = SB[1] * w0.hi + svB * b0.hi + vB * k0.hi;
                    SB[2] = SB[2] * w1.lo + svB * b1.lo + vB * k1.lo; SB[3] = SB[3] * w1.hi + svB * b1.hi + vB * k1.hi;
                    const f32x2 yA2 = (SA[0] * r0.lo + SA[1] * r0.hi) + (SA[2] * r1.lo + SA[3] * r1.hi);
                    const f32x2 yB2 = (SB[0] * r0.lo + SB[1] * r0.hi) + (SB[2] * r1.lo + SB[3] * r1.hi);
                    ypA[t & 7] = yA2.x + yA2.y; ypB[t & 7] = yB2.x + yB2.y;
                    if ((t & 7) == 7) *(unsigned*)(yout + (size_t)(c * RW_T + (t & ~7)) * 1024) = cvt_pk_bf16(rs8_sum(ypA, sb2, sb1, sb0), rs8_sum(ypB, sb2, sb1, sb0));
                }
            }
        } else {
            const int pt = tid - 256, pw = wid - 4;
            unsigned ep = 0u;
            for (int c2 = pt; c2 < 320; c2 += 256) { const int mi = c2 < 64 ? h * 64 + c2 : c2 < 128 ? 1024 + h * 64 + (c2 - 64) : c2 < 192 ? 2048 + h * 64 + (c2 - 128) : 3072 + (c2 - 192);
                muS[c2] = p.mu[(size_t)l * 3200 + mi]; }
            if (pt < 64) { const size_t o = (size_t)l * 1024 + h * 64 + pt;
                parS[pt] = p.w0[o]; parS[64 + pt] = p.a0[o]; parS[128 + pt] = p.k_k[o]; parS[192 + pt] = p.k_a[o]; parS[256 + pt] = p.r_k[o]; }
            const int mat = pw >> 1, ct0 = (pw & 1) * 2;
            bf16x8 bfr[2][2];
#pragma unroll
            for (int ci = 0; ci < 2; ++ci) { const u16* Bt = (mat ? p.A2t : p.W2t) + (size_t)l * 1024 * 64 + (size_t)(h * 64 + (ct0 + ci) * 16 + (lane & 15)) * 64 + (lane >> 4) * 8;
                bfr[ci][0] = *(const bf16x8*)(Bt); bfr[ci][1] = *(const bf16x8*)(Bt + 32); }
            u32x4 rg[6];
            int goff[6], loff[6];
#pragma unroll
            for (int i = 0; i < 6; ++i) { const int piece = pt + 256 * i, row = piece / 40, pc = piece % 40;
                const int col = pc < 8 ? C_R + h * 64 + pc * 8 : pc < 16 ? C_K + h * 64 + (pc - 8) * 8 : pc < 24 ? C_V + h * 64 + (pc - 16) * 8 : C_WD + (pc - 24) * 8;
                goff[i] = piece < 33 * 40 ? row * NP + col : -1; loff[i] = row * 320 + pc * 8; }
            const u16* pbase = p.P + (size_t)b * SEQ * NP;
#define RW_ISSUE(t0_) do { _Pragma("unroll") for (int i = 0; i < 6; ++i) { rg[i] = (u32x4){0u, 0u, 0u, 0u}; \
                if (goff[i] >= 0 && ((t0_) > 0 || goff[i] >= NP)) rg[i] = *(const u32x4*)(pbase + (ptrdiff_t)((t0_) - 1) * NP + goff[i]); } } while (0)
            RW_ISSUE(0);
            for (int c = 0; c < SEQ / RW_T; ++c) {
                const int t0 = c * RW_T;
                LAS float* opW = (LAS float*)(lds + (c & 1) * RW_XB); LAS float* opA = opW + 2048; LAS float* opB = opW + 4096; LAS float* opK = opW + 6144; LAS float* opR = opW + 8192; LAS float* opV = opW + 10240;
#pragma unroll
                for (int i = 0; i < 6; ++i) { if (goff[i] >= 0) *(LAS u32x4*)(raw + loff[i]) = rg[i]; }
                prep_bar(flg, pw, lane, ep);
                if (c + 1 < SEQ / RW_T) RW_ISSUE(t0 + RW_T);
#pragma unroll
                for (int reg = 0; reg < 5; ++reg)
#pragma unroll
                    for (int i = 0; i < 2; ++i) { const int e = pt + 256 * i, t = e >> 4, qd = e & 15, cc = reg * 64 + 4 * qd;
                        const u32x2 cu = *(const LAS u32x2*)(raw + (t + 1) * 320 + cc), pu = *(const LAS u32x2*)(raw + t * 320 + cc);
                        const f32x4 mu4 = *(const LAS f32x4*)(muS + cc);
                        const f32x4 cur = {bflo(cu.x), bfhi(cu.x), bflo(cu.y), bfhi(cu.y)}, prv = {bflo(pu.x), bfhi(pu.x), bflo(pu.y), bfhi(pu.y)};
                        const f32x4 xs = cur + mu4 * (prv - cur);
                        if (reg == 0) *(LAS f32x4*)(opR + t * 64 + 4 * qd) = xs;
                        else if (reg == 1) *(LAS f32x4*)(kS + t * 64 + 4 * qd) = xs;
                        else if (reg == 2) *(LAS f32x4*)(opV + t * 64 + 4 * qd) = xs;
                        else if (reg == 3) { float th[4];
#pragma unroll
                            for (int q = 0; q < 4; ++q) th[q] = 1.f - 2.f * __builtin_amdgcn_rcpf(__expf(2.f * xs[q]) + 1.f);
                            u32x2 o; o.x = cvt_pk_bf16(th[0], th[1]); o.y = cvt_pk_bf16(th[2], th[3]); *(LAS u32x2*)(A1 + t * 72 + 4 * qd) = o; }
                        else { u32x2 o; o.x = cvt_pk_bf16(xs.x, xs.y); o.y = cvt_pk_bf16(xs.z, xs.w); *(LAS u32x2*)(A2 + t * 72 + 4 * qd) = o; } }
                prep_bar(flg, pw, lane, ep);
                { LAS u16* Ab = mat ? A2 : A1;
#pragma unroll
                    for (int ci = 0; ci < 2; ++ci)
#pragma unroll
                        for (int rt = 0; rt < 2; ++rt) { f32x4 acc = {0.f, 0.f, 0.f, 0.f};
#pragma unroll
                            for (int ks = 0; ks < 2; ++ks) { const bf16x8 af = *(const LAS bf16x8*)(Ab + (rt * 16 + (lane & 15)) * 72 + ks * 32 + (lane >> 4) * 8); acc = mfma16(af, bfr[ci][ks], acc); }
                            const int cc = (ct0 + ci) * 16 + (lane & 15);
#pragma unroll
                            for (int i = 0; i < 4; ++i) { const int t = rt * 16 + (lane >> 4) * 4 + i;
                                if (mat == 0) { float wv = parS[cc] + acc[i]; wv = fminf(wv, 0.f) - __logf(1.f + __expf(-fabsf(wv))) - 0.5f; opW[t * 64 + cc] = __expf(-__expf(wv)); }
                                else aS[t * 64 + cc] = __builtin_amdgcn_rcpf(1.f + __expf(-(parS[64 + cc] + acc[i]))); } } }
                prep_bar(flg, pw, lane, ep);
#pragma unroll
                for (int j = 0; j < 2; ++j) { const int item = pt + 256 * j, t = item >> 4, sub = item & 15, c4 = sub * 4;
                    const f32x4 kr = *(const LAS f32x4*)(kS + t * 64 + c4), av = *(const LAS f32x4*)(aS + t * 64 + c4), rr = *(const LAS f32x4*)(opR + t * 64 + c4);
                    const f32x4 kkp = *(const LAS f32x4*)(parS + 128 + c4), kap = *(const LAS f32x4*)(parS + 192 + c4), rkp = *(const LAS f32x4*)(parS + 256 + c4);
                    f32x4 kk = kr * kkp;
                    float ss = kk.x * kk.x + kk.y * kk.y + kk.z * kk.z + kk.w * kk.w; ss = red16_sum(ss);
                    const float inv = rsqrtf(fmaxf(ss, 1e-24f));
                    kk.x *= inv; kk.y *= inv; kk.z *= inv; kk.w *= inv;
                    const f32x4 km = kr * (1.f + (av - 1.f) * kap);
                    *(LAS f32x4*)(opA + t * 64 + c4) = -kk;
                    *(LAS f32x4*)(opB + t * 64 + c4) = kk * av;
                    *(LAS f32x4*)(opK + t * 64 + c4) = km;
                    float bo = rr.x * km.x * rkp.x + rr.y * km.y * rkp.y + rr.z * km.z * rkp.z + rr.w * km.w * rkp.w; bo = red16_sum(bo);
                    if (sub == 0) p.ybonus[(size_t)(b * SEQ + t0 + t) * 16 + h] = bo; }
                __syncthreads();
            }
        }
    }
    __syncthreads();
}

__device__ void rwkv_post_block(const Params& p, int l, int bh, int half) {
    const int tid = tid_(), b = bh >> 4, h = bh & 15, c4 = (tid & 15) * 4;
    const size_t po = (size_t)l * 1024 + h * 64 + c4;
    const f32x4 lw = *(const f32x4*)(p.ln_w + po), lb = *(const f32x4*)(p.ln_b + po), muv = *(const f32x4*)(p.mu + (size_t)l * 3200 + 2048 + h * 64 + c4);
    const int tokb = b * SEQ + half * 1024 + (tid >> 4);
#pragma unroll 1
    for (int bt = 0; bt < 8; ++bt) {
        u32x2 yb[4], vc[4], vp[4], gg[4]; float bo[4];
#pragma unroll
        for (int q = 0; q < 4; ++q) { const int tok = tokb + (bt * 4 + q) * 32;
            yb[q] = *(const u32x2*)(p.yraw + (size_t)tok * 1024 + h * 64 + c4);
            vc[q] = *(const u32x2*)(p.P + (size_t)tok * NP + C_V + h * 64 + c4);
            vp[q] = (u32x2){0u, 0u};
            if ((tok & (SEQ - 1)) != 0) vp[q] = *(const u32x2*)(p.P + (size_t)(tok - 1) * NP + C_V + h * 64 + c4);
            gg[q] = *(const u32x2*)(p.P + (size_t)tok * NP + C_GA + h * 64 + c4);
            bo[q] = p.ybonus[(size_t)tok * 16 + h]; }
#pragma unroll
        for (int q = 0; q < 4; ++q) { const int tok = tokb + (bt * 4 + q) * 32;
            const f32x4 yv = {bflo(yb[q].x), bfhi(yb[q].x), bflo(yb[q].y), bfhi(yb[q].y)};
            const float mean = red16_sum(yv.x + yv.y + yv.z + yv.w) * (1.f / 64.f);
            const f32x4 d = yv - mean;
            const float var = red16_sum(d.x * d.x + d.y * d.y + d.z * d.z + d.w * d.w) * (1.f / 64.f);
            const float rs = rsqrtf(var + 64e-5f);
            f32x4 v = {bflo(vc[q].x), bfhi(vc[q].x), bflo(vc[q].y), bfhi(vc[q].y)};
            const f32x4 pv = {bflo(vp[q].x), bfhi(vp[q].x), bflo(vp[q].y), bfhi(vp[q].y)};
            v += muv * (pv - v);
            const f32x4 r = d * rs * lw + lb + bo[q] * v;
            u32x2 o; o.x = cvt_pk_bf16(r.x * siluf_(bflo(gg[q].x)), r.y * siluf_(bfhi(gg[q].x))); o.y = cvt_pk_bf16(r.z * siluf_(bflo(gg[q].y)), r.w * siluf_(bfhi(gg[q].y)));
            *(u32x2*)(p.MIX + (size_t)tok * DM + h * 64 + c4) = o; }
    }
}
__device__ __forceinline__ void wg_publish(unsigned* word, unsigned add) {
    asm volatile("s_waitcnt vmcnt(0)" ::: "memory");
    __syncthreads();
    if (threadIdx.x == 0) { __builtin_amdgcn_fence(__ATOMIC_RELEASE, "agent"); asm volatile("s_waitcnt vmcnt(0)" ::: "memory");
        __hip_atomic_fetch_add(word, add, __ATOMIC_RELAXED, __HIP_MEMORY_SCOPE_AGENT); }
}
__device__ __forceinline__ void wg_wait_ge(unsigned* word, unsigned need) {
    if (threadIdx.x == 0) { unsigned sp = 0u;
        while (__hip_atomic_load(word, __ATOMIC_RELAXED, __HIP_MEMORY_SCOPE_AGENT) < need) { __builtin_amdgcn_s_sleep(2); if (++sp > (1u << 24)) break; }
        __builtin_amdgcn_fence(__ATOMIC_ACQUIRE, "agent"); asm volatile("s_waitcnt vmcnt(0)" ::: "memory"); }
    __syncthreads();
}

constexpr int MB_K = 0, MB_VT = 17408, MB_PW = 35840, MB_KM = 54272, MB_SEL = 57856, MB_TM = 58368;
__device__ void moba_task(const Params& p, LAS unsigned char* lds, int task) {
    const int tid = tid_(), wid = tid >> 6, lane = tid & 63, l15 = lane & 15, lq = lane >> 4;
    const int qt = 15 - (task >> 5), bh = task & 31, b = bh >> 2, h = bh & 3, qblk = qt >> 1, q0 = qt * 128;
    LAS u16* Kt = (LAS u16*)(lds + MB_K); LAS u16* VT = (LAS u16*)(lds + MB_VT); LAS u16* Pw = (LAS u16*)(lds + MB_PW) + wid * 16 * 72;
    LAS float* kmS = (LAS float*)(lds + MB_KM); LAS int* selS = (LAS int*)(lds + MB_SEL); LAS int* tmS = (LAS int*)(lds + MB_TM);
    __syncthreads();
    for (int i = tid; i < qblk * 128; i += 512) kmS[i] = p.kmean[(size_t)(bh * 8) * 128 + i];
    if (tid == 0) *tmS = 0;
    __syncthreads();
    if (tid < 128) {
        const u16* qp = p.P + (size_t)(b * SEQ + q0 + tid) * NP + C_QB + h * 128;
        float g[7];
#pragma unroll
        for (int j = 0; j < 7; ++j) g[j] = 0.f;
        for (int d8 = 0; d8 < 128; d8 += 8) {
            const uint4 v = *(const uint4*)(qp + d8);
            const float q[8] = {bflo(v.x), bfhi(v.x), bflo(v.y), bfhi(v.y), bflo(v.z), bfhi(v.z), bflo(v.w), bfhi(v.w)};
#pragma unroll
            for (int j = 0; j < 7; ++j) if (j < qblk) {
#pragma unroll
                for (int e = 0; e < 8; ++e) g[j] += q[e] * kmS[j * 128 + d8 + e]; }
        }
        int mask = 0;
#pragma unroll
        for (int r = 0; r < 3; ++r) { float best = -INFINITY; int bi = -1;
#pragma unroll
            for (int j = 0; j < 7; ++j) if (j < qblk && !((mask >> j) & 1) && g[j] > best) { best = g[j]; bi = j; }
            if (bi >= 0) mask |= 1 << bi; }
        mask |= 1 << qblk;
        selS[tid] = mask; atomicOr((int*)tmS, mask);
    }
    __syncthreads();
    const int tmask = *tmS;
    bf16x8 qf[4];
    { const u16* qp = p.P + (size_t)(b * SEQ + q0 + wid * 16 + l15) * NP + C_QB + h * 128 + lq * 8;
#pragma unroll
        for (int ks = 0; ks < 4; ++ks) qf[ks] = *(const bf16x8*)(qp + ks * 32); }
    int rm[4]; int wmask = 0;
#pragma unroll
    for (int i = 0; i < 4; ++i) rm[i] = selS[wid * 16 + lq * 4 + i];
    for (int i = 0; i < 16; ++i) wmask |= selS[wid * 16 + i];
    float m[4], ls[4]; f32x4 O[8];
#pragma unroll
    for (int i = 0; i < 4; ++i) { m[i] = -1e30f; ls[i] = 0.f; }
#pragma unroll
    for (int dt = 0; dt < 8; ++dt) O[dt] = (f32x4){0.f, 0.f, 0.f, 0.f};
    const float sc2 = 0.08838834764831845f * 1.4426950408889634f;
    const int last = (q0 + 127) >> 6;
    const int kp = lane & 31, vd8 = (wid * 2 + (lane >> 5)) * 8;
    struct Stage { u32x4 k0, k1, v0, v1; };
    auto issue = [&](Stage& R, int tt) {
        const size_t kb_ = (size_t)(b * SEQ + tt * 64);
        R.k0 = *(const u32x4*)(p.P + (kb_ + (tid >> 4)) * NP + C_KB + h * 128 + (tid & 15) * 8); R.k1 = *(const u32x4*)(p.P + (kb_ + 32 + (tid >> 4)) * NP + C_KB + h * 128 + (tid & 15) * 8);
        R.v0 = *(const u32x4*)(p.P + (kb_ + 2 * kp) * NP + C_VB + h * 128 + vd8); R.v1 = *(const u32x4*)(p.P + (kb_ + 2 * kp + 1) * NP + C_VB + h * 128 + vd8); };
    auto nextv = [&](int t) { ++t; while (t <= last && !((tmask >> (t >> 2)) & 1)) ++t; return t; };
    auto stage = [&](const Stage& R) {
        { const int ka = tid >> 4, kb2 = 32 + (tid >> 4);
          *(LAS u32x4*)(Kt + ((ka & 3) * 16 + (ka >> 2)) * 136 + (tid & 15) * 8) = R.k0; *(LAS u32x4*)(Kt + ((kb2 & 3) * 16 + (kb2 >> 2)) * 136 + (tid & 15) * 8) = R.k1; }
        LAS unsigned* vt = (LAS unsigned*)(VT + vd8 * 72 + 2 * kp);
        vt[0] = (R.v0.x & 0xffffu) | (R.v1.x << 16); vt[36] = (R.v0.x >> 16) | (R.v1.x & 0xffff0000u);
        vt[72] = (R.v0.y & 0xffffu) | (R.v1.y << 16); vt[108] = (R.v0.y >> 16) | (R.v1.y & 0xffff0000u);
        vt[144] = (R.v0.z & 0xffffu) | (R.v1.z << 16); vt[180] = (R.v0.z >> 16) | (R.v1.z & 0xffff0000u);
        vt[216] = (R.v0.w & 0xffffu) | (R.v1.w << 16); vt[252] = (R.v0.w >> 16) | (R.v1.w & 0xffff0000u); };
    auto compute = [&](int ti) {
        const int j = ti >> 2, key0 = ti * 64, qw0 = q0 + wid * 16;
        const bool own = (j == qblk);
        if (((wmask >> j) & 1) && !(own && key0 > qw0 + 15)) {
            f32x4 s[4];
#pragma unroll
            for (int nt = 0; nt < 4; ++nt) { s[nt] = (f32x4){0.f, 0.f, 0.f, 0.f};
#pragma unroll
                for (int ks = 0; ks < 4; ++ks) { const bf16x8 kf = *(const LAS bf16x8*)(Kt + (nt * 16 + l15) * 136 + ks * 32 + lq * 8); s[nt] = mfma16(qf[ks], kf, s[nt]); } }
            const bool diag = own && (key0 + 63 > qw0);
#pragma unroll
            for (int i = 0; i < 4; ++i) {
                const int qpos = qw0 + lq * 4 + i;
                const float bias = (own || ((rm[i] >> j) & 1)) ? 0.f : -3e30f;
                float sv[4];
#pragma unroll
                for (int nt = 0; nt < 4; ++nt) sv[nt] = s[nt][i] * sc2 + bias;
                if (diag) {
#pragma unroll
                    for (int nt = 0; nt < 4; ++nt) sv[nt] = (key0 + l15 * 4 + nt <= qpos) ? sv[nt] : -3e30f; }
                float mx = fmaxf(fmaxf(sv[0], sv[1]), fmaxf(sv[2], sv[3]));
                mx = red16_max(mx);
                const float mnew = fmaxf(m[i], mx), alpha = __builtin_amdgcn_exp2f(m[i] - mnew);
                const float p0 = __builtin_amdgcn_exp2f(sv[0] - mnew), p1 = __builtin_amdgcn_exp2f(sv[1] - mnew), p2 = __builtin_amdgcn_exp2f(sv[2] - mnew), p3 = __builtin_amdgcn_exp2f(sv[3] - mnew);
                u32x2 pw; pw.x = cvt_pk_bf16(p0, p1); pw.y = cvt_pk_bf16(p2, p3);
                *(LAS u32x2*)(Pw + (lq * 4 + i) * 72 + l15 * 4) = pw;
                const float rs = red16_sum((p0 + p1) + (p2 + p3));
                ls[i] = ls[i] * alpha + rs; m[i] = mnew;
#pragma unroll
                for (int dt = 0; dt < 8; ++dt) O[dt][i] *= alpha;
            }
            __builtin_amdgcn_wave_barrier();
            bf16x8 pf[2];
#pragma unroll
            for (int ks = 0; ks < 2; ++ks) pf[ks] = *(const LAS bf16x8*)(Pw + l15 * 72 + ks * 32 + lq * 8);
#pragma unroll
            for (int dt = 0; dt < 8; ++dt)
#pragma unroll
                for (int ks = 0; ks < 2; ++ks) { const bf16x8 vf = *(const LAS bf16x8*)(VT + (dt * 16 + l15) * 72 + ks * 32 + lq * 8); O[dt] = mfma16(pf[ks], vf, O[dt]); }
            __builtin_amdgcn_wave_barrier();
        } };
    Stage R0, R1;
    int ta = 0;
    while (ta <= last && !((tmask >> (ta >> 2)) & 1)) ++ta;
    int tb = nextv(ta);
    if (ta <= last) issue(R0, ta);
    if (tb <= last) issue(R1, tb);
    while (ta <= last) {
        int tc = nextv(tb);
        __syncthreads(); stage(R0); __syncthreads();
        if (tc <= last) issue(R0, tc);
        compute(ta);
        if (tb > last) break;
        int td = nextv(tc);
        __syncthreads(); stage(R1); __syncthreads();
        if (td <= last) issue(R1, td);
        compute(tb);
        ta = tc; tb = td;
    }
#pragma unroll
    for (int i = 0; i < 4; ++i) { const float inv = 1.f / ls[i]; const size_t tok = (size_t)(b * SEQ + q0 + wid * 16 + lq * 4 + i);
#pragma unroll
        for (int dt = 0; dt < 8; ++dt) { const int d = dt * 16 + l15;
            const float g = bf2f(p.P[tok * NP + C_GB + h * 128 + d]);
            p.MIX[tok * DM + 1024 + h * 128 + d] = f2bf(O[dt][i] * inv * siluf_(g)); } }
}

constexpr int GL_QE = 0, GL_KE = 9216, GL_KDT = 18432, GL_VT = 27648, GL_ATT = 46080, GL_ST = 55296, GL_LA = 73728, GL_TOT = 90112,
              GL_AUP = 92160, GL_LOW = 96256, GL_DEC = 100352, GL_ABS = 100608, GL_GNW = 100864, GL_OB = 0;
__device__ void gla_task(const Params& p, int l, LAS unsigned char* lds, int bh, int hs, int nlen) {
    const int tid = tid_(), wid = tid >> 6, lane = tid & 63, l15 = lane & 15, lq = lane >> 4;
    const int b = bh >> 2, h = bh & 3;
    LAS u16* QE = (LAS u16*)(lds + GL_QE); LAS u16* KE = (LAS u16*)(lds + GL_KE); LAS u16* KDT = (LAS u16*)(lds + GL_KDT); LAS u16* VT = (LAS u16*)(lds + GL_VT);
    LAS u16* ATT = (LAS u16*)(lds + GL_ATT); LAS u16* ST = (LAS u16*)(lds + GL_ST); LAS float* LA = (LAS float*)(lds + GL_LA); LAS float* TOT = (LAS float*)(lds + GL_TOT);
    LAS float* AUP = (LAS float*)(lds + GL_AUP); LAS float* LOW = (LAS float*)(lds + GL_LOW); LAS float* DEC = (LAS float*)(lds + GL_DEC); LAS float* OB = (LAS float*)(lds + GL_OB); LAS float* ABS = (LAS float*)(lds + GL_ABS); LAS float* GNW = (LAS float*)(lds + GL_GNW);
    __syncthreads();
    for (int i = tid; i < 1024; i += 512) AUP[i] = p.a_up[(size_t)l * 16 * 256 + (i >> 6) * 256 + h * 64 + (i & 63)];
    for (int i = tid; i < 128 * 72 / 2; i += 512) ((LAS unsigned*)ST)[i] = 0u;
    if (tid < 64) ABS[tid] = p.a_b[(size_t)l * 256 + h * 64 + tid];
    if (tid >= 64 && tid < 192) GNW[tid - 64] = p.gnw[(size_t)l * 128 + tid - 64];
    f32x4 Sacc[4];
#pragma unroll
    for (int c = 0; c < 4; ++c) Sacc[c] = (f32x4){0.f, 0.f, 0.f, 0.f};
    const int rt = wid >> 1, dv0t = (wid & 1) * 4;
    const int tp = lane & 31, dg = wid * 2 + (lane >> 5);
    for (int n = hs * 16; n < hs * 16 + nlen; ++n) {
        const size_t tokb = (size_t)(b * SEQ + n * 64);
        const u16* rowp = p.P + (tokb + (tid >> 3)) * NP;
        const u16* rp0 = p.P + (tokb + 2 * tp) * NP; const u16* rp1 = rp0 + NP;
        const unsigned c_low = *(const unsigned*)(rowp + C_LOW + (tid & 7) * 2);
        const u32x2 c_q0 = *(const u32x2*)(rp0 + C_QC + h * 64 + dg * 4), c_q1 = *(const u32x2*)(rp1 + C_QC + h * 64 + dg * 4);
        const u32x2 c_k0 = *(const u32x2*)(rp0 + C_KC + h * 64 + dg * 4), c_k1 = *(const u32x2*)(rp1 + C_KC + h * 64 + dg * 4);
        const u32x4 c_v0 = *(const u32x4*)(rp0 + C_VC + h * 128 + dg * 8), c_v1 = *(const u32x4*)(rp1 + C_VC + h * 128 + dg * 8);
        const u32x4 c_g0 = *(const u32x4*)(rowp + C_GC + h * 128 + (tid & 7) * 16), c_g1 = *(const u32x4*)(rowp + C_GC + h * 128 + (tid & 7) * 16 + 8);
        { const int e2 = tid * 2, t = e2 >> 4, r = e2 & 15; LOW[t * 16 + r] = bflo(c_low); LOW[t * 16 + r + 1] = bfhi(c_low); }
        __syncthreads();
        { const int t = tid >> 3, d0 = (tid & 7) * 8;
            f32x4 lo[4];
#pragma unroll
            for (int i = 0; i < 4; ++i) lo[i] = *(const LAS f32x4*)(LOW + t * 16 + 4 * i);
            f32x4 z0 = *(const LAS f32x4*)(ABS + d0), z1 = *(const LAS f32x4*)(ABS + d0 + 4);
#pragma unroll
            for (int r = 0; r < 16; ++r) { const f32x4 u0 = *(const LAS f32x4*)(AUP + r * 64 + d0), u1 = *(const LAS f32x4*)(AUP + r * 64 + d0 + 4);
                const float lv = lo[r >> 2][r & 3]; z0 += lv * u0; z1 += lv * u1; }
#pragma unroll
            for (int e = 0; e < 4; ++e) { z0[e] = (fminf(z0[e], 0.f) - __logf(1.f + __expf(-fabsf(z0[e])))) * (1.f / 16.f); z1[e] = (fminf(z1[e], 0.f) - __logf(1.f + __expf(-fabsf(z1[e])))) * (1.f / 16.f); }
            *(LAS f32x4*)(LA + t * 64 + d0) = z0; *(LAS f32x4*)(LA + t * 64 + d0 + 4) = z1; }
        __syncthreads();
        { float a = 0.f;
#pragma unroll
            for (int tt = 0; tt < 8; ++tt) { a += LA[(wid * 8 + tt) * 64 + lane]; LA[(wid * 8 + tt) * 64 + lane] = a; }
            TOT[wid * 64 + lane] = a; }
        __syncthreads();
        { const int t0 = 2 * tp, wt = tp >> 2, d0 = dg * 4;
            f32x4 off = {0.f, 0.f, 0.f, 0.f}, tot = {0.f, 0.f, 0.f, 0.f};
#pragma unroll
            for (int w2 = 0; w2 < 8; ++w2) { const f32x4 tv = *(const LAS f32x4*)(TOT + w2 * 64 + d0); tot += tv; off += (w2 < wt) ? tv : (f32x4){0.f, 0.f, 0.f, 0.f}; }
            const f32x4 b0 = *(const LAS f32x4*)(LA + t0 * 64 + d0) + off, b1 = *(const LAS f32x4*)(LA + (t0 + 1) * 64 + d0) + off;
            const float q0[4] = {bflo(c_q0.x), bfhi(c_q0.x), bflo(c_q0.y), bfhi(c_q0.y)}, q1[4] = {bflo(c_q1.x), bfhi(c_q1.x), bflo(c_q1.y), bfhi(c_q1.y)};
            const float k0[4] = {bflo(c_k0.x), bfhi(c_k0.x), bflo(c_k0.y), bfhi(c_k0.y)}, k1[4] = {bflo(c_k1.x), bfhi(c_k1.x), bflo(c_k1.y), bfhi(c_k1.y)};
            float qe0[4], qe1[4], ke0[4], ke1[4];
#pragma unroll
            for (int e = 0; e < 4; ++e) {
                qe0[e] = q0[e] * 0.125f * __expf(b0[e]); qe1[e] = q1[e] * 0.125f * __expf(b1[e]);
                ke0[e] = k0[e] * __expf(-b0[e]); ke1[e] = k1[e] * __expf(-b1[e]);
                *(LAS unsigned*)(KDT + (d0 + e) * 72 + t0) = cvt_pk_bf16(k0[e] * __expf(tot[e] - b0[e]), k1[e] * __expf(tot[e] - b1[e]));
                if (tp == 0) DEC[d0 + e] = __expf(tot[e]); }
            u32x2 o; o.x = cvt_pk_bf16(qe0[0], qe0[1]); o.y = cvt_pk_bf16(qe0[2], qe0[3]); *(LAS u32x2*)(QE + t0 * 72 + d0) = o;
            o.x = cvt_pk_bf16(qe1[0], qe1[1]); o.y = cvt_pk_bf16(qe1[2], qe1[3]); *(LAS u32x2*)(QE + (t0 + 1) * 72 + d0) = o;
            o.x = cvt_pk_bf16(ke0[0], ke0[1]); o.y = cvt_pk_bf16(ke0[2], ke0[3]); *(LAS u32x2*)(KE + t0 * 72 + d0) = o;
            o.x = cvt_pk_bf16(ke1[0], ke1[1]); o.y = cvt_pk_bf16(ke1[2], ke1[3]); *(LAS u32x2*)(KE + (t0 + 1) * 72 + d0) = o;
            { LAS unsigned* vt = (LAS unsigned*)(VT + dg * 8 * 72 + t0);
                vt[0] = (c_v0.x & 0xffffu) | (c_v1.x << 16); vt[36] = (c_v0.x >> 16) | (c_v1.x & 0xffff0000u);
                vt[72] = (c_v0.y & 0xffffu) | (c_v1.y << 16); vt[108] = (c_v0.y >> 16) | (c_v1.y & 0xffff0000u);
                vt[144] = (c_v0.z & 0xffffu) | (c_v1.z << 16); vt[180] = (c_v0.z >> 16) | (c_v1.z & 0xffff0000u);
                vt[216] = (c_v0.w & 0xffffu) | (c_v1.w << 16); vt[252] = (c_v0.w >> 16) | (c_v1.w & 0xffff0000u); } }
        __syncthreads();
        { bf16x8 af[2];
#pragma unroll
            for (int ks = 0; ks < 2; ++ks) af[ks] = *(const LAS bf16x8*)(QE + (rt * 16 + l15) * 72 + ks * 32 + lq * 8);
#pragma unroll
            for (int c2 = 0; c2 < 2; ++c2) { const int ctile = (wid & 1) * 2 + c2; f32x4 acc = {0.f, 0.f, 0.f, 0.f};
#pragma unroll
                for (int ks = 0; ks < 2; ++ks) { const bf16x8 bf = *(const LAS bf16x8*)(KE + (ctile * 16 + l15) * 72 + ks * 32 + lq * 8); acc = mfma16(af[ks], bf, acc); }
#pragma unroll
                for (int i = 0; i < 4; ++i) { const int t = rt * 16 + lq * 4 + i, jj = ctile * 16 + l15; ATT[t * 72 + jj] = f2bf(jj <= t ? acc[i] : 0.f); } } }
        __syncthreads();
        f32x4 oacc[4];
        { bf16x8 at[2], qf[2], kd[2];
#pragma unroll
            for (int ks = 0; ks < 2; ++ks) { at[ks] = *(const LAS bf16x8*)(ATT + (rt * 16 + l15) * 72 + ks * 32 + lq * 8); qf[ks] = *(const LAS bf16x8*)(QE + (rt * 16 + l15) * 72 + ks * 32 + lq * 8);
                kd[ks] = *(const LAS bf16x8*)(KDT + (rt * 16 + l15) * 72 + ks * 32 + lq * 8); }
            const f32x4 dec = *(const LAS f32x4*)(DEC + rt * 16 + lq * 4);
#pragma unroll
            for (int c = 0; c < 4; ++c) { const int dvt = dv0t + c; f32x4 acc = {0.f, 0.f, 0.f, 0.f};
                Sacc[c] *= dec;
#pragma unroll
                for (int ks = 0; ks < 2; ++ks) { const bf16x8 vf = *(const LAS bf16x8*)(VT + (dvt * 16 + l15) * 72 + ks * 32 + lq * 8), sf = *(const LAS bf16x8*)(ST + (dvt * 16 + l15) * 72 + ks * 32 + lq * 8);
                    acc = mfma16(at[ks], vf, acc); acc = mfma16(qf[ks], sf, acc); Sacc[c] = mfma16(kd[ks], vf, Sacc[c]); }
                oacc[c] = acc; } }
        __syncthreads();
#pragma unroll
        for (int c = 0; c < 4; ++c) { const int dv = (dv0t + c) * 16 + l15;
#pragma unroll
            for (int i = 0; i < 4; ++i) OB[(rt * 16 + lq * 4 + i) * 132 + dv] = oacc[c][i];
            u32x2 sv; sv.x = cvt_pk_bf16(Sacc[c][0], Sacc[c][1]); sv.y = cvt_pk_bf16(Sacc[c][2], Sacc[c][3]);
            *(LAS u32x2*)(ST + dv * 72 + rt * 16 + lq * 4) = sv; }
        __syncthreads();
        { const int t = tid >> 3, dvb = (tid & 7) * 16;
            f32x4 o4[4]; float ss = 0.f;
#pragma unroll
            for (int i = 0; i < 4; ++i) { o4[i] = *(const LAS f32x4*)(OB + t * 132 + dvb + 4 * i); ss += o4[i].x * o4[i].x + o4[i].y * o4[i].y + o4[i].z * o4[i].z + o4[i].w * o4[i].w; }
            ss = red8_sum(ss);
            const float rs = rsqrtf(ss * (1.f / 128.f) + 1e-6f);
            const float g[16] = {bflo(c_g0.x), bfhi(c_g0.x), bflo(c_g0.y), bfhi(c_g0.y), bflo(c_g0.z), bfhi(c_g0.z), bflo(c_g0.w), bfhi(c_g0.w),
                                 bflo(c_g1.x), bfhi(c_g1.x), bflo(c_g1.y), bfhi(c_g1.y), bflo(c_g1.z), bfhi(c_g1.z), bflo(c_g1.w), bfhi(c_g1.w)};
            float r[16];
#pragma unroll
            for (int e = 0; e < 16; ++e) r[e] = o4[e >> 2][e & 3] * rs * GNW[dvb + e] * siluf_(g[e]);
            u32x4 w0, w1; w0.x = cvt_pk_bf16(r[0], r[1]); w0.y = cvt_pk_bf16(r[2], r[3]); w0.z = cvt_pk_bf16(r[4], r[5]); w0.w = cvt_pk_bf16(r[6], r[7]);
            w1.x = cvt_pk_bf16(r[8], r[9]); w1.y = cvt_pk_bf16(r[10], r[11]); w1.z = cvt_pk_bf16(r[12], r[13]); w1.w = cvt_pk_bf16(r[14], r[15]);
            u16* op = p.MIX + (tokb + t) * DM + 1536 + h * 128 + dvb;
            *(u32x4*)op = w0; *(u32x4*)(op + 8) = w1; }
        __syncthreads();
    }
}

#define XB_TMO      128
#define XB_XCNT(j)  (256  + 64 * (j))
#define XB_XSUB(j)  (1280 + 64 * (j))
#define XB_XGEN(j)  (2304 + 64 * (j))
#define XB_TOP      3328
#define XB_TOPGEN   3392
#define XCD_BAR_WORDS 3456
#define XB_SPIN_CAP (1u << 18)

__device__ __forceinline__ unsigned xb_ld(unsigned* p)              { return __hip_atomic_load(p, __ATOMIC_RELAXED, __HIP_MEMORY_SCOPE_AGENT); }
__device__ __forceinline__ unsigned xb_add(unsigned* p, unsigned v) { return __hip_atomic_fetch_add(p, v, __ATOMIC_RELAXED, __HIP_MEMORY_SCOPE_AGENT); }
__device__ __forceinline__ unsigned xb_xcc_id() { return (unsigned)__builtin_amdgcn_s_getreg((3 << 11) | 20) & 0xFu; }
#define XB_SPIN(cond, bar) do { unsigned _sp = 0; while (cond) { __builtin_amdgcn_s_sleep(1); \
    if ((++_sp & 255u) == 0u) { if (xb_ld(&(bar)[XB_TMO])) break; if (_sp > XB_SPIN_CAP) { atomicAdd(&(bar)[XB_TMO], 1u); break; } } } } while (0)

struct XcdBarrier {
    unsigned* bar; unsigned x;
    volatile LAS unsigned* st;
};

__device__ __forceinline__ XcdBarrier xcd_barrier_post(unsigned* bar, volatile LAS unsigned* st) {
    XcdBarrier b; b.bar = bar; b.x = xb_xcc_id(); b.st = st;
    if (threadIdx.x == 0) (void)xb_add(&bar[XB_XCNT(b.x)], 1u);
    return b;
}
__device__ __forceinline__ void xcd_barrier_complete(unsigned* bar, unsigned x, unsigned& nloc, unsigned& nx) {
    const unsigned G = gridDim.x * gridDim.y * gridDim.z;
    unsigned sum, cnt, mine, sp = 0u;
    for (;;) {
        sum = 0u; cnt = 0u; mine = 0u;
#pragma unroll
        for (unsigned j = 0; j < 16; ++j) { const unsigned c = xb_ld(&bar[XB_XCNT(j)]); sum += c; cnt += (c > 0u) ? 1u : 0u; mine = (j == x) ? c : mine; }
        if (sum == G) break;
        __builtin_amdgcn_s_sleep(1);
        if ((++sp & 255u) == 0u) { if (xb_ld(&bar[XB_TMO])) break; if (sp > XB_SPIN_CAP) { atomicAdd(&bar[XB_TMO], 1u); break; } }
    }
    nloc = mine > 0u ? mine : 1u; nx = cnt > 0u ? cnt : 1u;
}

__device__ __forceinline__ void xcd_barrier(const XcdBarrier& b) {
    asm volatile("s_waitcnt vmcnt(0)" ::: "memory");
    __syncthreads();
    if (threadIdx.x == 0) {
        unsigned* bar = b.bar;
        __builtin_amdgcn_s_waitcnt(0);
        unsigned nloc = b.st[0], nx = b.st[1];
        if (nloc == 0u) { xcd_barrier_complete(bar, b.x, nloc, nx); b.st[0] = nloc; b.st[1] = nx; }
        const unsigned old = xb_add(&bar[XB_XSUB(b.x)], 1u);
        const unsigned gen = old / nloc;
        if (old + 1u == (gen + 1u) * nloc) {
            __builtin_amdgcn_fence(__ATOMIC_RELEASE, "agent");
            asm volatile("s_waitcnt vmcnt(0)" ::: "memory");
            const unsigned og = xb_add(&bar[XB_TOP], 1u);
            const unsigned tg = og / nx;
            if (og + 1u == (tg + 1u) * nx) xb_add(&bar[XB_TOPGEN], 1u);
            else XB_SPIN(xb_ld(&bar[XB_TOPGEN]) == tg, bar);
            __builtin_amdgcn_fence(__ATOMIC_ACQUIRE, "agent");
            xb_add(&bar[XB_XGEN(b.x)], 1u);
            asm volatile("s_waitcnt vmcnt(0)" ::: "memory");
        } else {
            XB_SPIN(xb_ld(&bar[XB_XGEN(b.x)]) == gen, bar);
            __builtin_amdgcn_fence(__ATOMIC_ACQUIRE, "agent");
            asm volatile("s_waitcnt vmcnt(0)" ::: "memory");
        }
    }
    __syncthreads();
}

constexpr int N_CONV_TASKS = 376;
__device__ __forceinline__ void conv_task(const Params& p, LAS unsigned char* lds, int ct) {
    __syncthreads();
    if (ct < 64) transpose_cvt_range(lds, p.w_out, p.WtOut, DM, DM, DM, ct * 16, ct * 16 + 16, 1);
    else if (ct < 312) transpose_cvt_range<true>(lds, p.w_in + (size_t)DM * DIN, p.WtIn + (size_t)NP * DM, DM, DIN, NP, (ct - 64) * 16, (ct - 64) * 16 + 16, 1);
    else transpose_cvt_range(lds, p.w_out + (size_t)DM * DM, p.WtOut + (size_t)DM * DM, DM, DM, DM, (ct - 312) * 16, (ct - 312) * 16 + 16, 1);
}
constexpr int N_PHASES = 9;
__device__ __forceinline__ void run_phase(const Params& p, int ph, LAS unsigned char* lds, LAS unsigned* qslot, int bid, int nb) {
    if (ph == 0) {
        transpose_cvt<true>(lds, p.w_in, p.WtIn, DM, DIN, NP, bid, nb);
        for (int l = 0; l < 2; ++l) {
            transpose_cvt(lds, p.w2 + (size_t)l * 64 * 1024, p.W2t + (size_t)l * 1024 * 64, 64, 1024, 1024, bid, nb);
            transpose_cvt(lds, p.a2 + (size_t)l * 64 * 1024, p.A2t + (size_t)l * 1024 * 64, 64, 1024, 1024, bid, nb);
        }
        rmsnorm_phase(p.x, p.norm_w, p.H, nullptr, bid, nb);
        return;
    }
    const int l = (ph - 1) / 4, s = (ph - 1) % 4;
    if (s == 0) {
        Gemm g; g.A = p.H; g.Bt = p.WtIn + (size_t)l * NP * DM; g.M = MTOK; g.N = C_GA; g.K = DM;
        StaticOrder S; S.init(MTOK, C_GA, nb, bid);
        EpiP E; E.O = p.P; E.ldc = NP;
        gemm_phase<EpiP, StaticOrder, false>(lds, g, S, E, nullptr);
        if (l == 0) {
            const int nunits = (MTOK / 256) * (C_GA / 256), rounds = (nunits + nb - 1) / nb;
            if ((rounds - 1) * nb + bid >= nunits) {
                LAS int* slot = (LAS int*)qslot;
                for (int it = 0; it < 2; ++it) {
                    __syncthreads();
                    if (tid_() == 0) *slot = (int)atomicAdd(p.sync + 1000, 1u);
                    __syncthreads();
                    const int tk = *slot;
                    if (tk >= N_CONV_TASKS) break;
                    conv_task(p, lds, tk);
                }
            }
        }
    } else if (s == 1) {
        unsigned* sy = p.sync + 512 * l;
        LAS int* slot = (LAS int*)qslot;
        const int nscan = nb >> 1;
        if (bid < nscan) {
            for (int task = bid; task < 128; task += nscan) { rwkv_scan_task(p, l, lds, task); wg_publish(sy + 64 + task, 1u); }
        } else {
            bool km_ready = false;
            for (;;) {
                __syncthreads();
                if (tid_() == 0) *slot = (int)atomicAdd(sy, 1u);
                __syncthreads();
                const int tk = *slot;
                if (tk >= 256 + 32 + 128 + 512) break;
                if (tk < 256) { __syncthreads(); kmean_phase(p, lds, tk, tk + 1, 1); wg_publish(sy + 16, 1u); }
                else if (tk < 288) gla_task(p, l, lds, tk - 256, 0, 32);
                else if (tk < 416) {
                    __syncthreads();
                    Gemm g; g.A = p.H; g.Bt = p.WtIn + (size_t)l * NP * DM; g.M = MTOK; g.N = NP; g.K = DM;
                    GaOrder S; S.base = tk - 288;
                    EpiP E; E.O = p.P; E.ldc = NP;
                    gemm_phase<EpiP, GaOrder, false>(lds, g, S, E, nullptr);
                    wg_publish(sy + 48, 1u); }
                else { if (!km_ready) { wg_wait_ge(sy + 16, 256u); km_ready = true; } moba_task(p, lds, tk - 416); }
            }
            if (l == 0) for (;;) {
                __syncthreads();
                if (tid_() == 0) *slot = (int)atomicAdd(p.sync + 1000, 1u);
                __syncthreads();
                const int tk = *slot;
                if (tk >= N_CONV_TASKS) break;
                conv_task(p, lds, tk);
            }
        }
        for (;;) {
            __syncthreads();
            if (tid_() == 0) *slot = (int)atomicAdd(sy + 32, 1u);
            __syncthreads();
            const int tk = *slot;
            if (tk >= 256) break;
            wg_wait_ge(sy + 64 + (tk >> 1), 1u);
            wg_wait_ge(sy + 48, 128u);
            rwkv_post_block(p, l, tk >> 1, tk & 1);
        }
    } else if (s == 2) {
        Gemm g; g.A = p.MIX; g.Bt = p.WtOut + (size_t)l * DM * DM; g.M = MTOK; g.N = DM; g.K = DM;
        StaticOrder S; S.init(MTOK, DM, nb, bid);
        EpiRes E; E.R = (l == 0) ? p.x : p.out; E.C = p.out; E.ldc = DM;
        gemm_phase<EpiRes, StaticOrder, false>(lds, g, S, E, nullptr);
    } else {
        if (l == 0) rmsnorm_phase(p.out, p.norm_w + DM, p.H, nullptr, bid, nb);
        else rmsnorm_phase(p.out, p.fnw, nullptr, p.out, bid, nb);
    }
}

__global__ void __launch_bounds__(512, 2) hybrid_fwd(Params p) {
    extern __shared__ __attribute__((aligned(16))) unsigned char shm[];
    LAS unsigned char* lds = (LAS unsigned char*)shm;
    const int bid = blockIdx.x, nb = gridDim.x;
#if defined(TEST_GEMM)
    { Gemm g; g.A = p.H; g.Bt = p.WtIn; g.M = MTOK; g.N = NP; g.K = DM;
      StaticOrder S; S.init(MTOK, NP, nb, bid);
      EpiP E; E.O = p.P; E.ldc = NP;
      gemm_phase<EpiP, StaticOrder, false>(lds, g, S, E, nullptr);
#if TEST_GEMM >= 2
      if (p.phase_lo) {
      Gemm g2; g2.A = p.H; g2.Bt = p.WtOut; g2.M = MTOK; g2.N = DM; g2.K = DM;
      StaticOrder S2; S2.init(MTOK, DM, nb, bid);
      EpiRes E2; E2.R = p.x; E2.C = p.out; E2.ldc = DM;
      gemm_phase<EpiRes, StaticOrder, false>(lds, g2, S2, E2, nullptr); }
#endif
    }
#elif ONE_LAUNCH
    cg::grid_group grid = cg::this_grid();
    __shared__ uint4 xb_words;
    if (threadIdx.x == 0) xb_words = make_uint4(0u, 0u, 0u, 0u);
    __syncthreads();
    const XcdBarrier xb = xcd_barrier_post(p.bar, (volatile LAS unsigned*)&xb_words);
    for (int ph = p.phase_lo; ph < p.phase_hi; ++ph) {
        run_phase(p, ph, lds, (LAS unsigned*)&xb_words.z, bid, nb);
#ifdef REPEAT_PH
        if (ph == REPEAT_PH) { xcd_barrier(xb); run_phase(p, ph, lds, (LAS unsigned*)&xb_words.z, bid, nb); }
#endif
        if (ph + 1 < p.phase_hi) { if (p.phase_lo < 0) grid.sync(); else xcd_barrier(xb); }
    }
#else
    run_phase(p, p.phase_lo, lds, nullptr, bid, nb);
#endif
}

extern "C" void kernel_launch(void* const* d_in, const int* in_sizes, int n_in, void* d_out, int out_size, void* d_ws, size_t ws_size, hipStream_t stream) {
    static int grid = 0;
    if (grid == 0) {
        int dev = 0, cus = 0, per_cu = 0;
        hipGetDevice(&dev);
        hipDeviceGetAttribute(&cus, hipDeviceAttributeMultiprocessorCount, dev);
        hipFuncSetAttribute((const void*)hybrid_fwd, hipFuncAttributeMaxDynamicSharedMemorySize, LDS_BYTES);
        hipOccupancyMaxActiveBlocksPerMultiprocessor(&per_cu, (const void*)hybrid_fwd, 512, LDS_BYTES);
        if (per_cu < 1) { fprintf(stderr, "kernel_launch: occupancy query says %d blocks per CU\n", per_cu); per_cu = 1; }
        (void)hipGetLastError();
        grid = cus;
    }
    Params p{};
    const float* const* in = (const float* const*)d_in;
    p.x = in[0]; p.norm_w = in[1]; p.w_in = in[2]; p.w_out = in[3]; p.mu = in[4]; p.w0 = in[5]; p.w2 = in[6]; p.a0 = in[7]; p.a2 = in[8];
    p.k_k = in[9]; p.k_a = in[10]; p.r_k = in[11]; p.ln_w = in[12]; p.ln_b = in[13]; p.a_up = in[14]; p.a_b = in[15]; p.gnw = in[16]; p.fnw = in[17];
    p.out = (float*)d_out;
    unsigned char* ws = (unsigned char*)d_ws; size_t off = 0;
    auto take = [&](size_t bytes) { unsigned char* r = ws + off; off += (bytes + 255) & ~(size_t)255; return r; };
    p.WtIn = (u16*)take((size_t)2 * NP * DM * 2); p.WtOut = (u16*)take((size_t)2 * DM * DM * 2);
    p.W2t = (u16*)take((size_t)2 * 1024 * 64 * 2); p.A2t = (u16*)take((size_t)2 * 1024 * 64 * 2);
    p.H = (u16*)take((size_t)MTOK * DM * 2); p.P = (u16*)take((size_t)MTOK * NP * 2);
    p.yraw = (u16*)take((size_t)MTOK * 1024 * 2); p.MIX = (u16*)take((size_t)MTOK * DM * 2); p.ybonus = (float*)take((size_t)MTOK * 16 * 4); p.kmean = (float*)take((size_t)256 * 128 * 4);
    p.bar = (unsigned*)take((size_t)XCD_BAR_WORDS * 4);
    p.sync = (unsigned*)take((size_t)1024 * 4);
    if (off > ws_size) { fprintf(stderr, "kernel_launch: workspace too small (%zu > %zu)\n", off, ws_size); return; }
#if ONE_LAUNCH
    hipMemsetAsync(p.bar, 0, (size_t)((unsigned char*)(p.sync + 1024) - (unsigned char*)p.bar), stream);
    p.phase_lo = 0; p.phase_hi = N_PHASES;
    void* args[] = {&p};
    hipError_t e = hipLaunchCooperativeKernel((const void*)hybrid_fwd, dim3(grid), dim3(512), args, LDS_BYTES, stream);
    if (e != hipSuccess) fprintf(stderr, "cooperative launch failed: %s (grid %d)\n", hipGetErrorString(e), grid);
#else
    for (int ph = 0; ph < N_PHASES; ++ph) { p.phase_lo = ph; p.phase_hi = ph + 1; hipLaunchKernelGGL(hybrid_fwd, dim3(grid), dim3(512), LDS_BYTES, stream, p); }
#endif
}
```
